# Optimizing an MI355X kernel written in HIP

```python
import math
import jax
import jax.numpy as jnp
from jax import lax
import numpy as np

D_MODEL = 1024
BATCH = 4
SEQ = 4096
DEPTH = 2

S5_WIDTH = 512
S5_GROUP = 16
S5_GROUPS = S5_WIDTH // S5_GROUP
S5_STATE = 64
S5_DT_MIN = 1e-3
S5_DT_MAX = 1e-1
DA_HEADS = 4
DA_HEAD_DIM = 64
DA_V_DIM = 2 * DA_HEAD_DIM
DA_QK_WIDTH = DA_HEADS * 2 * DA_HEAD_DIM
DA_V_WIDTH = DA_HEADS * DA_V_DIM
DA_SUBLN_EPS = 1e-5
Q_BLOCK = 128
RW_HEAD = 64
RW_WIDTH = 512
RW_HEADS = RW_WIDTH // RW_HEAD
RW_DECAY_LORA = 32
RW_A_LORA = 32
RW_V_LORA = 32
RW_G_LORA = 96
RW_LN_EPS = 64e-5
RW_SHIFT_WIDTH = 3 * RW_WIDTH + RW_DECAY_LORA + RW_A_LORA + RW_G_LORA
N_BRANCH = 3
BRANCH_WIDTH = 512
IN_S5_END = S5_WIDTH
IN_Q_END = IN_S5_END + DA_QK_WIDTH
IN_K_END = IN_Q_END + DA_QK_WIDTH
IN_V_END = IN_K_END + DA_V_WIDTH
IN_RW_END = IN_V_END + RW_SHIFT_WIDTH
N_IN = IN_RW_END + N_BRANCH * D_MODEL
RW_R_END = RW_WIDTH
RW_K_END = 2 * RW_WIDTH
RW_V_END = 3 * RW_WIDTH
RW_W_END = RW_V_END + RW_DECAY_LORA
RW_A_END = RW_W_END + RW_A_LORA
D_FF = ((8 * D_MODEL + 3 * 256 - 1) // (3 * 256)) * 256
NORM_EPS = 1e-6

kernel_name = 'hybrid_s5_diffattn_rwkv7_gated'


def rms_norm(x, g, eps=NORM_EPS):
    xf = x.astype(jnp.float32)
    y = xf * lax.rsqrt(jnp.mean(xf * xf, axis=-1, keepdims=True) + eps)
    return (y * g.astype(jnp.float32)).astype(x.dtype)


def _complex_affine_combine(earlier, later):
    a1r, a1i, b1r, b1i = earlier
    a2r, a2i, b2r, b2i = later
    return (a2r * a1r - a2i * a1i,
            a2r * a1i + a2i * a1r,
            a2r * b1r - a2i * b1i + b2r,
            a2r * b1i + a2i * b1r + b2i)


def s5_mixer(u, lam_re, lam_im, log_dt, b_re, b_im, c_re, c_im, d, w_glu):
    bsz, seq, _ = u.shape
    f32 = jnp.float32
    uf = u.astype(f32)
    ug = uf.reshape(bsz, seq, S5_GROUPS, S5_GROUP)
    dt = jnp.exp(log_dt.astype(f32))[:, None]
    lr = lam_re.astype(f32)
    li = lam_im.astype(f32)
    mag = jnp.exp(lr * dt)
    ar = mag * jnp.cos(li * dt)
    ai = mag * jnp.sin(li * dt)
    den = lr * lr + li * li
    nr = ar - 1.0
    kr = (nr * lr + ai * li) / den
    ki = (ai * lr - nr * li) / den
    br = b_re.astype(f32)
    bi = b_im.astype(f32)
    bbar_r = kr[..., None] * br - ki[..., None] * bi
    bbar_i = kr[..., None] * bi + ki[..., None] * br
    bu_r = jnp.einsum('blgc,gpc->blgp', ug, bbar_r)
    bu_i = jnp.einsum('blgc,gpc->blgp', ug, bbar_i)
    a_r = jnp.broadcast_to(ar, (1, seq) + ar.shape)
    a_i = jnp.broadcast_to(ai, (1, seq) + ai.shape)
    _, _, xr, xi = lax.associative_scan(_complex_affine_combine, (a_r, a_i, bu_r, bu_i), axis=1)
    y = (jnp.einsum('blgp,gcp->blgc', xr, c_re.astype(f32))
         - jnp.einsum('blgp,gcp->blgc', xi, c_im.astype(f32)))
    y = y.reshape(bsz, seq, S5_WIDTH) + d.astype(f32) * uf
    y = jax.nn.gelu(y)
    y = y * jax.nn.sigmoid(y @ w_glu.astype(f32))
    return y.astype(u.dtype)


def diff_attention(q, k, v, q_gain, k_gain, lam_vecs, subln_g, lambda_init):
    bsz, seq, _ = q.shape
    f32 = jnp.float32
    q = rms_norm(q.reshape(bsz, seq, DA_HEADS, 2, DA_HEAD_DIM), q_gain)
    k = rms_norm(k.reshape(bsz, seq, DA_HEADS, 2, DA_HEAD_DIM), k_gain)
    qf = (q.astype(f32) * (DA_HEAD_DIM ** -0.5)).transpose(0, 2, 3, 1, 4)
    kf = k.astype(f32).transpose(0, 2, 3, 1, 4)
    vf = v.astype(f32).reshape(bsz, seq, DA_HEADS, DA_V_DIM).transpose(0, 2, 1, 3)
    lv = lam_vecs.astype(f32)
    lam = jnp.exp(jnp.sum(lv[0] * lv[1])) - jnp.exp(jnp.sum(lv[2] * lv[3])) + lambda_init
    n_blk = seq // Q_BLOCK
    qb = qf.reshape(bsz, DA_HEADS, 2, n_blk, Q_BLOCK, DA_HEAD_DIM).transpose(3, 0, 1, 2, 4, 5)
    kpos = jnp.arange(seq)

    def one_block(args):
        qi, bi = args
        s = jnp.einsum('bhcqd,bhckd->bhcqk', qi, kf)
        qpos = bi * Q_BLOCK + jnp.arange(Q_BLOCK)
        causal = kpos[None, :] <= qpos[:, None]
        p = jax.nn.softmax(jnp.where(causal, s, -jnp.inf), axis=-1)
        attn = p[:, :, 0] - lam * p[:, :, 1]
        return jnp.einsum('bhqk,bhkd->bhqd', attn, vf)

    o = lax.map(one_block, (qb, jnp.arange(n_blk)))
    o = o.transpose(1, 0, 3, 2, 4).reshape(bsz, seq, DA_HEADS, DA_V_DIM)
    o = rms_norm(o, subln_g, DA_SUBLN_EPS) * (1.0 - lambda_init)
    return o.reshape(bsz, seq, DA_V_WIDTH).astype(v.dtype)


def rwkv7_scan(r, w, k, v, a, b):
    bsz, seq, nh, n = r.shape
    xs = tuple(jnp.moveaxis(t, 1, 0) for t in (r, w, k, v, a, b))

    def step(state, inp):
        r_t, w_t, k_t, v_t, a_t, b_t = inp
        sa = jnp.einsum('bhvk,bhk->bhv', state, a_t)
        state = (state * w_t[:, :, None, :] + sa[..., None] * b_t[:, :, None, :]
                 + v_t[..., None] * k_t[:, :, None, :])
        return state, jnp.einsum('bhvk,bhk->bhv', state, r_t)

    s0 = jnp.zeros((bsz, nh, n, n), jnp.float32)
    _, ys = lax.scan(step, s0, xs)
    return jnp.moveaxis(ys, 0, 1)


def rwkv7_mixer(z, mu, w0, w2, a0, a2, g2, k_k, k_a, r_k, ln_g, ln_b, v_first, v_gate):
    bsz, seq, _ = z.shape
    f32 = jnp.float32
    zf = z.astype(f32)
    prev = jnp.pad(zf, ((0, 0), (1, 0), (0, 0)))[:, :-1, :]
    zf = zf + (prev - zf) * mu.astype(f32)
    r = zf[..., :RW_R_END]
    k = zf[..., RW_R_END:RW_K_END]
    v = zf[..., RW_K_END:RW_V_END]
    zw = zf[..., RW_V_END:RW_W_END]
    za = zf[..., RW_W_END:RW_A_END]
    zg = zf[..., RW_A_END:]
    w_log = -jax.nn.softplus(-(w0.astype(f32) + jnp.tanh(zw) @ w2.astype(f32))) - 0.5
    decay = jnp.exp(-jnp.exp(w_log))
    a = jax.nn.sigmoid(a0.astype(f32) + za @ a2.astype(f32))
    g = jax.nn.sigmoid(zg) @ g2.astype(f32)
    kk = (k * k_k.astype(f32)).reshape(bsz, seq, RW_HEADS, RW_HEAD)
    kk = kk / jnp.maximum(jnp.linalg.norm(kk, axis=-1, keepdims=True), 1e-12)
    kk = kk.reshape(bsz, seq, RW_WIDTH)
    k = k * (1.0 + (a - 1.0) * k_a.astype(f32))
    if v_gate is None:
        v_first = v
    else:
        v0, v1, v2 = v_gate
        mix = jax.nn.sigmoid(v0.astype(f32) + (v @ v1.astype(f32)) @ v2.astype(f32))
        v = v + (v_first - v) * mix
    hs = (bsz, seq, RW_HEADS, RW_HEAD)
    rh, kh, vh = r.reshape(hs), k.reshape(hs), v.reshape(hs)
    y = rwkv7_scan(rh, decay.reshape(hs), kh, vh, -kk.reshape(hs), (kk * a).reshape(hs))
    mean = jnp.mean(y, axis=-1, keepdims=True)
    var = jnp.mean(jnp.square(y - mean), axis=-1, keepdims=True)
    y = ((y - mean) * lax.rsqrt(var + RW_LN_EPS)).reshape(bsz, seq, RW_WIDTH)
    y = y * ln_g.astype(f32) + ln_b.astype(f32)
    bonus = jnp.sum(rh * kh * r_k.astype(f32), axis=-1, keepdims=True) * vh
    y = (y + bonus.reshape(bsz, seq, RW_WIDTH)) * g
    return y.astype(z.dtype), v_first


def setup_inputs(seed: int = 0) -> dict:
    key = jax.random.key(seed)
    ks = iter(jax.random.split(key, 48))
    f32 = jnp.float32

    def nrm(shape, scale):
        return scale * jax.random.normal(next(ks), shape, f32)

    G, P, C = S5_GROUPS, S5_STATE, S5_GROUP
    inp = {}
    inp['x'] = nrm((BATCH, SEQ, D_MODEL), 1.0)
    inp['norm1_g'] = 1.0 + nrm((DEPTH, D_MODEL), 0.02)
    inp['w_in'] = nrm((DEPTH, D_MODEL, N_IN), D_MODEL ** -0.5)
    inp['s5_lambda_re'] = -0.5 + nrm((DEPTH, G, P), 0.01)
    inp['s5_lambda_im'] = math.pi * jnp.arange(P, dtype=f32) + nrm((DEPTH, G, P), 0.01)
    inp['s5_log_dt'] = jax.random.uniform(next(ks), (DEPTH, G), f32, math.log(S5_DT_MIN), math.log(S5_DT_MAX))
    inp['s5_b_re'] = nrm((DEPTH, G, P, C), (2 * C) ** -0.5)
    inp['s5_b_im'] = nrm((DEPTH, G, P, C), (2 * C) ** -0.5)
    inp['s5_c_re'] = nrm((DEPTH, G, C, P), P ** -0.5)
    inp['s5_c_im'] = nrm((DEPTH, G, C, P), P ** -0.5)
    inp['s5_d'] = nrm((DEPTH, S5_WIDTH), 1.0)
    inp['s5_w_glu'] = nrm((DEPTH, S5_WIDTH, S5_WIDTH), S5_WIDTH ** -0.5)
    inp['da_q_gain'] = 1.0 + nrm((DEPTH, 2, DA_HEAD_DIM), 0.02)
    inp['da_k_gain'] = 1.0 + nrm((DEPTH, 2, DA_HEAD_DIM), 0.02)
    inp['da_lambda'] = nrm((DEPTH, 4, DA_HEAD_DIM), 0.1)
    inp['da_subln_g'] = 1.0 + nrm((DEPTH, DA_V_DIM), 0.02)
    inp['rw_mu'] = jax.random.uniform(next(ks), (DEPTH, RW_SHIFT_WIDTH), f32)
    inp['rw_w0'] = jnp.linspace(-6.5, -1.5, RW_WIDTH, dtype=f32) + nrm((DEPTH, RW_WIDTH), 0.1)
    inp['rw_w2'] = nrm((DEPTH, RW_DECAY_LORA, RW_WIDTH), 0.1)
    inp['rw_a0'] = nrm((DEPTH, RW_WIDTH), 0.1)
    inp['rw_a2'] = nrm((DEPTH, RW_A_LORA, RW_WIDTH), 0.1)
    inp['rw_g2'] = nrm((DEPTH, RW_G_LORA, RW_WIDTH), RW_G_LORA ** -0.5)
    inp['rw_k_k'] = 0.85 + nrm((DEPTH, RW_WIDTH), 0.02)
    inp['rw_k_a'] = 1.0 + nrm((DEPTH, RW_WIDTH), 0.02)
    inp['rw_r_k'] = nrm((DEPTH, RW_HEADS, RW_HEAD), 0.05)
    inp['rw_ln_g'] = 1.0 + nrm((DEPTH, RW_WIDTH), 0.02)
    inp['rw_ln_b'] = nrm((DEPTH, RW_WIDTH), 0.01)
    inp['rw_v0'] = 1.0 + nrm((DEPTH - 1, RW_WIDTH), 0.02)
    inp['rw_v1'] = nrm((DEPTH - 1, RW_WIDTH, RW_V_LORA), RW_WIDTH ** -0.5)
    inp['rw_v2'] = nrm((DEPTH - 1, RW_V_LORA, RW_WIDTH), 0.1)
    inp['w_branch'] = nrm((DEPTH, N_BRANCH, BRANCH_WIDTH, D_MODEL), BRANCH_WIDTH ** -0.5)
    inp['w_out'] = nrm((DEPTH, D_MODEL, D_MODEL), D_MODEL ** -0.5)
    inp['norm2_g'] = 1.0 + nrm((DEPTH, D_MODEL), 0.02)
    inp['w_ffn_in'] = nrm((DEPTH, D_MODEL, 2 * D_FF), D_MODEL ** -0.5)
    inp['w_ffn_out'] = nrm((DEPTH, D_FF, D_MODEL), D_FF ** -0.5)
    return inp


def reference(x, norm1_g, w_in, s5_lambda_re, s5_lambda_im, s5_log_dt, s5_b_re, s5_b_im,
              s5_c_re, s5_c_im, s5_d, s5_w_glu, da_q_gain, da_k_gain, da_lambda, da_subln_g,
              rw_mu, rw_w0, rw_w2, rw_a0, rw_a2, rw_g2, rw_k_k, rw_k_a, rw_r_k, rw_ln_g, rw_ln_b,
              rw_v0, rw_v1, rw_v2, w_branch, w_out, norm2_g, w_ffn_in, w_ffn_out):
    bsz, seq, _ = x.shape
    v_first = None
    for i in range(DEPTH):
        h = rms_norm(x, norm1_g[i])
        proj = h @ w_in[i]
        u_s5 = proj[..., :IN_S5_END]
        q = proj[..., IN_S5_END:IN_Q_END]
        k = proj[..., IN_Q_END:IN_K_END]
        v = proj[..., IN_K_END:IN_V_END]
        z_rw = proj[..., IN_V_END:IN_RW_END]
        gate_logits = proj[..., IN_RW_END:]
        y_a = s5_mixer(u_s5, s5_lambda_re[i], s5_lambda_im[i], s5_log_dt[i], s5_b_re[i], s5_b_im[i],
                       s5_c_re[i], s5_c_im[i], s5_d[i], s5_w_glu[i])
        lambda_init = 0.8 - 0.6 * math.exp(-0.3 * i)
        y_b = diff_attention(q, k, v, da_q_gain[i], da_k_gain[i], da_lambda[i], da_subln_g[i], lambda_init)
        v_gate = None if i == 0 else (rw_v0[i - 1], rw_v1[i - 1], rw_v2[i - 1])
        y_c, v_first = rwkv7_mixer(z_rw, rw_mu[i], rw_w0[i], rw_w2[i], rw_a0[i], rw_a2[i], rw_g2[i],
                                   rw_k_k[i], rw_k_a[i], rw_r_k[i], rw_ln_g[i], rw_ln_b[i], v_first, v_gate)
        branches = jnp.stack([y_a, y_b, y_c.astype(y_a.dtype)], axis=2)
        branch_out = jnp.einsum('blnc,ncd->blnd', branches, w_branch[i])
        gates = jax.nn.sigmoid(gate_logits.reshape(bsz, seq, N_BRANCH, D_MODEL))
        merged = jnp.sum(gates * branch_out, axis=2)
        x = x + (merged @ w_out[i]).astype(x.dtype)
        h2 = rms_norm(x, norm2_g[i])
        gu = h2 @ w_ffn_in[i]
        x = x + ((jax.nn.silu(gu[..., :D_FF]) * gu[..., D_FF:]) @ w_ffn_out[i]).astype(x.dtype)
    return x
```

```cpp
#include <hip/hip_runtime.h>
#include <hip/hip_cooperative_groups.h>
#include <cstdio>
#include <cstdint>

namespace pg8 {
#define PG8_LAS __attribute__((address_space(3)))
typedef unsigned short bf16_t;
typedef short bf16x8 __attribute__((ext_vector_type(8)));
typedef float f32x4 __attribute__((ext_vector_type(4)));
typedef unsigned u32x4 __attribute__((ext_vector_type(4)));
constexpr int BM = 256, BK = 64, HALF = 128, HTB = HALF * BK * 2  , STAGE_BYTES = 8 * HTB, NXCD = 8, WGM = 8;

__host__ __device__ __forceinline__ int lds_byte(int r, int c) { const int st = (r >> 4) * 2 + (c >> 5), rr = r & 15, cc = c & 31, ob = rr * 64 + cc * 2; return st * 1024 + (ob ^ (((ob >> 9) & 1) << 5)); }
__host__ __device__ __forceinline__ void stage_rc(int b, int& R, int& C) { const int st = b / 1024, sb = b % 1024, swz = sb ^ (((sb >> 9) & 1) << 5); R = (st >> 1) * 16 + swz / 64; C = (st & 1) * 32 + (swz % 64) / 2; }
__host__ __device__ __forceinline__ int perm32(int rho) { const int n = rho >> 4, i = rho & 15; return 8 * (i >> 2) + 4 * n + (i & 3); }

struct Unit { int pm, pn; };
struct Gemm { const bf16_t* A; const bf16_t* Bt; int M, N, K; int lda, ldb; int a_skip_shift; int a_skip_bytes; int kwrap; int wrap_bytes; int b_shift; int b_stride_bytes;
  __device__ __forceinline__ const char* abase(const Unit& u) const { return (const char*)A + (size_t)u.pm * (size_t)(256 * 2) * lda + (size_t)(u.pm >> a_skip_shift) * a_skip_bytes; }
  __device__ __forceinline__ const char* bbase(const Unit& u) const { return (const char*)Bt + (size_t)u.pn * (size_t)(256 * 2) * ldb + (size_t)(u.pm >> b_shift) * b_stride_bytes; } };

struct StaticOrder {
    int nM, nN, nwg, G, c;
    __host__ __device__ void init(int M, int N, int G_, int c_) { nM = M / BM; nN = N / BM; nwg = nM * nN; G = G_; c = c_; }
    __host__ __device__ bool next(int i, Unit& u) const {
        const long L = (long)i * G + c; if (L >= nwg) return false;
        int wgid = (int)L; { const int q = nwg / NXCD, r = nwg % NXCD, xcd = wgid % NXCD, off = wgid / NXCD; wgid = (xcd < r ? xcd * (q + 1) : r * (q + 1) + (xcd - r) * q) + off; }
        const int nig = WGM * nN, gid = wgid / nig, fm = gid * WGM, gsz = (nM - fm) < WGM ? (nM - fm) : WGM;
        u.pm = fm + ((wgid % nig) % gsz); u.pn = (wgid % nig) / gsz; return true;
    }
    __device__ __forceinline__ void a_ready(const Unit&) const {}
    __device__ __forceinline__ void done(const Unit&) const {}
};

typedef float cvt_f32x2_t __attribute__((ext_vector_type(2))); typedef __bf16 cvt_bf16x2_t __attribute__((ext_vector_type(2)));
__device__ __forceinline__ unsigned cvt_pk_bf16(float lo, float hi) { cvt_f32x2_t v = {lo, hi}; cvt_bf16x2_t b = __builtin_convertvector(v, cvt_bf16x2_t); return __builtin_bit_cast(unsigned, b); }
typedef float f32x2 __attribute__((ext_vector_type(2)));
__device__ __forceinline__ f32x2 gelu_pk(f32x2 v) {
    const f32x2 av = __builtin_elementwise_abs(v), d = av * 0.2316418882f + 1.0f;
    f32x2 t; t.x = __builtin_amdgcn_rcpf(d.x); t.y = __builtin_amdgcn_rcpf(d.y);
    f32x2 q = t * 0.5307027145f + (-0.7265760135f); q = q * t + 0.7107068705f; q = q * t + (-0.142248368f); q = q * t + 0.127414796f; q = q * t;
    const f32x2 s = (v * v) * (-0.72134752044f);
    f32x2 e; e.x = __builtin_amdgcn_exp2f(s.x); e.y = __builtin_amdgcn_exp2f(s.y);
    const f32x2 m = v * (q * e), r = v - m;
    f32x2 o; o.x = v.x < 0.f ? m.x : r.x; o.y = v.y < 0.f ? m.y : r.y; return o;
}

template <int ACT  > struct EpiBf16 {
    static constexpr bool PERM = true, AFTER_DRAIN = false; static_assert(ACT == 0 || ACT == 1, "EpiBf16: ACT is 0 (none) or 1 (gelu_pk)");
    bf16_t* O; int ldc; const float* bias; int split_cols; size_t split_stride; float scale0;
    __device__ __forceinline__ void operator()(const f32x4 (&acc)[2][2][4][2], const Unit& u, int wr, int wc, int fr, int fq) const {
        const int row0 = u.pm * BM + wr * 64 + fr; int colt = u.pn * BM; bf16_t* base = O;
        float sc = 1.f; if (split_cols) { const int t = colt / split_cols; base += (size_t)t * split_stride; colt -= t * split_cols; if (t == 0) sc = scale0; }
        const int col0 = colt + wc * 32 + 8 * fq, bcol0 = u.pn * BM + wc * 32 + 8 * fq;
        f32x4 bv[2][2];
#pragma unroll
        for (int bj = 0; bj < 2; ++bj)
#pragma unroll
            for (int n = 0; n < 2; ++n) bv[bj][n] = bias ? *(const f32x4*)(bias + bcol0 + bj * HALF + 4 * n) : (f32x4){0.f, 0.f, 0.f, 0.f};
#pragma unroll
        for (int ai = 0; ai < 2; ++ai)
#pragma unroll
            for (int m = 0; m < 4; ++m) { bf16_t* rowp = base + (size_t)(row0 + ai * HALF + m * 16) * ldc + col0;
#pragma unroll
                for (int bj = 0; bj < 2; ++bj) { f32x4 v0 = acc[ai][bj][m][0] + bv[bj][0], v1 = acc[ai][bj][m][1] + bv[bj][1];
                    if (ACT == 1) { f32x2 a = gelu_pk((f32x2){v0[0], v0[1]}), b = gelu_pk((f32x2){v0[2], v0[3]}), c = gelu_pk((f32x2){v1[0], v1[1]}), d = gelu_pk((f32x2){v1[2], v1[3]});
                        v0 = (f32x4){a.x, a.y, b.x, b.y}; v1 = (f32x4){c.x, c.y, d.x, d.y}; }
                    v0 = v0 * sc; v1 = v1 * sc; u32x4 w; w.x = cvt_pk_bf16(v0[0], v0[1]); w.y = cvt_pk_bf16(v0[2], v0[3]); w.z = cvt_pk_bf16(v1[0], v1[1]); w.w = cvt_pk_bf16(v1[2], v1[3]);
                    *(u32x4*)(rowp + bj * HALF) = w; } }
    }
};
template <class Epi, class Sched, bool ALIGN_EPI = false, bool SP2 = false>
__device__ __forceinline__ void gemm_phase(PG8_LAS unsigned char* lds, const Gemm g, const Sched& S, const Epi& E) {
    int tid_l = threadIdx.x; asm volatile("" : "+v"(tid_l)); const int tid = tid_l, wid = __builtin_amdgcn_readfirstlane(tid >> 6), lane = tid & 63, wr = wid >> 2, wc = wid & 3, fr = lane & 15, fq = lane >> 4;
    const int K = g.K, nt = K / BK;
    unsigned voffA[2], voffB[2];
#pragma unroll
    for (int i = 0; i < 2; ++i) { int R, C; stage_rc(tid * 16 + i * 8192, R, C); const int Rb = Epi::PERM ? ((R & ~31) + perm32(R & 31)) : R;
        voffA[i] = (unsigned)(R * g.lda + C) * 2u; voffB[i] = (unsigned)(Rb * g.ldb + C) * 2u; }
    const size_t kstep = (size_t)(BK * 2);
    const size_t hstepA = (size_t)HALF * g.lda * 2, hstepB = (size_t)HALF * g.ldb * 2; const size_t wrapb = (size_t)g.wrap_bytes;
    const unsigned ldsw = (unsigned)wid * 1024u;
    const int aoff = lds_byte(wr * 64 + fr, fq * 8), boff = lds_byte(wc * 32 + fr, fq * 8);
#define PG8_SA(b, h) (((b) * 2 + (h)) * HTB)
#define PG8_SB(b, h) ((4 + (b) * 2 + (h)) * HTB)
#define PG8_STAGE(bufoff, gbase, voff) do { _Pragma("unroll") for (int _i = 0; _i < 2; ++_i) \
        __builtin_amdgcn_global_load_lds((const unsigned*)((const char*)(gbase) + (voff)[_i]), (PG8_LAS unsigned*)(lds + (bufoff) + ldsw + _i * 8192), 16, 0, 0); } while (0)
#define PG8_LDA(dst, b, h) do { _Pragma("unroll") for (int m = 0; m < 4; ++m) _Pragma("unroll") for (int k = 0; k < 2; ++k) dst[m][k] = *(const PG8_LAS bf16x8*)(lds + PG8_SA(b, h) + aoff + m * 2048 + k * 1024); } while (0)
#define PG8_LDB(dst, b, h) do { _Pragma("unroll") for (int n = 0; n < 2; ++n) _Pragma("unroll") for (int k = 0; k < 2; ++k) dst[n][k] = *(const PG8_LAS bf16x8*)(lds + PG8_SB(b, h) + boff + n * 2048 + k * 1024); } while (0)
#define PG8_MMA(ai, bj, At, Bt) do { __builtin_amdgcn_s_setprio(1); _Pragma("unroll") for (int m = 0; m < 4; ++m) _Pragma("unroll") for (int n = 0; n < 2; ++n) _Pragma("unroll") for (int k = 0; k < 2; ++k) \
        acc[ai][bj][m][n] = __builtin_amdgcn_mfma_f32_16x16x32_bf16(Bt[n][k], At[m][k], acc[ai][bj][m][n], 0, 0, 0); __builtin_amdgcn_s_setprio(0); } while (0)
#define PG8_WAIT_V(n) asm volatile("s_waitcnt vmcnt(" #n ")" ::: "memory")
#define PG8_WAIT_L(n) asm volatile("s_waitcnt lgkmcnt(" #n ")" ::: "memory")
#define PG8_BAR __builtin_amdgcn_s_barrier()
#define PG8_SCHED __builtin_amdgcn_sched_barrier(0)
    Unit cur, nxt; int ui = 0;
    if (!S.next(0, cur)) return;
    f32x4 acc[2][2][4][2];
#pragma unroll
    for (int a = 0; a < 2; ++a)
#pragma unroll
        for (int b = 0; b < 2; ++b)
#pragma unroll
            for (int m = 0; m < 4; ++m)
#pragma unroll
                for (int n = 0; n < 2; ++n) acc[a][b][m][n] = (f32x4){0.f, 0.f, 0.f, 0.f};
    bf16x8 At[4][2], B0[2][2], B1[2][2];
    const char* cA = g.abase(cur); const char* cB = g.bbase(cur);
    S.a_ready(cur);
    if constexpr (SP2) {
        PG8_STAGE(PG8_SB(0, 0), cB, voffB); PG8_STAGE(PG8_SB(0, 1), cB + hstepB, voffB); PG8_STAGE(PG8_SA(0, 0), cA, voffA); PG8_STAGE(PG8_SA(0, 1), cA + hstepA, voffA);
        if (wr == 1) PG8_BAR;
        PG8_WAIT_V(2); PG8_BAR;
        PG8_STAGE(PG8_SB(1, 0), cB + kstep, voffB); PG8_STAGE(PG8_SA(1, 0), cA + kstep, voffA); PG8_STAGE(PG8_SB(1, 1), cB + hstepB + kstep, voffB);
        PG8_WAIT_V(6); PG8_BAR;
    } else {
        PG8_STAGE(PG8_SB(0, 0), cB, voffB); PG8_STAGE(PG8_SA(0, 0), cA, voffA); PG8_STAGE(PG8_SB(0, 1), cB + hstepB, voffB); PG8_STAGE(PG8_SA(0, 1), cA + hstepA, voffA);
        if (wr == 1) PG8_BAR;
        PG8_WAIT_V(4); PG8_BAR;
        PG8_STAGE(PG8_SB(1, 0), cB + kstep, voffB); PG8_STAGE(PG8_SA(1, 0), cA + kstep, voffA); PG8_STAGE(PG8_SB(1, 1), cB + hstepB + kstep, voffB);
        PG8_WAIT_V(6); PG8_BAR;
    }
    for (;;) {
        const bool has_next = S.next(ui + 1, nxt);
        const char* nA = has_next ? g.abase(nxt) : cA; const char* nB = has_next ? g.bbase(nxt) : cB;
        for (int t = 0; t < nt; t += 2) {
            const bool last = (t == nt - 2);
            const char* a1 = cA + (size_t)(t + 1) * kstep - ((t + 1) >= g.kwrap ? wrapb : (size_t)0);
            const char* a2 = last ? nA : cA + (size_t)(t + 2) * kstep - ((t + 2) >= g.kwrap ? wrapb : (size_t)0); const char* b2 = last ? nB : cB + (size_t)(t + 2) * kstep;
            const char* a3 = a2 + kstep; const char* b3 = b2 + kstep;
            if (last && has_next) S.a_ready(nxt);
            if constexpr (SP2) {
            PG8_LDB(B0, 0, 0); PG8_LDB(B1, 0, 1); PG8_SCHED; PG8_LDA(At, 0, 0); PG8_STAGE(PG8_SA(1, 1), a1 + hstepA, voffA);
            PG8_WAIT_V(8); PG8_WAIT_L(0); PG8_BAR; PG8_MMA(0, 0, At, B0); PG8_MMA(0, 1, At, B1); PG8_BAR; PG8_SCHED;
            PG8_LDA(At, 0, 1); PG8_STAGE(PG8_SB(0, 0), b2, voffB); PG8_STAGE(PG8_SB(0, 1), b2 + hstepB, voffB); PG8_STAGE(PG8_SA(0, 0), a2, voffA);
            PG8_WAIT_V(8); PG8_WAIT_L(0); PG8_BAR; PG8_MMA(1, 0, At, B0); PG8_MMA(1, 1, At, B1); PG8_BAR; PG8_SCHED;
            PG8_LDB(B0, 1, 0); PG8_LDB(B1, 1, 1); PG8_SCHED; PG8_LDA(At, 1, 0); PG8_STAGE(PG8_SA(0, 1), a2 + hstepA, voffA);
            PG8_WAIT_V(8); PG8_WAIT_L(0); PG8_BAR; PG8_MMA(0, 0, At, B0); PG8_MMA(0, 1, At, B1); PG8_BAR; PG8_SCHED;
            PG8_LDA(At, 1, 1); PG8_STAGE(PG8_SB(1, 0), b3, voffB); PG8_STAGE(PG8_SB(1, 1), b3 + hstepB, voffB); PG8_STAGE(PG8_SA(1, 0), a3, voffA);
            PG8_WAIT_V(8); PG8_WAIT_L(0); PG8_BAR; PG8_MMA(1, 0, At, B0); PG8_MMA(1, 1, At, B1); PG8_BAR; PG8_SCHED;
            } else {
            PG8_LDB(B0, 0, 0); PG8_SCHED; PG8_LDA(At, 0, 0); PG8_STAGE(PG8_SA(1, 1), a1 + hstepA, voffA);
            PG8_WAIT_L(8); PG8_BAR; PG8_WAIT_L(0); PG8_MMA(0, 0, At, B0); PG8_BAR; PG8_SCHED;
            PG8_LDB(B1, 0, 1); PG8_STAGE(PG8_SB(0, 0), b2, voffB);
            PG8_BAR; PG8_WAIT_L(0); PG8_MMA(0, 1, At, B1); PG8_BAR;
            PG8_LDA(At, 0, 1); PG8_STAGE(PG8_SA(0, 0), a2, voffA);
            PG8_BAR; PG8_WAIT_L(0); PG8_MMA(1, 0, At, B0); PG8_BAR; PG8_SCHED;
            PG8_STAGE(PG8_SB(0, 1), b2 + hstepB, voffB);
            PG8_WAIT_V(6); PG8_BAR; PG8_MMA(1, 1, At, B1); PG8_BAR;
            PG8_LDB(B0, 1, 0); PG8_SCHED; PG8_LDA(At, 1, 0); PG8_STAGE(PG8_SA(0, 1), a2 + hstepA, voffA);
            PG8_WAIT_L(8); PG8_BAR; PG8_WAIT_L(0); PG8_MMA(0, 0, At, B0); PG8_BAR; PG8_SCHED;
            PG8_LDB(B1, 1, 1); PG8_STAGE(PG8_SB(1, 0), b3, voffB);
            PG8_BAR; PG8_WAIT_L(0); PG8_MMA(0, 1, At, B1); PG8_BAR;
            PG8_LDA(At, 1, 1); PG8_STAGE(PG8_SA(1, 0), a3, voffA);
            PG8_BAR; PG8_WAIT_L(0); PG8_MMA(1, 0, At, B0); PG8_BAR; PG8_SCHED;
            PG8_STAGE(PG8_SB(1, 1), b3 + hstepB, voffB);
            PG8_WAIT_V(6); PG8_BAR; PG8_MMA(1, 1, At, B1); PG8_BAR;
            }
        }
        if constexpr (ALIGN_EPI) { if (wr == 0) PG8_BAR; }
        if constexpr (!Epi::AFTER_DRAIN) { E(acc, cur, wr, wc, fr, fq); S.done(cur); }
        if (!has_next) break;
#pragma unroll
        for (int a = 0; a < 2; ++a)
#pragma unroll
            for (int b = 0; b < 2; ++b)
#pragma unroll
                for (int m = 0; m < 4; ++m)
#pragma unroll
                    for (int n = 0; n < 2; ++n) acc[a][b][m][n] = (f32x4){0.f, 0.f, 0.f, 0.f};
        cur = nxt; cA = nA; cB = nB; ++ui;
        if constexpr (ALIGN_EPI) { if (wr == 1) PG8_BAR; }
    }
    PG8_WAIT_V(0);
    if constexpr (!ALIGN_EPI) { if (wr == 0) PG8_BAR; }
    PG8_BAR;
    if constexpr (Epi::AFTER_DRAIN) { E.fused(acc, cur, wr, wc, fr, fq, lds, wid, lane); S.done(cur); }
#undef PG8_SA
#undef PG8_SB
#undef PG8_STAGE
#undef PG8_LDA
#undef PG8_LDB
#undef PG8_MMA
#undef PG8_WAIT_V
#undef PG8_WAIT_L
#undef PG8_BAR
#undef PG8_SCHED
}
}
#include <hip/hip_bf16.h>
#include <cmath>
namespace attn_body {
using bf16=__hip_bfloat16;
using bf16x8=__attribute__((ext_vector_type(8)))short;
using s16x4=__attribute__((ext_vector_type(4)))short;
using f32x16=__attribute__((ext_vector_type(16)))float;
using u32x4=__attribute__((ext_vector_type(4)))unsigned;
constexpr int BATCH=4,NHEAD=16,SEQ=4096,D=64,DMQ=512,DMO=1024;
constexpr int NW=8,QBLK=32,QB=QBLK*NW,KVBLK=64,NQB=SEQ/QB;
constexpr int ATTN_UNIT_ROWS=QB;
__device__ __forceinline__ int crow(int r,int hi){return (r&3)+8*(r>>2)+4*hi;}
#define SBAR() __builtin_amdgcn_sched_barrier(0)
__device__ __forceinline__ void cmask(f32x16&p0,f32x16&p1,int jb,int qrel,int hi){
  const float NEG=-INFINITY; int kb=64*jb+4*hi;
  #pragma unroll
  for(int r=0;r<16;++r){int kv=kb+(r&3)+8*(r>>2); if(kv>qrel)p0[r]=NEG; if(kv+32>qrel)p1[r]=NEG;}
}

constexpr int NSLOT=3, SLOTB=8192;
constexpr int LDS_K=0, LDS_V=NSLOT*SLOTB, LDS_WS=2*NSLOT*SLOTB, LDS_OST=LDS_WS+NW*64*4, LDS_BYTES=LDS_OST+NW*4096;
constexpr float C2=0.125f*1.4426950408889634f;
__device__ __forceinline__ void glds16(const void*gsrc,unsigned lds_dst){unsigned keep;
  asm volatile("s_mov_b32 %0, m0\n\ts_mov_b32 m0, %2\n\ts_nop 0\n\tglobal_load_lds_dwordx4 %1, off\n\ts_mov_b32 m0, %0":"=&s"(keep):"v"(gsrc),"s"(lds_dst):"memory");}
__device__ __forceinline__ float max3f(float a,float b,float c){float r;asm("v_max3_f32 %0, %1, %2, %3":"=v"(r):"v"(a),"v"(b),"v"(c));return r;}
__device__ __forceinline__ float max2f(float a,float b){float r;asm("v_max_f32_e32 %0, %1, %2":"=v"(r):"v"(a),"v"(b));return r;}
__device__ __forceinline__ float fadd_s(float a,float b){float r;asm("v_add_f32_e32 %0, %1, %2":"=v"(r):"v"(a),"v"(b));return r;}
__device__ __forceinline__ float fsub_s(float a,float b){float r;asm("v_sub_f32_e32 %0, %1, %2":"=v"(r):"v"(a),"v"(b));return r;}
typedef float f32x2_t __attribute__((ext_vector_type(2))); typedef __bf16 bf16x2_t __attribute__((ext_vector_type(2)));
__device__ __forceinline__ unsigned cvtpk_s(float lo,float hi){f32x2_t v={lo,hi};bf16x2_t b=__builtin_convertvector(v,bf16x2_t);return __builtin_bit_cast(unsigned,b);}
#define WAIT_BAR(N) asm volatile("s_waitcnt vmcnt(" #N ") lgkmcnt(0)\n\ts_barrier":::"memory")

__device__ __forceinline__ void qkt(f32x16&p0,f32x16&p1,const char*Kslot,const bf16x8*qr,const f32x16&negm,int r32,int hi){
  const char*kb=Kslot+hi*1024+r32*16;
  #pragma unroll
  for(int d0=0;d0<4;++d0){
    const bf16x8 b0=*reinterpret_cast<const bf16x8*>(kb+d0*2048);
    const bf16x8 b1=*reinterpret_cast<const bf16x8*>(kb+d0*2048+512);
    if(d0==0){p0=__builtin_amdgcn_mfma_f32_32x32x16_bf16(b0,qr[0],negm,0,0,0);p1=__builtin_amdgcn_mfma_f32_32x32x16_bf16(b1,qr[0],negm,0,0,0);}
    else{p0=__builtin_amdgcn_mfma_f32_32x32x16_bf16(b0,qr[d0],p0,0,0,0);p1=__builtin_amdgcn_mfma_f32_32x32x16_bf16(b1,qr[d0],p1,0,0,0);}}
}
typedef __attribute__((address_space(3))) const char* lds_cptr;
typedef short v4i16_t __attribute__((ext_vector_type(4)));
__device__ __forceinline__ void kload8(bf16x8*kf,lds_cptr kp){
  kf[0]=*(const __attribute__((address_space(3))) bf16x8*)(kp);      kf[1]=*(const __attribute__((address_space(3))) bf16x8*)(kp+512);
  kf[2]=*(const __attribute__((address_space(3))) bf16x8*)(kp+2048); kf[3]=*(const __attribute__((address_space(3))) bf16x8*)(kp+2560);
  kf[4]=*(const __attribute__((address_space(3))) bf16x8*)(kp+4096); kf[5]=*(const __attribute__((address_space(3))) bf16x8*)(kp+4608);
  kf[6]=*(const __attribute__((address_space(3))) bf16x8*)(kp+6144); kf[7]=*(const __attribute__((address_space(3))) bf16x8*)(kp+6656);
}
__device__ __forceinline__ void kload2(bf16x8*kf,lds_cptr kp,int j){ kf[2*j]=*(const __attribute__((address_space(3))) bf16x8*)(kp+j*2048); kf[2*j+1]=*(const __attribute__((address_space(3))) bf16x8*)(kp+j*2048+512); }
__device__ __forceinline__ s16x4 vtr(lds_cptr p){ return __builtin_bit_cast(s16x4,__builtin_amdgcn_ds_read_tr16_b64_v4i16((__attribute__((address_space(3))) v4i16_t*)p)); }
__device__ __forceinline__ float rowmax(const f32x16&p0,const f32x16&p1){
  float a=max3f(p0[0],p0[1],p1[0]),b=max3f(p0[2],p0[3],p1[1]);a=max3f(a,p1[2],p1[3]);
  #pragma unroll
  for(int r=4;r<16;r+=4){a=max3f(a,p0[r],p0[r+1]);b=max3f(b,p0[r+2],p0[r+3]);a=max3f(a,p1[r],p1[r+1]);b=max3f(b,p1[r+2],p1[r+3]);}
  const float m=max2f(a,b);
  auto rr=__builtin_amdgcn_permlane32_swap(__float_as_uint(m),__float_as_uint(m),false,false);
  return max2f(__uint_as_float(rr[0]),__uint_as_float(rr[1]));
}
__device__ __forceinline__ void pv(f32x16*o,int vb,bf16x8 pa0,bf16x8 pa1,bf16x8 pa2,bf16x8 pa3){
  #pragma unroll
  for(int d0=0;d0<2;++d0){s16x4 lo[4],hi[4];
    #pragma unroll
    for(int ks=0;ks<4;++ks){
      asm volatile("ds_read_b64_tr_b16 %0,%1 offset:%c2":"=&v"(lo[ks]):"v"(vb),"i"(d0*4096+ks*1024):"memory");
      asm volatile("ds_read_b64_tr_b16 %0,%1 offset:%c2":"=&v"(hi[ks]):"v"(vb),"i"(d0*4096+ks*1024+512):"memory");}
    asm volatile("s_waitcnt lgkmcnt(0)":::"memory");SBAR();
    #define PK(k) (bf16x8){lo[k][0],lo[k][1],lo[k][2],lo[k][3],hi[k][0],hi[k][1],hi[k][2],hi[k][3]}
    o[d0]=__builtin_amdgcn_mfma_f32_32x32x16_bf16(pa0,PK(0),o[d0],0,0,0);
    o[d0]=__builtin_amdgcn_mfma_f32_32x32x16_bf16(pa1,PK(1),o[d0],0,0,0);
    o[d0]=__builtin_amdgcn_mfma_f32_32x32x16_bf16(pa2,PK(2),o[d0],0,0,0);
    o[d0]=__builtin_amdgcn_mfma_f32_32x32x16_bf16(pa3,PK(3),o[d0],0,0,0);
    #undef PK
  }
}

#ifndef ATTN_STORE16
#define ATTN_STORE16(p,v) (*(u32x4*)(p)=(v))
#endif
template<int THRL> __device__ __forceinline__ void attn_unit(int b,int cq,int ck,int cv,int co,int qb,const bf16*Q,const bf16*__restrict__ K,const bf16*__restrict__ V,bf16*O,char*shm){
  int tid_l=threadIdx.x; asm volatile("":"+v"(tid_l)); const int tid=tid_l,lane=tid&63,r32=lane&31,hi=lane>>5; const int wid=__builtin_amdgcn_readfirstlane(tid>>6);
  const long rowbase=(long)b*SEQ; const int q0=qb*QB;
  const bf16*Qw=Q+(rowbase+q0+wid*QBLK)*DMQ+cq;
  const bf16*Kh=K+rowbase*DMQ+ck,*Vh=V+rowbase*DMQ+cv;
  const unsigned lds0=(unsigned)(uintptr_t)shm;
  float*wsf=(float*)(shm+LDS_WS)+wid*64;
  const bf16*ksrc=Kh+(long)lane*DMQ+wid*8;
  const bf16*vsrc=Vh+(long)(16*(wid&3)+(lane>>2))*DMQ+(wid>>2)*32+(lane&3)*8;
  const unsigned kdst=lds0+LDS_K+wid*1024, vdst=lds0+LDS_V+wid*1024;
  #define DMA_K(t,slot) glds16(ksrc+(long)(t)*KVBLK*DMQ,(unsigned)__builtin_amdgcn_readfirstlane(kdst+(slot)))
  #define DMA_V(t,slot) glds16(vsrc+(long)(t)*KVBLK*DMQ,(unsigned)__builtin_amdgcn_readfirstlane(vdst+(slot)))
  const int vb0=(int)(lds0+LDS_V)+((lane>>4)&1)*32+(lane&3)*8+(4*hi+((lane&15)>>2))*64;
  const char*Kbase=shm+LDS_K; bf16x8 kf[8];
  const lds_cptr shm3=(lds_cptr)shm; const lds_cptr kp0=shm3+LDS_K+hi*1024+r32*16; const lds_cptr vp0=shm3+LDS_V+((lane>>4)&1)*32+(lane&3)*8+(4*hi+((lane&15)>>2))*64;
  const int NT=(q0+QB)/KVBLK;
  DMA_K(0,0);DMA_V(0,0);DMA_K(1,SLOTB);
  bf16x8 qr[4];
  #pragma unroll
  for(int d0=0;d0<4;++d0)qr[d0]=*reinterpret_cast<const bf16x8*>(&Qw[(long)r32*DMQ+d0*16+hi*8]);
  float mhat=0.f,l_reg=0.f;f32x16 o[2];o[0]=f32x16{};o[1]=f32x16{};f32x16 negm=f32x16{};asm volatile("":"+v"(negm));
  const int qrel=wid*QBLK+r32;
  #define CMASK(P0,P1,t) do{int jb_=(t)-(NT-4); if(jb_>=0)cmask(P0,P1,jb_,qrel,hi);}while(0)
  bool resc=false;
  #define START(P0,P1) do{ const float rm=rowmax(P0,P1); resc=false; \
    { const float dl=rm; mhat=fadd_s(mhat,dl); \
      _Pragma("unroll") for(int r=0;r<16;++r){P0[r]=fsub_s(P0[r],dl);P1[r]=fsub_s(P1[r],dl);} \
      _Pragma("unroll") for(int r=0;r<16;++r)negm[r]=-mhat; asm volatile("":"+v"(negm)); } \
    _Pragma("unroll") for(int r=0;r<16;++r)P0[r]=__builtin_amdgcn_exp2f(P0[r]); }while(0)
  #define RESC() do{ if(resc){ asm volatile("s_waitcnt lgkmcnt(0)":::"memory"); \
      _Pragma("unroll") for(int d_=0;d_<2;++d_) _Pragma("unroll") for(int r=0;r<16;++r)o[d_][r]*=wsf[crow(r,hi)]; } }while(0)
  f32x16 pA0,pA1,pB0,pB1;
  int sl_prev=0,sl_cur=0,sl_next=SLOTB;
  #define ROT() do{sl_prev=sl_cur;sl_cur=sl_next;sl_next=(sl_next==(NSLOT-1)*SLOTB)?0:sl_next+SLOTB;}while(0)
  DMA_K(2,2*SLOTB);
  WAIT_BAR(3);
  qkt(pA0,pA1,Kbase,qr,negm,r32,hi);asm volatile("s_nop 15\n\ts_nop 7":"+v"(pA0),"+v"(pA1));CMASK(pA0,pA1,0);
  START(pA0,pA1);
  _Pragma("unroll") for(int r=0;r<16;++r)pA1[r]=__builtin_amdgcn_exp2f(pA1[r]);
  WAIT_BAR(0);
  DMA_K(3,0);DMA_V(1,SLOTB);
  ROT();
  kload8(kf,kp0+sl_cur);
  WAIT_BAR(2);
  s16x4 vlo[8],vhi[8]; u32x4 pw0,pw1,pw2,pw3;
  #define PKW(P,B) cvtpk_s(P[B],P[B+1])
  #define PAF(k) __builtin_bit_cast(bf16x8,pw##k)
  #define VFR(i) (bf16x8){vlo[i][0],vlo[i][1],vlo[i][2],vlo[i][3],vhi[i][0],vhi[i][1],vhi[i][2],vhi[i][3]}
  #define PIN(x) asm volatile("":"+v"(x))
  #define MX3(a,b,c) __builtin_fmaxf(__builtin_fmaxf((a),(b)),(c))
  #define GAPA(MF,A0,A1,A2,A3,W0,W1,PW) do{ MF; sacc+=A0; sacc+=A1; sacc+=A2; sacc+=A3; PIN(sacc); W0; W1; PIN(PW); SBAR(); }while(0)
  #define EX(v) __builtin_amdgcn_exp2f(v)
  #define GAPB(MF,X,B) do{ MF; X[B]=EX(X[B]); X[B+1]=EX(X[B+1]); X[B+2]=EX(X[B+2]); X[B+3]=EX(X[B+3]); PIN(X); SBAR(); }while(0)
  #define VRD(i) do{ vlo[i]=vtr(vp_+(((i)>>2)*4096+((i)&3)*1024)); vhi[i]=vtr(vp_+(((i)>>2)*4096+((i)&3)*1024+512)); }while(0)
  #define KRD(G,j) do{ if(G){ kload2(kf,kp0+sl_next,j); SBAR(); } }while(0)
  #define STEP(C0,C1,P0,P1,t,GK,GV,GL) do{ SBAR(); \
    const lds_cptr vp_=vp0+sl_prev; \
    VRD(0); SBAR(); float sacc=(P0[0]+P0[1]); \
    GAPA(C0=__builtin_amdgcn_mfma_f32_32x32x16_bf16(kf[0],qr[0],negm,0,0,0), P0[2],P0[3],P0[4],P0[5],     pw0[0]=PKW(P0,0), pw0[1]=PKW(P0,2), pw0); \
    VRD(4); SBAR(); GAPA(C1=__builtin_amdgcn_mfma_f32_32x32x16_bf16(kf[1],qr[0],negm,0,0,0), P0[6],P0[7],P0[8],P0[9],     pw0[2]=PKW(P0,4), pw0[3]=PKW(P0,6), pw0); \
    VRD(1); SBAR(); GAPA(C0=__builtin_amdgcn_mfma_f32_32x32x16_bf16(kf[2],qr[1],C0,0,0,0),   P0[10],P0[11],P0[12],P0[13], pw1[0]=PKW(P0,8), pw1[1]=PKW(P0,10), pw1); \
    VRD(5); SBAR(); GAPA(C1=__builtin_amdgcn_mfma_f32_32x32x16_bf16(kf[3],qr[1],C1,0,0,0),   P0[14],P0[15],P1[0],P1[1],   pw1[2]=PKW(P0,12),pw1[3]=PKW(P0,14), pw1); \
    VRD(2); SBAR(); GAPA(C0=__builtin_amdgcn_mfma_f32_32x32x16_bf16(kf[4],qr[2],C0,0,0,0),   P1[2],P1[3],P1[4],P1[5],     pw2[0]=PKW(P1,0), pw2[1]=PKW(P1,2), pw2); \
    VRD(6); SBAR(); GAPA(C1=__builtin_amdgcn_mfma_f32_32x32x16_bf16(kf[5],qr[2],C1,0,0,0),   P1[6],P1[7],P1[8],P1[9],     pw2[2]=PKW(P1,4), pw2[3]=PKW(P1,6), pw2); \
    VRD(3); SBAR(); GAPA(C0=__builtin_amdgcn_mfma_f32_32x32x16_bf16(kf[6],qr[3],C0,0,0,0),   P1[10],P1[11],P1[12],P1[13], pw3[0]=PKW(P1,8), pw3[1]=PKW(P1,10), pw3); \
    VRD(7); SBAR(); GAPA(C1=__builtin_amdgcn_mfma_f32_32x32x16_bf16(kf[7],qr[3],C1,0,0,0),   P1[14],P1[15],0.f,0.f,       pw3[2]=PKW(P1,12),pw3[3]=PKW(P1,14), pw3); \
    l_reg+=sacc; \
    if(GK){DMA_K((t)+3,sl_cur);} if(GV){DMA_V((t)+1,sl_next);} \
    CMASK(C0,C1,t); \
    { float a=MX3(C0[0],C0[1],C1[0]),b=MX3(C0[2],C0[3],C1[1]); a=MX3(a,C1[2],C1[3]); \
      _Pragma("unroll") for(int r=4;r<16;r+=4){a=MX3(a,C0[r],C0[r+1]);b=MX3(b,C0[r+2],C0[r+3]);a=MX3(a,C1[r],C1[r+1]);b=MX3(b,C1[r+2],C1[r+3]);} \
      float rm=__builtin_fmaxf(a,b); { auto rr=__builtin_amdgcn_permlane32_swap(__float_as_uint(rm),__float_as_uint(rm),false,false); rm=__builtin_fmaxf(__uint_as_float(rr[0]),__uint_as_float(rr[1])); } \
      resc=false; \
      if(__builtin_expect(__any(rm>(float)THRL),0)){ const float dl=__builtin_fmaxf(rm,0.f); mhat+=dl; \
        _Pragma("unroll") for(int r=0;r<16;++r){C0[r]-=dl;C1[r]-=dl;} \
        _Pragma("unroll") for(int r=0;r<16;++r)negm[r]=-mhat; asm volatile("":"+v"(negm)); \
        const float f=__builtin_amdgcn_exp2f(-dl); l_reg*=f; if(hi==0)wsf[r32]=f; resc=true; } } \
    SBAR(); \
    GAPB(o[0]=__builtin_amdgcn_mfma_f32_32x32x16_bf16(PAF(0),VFR(0),o[0],0,0,0), C0,0); \
    GAPB(o[1]=__builtin_amdgcn_mfma_f32_32x32x16_bf16(PAF(0),VFR(4),o[1],0,0,0), C0,4); \
    KRD(GL,0); GAPB(o[0]=__builtin_amdgcn_mfma_f32_32x32x16_bf16(PAF(1),VFR(1),o[0],0,0,0), C0,8); \
    KRD(GL,1); GAPB(o[1]=__builtin_amdgcn_mfma_f32_32x32x16_bf16(PAF(1),VFR(5),o[1],0,0,0), C0,12); \
    KRD(GL,2); GAPB(o[0]=__builtin_amdgcn_mfma_f32_32x32x16_bf16(PAF(2),VFR(2),o[0],0,0,0), C1,0); \
    KRD(GL,3); GAPB(o[1]=__builtin_amdgcn_mfma_f32_32x32x16_bf16(PAF(2),VFR(6),o[1],0,0,0), C1,4); \
    GAPB(o[0]=__builtin_amdgcn_mfma_f32_32x32x16_bf16(PAF(3),VFR(3),o[0],0,0,0), C1,8); \
    GAPB(o[1]=__builtin_amdgcn_mfma_f32_32x32x16_bf16(PAF(3),VFR(7),o[1],0,0,0), C1,12); \
    }while(0)
  int t=1;
  #undef CMASK
  #define CMASK(P0,P1,t) do{}while(0)
  for(;t+5<NT;t+=2){
    STEP(pB0,pB1,pA0,pA1,t,true,true,true);     WAIT_BAR(2); RESC(); ROT();
    STEP(pA0,pA1,pB0,pB1,t+1,true,true,true);   WAIT_BAR(2); RESC(); ROT();
  }
  #undef CMASK
  #define CMASK(P0,P1,t) do{int jb_=(t)-(NT-4); if(jb_>=0)cmask(P0,P1,jb_,qrel,hi);}while(0)
  #define ENDW(tt) do{ if((tt)+3<NT){WAIT_BAR(2);} else if((tt)+2<NT){WAIT_BAR(1);} else {WAIT_BAR(0);} }while(0)
  for(;t+1<NT;t+=2){
    STEP(pB0,pB1,pA0,pA1,t,(t+3<NT),(t+1<NT),(t+1<NT));       ENDW(t);   RESC(); ROT();
    STEP(pA0,pA1,pB0,pB1,t+1,(t+4<NT),(t+2<NT),(t+2<NT));     ENDW(t+1); RESC(); ROT();
  }
  STEP(pB0,pB1,pA0,pA1,NT-1,false,false,false); RESC();
  { float sacc=pB0[0]+pB0[1]; _Pragma("unroll") for(int r=2;r<16;++r)sacc+=pB0[r]; _Pragma("unroll") for(int r=0;r<16;++r)sacc+=pB1[r]; l_reg+=sacc;
    pw0=(u32x4){PKW(pB0,0),PKW(pB0,2),PKW(pB0,4),PKW(pB0,6)};pw1=(u32x4){PKW(pB0,8),PKW(pB0,10),PKW(pB0,12),PKW(pB0,14)};pw2=(u32x4){PKW(pB1,0),PKW(pB1,2),PKW(pB1,4),PKW(pB1,6)};pw3=(u32x4){PKW(pB1,8),PKW(pB1,10),PKW(pB1,12),PKW(pB1,14)};
    SBAR(); pv(o,vb0+sl_cur,PAF(0),PAF(1),PAF(2),PAF(3)); }
  #undef PKW
  #undef PAF
  #undef VFR
  #undef PIN
  #undef MX3
  #undef GAPA
  #undef GAPB
  #undef EX
  #undef VRD
  #undef KRD
  #undef STEP
  #undef ENDW
  {auto rr=__builtin_amdgcn_permlane32_swap(__float_as_uint(l_reg),__float_as_uint(l_reg),false,false);l_reg=__uint_as_float(rr[0])+__uint_as_float(rr[1]);}
  if(hi==0)wsf[32+r32]=l_reg;asm volatile("s_waitcnt lgkmcnt(0)":::"memory");
  float rli[16];
  #pragma unroll
  for(int r=0;r<16;++r)rli[r]=__builtin_amdgcn_rcpf(wsf[32+crow(r,hi)]);
  bf16*Ow=O+(rowbase+q0+wid*QBLK)*DMO+co;
  { bf16*stg=(bf16*)(shm+LDS_OST)+wid*2048;
    #pragma unroll
    for(int r=0;r<16;++r){const int orow=crow(r,hi);
      #pragma unroll
      for(int d0=0;d0<2;++d0)stg[orow*64+d0*32+r32]=__float2bfloat16(o[d0][r]*rli[r]);}
    asm volatile("s_waitcnt lgkmcnt(0)":::"memory");
    #pragma unroll
    for(int i=0;i<4;++i){const int row=i*8+(lane>>3),ch=lane&7; const u32x4 v=*(const u32x4*)(stg+row*64+ch*8); ATTN_STORE16(Ow+(long)row*DMO+ch*8,v);} }
  asm volatile("s_waitcnt lgkmcnt(0)\n\ts_barrier":::"memory");
  #undef DMA_K
  #undef DMA_V
  #undef CMASK
  #undef START
  #undef RESC
  #undef ROT
}
constexpr int ATTN_LDS_BYTES=LDS_BYTES;
#undef SBAR
#undef WAIT_BAR
}
namespace cg = cooperative_groups;
#define GAS __attribute__((address_space(1)))
#define LAS __attribute__((address_space(3)))
typedef unsigned short bf16;
typedef unsigned v4u __attribute__((ext_vector_type(4)));
typedef unsigned v2u __attribute__((ext_vector_type(2)));
typedef float f32x4 __attribute__((ext_vector_type(4)));
constexpr int NWAVES = 8, NTHR = 512;
constexpr int M = 16384, DMOD = 1024, SEQ = 4096, NIN = 6816, DFF = 2816, ZP = 1728;
constexpr size_t MiB = 1u << 20;
constexpr size_t WS_CTL = 0;
constexpr size_t WS_WGLU = 1 * MiB, WS_WB = WS_WGLU + MiB / 2, WS_WO = WS_WB + 3 * MiB, WS_WFI = WS_WO + 2 * MiB, WS_WFO = WS_WFI + 11 * MiB;
constexpr size_t WS_WX = 23 * MiB, WS_W1A = WS_WX, WS_W1B = WS_WX + 4 * MiB, WS_E = WS_WX, WS_WG = WS_WX;
constexpr size_t WS_VF = 40 * MiB, WS_US = 56 * MiB, WS_YA = 80 * MiB, WS_Z = 96 * MiB, WS_QB = 150 * MiB, WS_KB = 166 * MiB, WS_VB = 182 * MiB;
constexpr size_t WS_XNP = 198 * MiB, WS_O = 198 * MiB, WS_AB = 231 * MiB, WS_PT = 247 * MiB, WS_MT = 249 * MiB, WS_END = 256 * MiB;
constexpr size_t WS_XN = 150 * MiB, WS_YL = 182 * MiB, WS_G = 182 * MiB, WS_MERGED = 214 * MiB, WS_H2N = 96 * MiB, WS_HID = 150 * MiB;
static_assert(WS_WFO + (size_t)1024 * 2816 * 2 <= WS_WX && WS_Z + (size_t)M * ZP * 2 <= WS_QB && WS_XNP + (size_t)4 * 4097 * 1024 * 2 <= WS_AB && WS_MT + (size_t)32 * 256 * 384 * 2 <= WS_END && WS_HID + (size_t)M * DFF * 2 <= WS_END, "ws map");
constexpr int LDS_BYTES = 147456;
constexpr float C2Q = 0.125f * 1.4426950408889634f;

__device__ __forceinline__ unsigned f2bf(float f) { unsigned u = __builtin_bit_cast(unsigned, f); return (u + 0x7fffu + ((u >> 16) & 1u)) >> 16; }
__device__ __forceinline__ float bf2f(unsigned b) { return __uint_as_float(b << 16); }
__device__ __forceinline__ void unpack8(const v4u w, float* f) {
    f[0] = __uint_as_float(w.x << 16); f[1] = __uint_as_float(w.x & 0xffff0000u); f[2] = __uint_as_float(w.y << 16); f[3] = __uint_as_float(w.y & 0xffff0000u);
    f[4] = __uint_as_float(w.z << 16); f[5] = __uint_as_float(w.z & 0xffff0000u); f[6] = __uint_as_float(w.w << 16); f[7] = __uint_as_float(w.w & 0xffff0000u); }
__device__ __forceinline__ v4u pack8(const float* f) { v4u w; w.x = pg8::cvt_pk_bf16(f[0], f[1]); w.y = pg8::cvt_pk_bf16(f[2], f[3]); w.z = pg8::cvt_pk_bf16(f[4], f[5]); w.w = pg8::cvt_pk_bf16(f[6], f[7]); return w; }
__device__ __forceinline__ float sigm(float x) { return __builtin_amdgcn_rcpf(1.f + __expf(-x)); }
__device__ __forceinline__ float tanh_f(float x) { return 1.f - 2.f * __builtin_amdgcn_rcpf(1.f + __expf(2.f * x)); }
__device__ __forceinline__ float wave_sum(float v) {
#pragma unroll
    for (int o = 1; o < 64; o <<= 1) v += __shfl_xor(v, o);
    return v; }
__device__ __forceinline__ float dppf(float x, const int ctrl) { return x; }
#define DPP_ADD(x, ctrl) ((x) + __builtin_bit_cast(float, __builtin_amdgcn_update_dpp(0, __builtin_bit_cast(int, (x)), (ctrl), 0xf, 0xf, true)))
__device__ __forceinline__ float row16_sum(float x) { x = DPP_ADD(x, 0xB1); x = DPP_ADD(x, 0x4E); x = DPP_ADD(x, 0x141); x = DPP_ADD(x, 0x140); return x; }

template <int MODE> struct Epi8 {
    static constexpr bool PERM = true, AFTER_DRAIN = false;
    bf16* O; int ldc; const bf16* X; const float* P;
    __device__ __forceinline__ void operator()(const pg8::f32x4 (&acc)[2][2][4][2], const pg8::Unit& u, int wr, int wc, int fr, int fq) const {
#pragma unroll
        for (int ai = 0; ai < 2; ++ai)
#pragma unroll
            for (int m = 0; m < 4; ++m) {
                const int row = u.pm * 256 + ai * 128 + wr * 64 + m * 16 + fr;
                if (MODE == 8) {
                    float o[8];
#pragma unroll
                    for (int i = 0; i < 8; ++i) { const float gte = acc[ai][0][m][i >> 2][i & 3], up = acc[ai][1][m][i >> 2][i & 3]; o[i] = gte * sigm(gte) * up; }
                    *(v4u*)(O + (size_t)row * DFF + u.pn * 128 + wc * 32 + 8 * fq) = pack8(o);
                } else {
#pragma unroll
                for (int bj = 0; bj < 2; ++bj) {
                    const int col = u.pn * 256 + bj * 128 + wc * 32 + 8 * fq;
                    float v[8];
#pragma unroll
                    for (int i = 0; i < 8; ++i) v[i] = acc[ai][bj][m][i >> 2][i & 3];
                    if (MODE == 0) { if (col < ldc) *(v4u*)(O + (size_t)row * ldc + col) = pack8(v); }
                    else if (MODE == 1) {
                        if (u.pn < 2) { const int g = col >> 4, cc = col & 15, b = row >> 12, t = row & 4095, ch = t >> 4, s = t & 15;
                            *(v4u*)((bf16*)X + ((size_t)(g * 1024 + b * 256 + ch) * 384 + s * 16 + cc)) = pack8(v); }
                        else { const int tsel = (col >> 9) - 1, cl = col & 511; *(v4u*)(O + (size_t)tsel * (8u * MiB) + (size_t)row * 512 + cl) = pack8(v); }
                    }
                    else if (MODE == 2) { if (bj == 0) *(v4u*)(O + (size_t)row * 384 + 256 + (col & 255)) = pack8(v); }
                    else if (MODE == 3) {
                        const int g = row >> 10, b = (row >> 8) & 3, ch = row & 255, cl = col & 255, t = cl >> 4, cc = cl & 15;
                        float uu[8]; unpack8(*(const v4u*)(X + (size_t)row * 384 + cl), uu);
#pragma unroll
                        for (int i = 0; i < 8; ++i) { const float y = v[i] + P[g * 16 + cc + i] * uu[i]; v[i] = y * sigm(1.5957691216f * (y + 0.044715f * y * y * y)); }
                        *(v4u*)(O + (size_t)(b * 4096 + ch * 16 + t) * 512 + g * 16 + cc) = pack8(v);
                    }
                    else if (MODE == 4) { float y[8]; unpack8(*(const v4u*)(X + (size_t)row * 512 + col), y);
#pragma unroll
                        for (int i = 0; i < 8; ++i) v[i] = y[i] * sigm(v[i]);
                        *(v4u*)(O + (size_t)row * 512 + col) = pack8(v); }
                    else if (MODE == 5) {
#pragma unroll
                        for (int i = 0; i < 8; ++i) v[i] = sigm(v[i]);
                        *(v4u*)(O + (size_t)row * 1024 + col) = pack8(v); }
                    else if (MODE == 6 || MODE == 7) { float gt[8]; unpack8(*(const v4u*)(X + (size_t)row * 1024 + col), gt);
                        float pm_[8];
                        if (MODE == 7) unpack8(*(const v4u*)(O + (size_t)row * 1024 + col), pm_);
#pragma unroll
                        for (int i = 0; i < 8; ++i) v[i] = (MODE == 7 ? pm_[i] : 0.f) + gt[i] * v[i];
                        *(v4u*)(O + (size_t)row * 1024 + col) = pack8(v); }
                }
                }
            }
    }
};
struct EpiRes {
    static constexpr bool PERM = false, AFTER_DRAIN = false;
    const float* xin; float* xout;
    __device__ __forceinline__ void operator()(const pg8::f32x4 (&acc)[2][2][4][2], const pg8::Unit& u, int wr, int wc, int fr, int fq) const {
#pragma unroll
        for (int ai = 0; ai < 2; ++ai)
#pragma unroll
            for (int m = 0; m < 4; ++m) { const size_t off = (size_t)(u.pm * 256 + ai * 128 + wr * 64 + m * 16 + fr) * 1024 + u.pn * 256 + wc * 32 + 4 * fq;
#pragma unroll
                for (int bj = 0; bj < 2; ++bj)
#pragma unroll
                    for (int n = 0; n < 2; ++n) { const f32x4 b = *(const f32x4*)(xin + off + bj * 128 + n * 16); f32x4 o; o.x = b.x + acc[ai][bj][m][n][0]; o.y = b.y + acc[ai][bj][m][n][1]; o.z = b.z + acc[ai][bj][m][n][2]; o.w = b.w + acc[ai][bj][m][n][3];
                        *(f32x4*)(xout + off + bj * 128 + n * 16) = o; } }
    }
};
__device__ __forceinline__ pg8::Gemm mkgemm(const bf16* A, const bf16* Bt, int Mr, int N, int K, int lda, int ldb) {
    pg8::Gemm g; g.A = A; g.Bt = Bt; g.M = Mr; g.N = N; g.K = K; g.lda = lda; g.ldb = ldb; g.a_skip_shift = 30; g.a_skip_bytes = 0; g.kwrap = 1 << 20; g.wrap_bytes = 0; g.b_shift = 30; g.b_stride_bytes = 0; return g; }
template <class Epi> __device__ __forceinline__ void run_gemm(LAS unsigned char* lds, const pg8::Gemm& g, const Epi& E, int G, int c) {
    asm volatile("" : "+s"(G), "+s"(c));
    pg8::StaticOrder S; S.init(g.M, g.N, G, c);
    pg8::gemm_phase<Epi, pg8::StaticOrder, true, true>(lds, g, S, E);
}

__device__ __forceinline__ void tr_item(const float* W, int ldw, int k0, int c0, bf16* WT, int ldt, int drow, int koff, const float* mu, int smode, LAS float* scr, int lane) {
#pragma unroll 8
    for (int i = 0; i < 32; ++i) { const int kk = 2 * i + (lane >> 5); scr[kk * 33 + (lane & 31)] = W[(size_t)(k0 + kk) * ldw + c0 + (lane & 31)]; }
    asm volatile("s_waitcnt lgkmcnt(0)" ::: "memory");
    const int c = lane & 7;
#pragma unroll
    for (int j = 0; j < 4; ++j) { const int n = (lane >> 3) + 8 * j; const LAS float* s = scr + (8 * c) * 33 + n;
        float sc = 1.f; if (smode) { const float m_ = mu[n]; sc = (smode == 1) ? 1.f - m_ : m_; }
        v4u o; o.x = pg8::cvt_pk_bf16(s[0 * 33] * sc, s[1 * 33] * sc); o.y = pg8::cvt_pk_bf16(s[2 * 33] * sc, s[3 * 33] * sc); o.z = pg8::cvt_pk_bf16(s[4 * 33] * sc, s[5 * 33] * sc); o.w = pg8::cvt_pk_bf16(s[6 * 33] * sc, s[7 * 33] * sc);
        *(v4u*)(WT + (size_t)(drow + n) * ldt + koff + k0 + 8 * c) = o; }
    asm volatile("s_waitcnt lgkmcnt(0)" ::: "memory");
}
__device__ __forceinline__ void rms_row(const float* xrow, const float* gain, bf16* orow, int lane) {
    const f32x4* xr = (const f32x4*)xrow + lane; const f32x4* gr = (const f32x4*)gain + lane;
    f32x4 v[4]; float s = 0.f;
#pragma unroll
    for (int j = 0; j < 4; ++j) { v[j] = xr[64 * j]; s += (v[j].x * v[j].x + v[j].y * v[j].y) + (v[j].z * v[j].z + v[j].w * v[j].w); }
    const float rstd = 1.f / sqrtf(wave_sum(s) * (1.f / 1024.f) + 1e-6f);
    v2u* o8 = (v2u*)orow + lane;
#pragma unroll
    for (int j = 0; j < 4; ++j) { const f32x4 g = gr[64 * j]; v2u w; w.x = pg8::cvt_pk_bf16(v[j].x * rstd * g.x, v[j].y * rstd * g.y); w.y = pg8::cvt_pk_bf16(v[j].z * rstd * g.z, v[j].w * rstd * g.w); o8[64 * j] = w; }
}
struct Ptrs { const float* in[35]; float* out; unsigned char* ws; };

__device__ __forceinline__ void weight_items(const Ptrs& P, int L, int gw, int NGW, LAS float* scr, int lane) {
    unsigned char* ws = P.ws;
    const float* w_in = P.in[2] + (size_t)L * 1024 * NIN; const float* mu = P.in[16] + (size_t)L * 1696;
    constexpr int I1A = 16 * 64, I1B = 16 * 53, IGLU = 8 * 16, IWB = 8 * 32, IWO = 16 * 32, IFI = 16 * 176, IFO = 44 * 32;
    constexpr int NIT = I1A + 2 * I1B + IGLU + 3 * IWB + IWO + IFI + IFO;
    for (int it = gw; it < NIT; it += NGW) {
        int r = it;
        if (r < I1A) { const int kb = r / 64, nb = r % 64; tr_item(w_in, NIN, kb * 64, nb * 32, (bf16*)(ws + WS_W1A), 1024, nb * 32, 0, nullptr, 0, scr, lane); continue; } r -= I1A;
        if (r < I1B) { const int kb = r / 53, nb = r % 53; tr_item(w_in, NIN, kb * 64, 2048 + nb * 32, (bf16*)(ws + WS_W1B), 2048, nb * 32, 0, mu + nb * 32, 1, scr, lane); continue; } r -= I1B;
        if (r < I1B) { const int kb = r / 53, nb = r % 53; tr_item(w_in, NIN, kb * 64, 2048 + nb * 32, (bf16*)(ws + WS_W1B), 2048, nb * 32, 1024, mu + nb * 32, 2, scr, lane); continue; } r -= I1B;
        if (r < IGLU) { const int kb = r / 16, nb = r % 16; tr_item(P.in[11] + (size_t)L * 512 * 512, 512, kb * 64, nb * 32, (bf16*)(ws + WS_WGLU), 512, nb * 32, 0, nullptr, 0, scr, lane); continue; } r -= IGLU;
        if (r < 3 * IWB) { const int n = r / IWB, q = r % IWB, kb = q / 32, nb = q % 32; tr_item(P.in[30] + ((size_t)L * 3 + n) * 512 * 1024, 1024, kb * 64, nb * 32, (bf16*)(ws + WS_WB) + (size_t)n * 1024 * 512, 512, nb * 32, 0, nullptr, 0, scr, lane); continue; } r -= 3 * IWB;
        if (r < IWO) { const int kb = r / 32, nb = r % 32; tr_item(P.in[31] + (size_t)L * 1024 * 1024, 1024, kb * 64, nb * 32, (bf16*)(ws + WS_WO), 1024, nb * 32, 0, nullptr, 0, scr, lane); continue; } r -= IWO;
        if (r < IFI) { const int kb = r / 176, nb = r % 176; const int n0 = nb * 32; const int drow = (n0 < DFF) ? (n0 / 128) * 256 + (n0 % 128) : ((n0 - DFF) / 128) * 256 + 128 + ((n0 - DFF) % 128);
            tr_item(P.in[33] + (size_t)L * 1024 * 2 * DFF, 2 * DFF, kb * 64, n0, (bf16*)(ws + WS_WFI), 1024, drow, 0, nullptr, 0, scr, lane); continue; } r -= IFI;
        { const int kb = r / 32, nb = r % 32; tr_item(P.in[34] + (size_t)L * DFF * 1024, 1024, kb * 64, nb * 32, (bf16*)(ws + WS_WFO), DFF, nb * 32, 0, nullptr, 0, scr, lane); }
    }
}
__device__ __forceinline__ void s5_tables(const Ptrs& P, int L, int g, LAS float* sm, int tid) {
    LAS float* apr = sm; LAS float* api = sm + 17 * 64; LAS float* bbr = sm + 2 * 17 * 64; LAS float* bbi = bbr + 1024; LAS float* Ks = bbi + 1024;
    const float* lre = P.in[3] + (size_t)L * 2048; const float* lim = P.in[4] + (size_t)L * 2048; const float* ldt = P.in[5] + L * 32;
    const float* bre = P.in[6] + (size_t)L * 32768; const float* bim = P.in[7] + (size_t)L * 32768; const float* cre = P.in[8] + (size_t)L * 32768; const float* cim = P.in[9] + (size_t)L * 32768;
    if (tid < 64) { const int p = tid; const float dt = __expf(ldt[g]); const float lr = lre[g * 64 + p], li = lim[g * 64 + p];
        for (int j = 0; j <= 16; ++j) { const double ang = (double)j * (double)li * (double)dt * 0.15915494309189535; const float rev = (float)(ang - __builtin_floor(ang));
            const float mg = __expf((float)j * lr * dt); apr[j * 64 + p] = mg * __builtin_amdgcn_cosf(rev); api[j * 64 + p] = mg * __builtin_amdgcn_sinf(rev); }
        const float ar = apr[64 + p], ai = api[64 + p], den = lr * lr + li * li, nr = ar - 1.f, kr = (nr * lr + ai * li) / den, ki = (ai * lr - nr * li) / den;
        for (int c = 0; c < 16; ++c) { const float br = bre[(g * 64 + p) * 16 + c], bi = bim[(g * 64 + p) * 16 + c]; bbr[p * 16 + c] = kr * br - ki * bi; bbi[p * 16 + c] = kr * bi + ki * br; } }
    __syncthreads();
    { const int cc = tid & 255, cp = cc >> 4, c = cc & 15, j0 = (tid >> 8) * 8;
        for (int j = j0; j < j0 + 8; ++j) { float s = 0.f;
            for (int p = 0; p < 64; ++p) { const float tr = apr[j * 64 + p] * bbr[p * 16 + c] - api[j * 64 + p] * bbi[p * 16 + c], ti = apr[j * 64 + p] * bbi[p * 16 + c] + api[j * 64 + p] * bbr[p * 16 + c];
                s += cre[(g * 16 + cp) * 64 + p] * tr - cim[(g * 16 + cp) * 64 + p] * ti; }
            Ks[j * 256 + cc] = s; } }
    __syncthreads();
    bf16* Mt = (bf16*)(P.ws + WS_MT) + (size_t)g * 256 * 384; bf16* Pt = (bf16*)(P.ws + WS_PT) + (size_t)g * 128 * 256;
    for (int idx = tid; idx < 256 * 48; idx += NTHR) { const int n = idx / 48, kg = idx % 48, t = n >> 4, cp = n & 15; float v[8];
        if (kg < 32) { const int s = kg >> 1, c0 = (kg & 1) * 8;
#pragma unroll
            for (int i = 0; i < 8; ++i) v[i] = (s <= t) ? Ks[(t - s) * 256 + cp * 16 + c0 + i] : 0.f; }
        else {
#pragma unroll
            for (int i = 0; i < 8; ++i) { const int jj = (kg - 32) * 8 + i, p = jj & 63; const float cr = cre[(g * 16 + cp) * 64 + p], ci = cim[(g * 16 + cp) * 64 + p], ar = apr[(t + 1) * 64 + p], ai = api[(t + 1) * 64 + p];
                v[i] = (jj < 64) ? (cr * ar - ci * ai) : -(cr * ai + ci * ar); } }
        *(v4u*)(Mt + (size_t)n * 384 + kg * 8) = pack8(v); }
    for (int idx = tid; idx < 128 * 32; idx += NTHR) { const int jj = idx >> 5, kg = idx & 31, p = jj & 63, s = kg >> 1, c0 = (kg & 1) * 8; float v[8];
        const float ar = apr[(15 - s) * 64 + p], ai = api[(15 - s) * 64 + p];
#pragma unroll
        for (int i = 0; i < 8; ++i) { const float br = bbr[p * 16 + c0 + i], bi = bbi[p * 16 + c0 + i]; v[i] = (jj < 64) ? (ar * br - ai * bi) : (ar * bi + ai * br); }
        *(v4u*)(Pt + (size_t)jj * 256 + kg * 8) = pack8(v); }
    __syncthreads();
}
__device__ __forceinline__ void s5_chunk_scan(const Ptrs& P, int L, int gidx) {
    const int p = gidx & 63, g = (gidx >> 6) & 31, b = gidx >> 11;
    const float dt = __expf(P.in[5][L * 32 + g]); const float lr = P.in[3][(size_t)L * 2048 + g * 64 + p], li = P.in[4][(size_t)L * 2048 + g * 64 + p];
    const double ang = 16.0 * (double)li * (double)dt * 0.15915494309189535; const float rev = (float)(ang - __builtin_floor(ang)); const float mg = __expf(16.f * lr * dt);
    const float ar = mg * __builtin_amdgcn_cosf(rev), ai = mg * __builtin_amdgcn_sinf(rev);
    bf16* base = (bf16*)(P.ws + WS_US) + (size_t)(g * 1024 + b * 256) * 384 + 256 + p;
    float xr = 0.f, xi = 0.f;
#pragma unroll 8
    for (int c = 0; c < 256; ++c) { bf16* q = base + (size_t)c * 384; const float sr = bf2f(q[0]), si = bf2f(q[64]); q[0] = (bf16)f2bf(xr); q[64] = (bf16)f2bf(xi);
        const float nr = ar * xr - ai * xi + sr, ni = ar * xi + ai * xr + si; xr = nr; xi = ni; }
}

__device__ __forceinline__ void prep_phase(const Ptrs& P, int L, LAS unsigned char* lds, int gw, int NGW, int tid, int wave, int lane) {
    asm volatile("" : "+v"(tid), "+v"(lane)); asm volatile("" : "+s"(wave));
    unsigned char* ws = P.ws;
    LAS bf16* w2s = (LAS bf16*)lds; LAS bf16* a2s = w2s + 32 * 512; LAS bf16* v2s = a2s + 32 * 512; LAS unsigned* v1s = (LAS unsigned*)(v2s + 32 * 512);
    LAS float* vrow = (LAS float*)(lds + 131072) + wave * 512;
    const float* w2 = P.in[18] + (size_t)L * 32 * 512; const float* a2 = P.in[20] + (size_t)L * 32 * 512;
    for (int i = tid; i < 32 * 512; i += NTHR) { w2s[i] = (bf16)f2bf(w2[i]); a2s[i] = (bf16)f2bf(a2[i]); }
    if (L == 1) { const float* v2 = P.in[29]; const float* v1 = P.in[28];
        for (int i = tid; i < 32 * 512; i += NTHR) v2s[i] = (bf16)f2bf(v2[i]);
        for (int i = tid; i < 256 * 32; i += NTHR) { const int c2 = i >> 5, j = i & 31; v1s[i] = f2bf(v1[(2 * c2) * 32 + j]) | (f2bf(v1[(2 * c2 + 1) * 32 + j]) << 16); } }
    __syncthreads();
    const int c0 = lane * 8;
    float qg[8], kg[8], w0r[8], a0r[8], v0r[8];
#pragma unroll
    for (int i = 0; i < 8; ++i) { qg[i] = P.in[12][L * 128 + ((c0 + i) & 127)] * C2Q; kg[i] = P.in[13][L * 128 + ((c0 + i) & 127)]; w0r[i] = P.in[17][L * 512 + c0 + i]; a0r[i] = P.in[19][L * 512 + c0 + i]; v0r[i] = (L == 1) ? P.in[27][c0 + i] : 0.f; }
    for (int m = gw; m < M; m += NGW) {
        {
            bf16* qp = (bf16*)(ws + WS_QB) + (size_t)m * 512 + c0; bf16* kp = (bf16*)(ws + WS_KB) + (size_t)m * 512 + c0;
            float q[8], k[8]; unpack8(*(const v4u*)qp, q); unpack8(*(const v4u*)kp, k);
            float sq = 0.f, sk = 0.f;
#pragma unroll
            for (int i = 0; i < 8; ++i) { sq += q[i] * q[i]; sk += k[i] * k[i]; }
            sq += __shfl_xor(sq, 1); sq += __shfl_xor(sq, 2); sq += __shfl_xor(sq, 4); sk += __shfl_xor(sk, 1); sk += __shfl_xor(sk, 2); sk += __shfl_xor(sk, 4);
            const float rq = 1.f / sqrtf(sq * (1.f / 64.f) + 1e-6f), rk = 1.f / sqrtf(sk * (1.f / 64.f) + 1e-6f);
#pragma unroll
            for (int i = 0; i < 8; ++i) { q[i] *= rq * qg[i]; k[i] *= rk * kg[i]; }
            *(v4u*)qp = pack8(q); *(v4u*)kp = pack8(k);
        }
        bf16* zr = (bf16*)(ws + WS_Z) + (size_t)m * ZP;
        const float zz = bf2f(zr[1536 + lane]);
        const float tz = (lane < 32) ? tanh_f(zz) : zz;
        float aw[8], aa[8];
#pragma unroll
        for (int i = 0; i < 8; ++i) { aw[i] = w0r[i]; aa[i] = a0r[i]; }
#pragma unroll
        for (int j = 0; j < 32; ++j) { const float tw = __shfl(tz, j), ta = __shfl(tz, 32 + j); float w8[8], a8[8]; unpack8(*(const LAS v4u*)(w2s + j * 512 + c0), w8); unpack8(*(const LAS v4u*)(a2s + j * 512 + c0), a8);
#pragma unroll
            for (int i = 0; i < 8; ++i) { aw[i] += tw * w8[i]; aa[i] += ta * a8[i]; } }
#pragma unroll
        for (int i = 0; i < 8; ++i) { aw[i] = 0.6065306597f * sigm(aw[i]); aa[i] = sigm(aa[i]); }
        *(v4u*)((bf16*)(ws + WS_E) + (size_t)m * 512 + c0) = pack8(aw); *(v4u*)((bf16*)(ws + WS_AB) + (size_t)m * 512 + c0) = pack8(aa);
        const v4u vraw = *(const v4u*)(zr + 1024 + c0);
        if (L == 0) { *(v4u*)((bf16*)(ws + WS_VF) + (size_t)m * 512 + c0) = vraw; }
        else { float v[8], vf[8]; unpack8(vraw, v); unpack8(*(const v4u*)((const bf16*)(ws + WS_VF) + (size_t)m * 512 + c0), vf);
#pragma unroll
            for (int i = 0; i < 8; ++i) vrow[c0 + i] = v[i];
            asm volatile("s_waitcnt lgkmcnt(0)" ::: "memory");
            const int j = lane & 31, hf = lane >> 5; float s = 0.f;
#pragma unroll 8
            for (int c2 = 0; c2 < 128; ++c2) { const unsigned pk = v1s[(hf * 128 + c2) * 32 + j]; s += vrow[hf * 256 + 2 * c2] * __uint_as_float(pk << 16) + vrow[hf * 256 + 2 * c2 + 1] * __uint_as_float(pk & 0xffff0000u); }
            s += __shfl_xor(s, 32);
            float am[8];
#pragma unroll
            for (int i = 0; i < 8; ++i) am[i] = v0r[i];
#pragma unroll
            for (int jj = 0; jj < 32; ++jj) { const float sj = __shfl(s, jj); float w8[8]; unpack8(*(const LAS v4u*)(v2s + jj * 512 + c0), w8);
#pragma unroll
                for (int i = 0; i < 8; ++i) am[i] += sj * w8[i]; }
#pragma unroll
            for (int i = 0; i < 8; ++i) v[i] = v[i] + (vf[i] - v[i]) * sigm(am[i]);
            *(v4u*)(zr + 1024 + c0) = pack8(v);
            asm volatile("s_waitcnt lgkmcnt(0)" ::: "memory"); }
    }
    __syncthreads();
}

__device__ __forceinline__ void rwkv_unit(const Ptrs& P, int L, LAS unsigned char* lds, int b, int h, int qr, int tid, int wave, int lane) {
    constexpr int T = 32, TOKF = 336;
    asm volatile("" : "+v"(tid), "+v"(lane)); asm volatile("" : "+s"(wave));
    unsigned char* ws = P.ws;
    const bf16* Z = (const bf16*)(ws + WS_Z); const bf16* AB = (const bf16*)(ws + WS_AB); const bf16* EB = (const bf16*)(ws + WS_E); bf16* YC = (bf16*)(ws + WS_YA);
    LAS float* buf0 = (LAS float*)lds; LAS float* buf1 = buf0 + T * TOKF;
    const bool producer = wave >= 4;
    const int pt = tid - 256, tok = pt >> 3, ks = (pt & 7) * 8;
    float kkk[8], kka[8];
    if (producer) {
#pragma unroll
        for (int i = 0; i < 8; ++i) { kkk[i] = P.in[22][L * 512 + h * 64 + ks + i]; kka[i] = P.in[23][L * 512 + h * 64 + ks + i]; } }
    const int row = wave * 4 + (lane >> 4), kq = lane & 15;
    f32x4 S = {0.f, 0.f, 0.f, 0.f};
    const size_t m00 = (size_t)b * SEQ;
#define RW_PRODUCE(c, buf) do { const size_t m_ = m00 + (size_t)(c) * T + tok; const bf16* zr_ = Z + m_ * ZP; \
        float r_[8], k_[8], a_[8], e_[8]; unpack8(*(const v4u*)(zr_ + h * 64 + ks), r_); unpack8(*(const v4u*)(zr_ + 512 + h * 64 + ks), k_); \
        unpack8(*(const v4u*)(AB + m_ * 512 + h * 64 + ks), a_); unpack8(*(const v4u*)(EB + m_ * 512 + h * 64 + ks), e_); \
        float kk_[8], ss_ = 0.f; _Pragma("unroll") for (int i = 0; i < 8; ++i) { kk_[i] = k_[i] * kkk[i]; ss_ += kk_[i] * kk_[i]; } \
        ss_ += __shfl_xor(ss_, 1); ss_ += __shfl_xor(ss_, 2); ss_ += __shfl_xor(ss_, 4); const float inv_ = 1.f / fmaxf(sqrtf(ss_), 1e-12f); \
        LAS float* d_ = (buf) + tok * TOKF + ks; f32x4 o0, o1; \
        o0 = (f32x4){-kk_[0] * inv_, -kk_[1] * inv_, -kk_[2] * inv_, -kk_[3] * inv_}; o1 = (f32x4){-kk_[4] * inv_, -kk_[5] * inv_, -kk_[6] * inv_, -kk_[7] * inv_}; *(LAS f32x4*)(d_) = o0; *(LAS f32x4*)(d_ + 4) = o1; \
        o0 = (f32x4){kk_[0] * inv_ * a_[0], kk_[1] * inv_ * a_[1], kk_[2] * inv_ * a_[2], kk_[3] * inv_ * a_[3]}; o1 = (f32x4){kk_[4] * inv_ * a_[4], kk_[5] * inv_ * a_[5], kk_[6] * inv_ * a_[6], kk_[7] * inv_ * a_[7]}; *(LAS f32x4*)(d_ + 64) = o0; *(LAS f32x4*)(d_ + 68) = o1; \
        o0 = (f32x4){__expf(-e_[0]), __expf(-e_[1]), __expf(-e_[2]), __expf(-e_[3])}; o1 = (f32x4){__expf(-e_[4]), __expf(-e_[5]), __expf(-e_[6]), __expf(-e_[7])}; *(LAS f32x4*)(d_ + 128) = o0; *(LAS f32x4*)(d_ + 132) = o1; \
        o0 = (f32x4){k_[0] * (1.f + (a_[0] - 1.f) * kka[0]), k_[1] * (1.f + (a_[1] - 1.f) * kka[1]), k_[2] * (1.f + (a_[2] - 1.f) * kka[2]), k_[3] * (1.f + (a_[3] - 1.f) * kka[3])}; \
        o1 = (f32x4){k_[4] * (1.f + (a_[4] - 1.f) * kka[4]), k_[5] * (1.f + (a_[5] - 1.f) * kka[5]), k_[6] * (1.f + (a_[6] - 1.f) * kka[6]), k_[7] * (1.f + (a_[7] - 1.f) * kka[7])}; *(LAS f32x4*)(d_ + 192) = o0; *(LAS f32x4*)(d_ + 196) = o1; \
        o0 = (f32x4){r_[0], r_[1], r_[2], r_[3]}; o1 = (f32x4){r_[4], r_[5], r_[6], r_[7]}; *(LAS f32x4*)(d_ + 256) = o0; *(LAS f32x4*)(d_ + 260) = o1; \
        if ((pt & 7) < 2) { float v_[8]; unpack8(*(const v4u*)(zr_ + 1024 + h * 64 + qr * 16 + ks), v_); LAS float* dv_ = (buf) + tok * TOKF + 320 + ks; \
            *(LAS f32x4*)(dv_) = (f32x4){v_[0], v_[1], v_[2], v_[3]}; *(LAS f32x4*)(dv_ + 4) = (f32x4){v_[4], v_[5], v_[6], v_[7]}; } } while (0)
    if (producer) RW_PRODUCE(0, buf0);
    __syncthreads();
    for (int c = 0; c < SEQ / T; ++c) {
        LAS float* cur = (c & 1) ? buf1 : buf0; LAS float* nxt = (c & 1) ? buf0 : buf1;
        if (producer) { if (c + 1 < SEQ / T) RW_PRODUCE(c + 1, nxt); }
        else {
            bf16* yo = YC + (m00 + (size_t)c * T) * 512 + h * 64 + qr * 16 + row;
#pragma unroll 4
            for (int t = 0; t < T; ++t) { const LAS float* bs = cur + t * TOKF + kq * 4;
                const f32x4 a4 = *(const LAS f32x4*)(bs), b4 = *(const LAS f32x4*)(bs + 64), w4 = *(const LAS f32x4*)(bs + 128), k4 = *(const LAS f32x4*)(bs + 192), r4 = *(const LAS f32x4*)(bs + 256);
                const float vv = cur[t * TOKF + 320 + row];
                float sa = (S.x * a4.x + S.y * a4.y) + (S.z * a4.z + S.w * a4.w); sa = row16_sum(sa);
                S = S * w4 + (b4 * sa + k4 * vv);
                float y = (S.x * r4.x + S.y * r4.y) + (S.z * r4.z + S.w * r4.w); y = row16_sum(y);
                if (kq == 0) yo[(size_t)t * 512] = (bf16)f2bf(y); }
        }
        __syncthreads();
    }
#undef RW_PRODUCE
}

__device__ __forceinline__ void post_phase(const Ptrs& P, int L, LAS unsigned char* lds, int gw, int NGW, int tid, int wave, int lane) {
    asm volatile("" : "+v"(tid), "+v"(lane)); asm volatile("" : "+s"(wave));
    unsigned char* ws = P.ws;
    LAS bf16* g2s = (LAS bf16*)lds;
    const float* g2 = P.in[21] + (size_t)L * 96 * 512;
    for (int i = tid; i < 96 * 512; i += NTHR) g2s[i] = (bf16)f2bf(g2[i]);
    __syncthreads();
    const float lam_init = (L == 0) ? 0.2f : 0.35550906f;
    const float* lv = P.in[14] + L * 256;
    const float lam = __expf(wave_sum(lv[lane] * lv[64 + lane])) - __expf(wave_sum(lv[128 + lane] * lv[192 + lane])) + lam_init;
    const int c0 = lane * 8;
    float sg[8], lng[8], lnb[8], rk[8], ka[8];
#pragma unroll
    for (int i = 0; i < 8; ++i) { sg[i] = P.in[15][L * 128 + ((c0 + i) & 127)] * (1.f - lam_init); lng[i] = P.in[25][L * 512 + c0 + i]; lnb[i] = P.in[26][L * 512 + c0 + i]; rk[i] = P.in[24][L * 512 + c0 + i]; ka[i] = P.in[23][L * 512 + c0 + i]; }
    const float* xsrc = (L == 0) ? P.in[0] : P.out;
    for (int m = gw; m < M; m += NGW) {
        bf16* zr = (bf16*)(ws + WS_Z) + (size_t)m * ZP;
        float r[8], k[8], v[8], a[8], yr[8];
        unpack8(*(const v4u*)(zr + c0), r); unpack8(*(const v4u*)(zr + 512 + c0), k); unpack8(*(const v4u*)(zr + 1024 + c0), v);
        unpack8(*(const v4u*)((const bf16*)(ws + WS_AB) + (size_t)m * 512 + c0), a); unpack8(*(const v4u*)((const bf16*)(ws + WS_YA) + (size_t)m * 512 + c0), yr);
        const float z0 = sigm(bf2f(zr[1600 + (lane & 31)])), z1 = sigm(bf2f(zr[1632 + (lane & 31)])), z2 = sigm(bf2f(zr[1664 + (lane & 31)]));
        float s1 = 0.f;
#pragma unroll
        for (int i = 0; i < 8; ++i) s1 += yr[i];
        s1 += __shfl_xor(s1, 1); s1 += __shfl_xor(s1, 2); s1 += __shfl_xor(s1, 4); const float mean = s1 * (1.f / 64.f);
        float s2 = 0.f, bd = 0.f;
#pragma unroll
        for (int i = 0; i < 8; ++i) { const float d = yr[i] - mean; s2 += d * d; bd += r[i] * (k[i] * (1.f + (a[i] - 1.f) * ka[i])) * rk[i]; }
        s2 += __shfl_xor(s2, 1); s2 += __shfl_xor(s2, 2); s2 += __shfl_xor(s2, 4); bd += __shfl_xor(bd, 1); bd += __shfl_xor(bd, 2); bd += __shfl_xor(bd, 4);
        const float rstd = 1.f / sqrtf(s2 * (1.f / 64.f) + 64e-5f);
        float gacc[8];
#pragma unroll
        for (int i = 0; i < 8; ++i) gacc[i] = 0.f;
#pragma unroll 8
        for (int j = 0; j < 32; ++j) { const float t0 = __shfl(z0, j), t1 = __shfl(z1, j), t2 = __shfl(z2, j); float w0[8], w1[8], w2[8];
            unpack8(*(const LAS v4u*)(g2s + j * 512 + c0), w0); unpack8(*(const LAS v4u*)(g2s + (32 + j) * 512 + c0), w1); unpack8(*(const LAS v4u*)(g2s + (64 + j) * 512 + c0), w2);
#pragma unroll
            for (int i = 0; i < 8; ++i) gacc[i] += t0 * w0[i] + t1 * w1[i] + t2 * w2[i]; }
        float yc[8];
#pragma unroll
        for (int i = 0; i < 8; ++i) yc[i] = ((yr[i] - mean) * rstd * lng[i] + lnb[i] + bd * v[i]) * gacc[i];
        const int hd = lane >> 4, j0 = (lane & 15) * 8; const bf16* orow = (const bf16*)(ws + WS_O) + (size_t)m * 1024 + hd * 256 + j0;
        float o0[8], o1[8]; unpack8(*(const v4u*)orow, o0); unpack8(*(const v4u*)(orow + 128), o1);
        float so = 0.f;
#pragma unroll
        for (int i = 0; i < 8; ++i) { o0[i] = o0[i] - lam * o1[i]; so += o0[i] * o0[i]; }
        so += __shfl_xor(so, 1); so += __shfl_xor(so, 2); so += __shfl_xor(so, 4); so += __shfl_xor(so, 8);
        const float ro = 1.f / sqrtf(so * (1.f / 128.f) + 1e-5f);
#pragma unroll
        for (int i = 0; i < 8; ++i) o0[i] *= ro * sg[i];
        *(v4u*)(zr + c0) = pack8(yc); *(v4u*)(zr + 512 + c0) = pack8(o0);
        rms_row(xsrc + (size_t)m * 1024, P.in[1] + L * 1024, (bf16*)(ws + WS_XN) + (size_t)m * 1024, lane);
    }
    __syncthreads();
}


__device__ __forceinline__ void dump_stage(const Ptrs& P, int k, int blk, int G, int tid) {
    unsigned char* ws = P.ws; float* out = P.out;
    for (size_t i = (size_t)blk * NTHR + tid; i < (size_t)M * 1024; i += (size_t)G * NTHR) {
        const size_t m = i >> 10; const int c = (int)(i & 1023); float v = 0.f;
        const bf16* Z = (const bf16*)(ws + WS_Z); const bf16* US = (const bf16*)(ws + WS_US);
        if (k == 1) v = bf2f(Z[m * ZP + c]) + bf2f(Z[m * ZP + 704 + c]) + bf2f(((const bf16*)(ws + WS_QB))[m * 512 + (c & 511)]) + bf2f(((const bf16*)(ws + WS_KB))[m * 512 + (c & 511)]) + bf2f(((const bf16*)(ws + WS_VB))[m * 512 + (c & 511)]) + bf2f(US[m * 768 + (c % 768)]);
        else if (k == 2) {
#if !defined(DSEL) || DSEL==1
            v += bf2f(US[m * 768 + (c % 768)]);
#endif
#if !defined(DSEL) || DSEL==2
            v += bf2f(((const bf16*)(ws + WS_E))[m * 512 + (c & 511)]) + bf2f(((const bf16*)(ws + WS_AB))[m * 512 + (c & 511)]);
#endif
#if !defined(DSEL) || DSEL==3
            v += bf2f(((const bf16*)(ws + WS_QB))[m * 512 + (c & 511)]) + bf2f(((const bf16*)(ws + WS_KB))[m * 512 + (c & 511)]);
#endif
#if !defined(DSEL) || DSEL==4
            v += bf2f(Z[m * ZP + 1024 + (c & 511)]) + bf2f(((const bf16*)(ws + WS_VF))[m * 512 + (c & 511)]);
#endif
        }
        else if (k == 3) v = bf2f(((const bf16*)(ws + WS_O))[m * 1024 + c]) + bf2f(((const bf16*)(ws + WS_YA))[m * 512 + (c & 511)]) + bf2f(US[m * 768 + (c % 768)]);
        else if (k == 4) v = bf2f(Z[m * ZP + c]) + bf2f(((const bf16*)(ws + WS_XN))[m * 1024 + c]) + bf2f(((const bf16*)(ws + WS_YL))[m * 512 + (c & 511)]);
        else if (k == 5) v = bf2f(((const bf16*)(ws + WS_YA))[m * 512 + (c & 511)]);
        else if (k == 6) v = bf2f(((const bf16*)(ws + WS_MERGED))[m * 1024 + c]);
        else if (k == 9) v = bf2f(((const bf16*)(ws + WS_HID))[m * DFF + c]) + bf2f(((const bf16*)(ws + WS_HID))[m * DFF + 1024 + c]) + bf2f(((const bf16*)(ws + WS_H2N))[m * 1024 + c]);
        out[i] = v;
    }
}
#define GSYNC() do { asm volatile("s_waitcnt vmcnt(0) lgkmcnt(0)" ::: "memory"); __builtin_amdgcn_fence(__ATOMIC_RELEASE, "agent"); asm volatile("s_waitcnt vmcnt(0)" ::: "memory"); grid.sync(); __builtin_amdgcn_fence(__ATOMIC_ACQUIRE, "agent"); asm volatile("s_waitcnt vmcnt(0)" ::: "memory"); } while (0)
struct Args { Ptrs p; int pad0, pad1; };
__global__ void __launch_bounds__(NTHR, 2) mega_fwd(Args args) {
    extern __shared__ __attribute__((aligned(16))) unsigned char lds_raw[];
    LAS unsigned char* lds = (LAS unsigned char*)lds_raw;
    cg::grid_group grid = cg::this_grid();
    const Ptrs& P = args.p;
    unsigned char* ws = P.ws;
    const int tid0 = threadIdx.x, wave0 = __builtin_amdgcn_readfirstlane(tid0 >> 6);
    const int wave = wave0;
    const int G0 = gridDim.x, blk0 = blockIdx.x;
    const int gw0 = blk0 * NWAVES + wave, NGW0 = G0 * NWAVES;
    unsigned* ctl = (unsigned*)(ws + WS_CTL);
    for (int L = 0; L < 2; ++L) {
        int gw = gw0, NGW = NGW0, blk = blk0, G = G0; asm volatile("" : "+s"(gw), "+s"(NGW), "+s"(blk), "+s"(G));
        int tid = tid0; asm volatile("" : "+v"(tid)); int lane = tid & 63;
#define RELAUNDER() do { asm volatile("" : "+v"(tid)); lane = tid & 63; asm volatile("" : "+s"(gw), "+s"(NGW), "+s"(blk), "+s"(G)); } while (0)
        const float* xsrc = (L == 0) ? P.in[0] : P.out;
#if !defined(ONLY) || ONLY==0
        if (blk < 32) s5_tables(P, L, blk, (LAS float*)lds, tid);
        weight_items(P, L, gw, NGW, (LAS float*)(lds + wave * 16384), lane);
        for (int i = blk * NTHR + tid; i < 96 * 2048 / 8; i += G * NTHR) ((v4u*)((bf16*)(ws + WS_W1B) + (size_t)1696 * 2048))[i] = (v4u){0u, 0u, 0u, 0u};
        if (blk < 4) { for (int i = tid; i < 128; i += NTHR) ((v4u*)((bf16*)(ws + WS_XNP) + (size_t)blk * 4097 * 1024))[i] = (v4u){0u, 0u, 0u, 0u}; }
        for (int m = gw; m < M; m += NGW) rms_row(xsrc + (size_t)m * 1024, P.in[1] + L * 1024, (bf16*)(ws + WS_XNP) + ((size_t)(m >> 12) * 4097 + 1 + (m & 4095)) * 1024, lane);
        GSYNC(); RELAUNDER();
#endif
#if !defined(ONLY) || ONLY==1
        { pg8::Gemm g = mkgemm((const bf16*)(ws + WS_XNP) + 1024, (const bf16*)(ws + WS_W1A), M, 2048, 1024, 1024, 1024); g.a_skip_shift = 4; g.a_skip_bytes = 2048;
          Epi8<1> E{(bf16*)(ws + WS_QB), 512, (const bf16*)(ws + WS_US), nullptr};
#if !defined(SUB) || SUB==0
          run_gemm(lds, g, E, G, blk);
#endif
          }
        { pg8::Gemm g = mkgemm((const bf16*)(ws + WS_XNP) + 1024, (const bf16*)(ws + WS_W1B), M, 1792, 2048, 1024, 2048); g.a_skip_shift = 4; g.a_skip_bytes = 2048; g.kwrap = 16; g.wrap_bytes = 4096;
          Epi8<0> E{(bf16*)(ws + WS_Z), ZP, nullptr, nullptr};
#if !defined(SUB) || SUB==1
          run_gemm(lds, g, E, G, blk);
#endif
          }
        GSYNC(); RELAUNDER();
#if defined(STOP_AFTER) && STOP_AFTER==1
        dump_stage(P, 1, blk, G, tid); return;
#endif
#endif
#if !defined(ONLY) || ONLY==2
        { pg8::Gemm g = mkgemm((const bf16*)(ws + WS_US), (const bf16*)(ws + WS_PT), 32768, 256, 256, 384, 256); g.b_shift = 2; g.b_stride_bytes = 128 * 256 * 2;
          Epi8<2> E{(bf16*)(ws + WS_US), 384, nullptr, nullptr}; run_gemm(lds, g, E, G, blk); }
        __syncthreads();
        prep_phase(P, L, lds, gw, NGW, tid, wave, lane);
        GSYNC(); RELAUNDER();
#if defined(STOP_AFTER) && STOP_AFTER==2
        dump_stage(P, 2, blk, G, tid); return;
#endif
#endif
#if !defined(ONLY) || ONLY==3
        if (blk < 128) rwkv_unit(P, L, lds, blk >> 5, (blk >> 2) & 7, blk & 3, tid, wave, lane);
        else if (blk >= G - 16) s5_chunk_scan(P, L, (blk - (G - 16)) * NTHR + tid);
        __syncthreads();
        {
            volatile LAS unsigned* qslot = (volatile LAS unsigned*)(lds + 140000);
            for (;;) {
                if (tid == 0) qslot[0] = atomicAdd(ctl + 64 * L, 1u);
                __syncthreads();
                const unsigned uidx = qslot[0];
                __syncthreads();
                if (uidx >= 1024u) break;
                const int qb = 15 - (int)(uidx >> 6), bhv = uidx & 63, b = bhv >> 4, hv = bhv & 15, hh = hv >> 2, cc = (hv >> 1) & 1, half = hv & 1;
                attn_body::attn_unit<8>(b, (2 * hh + cc) * 64, (2 * hh + cc) * 64, (2 * hh + half) * 64, hv * 64, qb,
                    (const attn_body::bf16*)(ws + WS_QB), (const attn_body::bf16*)(ws + WS_KB), (const attn_body::bf16*)(ws + WS_VB), (attn_body::bf16*)(ws + WS_O), (char*)lds_raw);
            }
        }
        GSYNC(); RELAUNDER();
#if defined(STOP_AFTER) && STOP_AFTER==3
        dump_stage(P, 3, blk, G, tid); return;
#endif
#endif
#if !defined(ONLY) || ONLY==4
        { pg8::Gemm g = mkgemm((const bf16*)(ws + WS_US), (const bf16*)(ws + WS_MT), 32768, 256, 384, 384, 384); g.b_shift = 2; g.b_stride_bytes = 256 * 384 * 2;
          Epi8<3> E{(bf16*)(ws + WS_YL), 512, (const bf16*)(ws + WS_US), P.in[10] + L * 512}; run_gemm(lds, g, E, G, blk); }
        __syncthreads();
        { const float* w_in = P.in[2] + (size_t)L * 1024 * NIN; LAS float* scr = (LAS float*)(lds + wave * 16384);
          for (int it = gw; it < 16 * 96; it += NGW) { const int kb = it / 96, nb = it % 96; tr_item(w_in, NIN, kb * 64, 3744 + nb * 32, (bf16*)(ws + WS_WG), 1024, nb * 32, 0, nullptr, 0, scr, lane); } }
        __syncthreads();
        post_phase(P, L, lds, gw, NGW, tid, wave, lane);
        GSYNC(); RELAUNDER();
#if defined(STOP_AFTER) && STOP_AFTER==4
        dump_stage(P, 4, blk, G, tid); return;
#endif
#endif
#if !defined(ONLY) || ONLY==5
        { pg8::Gemm g = mkgemm((const bf16*)(ws + WS_YL), (const bf16*)(ws + WS_WGLU), M, 512, 512, 512, 512);
          Epi8<4> E{(bf16*)(ws + WS_YA), 512, (const bf16*)(ws + WS_YL), nullptr}; run_gemm(lds, g, E, G, blk); }
        GSYNC(); RELAUNDER();
#if defined(STOP_AFTER) && STOP_AFTER==5
        dump_stage(P, 5, blk, G, tid); return;
#endif
        for (int n = 1; n <= 2; ++n) {
            { pg8::Gemm g = mkgemm((const bf16*)(ws + WS_XN), (const bf16*)(ws + WS_WG) + (size_t)n * 1024 * 1024, M, 1024, 1024, 1024, 1024);
              Epi8<5> E{(bf16*)(ws + WS_G), 1024, nullptr, nullptr}; run_gemm(lds, g, E, G, blk); }
            { pg8::Gemm g = mkgemm((const bf16*)(ws + WS_Z) + (n == 1 ? 512 : 0), (const bf16*)(ws + WS_WB) + (size_t)n * 1024 * 512, M, 1024, 512, ZP, 512);
              if (n == 1) { Epi8<6> E{(bf16*)(ws + WS_MERGED), 1024, (const bf16*)(ws + WS_G), nullptr}; run_gemm(lds, g, E, G, blk); }
              else { Epi8<7> E{(bf16*)(ws + WS_MERGED), 1024, (const bf16*)(ws + WS_G), nullptr}; run_gemm(lds, g, E, G, blk); } }
        }
        GSYNC(); RELAUNDER();
#endif
#if !defined(ONLY) || ONLY==6
        { pg8::Gemm g = mkgemm((const bf16*)(ws + WS_XN), (const bf16*)(ws + WS_WG), M, 1024, 1024, 1024, 1024);
          Epi8<5> E{(bf16*)(ws + WS_G), 1024, nullptr, nullptr}; run_gemm(lds, g, E, G, blk); }
        { pg8::Gemm g = mkgemm((const bf16*)(ws + WS_YA), (const bf16*)(ws + WS_WB), M, 1024, 512, 512, 512);
          Epi8<7> E{(bf16*)(ws + WS_MERGED), 1024, (const bf16*)(ws + WS_G), nullptr}; run_gemm(lds, g, E, G, blk); }
        GSYNC(); RELAUNDER();
#if defined(STOP_AFTER) && STOP_AFTER==6
        dump_stage(P, 6, blk, G, tid); return;
#endif
#endif
#if !defined(ONLY) || ONLY==7
        { pg8::Gemm g = mkgemm((const bf16*)(ws + WS_MERGED), (const bf16*)(ws + WS_WO), M, 1024, 1024, 1024, 1024);
          EpiRes E{xsrc, P.out}; run_gemm(lds, g, E, G, blk); }
        GSYNC(); RELAUNDER();
#endif
#if !defined(ONLY) || ONLY==8
        for (int m = gw; m < M; m += NGW) rms_row(P.out + (size_t)m * 1024, P.in[32] + L * 1024, (bf16*)(ws + WS_H2N) + (size_t)m * 1024, lane);
        GSYNC(); RELAUNDER();
#endif
#if !defined(ONLY) || ONLY==9
        { pg8::Gemm g = mkgemm((const bf16*)(ws + WS_H2N), (const bf16*)(ws + WS_WFI), M, 2 * DFF, 1024, 1024, 1024);
          Epi8<8> E{(bf16*)(ws + WS_HID), DFF, nullptr, nullptr}; run_gemm(lds, g, E, G, blk); }
        GSYNC(); RELAUNDER();
#if defined(STOP_AFTER) && STOP_AFTER==9
        dump_stage(P, 9, blk, G, tid); return;
#endif
#endif
#if !defined(ONLY) || ONLY==10
        { pg8::Gemm g = mkgemm((const bf16*)(ws + WS_HID), (const bf16*)(ws + WS_WFO), M, 1024, DFF, DFF, DFF);
          EpiRes E{P.out, P.out}; run_gemm(lds, g, E, G, blk); }
#endif
        if (L == 0) GSYNC();
    }
}

extern "C" void kernel_launch(void* const* d_in, const int* in_sizes, int n_in, void* d_out, int out_size, void* d_ws, size_t ws_size, hipStream_t stream) {
    static int grid = 0;
    if (grid == 0) {
        if (n_in != 35 || out_size != M * DMOD || ws_size < WS_END) { fprintf(stderr, "kernel_launch: unexpected shapes (n_in %d out %d ws %zu)\n", n_in, out_size, ws_size); grid = -1; return; }
        int dev = 0, cus = 0, per_cu = 0;
        hipGetDevice(&dev); hipDeviceGetAttribute(&cus, hipDeviceAttributeMultiprocessorCount, dev);
        hipFuncSetAttribute((const void*)mega_fwd, hipFuncAttributeMaxDynamicSharedMemorySize, LDS_BYTES);
        hipOccupancyMaxActiveBlocksPerMultiprocessor(&per_cu, (const void*)mega_fwd, NTHR, LDS_BYTES);
        if (per_cu < 1) { fprintf(stderr, "kernel_launch: occupancy query says %d\n", per_cu); grid = -1; return; }
        grid = cus;
        if (grid < 144) { fprintf(stderr, "kernel_launch: grid %d too small\n", grid); grid = -1; return; }
    }
    if (grid < 0) return;
    hipMemsetAsync((char*)d_ws + WS_CTL, 0, 4096, stream);
    Args a{};
    for (int i = 0; i < 35; ++i) a.p.in[i] = (const float*)d_in[i];
    a.p.out = (float*)d_out; a.p.ws = (unsigned char*)d_ws;
    void* kargs[] = {&a};
    hipError_t e = hipLaunchCooperativeKernel((const void*)mega_fwd, dim3(grid), dim3(NTHR), kargs, LDS_BYTES, stream);
    if (e != hipSuccess) fprintf(stderr, "cooperative launch failed: %s (grid %d)\n", hipGetErrorString(e), grid);
}
```

```cpp
#include <hip/hip_runtime.h>
#include <hip/hip_cooperative_groups.h>
#include <cstdio>
#include <cstdint>

namespace pg8 {
#define PG8_LAS __attribute__((address_space(3)))
typedef unsigned short bf16_t;
typedef short bf16x8 __attribute__((ext_vector_type(8)));
typedef float f32x4 __attribute__((ext_vector_type(4)));
typedef unsigned u32x4 __attribute__((ext_vector_type(4)));
constexpr int BM = 256, BK = 64, HALF = 128, HTB = HALF * BK * 2  , STAGE_BYTES = 8 * HTB, NXCD = 8, WGM = 8;

__host__ __device__ __forceinline__ int lds_byte(int r, int c) { const int st = (r >> 4) * 2 + (c >> 5), rr = r & 15, cc = c & 31, ob = rr * 64 + cc * 2; return st * 1024 + (ob ^ (((ob >> 9) & 1) << 5)); }
__host__ __device__ __forceinline__ void stage_rc(int b, int& R, int& C) { const int st = b / 1024, sb = b % 1024, swz = sb ^ (((sb >> 9) & 1) << 5); R = (st >> 1) * 16 + swz / 64; C = (st & 1) * 32 + (swz % 64) / 2; }
__host__ __device__ __forceinline__ int perm32(int rho) { const int n = rho >> 4, i = rho & 15; return 8 * (i >> 2) + 4 * n + (i & 3); }

struct Unit { int pm, pn; };
struct Gemm { const bf16_t* A; const bf16_t* Bt; int M, N, K; int lda, ldb; int a_skip_shift; int a_skip_bytes; int kwrap; int wrap_bytes; int b_shift; int b_stride_bytes;
  __device__ __forceinline__ const char* abase(const Unit& u) const { return (const char*)A + (size_t)u.pm * (size_t)(256 * 2) * lda + (size_t)(u.pm >> a_skip_shift) * a_skip_bytes; }
  __device__ __forceinline__ const char* bbase(const Unit& u) const { return (const char*)Bt + (size_t)u.pn * (size_t)(256 * 2) * ldb + (size_t)(u.pm >> b_shift) * b_stride_bytes; } };

struct StaticOrder {
    int nM, nN, nwg, G, c;
    __host__ __device__ void init(int M, int N, int G_, int c_) { nM = M / BM; nN = N / BM; nwg = nM * nN; G = G_; c = c_; }
    __host__ __device__ bool next(int i, Unit& u) const {
        const long L = (long)i * G + c; if (L >= nwg) return false;
        int wgid = (int)L; { const int q = nwg / NXCD, r = nwg % NXCD, xcd = wgid % NXCD, off = wgid / NXCD; wgid = (xcd < r ? xcd * (q + 1) : r * (q + 1) + (xcd - r) * q) + off; }
        const int nig = WGM * nN, gid = wgid / nig, fm = gid * WGM, gsz = (nM - fm) < WGM ? (nM - fm) : WGM;
        u.pm = fm + ((wgid % nig) % gsz); u.pn = (wgid % nig) / gsz; return true;
    }
    __device__ __forceinline__ void a_ready(const Unit&) const {}
    __device__ __forceinline__ void done(const Unit&) const {}
};

typedef float cvt_f32x2_t __attribute__((ext_vector_type(2))); typedef __bf16 cvt_bf16x2_t __attribute__((ext_vector_type(2)));
__device__ __forceinline__ unsigned cvt_pk_bf16(float lo, float hi) { cvt_f32x2_t v = {lo, hi}; cvt_bf16x2_t b = __builtin_convertvector(v, cvt_bf16x2_t); return __builtin_bit_cast(unsigned, b); }
typedef float f32x2 __attribute__((ext_vector_type(2)));
__device__ __forceinline__ f32x2 gelu_pk(f32x2 v) {
    const f32x2 av = __builtin_elementwise_abs(v), d = av * 0.2316418882f + 1.0f;
    f32x2 t; t.x = __builtin_amdgcn_rcpf(d.x); t.y = __builtin_amdgcn_rcpf(d.y);
    f32x2 q = t * 0.5307027145f + (-0.7265760135f); q = q * t + 0.7107068705f; q = q * t + (-0.142248368f); q = q * t + 0.127414796f; q = q * t;
    const f32x2 s = (v * v) * (-0.72134752044f);
    f32x2 e; e.x = __builtin_amdgcn_exp2f(s.x); e.y = __builtin_amdgcn_exp2f(s.y);
    const f32x2 m = v * (q * e), r = v - m;
    f32x2 o; o.x = v.x < 0.f ? m.x : r.x; o.y = v.y < 0.f ? m.y : r.y; return o;
}

template <int ACT  > struct EpiBf16 {
    static constexpr bool PERM = true, AFTER_DRAIN = false; static_assert(ACT == 0 || ACT == 1, "EpiBf16: ACT is 0 (none) or 1 (gelu_pk)");
    bf16_t* O; int ldc; const float* bias; int split_cols; size_t split_stride; float scale0;
    __device__ __forceinline__ void operator()(const f32x4 (&acc)[2][2][4][2], const Unit& u, int wr, int wc, int fr, int fq) const {
        const int row0 = u.pm * BM + wr * 64 + fr; int colt = u.pn * BM; bf16_t* base = O;
        float sc = 1.f; if (split_cols) { const int t = colt / split_cols; base += (size_t)t * split_stride; colt -= t * split_cols; if (t == 0) sc = scale0; }
        const int col0 = colt + wc * 32 + 8 * fq, bcol0 = u.pn * BM + wc * 32 + 8 * fq;
        f32x4 bv[2][2];
#pragma unroll
        for (int bj = 0; bj < 2; ++bj)
#pragma unroll
            for (int n = 0; n < 2; ++n) bv[bj][n] = bias ? *(const f32x4*)(bias + bcol0 + bj * HALF + 4 * n) : (f32x4){0.f, 0.f, 0.f, 0.f};
#pragma unroll
        for (int ai = 0; ai < 2; ++ai)
#pragma unroll
            for (int m = 0; m < 4; ++m) { bf16_t* rowp = base + (size_t)(row0 + ai * HALF + m * 16) * ldc + col0;
#pragma unroll
                for (int bj = 0; bj < 2; ++bj) { f32x4 v0 = acc[ai][bj][m][0] + bv[bj][0], v1 = acc[ai][bj][m][1] + bv[bj][1];
                    if (ACT == 1) { f32x2 a = gelu_pk((f32x2){v0[0], v0[1]}), b = gelu_pk((f32x2){v0[2], v0[3]}), c = gelu_pk((f32x2){v1[0], v1[1]}), d = gelu_pk((f32x2){v1[2], v1[3]});
                        v0 = (f32x4){a.x, a.y, b.x, b.y}; v1 = (f32x4){c.x, c.y, d.x, d.y}; }
                    v0 = v0 * sc; v1 = v1 * sc; u32x4 w; w.x = cvt_pk_bf16(v0[0], v0[1]); w.y = cvt_pk_bf16(v0[2], v0[3]); w.z = cvt_pk_bf16(v1[0], v1[1]); w.w = cvt_pk_bf16(v1[2], v1[3]);
                    *(u32x4*)(rowp + bj * HALF) = w; } }
    }
};
template <class Epi, class Sched, bool ALIGN_EPI = false, bool SP2 = false>
__device__ __forceinline__ void gemm_phase(PG8_LAS unsigned char* lds, const Gemm g, const Sched& S, const Epi& E) {
    int tid_l = threadIdx.x; asm volatile("" : "+v"(tid_l)); const int tid = tid_l, wid = __builtin_amdgcn_readfirstlane(tid >> 6), lane = tid & 63, wr = wid >> 2, wc = wid & 3, fr = lane & 15, fq = lane >> 4;
    const int K = g.K, nt = K / BK;
    unsigned voffA[2], voffB[2];
#pragma unroll
    for (int i = 0; i < 2; ++i) { int R, C; stage_rc(tid * 16 + i * 8192, R, C); const int Rb = Epi::PERM ? ((R & ~31) + perm32(R & 31)) : R;
        voffA[i] = (unsigned)(R * g.lda + C) * 2u; voffB[i] = (unsigned)(Rb * g.ldb + C) * 2u; }
    const size_t kstep = (size_t)(BK * 2);
    const size_t hstepA = (size_t)HALF * g.lda * 2, hstepB = (size_t)HALF * g.ldb * 2; const size_t wrapb = (size_t)g.wrap_bytes;
    const unsigned ldsw = (unsigned)wid * 1024u;
    const int aoff = lds_byte(wr * 64 + fr, fq * 8), boff = lds_byte(wc * 32 + fr, fq * 8);
#define PG8_SA(b, h) (((b) * 2 + (h)) * HTB)
#define PG8_SB(b, h) ((4 + (b) * 2 + (h)) * HTB)
#define PG8_STAGE(bufoff, gbase, voff) do { _Pragma("unroll") for (int _i = 0; _i < 2; ++_i) \
        __builtin_amdgcn_global_load_lds((const unsigned*)((const char*)(gbase) + (voff)[_i]), (PG8_LAS unsigned*)(lds + (bufoff) + ldsw + _i * 8192), 16, 0, 0); } while (0)
#define PG8_LDA(dst, b, h) do { _Pragma("unroll") for (int m = 0; m < 4; ++m) _Pragma("unroll") for (int k = 0; k < 2; ++k) dst[m][k] = *(const PG8_LAS bf16x8*)(lds + PG8_SA(b, h) + aoff + m * 2048 + k * 1024); } while (0)
#define PG8_LDB(dst, b, h) do { _Pragma("unroll") for (int n = 0; n < 2; ++n) _Pragma("unroll") for (int k = 0; k < 2; ++k) dst[n][k] = *(const PG8_LAS bf16x8*)(lds + PG8_SB(b, h) + boff + n * 2048 + k * 1024); } while (0)
#define PG8_MMA(ai, bj, At, Bt) do { __builtin_amdgcn_s_setprio(1); _Pragma("unroll") for (int m = 0; m < 4; ++m) _Pragma("unroll") for (int n = 0; n < 2; ++n) _Pragma("unroll") for (int k = 0; k < 2; ++k) \
        acc[ai][bj][m][n] = __builtin_amdgcn_mfma_f32_16x16x32_bf16(Bt[n][k], At[m][k], acc[ai][bj][m][n], 0, 0, 0); __builtin_amdgcn_s_setprio(0); } while (0)
#define PG8_WAIT_V(n) asm volatile("s_waitcnt vmcnt(" #n ")" ::: "memory")
#define PG8_WAIT_L(n) asm volatile("s_waitcnt lgkmcnt(" #n ")" ::: "memory")
#define PG8_BAR __builtin_amdgcn_s_barrier()
#define PG8_SCHED __builtin_amdgcn_sched_barrier(0)
    Unit cur, nxt; int ui = 0;
    if (!S.next(0, cur)) return;
    f32x4 acc[2][2][4][2];
#pragma unroll
    for (int a = 0; a < 2; ++a)
#pragma unroll
        for (int b = 0; b < 2; ++b)
#pragma unroll
            for (int m = 0; m < 4; ++m)
#pragma unroll
                for (int n = 0; n < 2; ++n) acc[a][b][m][n] = (f32x4){0.f, 0.f, 0.f, 0.f};
    bf16x8 At[4][2], B0[2][2], B1[2][2];
    const char* cA = g.abase(cur); const char* cB = g.bbase(cur);
    S.a_ready(cur);
    if constexpr (SP2) {
        PG8_STAGE(PG8_SB(0, 0), cB, voffB); PG8_STAGE(PG8_SB(0, 1), cB + hstepB, voffB); PG8_STAGE(PG8_SA(0, 0), cA, voffA); PG8_STAGE(PG8_SA(0, 1), cA + hstepA, voffA);
        if (wr == 1) PG8_BAR;
        PG8_WAIT_V(2); PG8_BAR;
        PG8_STAGE(PG8_SB(1, 0), cB + kstep, voffB); PG8_STAGE(PG8_SA(1, 0), cA + kstep, voffA); PG8_STAGE(PG8_SB(1, 1), cB + hstepB + kstep, voffB);
        PG8_WAIT_V(6); PG8_BAR;
    } else {
        PG8_STAGE(PG8_SB(0, 0), cB, voffB); PG8_STAGE(PG8_SA(0, 0), cA, voffA); PG8_STAGE(PG8_SB(0, 1), cB + hstepB, voffB); PG8_STAGE(PG8_SA(0, 1), cA + hstepA, voffA);
        if (wr == 1) PG8_BAR;
        PG8_WAIT_V(4); PG8_BAR;
        PG8_STAGE(PG8_SB(1, 0), cB + kstep, voffB); PG8_STAGE(PG8_SA(1, 0), cA + kstep, voffA); PG8_STAGE(PG8_SB(1, 1), cB + hstepB + kstep, voffB);
        PG8_WAIT_V(6); PG8_BAR;
    }
    for (;;) {
        const bool has_next = S.next(ui + 1, nxt);
        const char* nA = has_next ? g.abase(nxt) : cA; const char* nB = has_next ? g.bbase(nxt) : cB;
        for (int t = 0; t < nt; t += 2) {
            const bool last = (t == nt - 2);
            const char* a1 = cA + (size_t)(t + 1) * kstep - ((t + 1) >= g.kwrap ? wrapb : (size_t)0);
            const char* a2 = last ? nA : cA + (size_t)(t + 2) * kstep - ((t + 2) >= g.kwrap ? wrapb : (size_t)0); const char* b2 = last ? nB : cB + (size_t)(t + 2) * kstep;
            const char* a3 = a2 + kstep; const char* b3 = b2 + kstep;
            if (last && has_next) S.a_ready(nxt);
            if constexpr (SP2) {
            PG8_LDB(B0, 0, 0); PG8_LDB(B1, 0, 1); PG8_SCHED; PG8_LDA(At, 0, 0); PG8_STAGE(PG8_SA(1, 1), a1 + hstepA, voffA);
            PG8_WAIT_V(8); PG8_WAIT_L(0); PG8_BAR; PG8_MMA(0, 0, At, B0); PG8_MMA(0, 1, At, B1); PG8_BAR; PG8_SCHED;
            PG8_LDA(At, 0, 1); PG8_STAGE(PG8_SB(0, 0), b2, voffB); PG8_STAGE(PG8_SB(0, 1), b2 + hstepB, voffB); PG8_STAGE(PG8_SA(0, 0), a2, voffA);
            PG8_WAIT_V(8); PG8_WAIT_L(0); PG8_BAR; PG8_MMA(1, 0, At, B0); PG8_MMA(1, 1, At, B1); PG8_BAR; PG8_SCHED;
            PG8_LDB(B0, 1, 0); PG8_LDB(B1, 1, 1); PG8_SCHED; PG8_LDA(At, 1, 0); PG8_STAGE(PG8_SA(0, 1), a2 + hstepA, voffA);
            PG8_WAIT_V(8); PG8_WAIT_L(0); PG8_BAR; PG8_MMA(0, 0, At, B0); PG8_MMA(0, 1, At, B1); PG8_BAR; PG8_SCHED;
            PG8_LDA(At, 1, 1); PG8_STAGE(PG8_SB(1, 0), b3, voffB); PG8_STAGE(PG8_SB(1, 1), b3 + hstepB, voffB); PG8_STAGE(PG8_SA(1, 0), a3, voffA);
            PG8_WAIT_V(8); PG8_WAIT_L(0); PG8_BAR; PG8_MMA(1, 0, At, B0); PG8_MMA(1, 1, At, B1); PG8_BAR; PG8_SCHED;
            } else {
            PG8_LDB(B0, 0, 0); PG8_SCHED; PG8_LDA(At, 0, 0); PG8_STAGE(PG8_SA(1, 1), a1 + hstepA, voffA);
            PG8_WAIT_L(8); PG8_BAR; PG8_WAIT_L(0); PG8_MMA(0, 0, At, B0); PG8_BAR; PG8_SCHED;
            PG8_LDB(B1, 0, 1); PG8_STAGE(PG8_SB(0, 0), b2, voffB);
            PG8_BAR; PG8_WAIT_L(0); PG8_MMA(0, 1, At, B1); PG8_BAR;
            PG8_LDA(At, 0, 1); PG8_STAGE(PG8_SA(0, 0), a2, voffA);
            PG8_BAR; PG8_WAIT_L(0); PG8_MMA(1, 0, At, B0); PG8_BAR; PG8_SCHED;
            PG8_STAGE(PG8_SB(0, 1), b2 + hstepB, voffB);
            PG8_WAIT_V(6); PG8_BAR; PG8_MMA(1, 1, At, B1); PG8_BAR;
            PG8_LDB(B0, 1, 0); PG8_SCHED; PG8_LDA(At, 1, 0); PG8_STAGE(PG8_SA(0, 1), a2 + hstepA, voffA);
            PG8_WAIT_L(8); PG8_BAR; PG8_WAIT_L(0); PG8_MMA(0, 0, At, B0); PG8_BAR; PG8_SCHED;
            PG8_LDB(B1, 1, 1); PG8_STAGE(PG8_SB(1, 0), b3, voffB);
            PG8_BAR; PG8_WAIT_L(0); PG8_MMA(0, 1, At, B1); PG8_BAR;
            PG8_LDA(At, 1, 1); PG8_STAGE(PG8_SA(1, 0), a3, voffA);
            PG8_BAR; PG8_WAIT_L(0); PG8_MMA(1, 0, At, B0); PG8_BAR; PG8_SCHED;
            PG8_STAGE(PG8_SB(1, 1), b3 + hstepB, voffB);
            PG8_WAIT_V(6); PG8_BAR; PG8_MMA(1, 1, At, B1); PG8_BAR;
            }
        }
        if constexpr (ALIGN_EPI) { if (wr == 0) PG8_BAR; }
        if constexpr (!Epi::AFTER_DRAIN) { E(acc, cur, wr, wc, fr, fq); S.done(cur); }
        if (!has_next) break;
#pragma unroll
        for (int a = 0; a < 2; ++a)
#pragma unroll
            for (int b = 0; b < 2; ++b)
#pragma unroll
                for (int m = 0; m < 4; ++m)
#pragma unroll
                    for (int n = 0; n < 2; ++n) acc[a][b][m][n] = (f32x4){0.f, 0.f, 0.f, 0.f};
        cur = nxt; cA = nA; cB = nB; ++ui;
        if constexpr (ALIGN_EPI) { if (wr == 1) PG8_BAR; }
    }
    PG8_WAIT_V(0);
    if constexpr (!ALIGN_EPI) { if (wr == 0) PG8_BAR; }
    PG8_BAR;
    if constexpr (Epi::AFTER_DRAIN) { E.fused(acc, cur, wr, wc, fr, fq, lds, wid, lane); S.done(cur); }
#undef PG8_SA
#undef PG8_SB
#undef PG8_STAGE
#undef PG8_LDA
#undef PG8_LDB
#undef PG8_MMA
#undef PG8_WAIT_V
#undef PG8_WAIT_L
#undef PG8_BAR
#undef PG8_SCHED
}
}
#include <hip/hip_bf16.h>
#include <cmath>
namespace attn_body {
using bf16=__hip_bfloat16;
using bf16x8=__attribute__((ext_vector_type(8)))short;
using s16x4=__attribute__((ext_vector_type(4)))short;
using f32x16=__attribute__((ext_vector_type(16)))float;
using u32x4=__attribute__((ext_vector_type(4)))unsigned;
constexpr int BATCH=4,NHEAD=16,SEQ=4096,D=64,DMQ=512,DMO=1024;
constexpr int NW=8,QBLK=32,QB=QBLK*NW,KVBLK=64,NQB=SEQ/QB;
constexpr int ATTN_UNIT_ROWS=QB;
__device__ __forceinline__ int crow(int r,int hi){return (r&3)+8*(r>>2)+4*hi;}
#define SBAR() __builtin_amdgcn_sched_barrier(0)
__device__ __forceinline__ void cmask(f32x16&p0,f32x16&p1,int jb,int qrel,int hi){
  const float NEG=-INFINITY; int kb=64*jb+4*hi;
  #pragma unroll
  for(int r=0;r<16;++r){int kv=kb+(r&3)+8*(r>>2); if(kv>qrel)p0[r]=NEG; if(kv+32>qrel)p1[r]=NEG;}
}

constexpr int NSLOT=3, SLOTB=8192;
constexpr int LDS_K=0, LDS_V=NSLOT*SLOTB, LDS_WS=2*NSLOT*SLOTB, LDS_OST=LDS_WS+NW*64*4, LDS_BYTES=LDS_OST+NW*4096;
constexpr float C2=0.125f*1.4426950408889634f;
__device__ __forceinline__ void glds16(const void*gsrc,unsigned lds_dst){unsigned keep;
  asm volatile("s_mov_b32 %0, m0\n\ts_mov_b32 m0, %2\n\ts_nop 0\n\tglobal_load_lds_dwordx4 %1, off\n\ts_mov_b32 m0, %0":"=&s"(keep):"v"(gsrc),"s"(lds_dst):"memory");}
__device__ __forceinline__ float max3f(float a,float b,float c){float r;asm("v_max3_f32 %0, %1, %2, %3":"=v"(r):"v"(a),"v"(b),"v"(c));return r;}
__device__ __forceinline__ float max2f(float a,float b){float r;asm("v_max_f32_e32 %0, %1, %2":"=v"(r):"v"(a),"v"(b));return r;}
__device__ __forceinline__ float fadd_s(float a,float b){float r;asm("v_add_f32_e32 %0, %1, %2":"=v"(r):"v"(a),"v"(b));return r;}
__device__ __forceinline__ float fsub_s(float a,float b){float r;asm("v_sub_f32_e32 %0, %1, %2":"=v"(r):"v"(a),"v"(b));return r;}
typedef float f32x2_t __attribute__((ext_vector_type(2))); typedef __bf16 bf16x2_t __attribute__((ext_vector_type(2)));
__device__ __forceinline__ unsigned cvtpk_s(float lo,float hi){f32x2_t v={lo,hi};bf16x2_t b=__builtin_convertvector(v,bf16x2_t);return __builtin_bit_cast(unsigned,b);}
#define WAIT_BAR(N) asm volatile("s_waitcnt vmcnt(" #N ") lgkmcnt(0)\n\ts_barrier":::"memory")

__device__ __forceinline__ void qkt(f32x16&p0,f32x16&p1,const char*Kslot,const bf16x8*qr,const f32x16&negm,int r32,int hi){
  const char*kb=Kslot+hi*1024+r32*16;
  #pragma unroll
  for(int d0=0;d0<4;++d0){
    const bf16x8 b0=*reinterpret_cast<const bf16x8*>(kb+d0*2048);
    const bf16x8 b1=*reinterpret_cast<const bf16x8*>(kb+d0*2048+512);
    if(d0==0){p0=__builtin_amdgcn_mfma_f32_32x32x16_bf16(b0,qr[0],negm,0,0,0);p1=__builtin_amdgcn_mfma_f32_32x32x16_bf16(b1,qr[0],negm,0,0,0);}
    else{p0=__builtin_amdgcn_mfma_f32_32x32x16_bf16(b0,qr[d0],p0,0,0,0);p1=__builtin_amdgcn_mfma_f32_32x32x16_bf16(b1,qr[d0],p1,0,0,0);}}
}
typedef __attribute__((address_space(3))) const char* lds_cptr;
typedef short v4i16_t __attribute__((ext_vector_type(4)));
__device__ __forceinline__ void kload8(bf16x8*kf,lds_cptr kp){
  kf[0]=*(const __attribute__((address_space(3))) bf16x8*)(kp);      kf[1]=*(const __attribute__((address_space(3))) bf16x8*)(kp+512);
  kf[2]=*(const __attribute__((address_space(3))) bf16x8*)(kp+2048); kf[3]=*(const __attribute__((address_space(3))) bf16x8*)(kp+2560);
  kf[4]=*(const __attribute__((address_space(3))) bf16x8*)(kp+4096); kf[5]=*(const __attribute__((address_space(3))) bf16x8*)(kp+4608);
  kf[6]=*(const __attribute__((address_space(3))) bf16x8*)(kp+6144); kf[7]=*(const __attribute__((address_space(3))) bf16x8*)(kp+6656);
}
__device__ __forceinline__ void kload2(bf16x8*kf,lds_cptr kp,int j){ kf[2*j]=*(const __attribute__((address_space(3))) bf16x8*)(kp+j*2048); kf[2*j+1]=*(const __attribute__((address_space(3))) bf16x8*)(kp+j*2048+512); }
__device__ __forceinline__ s16x4 vtr(lds_cptr p){ return __builtin_bit_cast(s16x4,__builtin_amdgcn_ds_read_tr16_b64_v4i16((__attribute__((address_space(3))) v4i16_t*)p)); }
__device__ __forceinline__ float rowmax(const f32x16&p0,const f32x16&p1){
  float a=max3f(p0[0],p0[1],p1[0]),b=max3f(p0[2],p0[3],p1[1]);a=max3f(a,p1[2],p1[3]);
  #pragma unroll
  for(int r=4;r<16;r+=4){a=max3f(a,p0[r],p0[r+1]);b=max3f(b,p0[r+2],p0[r+3]);a=max3f(a,p1[r],p1[r+1]);b=max3f(b,p1[r+2],p1[r+3]);}
  const float m=max2f(a,b);
  auto rr=__builtin_amdgcn_permlane32_swap(__float_as_uint(m),__float_as_uint(m),false,false);
  return max2f(__uint_as_float(rr[0]),__uint_as_float(rr[1]));
}
__device__ __forceinline__ void pv(f32x16*o,int vb,bf16x8 pa0,bf16x8 pa1,bf16x8 pa2,bf16x8 pa3){
  #pragma unroll
  for(int d0=0;d0<2;++d0){s16x4 lo[4],hi[4];
    #pragma unroll
    for(int ks=0;ks<4;++ks){
      asm volatile("ds_read_b64_tr_b16 %0,%1 offset:%c2":"=&v"(lo[ks]):"v"(vb),"i"(d0*4096+ks*1024):"memory");
      asm volatile("ds_read_b64_tr_b16 %0,%1 offset:%c2":"=&v"(hi[ks]):"v"(vb),"i"(d0*4096+ks*1024+512):"memory");}
    asm volatile("s_waitcnt lgkmcnt(0)":::"memory");SBAR();
    #define PK(k) (bf16x8){lo[k][0],lo[k][1],lo[k][2],lo[k][3],hi[k][0],hi[k][1],hi[k][2],hi[k][3]}
    o[d0]=__builtin_amdgcn_mfma_f32_32x32x16_bf16(pa0,PK(0),o[d0],0,0,0);
    o[d0]=__builtin_amdgcn_mfma_f32_32x32x16_bf16(pa1,PK(1),o[d0],0,0,0);
    o[d0]=__builtin_amdgcn_mfma_f32_32x32x16_bf16(pa2,PK(2),o[d0],0,0,0);
    o[d0]=__builtin_amdgcn_mfma_f32_32x32x16_bf16(pa3,PK(3),o[d0],0,0,0);
    #undef PK
  }
}

#ifndef ATTN_STORE16
#define ATTN_STORE16(p,v) (*(u32x4*)(p)=(v))
#endif
template<int THRL> __device__ __forceinline__ void attn_unit(int b,int cq,int ck,int cv,int co,int qb,const bf16*Q,const bf16*__restrict__ K,const bf16*__restrict__ V,bf16*O,char*shm){
  int tid_l=threadIdx.x; asm volatile("":"+v"(tid_l)); const int tid=tid_l,lane=tid&63,r32=lane&31,hi=lane>>5; const int wid=__builtin_amdgcn_readfirstlane(tid>>6);
  const long rowbase=(long)b*SEQ; const int q0=qb*QB;
  const bf16*Qw=Q+(rowbase+q0+wid*QBLK)*DMQ+cq;
  const bf16*Kh=K+rowbase*DMQ+ck,*Vh=V+rowbase*DMQ+cv;
  const unsigned lds0=(unsigned)(uintptr_t)shm;
  float*wsf=(float*)(shm+LDS_WS)+wid*64;
  const bf16*ksrc=Kh+(long)lane*DMQ+wid*8;
  const bf16*vsrc=Vh+(long)(16*(wid&3)+(lane>>2))*DMQ+(wid>>2)*32+(lane&3)*8;
  const unsigned kdst=lds0+LDS_K+wid*1024, vdst=lds0+LDS_V+wid*1024;
  #define DMA_K(t,slot) glds16(ksrc+(long)(t)*KVBLK*DMQ,(unsigned)__builtin_amdgcn_readfirstlane(kdst+(slot)))
  #define DMA_V(t,slot) glds16(vsrc+(long)(t)*KVBLK*DMQ,(unsigned)__builtin_amdgcn_readfirstlane(vdst+(slot)))
  const int vb0=(int)(lds0+LDS_V)+((lane>>4)&1)*32+(lane&3)*8+(4*hi+((lane&15)>>2))*64;
  const char*Kbase=shm+LDS_K; bf16x8 kf[8];
  const lds_cptr shm3=(lds_cptr)shm; const lds_cptr kp0=shm3+LDS_K+hi*1024+r32*16; const lds_cptr vp0=shm3+LDS_V+((lane>>4)&1)*32+(lane&3)*8+(4*hi+((lane&15)>>2))*64;
  const int NT=(q0+QB)/KVBLK;
  DMA_K(0,0);DMA_V(0,0);DMA_K(1,SLOTB);
  bf16x8 qr[4];
  #pragma unroll
  for(int d0=0;d0<4;++d0)qr[d0]=*reinterpret_cast<const bf16x8*>(&Qw[(long)r32*DMQ+d0*16+hi*8]);
  float mhat=0.f,l_reg=0.f;f32x16 o[2];o[0]=f32x16{};o[1]=f32x16{};f32x16 negm=f32x16{};asm volatile("":"+v"(negm));
  const int qrel=wid*QBLK+r32;
  #define CMASK(P0,P1,t) do{int jb_=(t)-(NT-4); if(jb_>=0)cmask(P0,P1,jb_,qrel,hi);}while(0)
  bool resc=false;
  #define START(P0,P1) do{ const float rm=rowmax(P0,P1); resc=false; \
    { const float dl=rm; mhat=fadd_s(mhat,dl); \
      _Pragma("unroll") for(int r=0;r<16;++r){P0[r]=fsub_s(P0[r],dl);P1[r]=fsub_s(P1[r],dl);} \
      _Pragma("unroll") for(int r=0;r<16;++r)negm[r]=-mhat; asm volatile("":"+v"(negm)); } \
    _Pragma("unroll") for(int r=0;r<16;++r)P0[r]=__builtin_amdgcn_exp2f(P0[r]); }while(0)
  #define RESC() do{ if(resc){ asm volatile("s_waitcnt lgkmcnt(0)":::"memory"); \
      _Pragma("unroll") for(int d_=0;d_<2;++d_) _Pragma("unroll") for(int r=0;r<16;++r)o[d_][r]*=wsf[crow(r,hi)]; } }while(0)
  f32x16 pA0,pA1,pB0,pB1;
  int sl_prev=0,sl_cur=0,sl_next=SLOTB;
  #define ROT() do{sl_prev=sl_cur;sl_cur=sl_next;sl_next=(sl_next==(NSLOT-1)*SLOTB)?0:sl_next+SLOTB;}while(0)
  DMA_K(2,2*SLOTB);
  WAIT_BAR(3);
  qkt(pA0,pA1,Kbase,qr,negm,r32,hi);asm volatile("s_nop 15\n\ts_nop 7":"+v"(pA0),"+v"(pA1));CMASK(pA0,pA1,0);
  START(pA0,pA1);
  _Pragma("unroll") for(int r=0;r<16;++r)pA1[r]=__builtin_amdgcn_exp2f(pA1[r]);
  WAIT_BAR(0);
  DMA_K(3,0);DMA_V(1,SLOTB);
  ROT();
  kload8(kf,kp0+sl_cur);
  WAIT_BAR(2);
  s16x4 vlo[8],vhi[8]; u32x4 pw0,pw1,pw2,pw3;
  #define PKW(P,B) cvtpk_s(P[B],P[B+1])
  #define PAF(k) __builtin_bit_cast(bf16x8,pw##k)
  #define VFR(i) (bf16x8){vlo[i][0],vlo[i][1],vlo[i][2],vlo[i][3],vhi[i][0],vhi[i][1],vhi[i][2],vhi[i][3]}
  #define PIN(x) asm volatile("":"+v"(x))
  #define MX3(a,b,c) __builtin_fmaxf(__builtin_fmaxf((a),(b)),(c))
  #define GAPA(MF,A0,A1,A2,A3,W0,W1,PW) do{ MF; sacc+=A0; sacc+=A1; sacc+=A2; sacc+=A3; PIN(sacc); W0; W1; PIN(PW); SBAR(); }while(0)
  #define EX(v) __builtin_amdgcn_exp2f(v)
  #define GAPB(MF,X,B) do{ MF; X[B]=EX(X[B]); X[B+1]=EX(X[B+1]); X[B+2]=EX(X[B+2]); X[B+3]=EX(X[B+3]); PIN(X); SBAR(); }while(0)
  #define VRD(i) do{ vlo[i]=vtr(vp_+(((i)>>2)*4096+((i)&3)*1024)); vhi[i]=vtr(vp_+(((i)>>2)*4096+((i)&3)*1024+512)); }while(0)
  #define KRD(G,j) do{ if(G){ kload2(kf,kp0+sl_next,j); SBAR(); } }while(0)
  #define STEP(C0,C1,P0,P1,t,GK,GV,GL) do{ SBAR(); \
    const lds_cptr vp_=vp0+sl_prev; \
    VRD(0); SBAR(); float sacc=(P0[0]+P0[1]); \
    GAPA(C0=__builtin_amdgcn_mfma_f32_32x32x16_bf16(kf[0],qr[0],negm,0,0,0), P0[2],P0[3],P0[4],P0[5],     pw0[0]=PKW(P0,0), pw0[1]=PKW(P0,2), pw0); \
    VRD(4); SBAR(); GAPA(C1=__builtin_amdgcn_mfma_f32_32x32x16_bf16(kf[1],qr[0],negm,0,0,0), P0[6],P0[7],P0[8],P0[9],     pw0[2]=PKW(P0,4), pw0[3]=PKW(P0,6), pw0); \
    VRD(1); SBAR(); GAPA(C0=__builtin_amdgcn_mfma_f32_32x32x16_bf16(kf[2],qr[1],C0,0,0,0),   P0[10],P0[11],P0[12],P0[13], pw1[0]=PKW(P0,8), pw1[1]=PKW(P0,10), pw1); \
    VRD(5); SBAR(); GAPA(C1=__builtin_amdgcn_mfma_f32_32x32x16_bf16(kf[3],qr[1],C1,0,0,0),   P0[14],P0[15],P1[0],P1[1],   pw1[2]=PKW(P0,12),pw1[3]=PKW(P0,14), pw1); \
    VRD(2); SBAR(); GAPA(C0=__builtin_amdgcn_mfma_f32_32x32x16_bf16(kf[4],qr[2],C0,0,0,0),   P1[2],P1[3],P1[4],P1[5],     pw2[0]=PKW(P1,0), pw2[1]=PKW(P1,2), pw2); \
    VRD(6); SBAR(); GAPA(C1=__builtin_amdgcn_mfma_f32_32x32x16_bf16(kf[5],qr[2],C1,0,0,0),   P1[6],P1[7],P1[8],P1[9],     pw2[2]=PKW(P1,4), pw2[3]=PKW(P1,6), pw2); \
    VRD(3); SBAR(); GAPA(C0=__builtin_amdgcn_mfma_f32_32x32x16_bf16(kf[6],qr[3],C0,0,0,0),   P1[10],P1[11],P1[12],P1[13], pw3[0]=PKW(P1,8), pw3[1]=PKW(P1,10), pw3); \
    VRD(7); SBAR(); GAPA(C1=__builtin_amdgcn_mfma_f32_32x32x16_bf16(kf[7],qr[3],C1,0,0,0),   P1[14],P1[15],0.f,0.f,       pw3[2]=PKW(P1,12),pw3[3]=PKW(P1,14), pw3); \
    l_reg+=sacc; \
    if(GK){DMA_K((t)+3,sl_cur);} if(GV){DMA_V((t)+1,sl_next);} \
    CMASK(C0,C1,t); \
    { float a=MX3(C0[0],C0[1],C1[0]),b=MX3(C0[2],C0[3],C1[1]); a=MX3(a,C1[2],C1[3]); \
      _Pragma("unroll") for(int r=4;r<16;r+=4){a=MX3(a,C0[r],C0[r+1]);b=MX3(b,C0[r+2],C0[r+3]);a=MX3(a,C1[r],C1[r+1]);b=MX3(b,C1[r+2],C1[r+3]);} \
      float rm=__builtin_fmaxf(a,b); { auto rr=__builtin_amdgcn_permlane32_swap(__float_as_uint(rm),__float_as_uint(rm),false,false); rm=__builtin_fmaxf(__uint_as_float(rr[0]),__uint_as_float(rr[1])); } \
      resc=false; \
      if(__builtin_expect(__any(rm>(float)THRL),0)){ const float dl=__builtin_fmaxf(rm,0.f); mhat+=dl; \
        _Pragma("unroll") for(int r=0;r<16;++r){C0[r]-=dl;C1[r]-=dl;} \
        _Pragma("unroll") for(int r=0;r<16;++r)negm[r]=-mhat; asm volatile("":"+v"(negm)); \
        const float f=__builtin_amdgcn_exp2f(-dl); l_reg*=f; if(hi==0)wsf[r32]=f; resc=true; } } \
    SBAR(); \
    GAPB(o[0]=__builtin_amdgcn_mfma_f32_32x32x16_bf16(PAF(0),VFR(0),o[0],0,0,0), C0,0); \
    GAPB(o[1]=__builtin_amdgcn_mfma_f32_32x32x16_bf16(PAF(0),VFR(4),o[1],0,0,0), C0,4); \
    KRD(GL,0); GAPB(o[0]=__builtin_amdgcn_mfma_f32_32x32x16_bf16(PAF(1),VFR(1),o[0],0,0,0), C0,8); \
    KRD(GL,1); GAPB(o[1]=__builtin_amdgcn_mfma_f32_32x32x16_bf16(PAF(1),VFR(5),o[1],0,0,0), C0,12); \
    KRD(GL,2); GAPB(o[0]=__builtin_amdgcn_mfma_f32_32x32x16_bf16(PAF(2),VFR(2),o[0],0,0,0), C1,0); \
    KRD(GL,3); GAPB(o[1]=__builtin_amdgcn_mfma_f32_32x32x16_bf16(PAF(2),VFR(6),o[1],0,0,0), C1,4); \
    GAPB(o[0]=__builtin_amdgcn_mfma_f32_32x32x16_bf16(PAF(3),VFR(3),o[0],0,0,0), C1,8); \
    GAPB(o[1]=__builtin_amdgcn_mfma_f32_32x32x16_bf16(PAF(3),VFR(7),o[1],0,0,0), C1,12); \
    }while(0)
  int t=1;
  #undef CMASK
  #define CMASK(P0,P1,t) do{}while(0)
  for(;t+5<NT;t+=2){
    STEP(pB0,pB1,pA0,pA1,t,true,true,true);     WAIT_BAR(2); RESC(); ROT();
    STEP(pA0,pA1,pB0,pB1,t+1,true,true,true);   WAIT_BAR(2); RESC(); ROT();
  }
  #undef CMASK
  #define CMASK(P0,P1,t) do{int jb_=(t)-(NT-4); if(jb_>=0)cmask(P0,P1,jb_,qrel,hi);}while(0)
  #define ENDW(tt) do{ if((tt)+3<NT){WAIT_BAR(2);} else if((tt)+2<NT){WAIT_BAR(1);} else {WAIT_BAR(0);} }while(0)
  for(;t+1<NT;t+=2){
    STEP(pB0,pB1,pA0,pA1,t,(t+3<NT),(t+1<NT),(t+1<NT));       ENDW(t);   RESC(); ROT();
    STEP(pA0,pA1,pB0,pB1,t+1,(t+4<NT),(t+2<NT),(t+2<NT));     ENDW(t+1); RESC(); ROT();
  }
  STEP(pB0,pB1,pA0,pA1,NT-1,false,false,false); RESC();
  { float sacc=pB0[0]+pB0[1]; _Pragma("unroll") for(int r=2;r<16;++r)sacc+=pB0[r]; _Pragma("unroll") for(int r=0;r<16;++r)sacc+=pB1[r]; l_reg+=sacc;
    pw0=(u32x4){PKW(pB0,0),PKW(pB0,2),PKW(pB0,4),PKW(pB0,6)};pw1=(u32x4){PKW(pB0,8),PKW(pB0,10),PKW(pB0,12),PKW(pB0,14)};pw2=(u32x4){PKW(pB1,0),PKW(pB1,2),PKW(pB1,4),PKW(pB1,6)};pw3=(u32x4){PKW(pB1,8),PKW(pB1,10),PKW(pB1,12),PKW(pB1,14)};
    SBAR(); pv(o,vb0+sl_cur,PAF(0),PAF(1),PAF(2),PAF(3)); }
  #undef PKW
  #undef PAF
  #undef VFR
  #undef PIN
  #undef MX3
  #undef GAPA
  #undef GAPB
  #undef EX
  #undef VRD
  #undef KRD
  #undef STEP
  #undef ENDW
  {auto rr=__builtin_amdgcn_permlane32_swap(__float_as_uint(l_reg),__float_as_uint(l_reg),false,false);l_reg=__uint_as_float(rr[0])+__uint_as_float(rr[1]);}
  if(hi==0)wsf[32+r32]=l_reg;asm volatile("s_waitcnt lgkmcnt(0)":::"memory");
  float rli[16];
  #pragma unroll
  for(int r=0;r<16;++r)rli[r]=__builtin_amdgcn_rcpf(wsf[32+crow(r,hi)]);
  bf16*Ow=O+(rowbase+q0+wid*QBLK)*DMO+co;
  { bf16*stg=(bf16*)(shm+LDS_OST)+wid*2048;
    #pragma unroll
    for(int r=0;r<16;++r){const int orow=crow(r,hi);
      #pragma unroll
      for(int d0=0;d0<2;++d0)stg[orow*64+d0*32+r32]=__float2bfloat16(o[d0][r]*rli[r]);}
    asm volatile("s_waitcnt lgkmcnt(0)":::"memory");
    #pragma unroll
    for(int i=0;i<4;++i){const int row=i*8+(lane>>3),ch=lane&7; const u32x4 v=*(const u32x4*)(stg+row*64+ch*8); ATTN_STORE16(Ow+(long)row*DMO+ch*8,v);} }
  asm volatile("s_waitcnt lgkmcnt(0)\n\ts_barrier":::"memory");
  #undef DMA_K
  #undef DMA_V
  #undef CMASK
  #undef START
  #undef RESC
  #undef ROT
}
constexpr int ATTN_LDS_BYTES=LDS_BYTES;
#undef SBAR
#undef WAIT_BAR
}
namespace cg = cooperative_groups;
#define GAS __attribute__((address_space(1)))
#define LAS __attribute__((address_space(3)))
typedef unsigned short bf16;
typedef unsigned v4u __attribute__((ext_vector_type(4)));
typedef unsigned v2u __attribute__((ext_vector_type(2)));
typedef float f32x4 __attribute__((ext_vector_type(4)));
constexpr int NWAVES = 8, NTHR = 512;
constexpr int M = 16384, DMOD = 1024, SEQ = 4096, NIN = 6816, DFF = 2816, ZP = 1728;
constexpr size_t MiB = 1u << 20;
constexpr size_t WS_CTL = 0;
constexpr size_t WS_WGLU = 1 * MiB, WS_WB = WS_WGLU + MiB / 2, WS_WO = WS_WB + 3 * MiB, WS_WFI = WS_WO + 2 * MiB, WS_WFO = WS_WFI + 11 * MiB;
constexpr size_t WS_WX = 23 * MiB, WS_W1A = WS_WX, WS_W1B = WS_WX + 4 * MiB, WS_E = WS_WX, WS_WG = WS_WX;
constexpr size_t WS_VF = 40 * MiB, WS_US = 56 * MiB, WS_YA = 80 * MiB, WS_Z = 96 * MiB, WS_QB = 150 * MiB, WS_KB = 166 * MiB, WS_VB = 182 * MiB;
constexpr size_t WS_XNP = 198 * MiB, WS_O = 198 * MiB, WS_AB = 231 * MiB, WS_PT = 247 * MiB, WS_MT = 249 * MiB, WS_END = 256 * MiB;
constexpr size_t WS_XN = 150 * MiB, WS_YL = 182 * MiB, WS_G = 182 * MiB, WS_MERGED = 214 * MiB, WS_H2N = 96 * MiB, WS_HID = 150 * MiB;
static_assert(WS_WFO + (size_t)1024 * 2816 * 2 <= WS_WX && WS_Z + (size_t)M * ZP * 2 <= WS_QB && WS_XNP + (size_t)4 * 4097 * 1024 * 2 <= WS_AB && WS_MT + (size_t)32 * 256 * 384 * 2 <= WS_END && WS_HID + (size_t)M * DFF * 2 <= WS_END, "ws map");
constexpr int LDS_BYTES = 147456;
constexpr float C2Q = 0.125f * 1.4426950408889634f;

__device__ __forceinline__ unsigned f2bf(float f) { unsigned u = __builtin_bit_cast(unsigned, f); return (u + 0x7fffu + ((u >> 16) & 1u)) >> 16; }
__device__ __forceinline__ float bf2f(unsigned b) { return __uint_as_float(b << 16); }
__device__ __forceinline__ void unpack8(const v4u w, float* f) {
    f[0] = __uint_as_float(w.x << 16); f[1] = __uint_as_float(w.x & 0xffff0000u); f[2] = __uint_as_float(w.y << 16); f[3] = __uint_as_float(w.y & 0xffff0000u);
    f[4] = __uint_as_float(w.z << 16); f[5] = __uint_as_float(w.z & 0xffff0000u); f[6] = __uint_as_float(w.w << 16); f[7] = __uint_as_float(w.w & 0xffff0000u); }
__device__ __forceinline__ v4u pack8(const float* f) { v4u w; w.x = pg8::cvt_pk_bf16(f[0], f[1]); w.y = pg8::cvt_pk_bf16(f[2], f[3]); w.z = pg8::cvt_pk_bf16(f[4], f[5]); w.w = pg8::cvt_pk_bf16(f[6], f[7]); return w; }
__device__ __forceinline__ float sigm(float x) { return __builtin_amdgcn_rcpf(1.f + __expf(-x)); }
__device__ __forceinline__ float tanh_f(float x) { return 1.f - 2.f * __builtin_amdgcn_rcpf(1.f + __expf(2.f * x)); }
__device__ __forceinline__ float wave_sum(float v) {
#pragma unroll
    for (int o = 1; o < 64; o <<= 1) v += __shfl_xor(v, o);
    return v; }
__device__ __forceinline__ float dppf(float x, const int ctrl) { return x; }
#define DPP_ADD(x, ctrl) ((x) + __builtin_bit_cast(float, __builtin_amdgcn_update_dpp(0, __builtin_bit_cast(int, (x)), (ctrl), 0xf, 0xf, true)))
__device__ __forceinline__ float row16_sum(float x) { x = DPP_ADD(x, 0xB1); x = DPP_ADD(x, 0x4E); x = DPP_ADD(x, 0x141); x = DPP_ADD(x, 0x140); return x; }

template <int MODE> struct Epi8 {
    static constexpr bool PERM = true, AFTER_DRAIN = false;
    bf16* O; int ldc; const bf16* X; const float* P;
    __device__ __forceinline__ void operator()(const pg8::f32x4 (&acc)[2][2][4][2], const pg8::Unit& u, int wr, int wc, int fr, int fq) const {
#pragma unroll
        for (int ai = 0; ai < 2; ++ai)
#pragma unroll
            for (int m = 0; m < 4; ++m) {
                const int row = u.pm * 256 + ai * 128 + wr * 64 + m * 16 + fr;
                if (MODE == 8) {
                    float o[8];
#pragma unroll
                    for (int i = 0; i < 8; ++i) { const float gte = acc[ai][0][m][i >> 2][i & 3], up = acc[ai][1][m][i >> 2][i & 3]; o[i] = gte * sigm(gte) * up; }
                    *(v4u*)(O + (size_t)row * DFF + u.pn * 128 + wc * 32 + 8 * fq) = pack8(o);
                } else {
#pragma unroll
                for (int bj = 0; bj < 2; ++bj) {
                    const int col = u.pn * 256 + bj * 128 + wc * 32 + 8 * fq;
                    float v[8];
#pragma unroll
                    for (int i = 0; i < 8; ++i) v[i] = acc[ai][bj][m][i >> 2][i & 3];
                    if (MODE == 0) { if (col < ldc) *(v4u*)(O + (size_t)row * ldc + col) = pack8(v); }
                    else if (MODE == 1) {
                        if (u.pn < 2) { const int g = col >> 4, cc = col & 15, b = row >> 12, t = row & 4095, ch = t >> 4, s = t & 15;
                            *(v4u*)((bf16*)X + ((size_t)(g * 1024 + b * 256 + ch) * 384 + s * 16 + cc)) = pack8(v); }
                        else { const int tsel = (col >> 9) - 1, cl = col & 511; *(v4u*)(O + (size_t)tsel * (8u * MiB) + (size_t)row * 512 + cl) = pack8(v); }
                    }
                    else if (MODE == 2) { if (bj == 0) *(v4u*)(O + (size_t)row * 384 + 256 + (col & 255)) = pack8(v); }
                    else if (MODE == 3) {
                        const int g = row >> 10, b = (row >> 8) & 3, ch = row & 255, cl = col & 255, t = cl >> 4, cc = cl & 15;
                        float uu[8]; unpack8(*(const v4u*)(X + (size_t)row * 384 + cl), uu);
#pragma unroll
                        for (int i = 0; i < 8; ++i) { const float y = v[i] + P[g * 16 + cc + i] * uu[i]; v[i] = y * sigm(1.5957691216f * (y + 0.044715f * y * y * y)); }
                        *(v4u*)(O + (size_t)(b * 4096 + ch * 16 + t) * 512 + g * 16 + cc) = pack8(v);
                    }
                    else if (MODE == 4) { float y[8]; unpack8(*(const v4u*)(X + (size_t)row * 512 + col), y);
#pragma unroll
                        for (int i = 0; i < 8; ++i) v[i] = y[i] * sigm(v[i]);
                        *(v4u*)(O + (size_t)row * 512 + col) = pack8(v); }
                    else if (MODE == 5) {
#pragma unroll
                        for (int i = 0; i < 8; ++i) v[i] = sigm(v[i]);
                        *(v4u*)(O + (size_t)row * 1024 + col) = pack8(v); }
                    else if (MODE == 6 || MODE == 7) { float gt[8]; unpack8(*(const v4u*)(X + (size_t)row * 1024 + col), gt);
                        float pm_[8];
                        if (MODE == 7) unpack8(*(const v4u*)(O + (size_t)row * 1024 + col), pm_);
#pragma unroll
                        for (int i = 0; i < 8; ++i) v[i] = (MODE == 7 ? pm_[i] : 0.f) + gt[i] * v[i];
                        *(v4u*)(O + (size_t)row * 1024 + col) = pack8(v); }
                }
                }
            }
    }
};
struct EpiRes {
    static constexpr bool PERM = false, AFTER_DRAIN = false;
    const float* xin; float* xout;
    __device__ __forceinline__ void operator()(const pg8::f32x4 (&acc)[2][2][4][2], const pg8::Unit& u, int wr, int wc, int fr, int fq) const {
#pragma unroll
        for (int ai = 0; ai < 2; ++ai)
#pragma unroll
            for (int m = 0; m < 4; ++m) { const size_t off = (size_t)(u.pm * 256 + ai * 128 + wr * 64 + m * 16 + fr) * 1024 + u.pn * 256 + wc * 32 + 4 * fq;
#pragma unroll
                for (int bj = 0; bj < 2; ++bj)
#pragma unroll
                    for (int n = 0; n < 2; ++n) { const f32x4 b = *(const f32x4*)(xin + off + bj * 128 + n * 16); f32x4 o; o.x = b.x + acc[ai][bj][m][n][0]; o.y = b.y + acc[ai][bj][m][n][1]; o.z = b.z + acc[ai][bj][m][n][2]; o.w = b.w + acc[ai][bj][m][n][3];
                        *(f32x4*)(xout + off + bj * 128 + n * 16) = o; } }
    }
};
__device__ __forceinline__ pg8::Gemm mkgemm(const bf16* A, const bf16* Bt, int Mr, int N, int K, int lda, int ldb) {
    pg8::Gemm g; g.A = A; g.Bt = Bt; g.M = Mr; g.N = N; g.K = K; g.lda = lda; g.ldb = ldb; g.a_skip_shift = 30; g.a_skip_bytes = 0; g.kwrap = 1 << 20; g.wrap_bytes = 0; g.b_shift = 30; g.b_stride_bytes = 0; return g; }
template <class Epi> __device__ __forceinline__ void run_gemm(LAS unsigned char* lds, const pg8::Gemm& g, const Epi& E, int G, int c) {
    asm volatile("" : "+s"(G), "+s"(c));
    pg8::StaticOrder S; S.init(g.M, g.N, G, c);
    pg8::gemm_phase<Epi, pg8::StaticOrder, true, true>(lds, g, S, E);
}

__device__ __forceinline__ void tr_item(const float* W, int ldw, int k0, int c0, bf16* WT, int ldt, int drow, int koff, const float* mu, int smode, LAS float* scr, int lane) {
#pragma unroll 8
    for (int i = 0; i < 32; ++i) { const int kk = 2 * i + (lane >> 5); scr[kk * 33 + (lane & 31)] = W[(size_t)(k0 + kk) * ldw + c0 + (lane & 31)]; }
    asm volatile("s_waitcnt lgkmcnt(0)" ::: "memory");
    const int c = lane & 7;
#pragma unroll
    for (int j = 0; j < 4; ++j) { const int n = (lane >> 3) + 8 * j; const LAS float* s = scr + (8 * c) * 33 + n;
        float sc = 1.f; if (smode) { const float m_ = mu[n]; sc = (smode == 1) ? 1.f - m_ : m_; }
        v4u o; o.x = pg8::cvt_pk_bf16(s[0 * 33] * sc, s[1 * 33] * sc); o.y = pg8::cvt_pk_bf16(s[2 * 33] * sc, s[3 * 33] * sc); o.z = pg8::cvt_pk_bf16(s[4 * 33] * sc, s[5 * 33] * sc); o.w = pg8::cvt_pk_bf16(s[6 * 33] * sc, s[7 * 33] * sc);
        *(v4u*)(WT + (size_t)(drow + n) * ldt + koff + k0 + 8 * c) = o; }
    asm volatile("s_waitcnt lgkmcnt(0)" ::: "memory");
}
__device__ __forceinline__ void rms_row(const float* xrow, const float* gain, bf16* orow, int lane) {
    const f32x4* xr = (const f32x4*)xrow + lane; const f32x4* gr = (const f32x4*)gain + lane;
    f32x4 v[4]; float s = 0.f;
#pragma unroll
    for (int j = 0; j < 4; ++j) { v[j] = xr[64 * j]; s += (v[j].x * v[j].x + v[j].y * v[j].y) + (v[j].z * v[j].z + v[j].w * v[j].w); }
    const float rstd = 1.f / sqrtf(wave_sum(s) * (1.f / 1024.f) + 1e-6f);
    v2u* o8 = (v2u*)orow + lane;
#pragma unroll
    for (int j = 0; j < 4; ++j) { const f32x4 g = gr[64 * j]; v2u w; w.x = pg8::cvt_pk_bf16(v[j].x * rstd * g.x, v[j].y * rstd * g.y); w.y = pg8::cvt_pk_bf16(v[j].z * rstd * g.z, v[j].w * rstd * g.w); o8[64 * j] = w; }
}
struct Ptrs { const float* in[35]; float* out; unsigned char* ws; };

__device__ __forceinline__ void weight_items(const Ptrs& P, int L, int gw, int NGW, LAS float* scr, int lane) {
    unsigned char* ws = P.ws;
    const float* w_in = P.in[2] + (size_t)L * 1024 * NIN; const float* mu = P.in[16] + (size_t)L * 1696;
    constexpr int I1A = 16 * 64, I1B = 16 * 53, IGLU = 8 * 16, IWB = 8 * 32, IWO = 16 * 32, IFI = 16 * 176, IFO = 44 * 32;
    constexpr int NIT = I1A + 2 * I1B + IGLU + 3 * IWB + IWO + IFI + IFO;
    for (int it = gw; it < NIT; it += NGW) {
        int r = it;
        if (r < I1A) { const int kb = r / 64, nb = r % 64; tr_item(w_in, NIN, kb * 64, nb * 32, (bf16*)(ws + WS_W1A), 1024, nb * 32, 0, nullptr, 0, scr, lane); continue; } r -= I1A;
        if (r < I1B) { const int kb = r / 53, nb = r % 53; tr_item(w_in, NIN, kb * 64, 2048 + nb * 32, (bf16*)(ws + WS_W1B), 2048, nb * 32, 0, mu + nb * 32, 1, scr, lane); continue; } r -= I1B;
        if (r < I1B) { const int kb = r / 53, nb = r % 53; tr_item(w_in, NIN, kb * 64, 2048 + nb * 32, (bf16*)(ws + WS_W1B), 2048, nb * 32, 1024, mu + nb * 32, 2, scr, lane); continue; } r -= I1B;
        if (r < IGLU) { const int kb = r / 16, nb = r % 16; tr_item(P.in[11] + (size_t)L * 512 * 512, 512, kb * 64, nb * 32, (bf16*)(ws + WS_WGLU), 512, nb * 32, 0, nullptr, 0, scr, lane); continue; } r -= IGLU;
        if (r < 3 * IWB) { const int n = r / IWB, q = r % IWB, kb = q / 32, nb = q % 32; tr_item(P.in[30] + ((size_t)L * 3 + n) * 512 * 1024, 1024, kb * 64, nb * 32, (bf16*)(ws + WS_WB) + (size_t)n * 1024 * 512, 512, nb * 32, 0, nullptr, 0, scr, lane); continue; } r -= 3 * IWB;
        if (r < IWO) { const int kb = r / 32, nb = r % 32; tr_item(P.in[31] + (size_t)L * 1024 * 1024, 1024, kb * 64, nb * 32, (bf16*)(ws + WS_WO), 1024, nb * 32, 0, nullptr, 0, scr, lane); continue; } r -= IWO;
        if (r < IFI) { const int kb = r / 176, nb = r % 176; const int n0 = nb * 32; const int drow = (n0 < DFF) ? (n0 / 128) * 256 + (n0 % 128) : ((n0 - DFF) / 128) * 256 + 128 + ((n0 - DFF) % 128);
            tr_item(P.in[33] + (size_t)L * 1024 * 2 * DFF, 2 * DFF, kb * 64, n0, (bf16*)(ws + WS_WFI), 1024, drow, 0, nullptr, 0, scr, lane); continue; } r -= IFI;
        { const int kb = r / 32, nb = r % 32; tr_item(P.in[34] + (size_t)L * DFF * 1024, 1024, kb * 64, nb * 32, (bf16*)(ws + WS_WFO), DFF, nb * 32, 0, nullptr, 0, scr, lane); }
    }
}
__device__ __forceinline__ void s5_tables(const Ptrs& P, int L, int g, LAS float* sm, int tid) {
    LAS float* apr = sm; LAS float* api = sm + 17 * 64; LAS float* bbr = sm + 2 * 17 * 64; LAS float* bbi = bbr + 1024; LAS float* Ks = bbi + 1024;
    const float* lre = P.in[3] + (size_t)L * 2048; const float* lim = P.in[4] + (size_t)L * 2048; const float* ldt = P.in[5] + L * 32;
    const float* bre = P.in[6] + (size_t)L * 32768; const float* bim = P.in[7] + (size_t)L * 32768; const float* cre = P.in[8] + (size_t)L * 32768; const float* cim = P.in[9] + (size_t)L * 32768;
    if (tid < 64) { const int p = tid; const float dt = __expf(ldt[g]); const float lr = lre[g * 64 + p], li = lim[g * 64 + p];
        for (int j = 0; j <= 16; ++j) { const double ang = (double)j * (double)li * (double)dt * 0.15915494309189535; const float rev = (float)(ang - __builtin_floor(ang));
            const float mg = __expf((float)j * lr * dt); apr[j * 64 + p] = mg * __builtin_amdgcn_cosf(rev); api[j * 64 + p] = mg * __builtin_amdgcn_sinf(rev); }
        const float ar = apr[64 + p], ai = api[64 + p], den = lr * lr + li * li, nr = ar - 1.f, kr = (nr * lr + ai * li) / den, ki = (ai * lr - nr * li) / den;
        for (int c = 0; c < 16; ++c) { const float br = bre[(g * 64 + p) * 16 + c], bi = bim[(g * 64 + p) * 16 + c]; bbr[p * 16 + c] = kr * br - ki * bi; bbi[p * 16 + c] = kr * bi + ki * br; } }
    __syncthreads();
    { const int cc = tid & 255, cp = cc >> 4, c = cc & 15, j0 = (tid >> 8) * 8;
        for (int j = j0; j < j0 + 8; ++j) { float s = 0.f;
            for (int p = 0; p < 64; ++p) { const float tr = apr[j * 64 + p] * bbr[p * 16 + c] - api[j * 64 + p] * bbi[p * 16 + c], ti = apr[j * 64 + p] * bbi[p * 16 + c] + api[j * 64 + p] * bbr[p * 16 + c];
                s += cre[(g * 16 + cp) * 64 + p] * tr - cim[(g * 16 + cp) * 64 + p] * ti; }
            Ks[j * 256 + cc] = s; } }
    __syncthreads();
    bf16* Mt = (bf16*)(P.ws + WS_MT) + (size_t)g * 256 * 384; bf16* Pt = (bf16*)(P.ws + WS_PT) + (size_t)g * 128 * 256;
    for (int idx = tid; idx < 256 * 48; idx += NTHR) { const int n = idx / 48, kg = idx % 48, t = n >> 4, cp = n & 15; float v[8];
        if (kg < 32) { const int s = kg >> 1, c0 = (kg & 1) * 8;
#pragma unroll
            for (int i = 0; i < 8; ++i) v[i] = (s <= t) ? Ks[(t - s) * 256 + cp * 16 + c0 + i] : 0.f; }
        else {
#pragma unroll
            for (int i = 0; i < 8; ++i) { const int jj = (kg - 32) * 8 + i, p = jj & 63; const float cr = cre[(g * 16 + cp) * 64 + p], ci = cim[(g * 16 + cp) * 64 + p], ar = apr[(t + 1) * 64 + p], ai = api[(t + 1) * 64 + p];
                v[i] = (jj < 64) ? (cr * ar - ci * ai) : -(cr * ai + ci * ar); } }
        *(v4u*)(Mt + (size_t)n * 384 + kg * 8) = pack8(v); }
    for (int idx = tid; idx < 128 * 32; idx += NTHR) { const int jj = idx >> 5, kg = idx & 31, p = jj & 63, s = kg >> 1, c0 = (kg & 1) * 8; float v[8];
        const float ar = apr[(15 - s) * 64 + p], ai = api[(15 - s) * 64 + p];
#pragma unroll
        for (int i = 0; i < 8; ++i) { const float br = bbr[p * 16 + c0 + i], bi = bbi[p * 16 + c0 + i]; v[i] = (jj < 64) ? (ar * br - ai * bi) : (ar * bi + ai * br); }
        *(v4u*)(Pt + (size_t)jj * 256 + kg * 8) = pack8(v); }
    __syncthreads();
}
__device__ __forceinline__ void s5_chunk_scan(const Ptrs& P, int L, int gidx) {
    const int p = gidx & 63, g = (gidx >> 6) & 31, b = gidx >> 11;
    const float dt = __expf(P.in[5][L * 32 + g]); const float lr = P.in[3][(size_t)L * 2048 + g * 64 + p], li = P.in[4][(size_t)L * 2048 + g * 64 + p];
    const double ang = 16.0 * (double)li * (double)dt * 0.15915494309189535; const float rev = (float)(ang - __builtin_floor(ang)); const float mg = __expf(16.f * lr * dt);
    const float ar = mg * __builtin_amdgcn_cosf(rev), ai = mg * __builtin_amdgcn_sinf(rev);
    bf16* base = (bf16*)(P.ws + WS_US) + (size_t)(g * 1024 + b * 256) * 384 + 256 + p;
    float xr = 0.f, xi = 0.f;
#pragma unroll 8
    for (int c = 0; c < 256; ++c) { bf16* q = base + (size_t)c * 384; const float sr = bf2f(q[0]), si = bf2f(q[64]); q[0] = (bf16)f2bf(xr); q[64] = (bf16)f2bf(xi);
        const float nr = ar * xr - ai * xi + sr, ni = ar * xi + ai * xr + si; xr = nr; xi = ni; }
}

__device__ __forceinline__ void prep_phase(const Ptrs& P, int L, LAS unsigned char* lds, int gw, int NGW, int tid, int wave, int lane) {
    asm volatile("" : "+v"(tid), "+v"(lane)); asm volatile("" : "+s"(wave));
    unsigned char* ws = P.ws;
    LAS bf16* w2s = (LAS bf16*)lds; LAS bf16* a2s = w2s + 32 * 512; LAS bf16* v2s = a2s + 32 * 512; LAS unsigned* v1s = (LAS unsigned*)(v2s + 32 * 512);
    LAS float* vrow = (LAS float*)(lds + 131072) + wave * 512;
    const float* w2 = P.in[18] + (size_t)L * 32 * 512; const float* a2 = P.in[20] + (size_t)L * 32 * 512;
    for (int i = tid; i < 32 * 512; i += NTHR) { w2s[i] = (bf16)f2bf(w2[i]); a2s[i] = (bf16)f2bf(a2[i]); }
    if (L == 1) { const float* v2 = P.in[29]; const float* v1 = P.in[28];
        for (int i = tid; i < 32 * 512; i += NTHR) v2s[i] = (bf16)f2bf(v2[i]);
        for (int i = tid; i < 256 * 32; i += NTHR) { const int c2 = i >> 5, j = i & 31; v1s[i] = f2bf(v1[(2 * c2) * 32 + j]) | (f2bf(v1[(2 * c2 + 1) * 32 + j]) << 16); } }
    __syncthreads();
    const int c0 = lane * 8;
    float qg[8], kg[8], w0r[8], a0r[8], v0r[8];
#pragma unroll
    for (int i = 0; i < 8; ++i) { qg[i] = P.in[12][L * 128 + ((c0 + i) & 127)] * C2Q; kg[i] = P.in[13][L * 128 + ((c0 + i) & 127)]; w0r[i] = P.in[17][L * 512 + c0 + i]; a0r[i] = P.in[19][L * 512 + c0 + i]; v0r[i] = (L == 1) ? P.in[27][c0 + i] : 0.f; }
    for (int m = gw; m < M; m += NGW) {
        {
            bf16* qp = (bf16*)(ws + WS_QB) + (size_t)m * 512 + c0; bf16* kp = (bf16*)(ws + WS_KB) + (size_t)m * 512 + c0;
            float q[8], k[8]; unpack8(*(const v4u*)qp, q); unpack8(*(const v4u*)kp, k);
            float sq = 0.f, sk = 0.f;
#pragma unroll
            for (int i = 0; i < 8; ++i) { sq += q[i] * q[i]; sk += k[i] * k[i]; }
            sq += __shfl_xor(sq, 1); sq += __shfl_xor(sq, 2); sq += __shfl_xor(sq, 4); sk += __shfl_xor(sk, 1); sk += __shfl_xor(sk, 2); sk += __shfl_xor(sk, 4);
            const float rq = 1.f / sqrtf(sq * (1.f / 64.f) + 1e-6f), rk = 1.f / sqrtf(sk * (1.f / 64.f) + 1e-6f);
#pragma unroll
            for (int i = 0; i < 8; ++i) { q[i] *= rq * qg[i]; k[i] *= rk * kg[i]; }
            *(v4u*)qp = pack8(q); *(v4u*)kp = pack8(k);
        }
        bf16* zr = (bf16*)(ws + WS_Z) + (size_t)m * ZP;
        const float zz = bf2f(zr[1536 + lane]);
        const float tz = (lane < 32) ? tanh_f(zz) : zz;
        float aw[8], aa[8];
#pragma unroll
        for (int i = 0; i < 8; ++i) { aw[i] = w0r[i]; aa[i] = a0r[i]; }
#pragma unroll
        for (int j = 0; j < 32; ++j) { const float tw = __shfl(tz, j), ta = __shfl(tz, 32 + j); float w8[8], a8[8]; unpack8(*(const LAS v4u*)(w2s + j * 512 + c0), w8); unpack8(*(const LAS v4u*)(a2s + j * 512 + c0), a8);
#pragma unroll
            for (int i = 0; i < 8; ++i) { aw[i] += tw * w8[i]; aa[i] += ta * a8[i]; } }
#pragma unroll
        for (int i = 0; i < 8; ++i) { aw[i] = 0.6065306597f * sigm(aw[i]); aa[i] = sigm(aa[i]); }
        *(v4u*)((bf16*)(ws + WS_E) + (size_t)m * 512 + c0) = pack8(aw); *(v4u*)((bf16*)(ws + WS_AB) + (size_t)m * 512 + c0) = pack8(aa);
        const v4u vraw = *(const v4u*)(zr + 1024 + c0);
        if (L == 0) { *(v4u*)((bf16*)(ws + WS_VF) + (size_t)m * 512 + c0) = vraw; }
        else { float v[8], vf[8]; unpack8(vraw, v); unpack8(*(const v4u*)((const bf16*)(ws + WS_VF) + (size_t)m * 512 + c0), vf);
#pragma unroll
            for (int i = 0; i < 8; ++i) vrow[c0 + i] = v[i];
            asm volatile("s_waitcnt lgkmcnt(0)" ::: "memory");
            const int j = lane & 31, hf = lane >> 5; float s = 0.f;
#pragma unroll 8
            for (int c2 = 0; c2 < 128; ++c2) { const unsigned pk = v1s[(hf * 128 + c2) * 32 + j]; s += vrow[hf * 256 + 2 * c2] * __uint_as_float(pk << 16) + vrow[hf * 256 + 2 * c2 + 1] * __uint_as_float(pk & 0xffff0000u); }
            s += __shfl_xor(s, 32);
            float am[8];
#pragma unroll
            for (int i = 0; i < 8; ++i) am[i] = v0r[i];
#pragma unroll
            for (int jj = 0; jj < 32; ++jj) { const float sj = __shfl(s, jj); float w8[8]; unpack8(*(const LAS v4u*)(v2s + jj * 512 + c0), w8);
#pragma unroll
                for (int i = 0; i < 8; ++i) am[i] += sj * w8[i]; }
#pragma unroll
            for (int i = 0; i < 8; ++i) v[i] = v[i] + (vf[i] - v[i]) * sigm(am[i]);
            *(v4u*)(zr + 1024 + c0) = pack8(v);
            asm volatile("s_waitcnt lgkmcnt(0)" ::: "memory"); }
    }
    __syncthreads();
}

__device__ __forceinline__ void rwkv_unit(const Ptrs& P, int L, LAS unsigned char* lds, int b, int h, int qr, int tid, int wave, int lane) {
    constexpr int T = 32, TOKF = 336;
    asm volatile("" : "+v"(tid), "+v"(lane)); asm volatile("" : "+s"(wave));
    unsigned char* ws = P.ws;
    const bf16* Z = (const bf16*)(ws + WS_Z); const bf16* AB = (const bf16*)(ws + WS_AB); const bf16* EB = (const bf16*)(ws + WS_E); bf16* YC = (bf16*)(ws + WS_YA);
    LAS float* buf0 = (LAS float*)lds; LAS float* buf1 = buf0 + T * TOKF;
    const bool producer = wave >= 4;
    const int pt = tid - 256, tok = pt >> 3, ks = (pt & 7) * 8;
    float kkk[8], kka[8];
    if (producer) {
#pragma unroll
        for (int i = 0; i < 8; ++i) { kkk[i] = P.in[22][L * 512 + h * 64 + ks + i]; kka[i] = P.in[23][L * 512 + h * 64 + ks + i]; } }
    const int row = wave * 4 + (lane >> 4), kq = lane & 15;
    f32x4 S = {0.f, 0.f, 0.f, 0.f};
    const size_t m00 = (size_t)b * SEQ;
#define RW_PRODUCE(c, buf) do { const size_t m_ = m00 + (size_t)(c) * T + tok; const bf16* zr_ = Z + m_ * ZP; \
        float r_[8], k_[8], a_[8], e_[8]; unpack8(*(const v4u*)(zr_ + h * 64 + ks), r_); unpack8(*(const v4u*)(zr_ + 512 + h * 64 + ks), k_); \
        unpack8(*(const v4u*)(AB + m_ * 512 + h * 64 + ks), a_); unpack8(*(const v4u*)(EB + m_ * 512 + h * 64 + ks), e_); \
        float kk_[8], ss_ = 0.f; _Pragma("unroll") for (int i = 0; i < 8; ++i) { kk_[i] = k_[i] * kkk[i]; ss_ += kk_[i] * kk_[i]; } \
        ss_ += __shfl_xor(ss_, 1); ss_ += __shfl_xor(ss_, 2); ss_ += __shfl_xor(ss_, 4); const float inv_ = 1.f / fmaxf(sqrtf(ss_), 1e-12f); \
        LAS float* d_ = (buf) + tok * TOKF + ks; f32x4 o0, o1; \
        o0 = (f32x4){-kk_[0] * inv_, -kk_[1] * inv_, -kk_[2] * inv_, -kk_[3] * inv_}; o1 = (f32x4){-kk_[4] * inv_, -kk_[5] * inv_, -kk_[6] * inv_, -kk_[7] * inv_}; *(LAS f32x4*)(d_) = o0; *(LAS f32x4*)(d_ + 4) = o1; \
        o0 = (f32x4){kk_[0] * inv_ * a_[0], kk_[1] * inv_ * a_[1], kk_[2] * inv_ * a_[2], kk_[3] * inv_ * a_[3]}; o1 = (f32x4){kk_[4] * inv_ * a_[4], kk_[5] * inv_ * a_[5], kk_[6] * inv_ * a_[6], kk_[7] * inv_ * a_[7]}; *(LAS f32x4*)(d_ + 64) = o0; *(LAS f32x4*)(d_ + 68) = o1; \
        o0 = (f32x4){__expf(-e_[0]), __expf(-e_[1]), __expf(-e_[2]), __expf(-e_[3])}; o1 = (f32x4){__expf(-e_[4]), __expf(-e_[5]), __expf(-e_[6]), __expf(-e_[7])}; *(LAS f32x4*)(d_ + 128) = o0; *(LAS f32x4*)(d_ + 132) = o1; \
        o0 = (f32x4){k_[0] * (1.f + (a_[0] - 1.f) * kka[0]), k_[1] * (1.f + (a_[1] - 1.f) * kka[1]), k_[2] * (1.f + (a_[2] - 1.f) * kka[2]), k_[3] * (1.f + (a_[3] - 1.f) * kka[3])}; \
        o1 = (f32x4){k_[4] * (1.f + (a_[4] - 1.f) * kka[4]), k_[5] * (1.f + (a_[5] - 1.f) * kka[5]), k_[6] * (1.f + (a_[6] - 1.f) * kka[6]), k_[7] * (1.f + (a_[7] - 1.f) * kka[7])}; *(LAS f32x4*)(d_ + 192) = o0; *(LAS f32x4*)(d_ + 196) = o1; \
        o0 = (f32x4){r_[0], r_[1], r_[2], r_[3]}; o1 = (f32x4){r_[4], r_[5], r_[6], r_[7]}; *(LAS f32x4*)(d_ + 256) = o0; *(LAS f32x4*)(d_ + 260) = o1; \
        if ((pt & 7) < 2) { float v_[8]; unpack8(*(const v4u*)(zr_ + 1024 + h * 64 + qr * 16 + ks), v_); LAS float* dv_ = (buf) + tok * TOKF + 320 + ks; \
            *(LAS f32x4*)(dv_) = (f32x4){v_[0], v_[1], v_[2], v_[3]}; *(LAS f32x4*)(dv_ + 4) = (f32x4){v_[4], v_[5], v_[6], v_[7]}; } } while (0)
    if (producer) RW_PRODUCE(0, buf0);
    __syncthreads();
    for (int c = 0; c < SEQ / T; ++c) {
        LAS float* cur = (c & 1) ? buf1 : buf0; LAS float* nxt = (c & 1) ? buf0 : buf1;
        if (producer) { if (c + 1 < SEQ / T) RW_PRODUCE(c + 1, nxt); }
        else {
            bf16* yo = YC + (m00 + (size_t)c * T) * 512 + h * 64 + qr * 16 + row;
#pragma unroll 4
            for (int t = 0; t < T; ++t) { const LAS float* bs = cur + t * TOKF + kq * 4;
                const f32x4 a4 = *(const LAS f32x4*)(bs), b4 = *(const LAS f32x4*)(bs + 64), w4 = *(const LAS f32x4*)(bs + 128), k4 = *(const LAS f32x4*)(bs + 192), r4 = *(const LAS f32x4*)(bs + 256);
                const float vv = cur[t * TOKF + 320 + row];
                float sa = (S.x * a4.x + S.y * a4.y) + (S.z * a4.z + S.w * a4.w); sa = row16_sum(sa);
                S = S * w4 + (b4 * sa + k4 * vv);
                float y = (S.x * r4.x + S.y * r4.y) + (S.z * r4.z + S.w * r4.w); y = row16_sum(y);
                if (kq == 0) yo[(size_t)t * 512] = (bf16)f2bf(y); }
        }
        __syncthreads();
    }
#undef RW_PRODUCE
}

__device__ __forceinline__ void post_phase(const Ptrs& P, int L, LAS unsigned char* lds, int gw, int NGW, int tid, int wave, int lane) {
    asm volatile("" : "+v"(tid), "+v"(lane)); asm volatile("" : "+s"(wave));
    unsigned char* ws = P.ws;
    LAS bf16* g2s = (LAS bf16*)lds;
    const float* g2 = P.in[21] + (size_t)L * 96 * 512;
    for (int i = tid; i < 96 * 512; i += NTHR) g2s[i] = (bf16)f2bf(g2[i]);
    __syncthreads();
    const float lam_init = (L == 0) ? 0.2f : 0.35550906f;
    const float* lv = P.in[14] + L * 256;
    const float lam = __expf(wave_sum(lv[lane] * lv[64 + lane])) - __expf(wave_sum(lv[128 + lane] * lv[192 + lane])) + lam_init;
    const int c0 = lane * 8;
    float sg[8], lng[8], lnb[8], rk[8], ka[8];
#pragma unroll
    for (int i = 0; i < 8; ++i) { sg[i] = P.in[15][L * 128 + ((c0 + i) & 127)] * (1.f - lam_init); lng[i] = P.in[25][L * 512 + c0 + i]; lnb[i] = P.in[26][L * 512 + c0 + i]; rk[i] = P.in[24][L * 512 + c0 + i]; ka[i] = P.in[23][L * 512 + c0 + i]; }
    const float* xsrc = (L == 0) ? P.in[0] : P.out;
    for (int m = gw; m < M; m += NGW) {
        bf16* zr = (bf16*)(ws + WS_Z) + (size_t)m * ZP;
        float r[8], k[8], v[8], a[8], yr[8];
        unpack8(*(const v4u*)(zr + c0), r); unpack8(*(const v4u*)(zr + 512 + c0), k); unpack8(*(const v4u*)(zr + 1024 + c0), v);
        unpack8(*(const v4u*)((const bf16*)(ws + WS_AB) + (size_t)m * 512 + c0), a); unpack8(*(const v4u*)((const bf16*)(ws + WS_YA) + (size_t)m * 512 + c0), yr);
        const float z0 = sigm(bf2f(zr[1600 + (lane & 31)])), z1 = sigm(bf2f(zr[1632 + (lane & 31)])), z2 = sigm(bf2f(zr[1664 + (lane & 31)]));
        float s1 = 0.f;
#pragma unroll
        for (int i = 0; i < 8; ++i) s1 += yr[i];
        s1 += __shfl_xor(s1, 1); s1 += __shfl_xor(s1, 2); s1 += __shfl_xor(s1, 4); const float mean = s1 * (1.f / 64.f);
        float s2 = 0.f, bd = 0.f;
#pragma unroll
        for (int i = 0; i < 8; ++i) { const float d = yr[i] - mean; s2 += d * d; bd += r[i] * (k[i] * (1.f + (a[i] - 1.f) * ka[i])) * rk[i]; }
        s2 += __shfl_xor(s2, 1); s2 += __shfl_xor(s2, 2); s2 += __shfl_xor(s2, 4); bd += __shfl_xor(bd, 1); bd += __shfl_xor(bd, 2); bd += __shfl_xor(bd, 4);
        const float rstd = 1.f / sqrtf(s2 * (1.f / 64.f) + 64e-5f);
        float gacc[8];
#pragma unroll
        for (int i = 0; i < 8; ++i) gacc[i] = 0.f;
#pragma unroll 8
        for (int j = 0; j < 32; ++j) { const float t0 = __shfl(z0, j), t1 = __shfl(z1, j), t2 = __shfl(z2, j); float w0[8], w1[8], w2[8];
            unpack8(*(const LAS v4u*)(g2s + j * 512 + c0), w0); unpack8(*(const LAS v4u*)(g2s + (32 + j) * 512 + c0), w1); unpack8(*(const LAS v4u*)(g2s + (64 + j) * 512 + c0), w2);
#pragma unroll
            for (int i = 0; i < 8; ++i) gacc[i] += t0 * w0[i] + t1 * w1[i] + t2 * w2[i]; }
        float yc[8];
#pragma unroll
        for (int i = 0; i < 8; ++i) yc[i] = ((yr[i] - mean) * rstd * lng[i] + lnb[i] + bd * v[i]) * gacc[i];
        const int hd = lane >> 4, j0 = (lane & 15) * 8; const bf16* orow = (const bf16*)(ws + WS_O) + (size_t)m * 1024 + hd * 256 + j0;
        float o0[8], o1[8]; unpack8(*(const v4u*)orow, o0); unpack8(*(const v4u*)(orow + 128), o1);
        float so = 0.f;
#pragma unroll
        for (int i = 0; i < 8; ++i) { o0[i] = o0[i] - lam * o1[i]; so += o0[i] * o0[i]; }
        so += __shfl_xor(so, 1); so += __shfl_xor(so, 2); so += __shfl_xor(so, 4); so += __shfl_xor(so, 8);
        const float ro = 1.f / sqrtf(so * (1.f / 128.f) + 1e-5f);
#pragma unroll
        for (int i = 0; i < 8; ++i) o0[i] *= ro * sg[i];
        *(v4u*)(zr + c0) = pack8(yc); *(v4u*)(zr + 512 + c0) = pack8(o0);
        rms_row(xsrc + (size_t)m * 1024, P.in[1] + L * 1024, (bf16*)(ws + WS_XN) + (size_t)m * 1024, lane);
    }
    __syncthreads();
}


__device__ __forceinline__ void dump_stage(const Ptrs& P, int k, int blk, int G, int tid) {
    unsigned char* ws = P.ws; float* out = P.out;
    for (size_t i = (size_t)blk * NTHR + tid; i < (size_t)M * 1024; i += (size_t)G * NTHR) {
        const size_t m = i >> 10; const int c = (int)(i & 1023); float v = 0.f;
        const bf16* Z = (const bf16*)(ws + WS_Z); const bf16* US = (const bf16*)(ws + WS_US);
        if (k == 1) v = bf2f(Z[m * ZP + c]) + bf2f(Z[m * ZP + 704 + c]) + bf2f(((const bf16*)(ws + WS_QB))[m * 512 + (c & 511)]) + bf2f(((const bf16*)(ws + WS_KB))[m * 512 + (c & 511)]) + bf2f(((const bf16*)(ws + WS_VB))[m * 512 + (c & 511)]) + bf2f(US[m * 768 + (c % 768)]);
        else if (k == 2) {
#if !defined(DSEL) || DSEL==1
            v += bf2f(US[m * 768 + (c % 768)]);
#endif
#if !defined(DSEL) || DSEL==2
            v += bf2f(((const bf16*)(ws + WS_E))[m * 512 + (c & 511)]) + bf2f(((const bf16*)(ws + WS_AB))[m * 512 + (c & 511)]);
#endif
#if !defined(DSEL) || DSEL==3
            v += bf2f(((const bf16*)(ws + WS_QB))[m * 512 + (c & 511)]) + bf2f(((const bf16*)(ws + WS_KB))[m * 512 + (c & 511)]);
#endif
#if !defined(DSEL) || DSEL==4
            v += bf2f(Z[m * ZP + 1024 + (c & 511)]) + bf2f(((const bf16*)(ws + WS_VF))[m * 512 + (c & 511)]);
#endif
        }
        else if (k == 3) v = bf2f(((const bf16*)(ws + WS_O))[m * 1024 + c]) + bf2f(((const bf16*)(ws + WS_YA))[m * 512 + (c & 511)]) + bf2f(US[m * 768 + (c % 768)]);
        else if (k == 4) v = bf2f(Z[m * ZP + c]) + bf2f(((const bf16*)(ws + WS_XN))[m * 1024 + c]) + bf2f(((const bf16*)(ws + WS_YL))[m * 512 + (c & 511)]);
        else if (k == 5) v = bf2f(((const bf16*)(ws + WS_YA))[m * 512 + (c & 511)]);
        else if (k == 6) v = bf2f(((const bf16*)(ws + WS_MERGED))[m * 1024 + c]);
        else if (k == 9) v = bf2f(((const bf16*)(ws + WS_HID))[m * DFF + c]) + bf2f(((const bf16*)(ws + WS_HID))[m * DFF + 1024 + c]) + bf2f(((const bf16*)(ws + WS_H2N))[m * 1024 + c]);
        out[i] = v;
    }
}
#define GSYNC() do { asm volatile("s_waitcnt vmcnt(0) lgkmcnt(0)" ::: "memory"); grid.sync(); } while (0)
struct Args { Ptrs p; int pad0, pad1; };
__global__ void __launch_bounds__(NTHR, 2) mega_fwd(Args args) {
    extern __shared__ __attribute__((aligned(16))) unsigned char lds_raw[];
    LAS unsigned char* lds = (LAS unsigned char*)lds_raw;
    cg::grid_group grid = cg::this_grid();
    const Ptrs& P = args.p;
    unsigned char* ws = P.ws;
    const int tid0 = threadIdx.x, wave0 = __builtin_amdgcn_readfirstlane(tid0 >> 6);
    const int wave = wave0;
    const int G0 = gridDim.x, blk0 = blockIdx.x;
    const int gw0 = blk0 * NWAVES + wave, NGW0 = G0 * NWAVES;
    unsigned* ctl = (unsigned*)(ws + WS_CTL);
    for (int L = 0; L < 2; ++L) {
        int gw = gw0, NGW = NGW0, blk = blk0, G = G0; asm volatile("" : "+s"(gw), "+s"(NGW), "+s"(blk), "+s"(G));
        int tid = tid0; asm volatile("" : "+v"(tid)); int lane = tid & 63;
#define RELAUNDER() do { asm volatile("" : "+v"(tid)); lane = tid & 63; asm volatile("" : "+s"(gw), "+s"(NGW), "+s"(blk), "+s"(G)); } while (0)
        const float* xsrc = (L == 0) ? P.in[0] : P.out;
#if !defined(ONLY) || ONLY==0
        if (blk < 32) s5_tables(P, L, blk, (LAS float*)lds, tid);
        weight_items(P, L, gw, NGW, (LAS float*)(lds + wave * 16384), lane);
        for (int i = blk * NTHR + tid; i < 96 * 2048 / 8; i += G * NTHR) ((v4u*)((bf16*)(ws + WS_W1B) + (size_t)1696 * 2048))[i] = (v4u){0u, 0u, 0u, 0u};
        if (blk < 4) { for (int i = tid; i < 128; i += NTHR) ((v4u*)((bf16*)(ws + WS_XNP) + (size_t)blk * 4097 * 1024))[i] = (v4u){0u, 0u, 0u, 0u}; }
        for (int m = gw; m < M; m += NGW) rms_row(xsrc + (size_t)m * 1024, P.in[1] + L * 1024, (bf16*)(ws + WS_XNP) + ((size_t)(m >> 12) * 4097 + 1 + (m & 4095)) * 1024, lane);
        GSYNC(); RELAUNDER();
#endif
#if !defined(ONLY) || ONLY==1
        { pg8::Gemm g = mkgemm((const bf16*)(ws + WS_XNP) + 1024, (const bf16*)(ws + WS_W1A), M, 2048, 1024, 1024, 1024); g.a_skip_shift = 4; g.a_skip_bytes = 2048;
          Epi8<1> E{(bf16*)(ws + WS_QB), 512, (const bf16*)(ws + WS_US), nullptr};
#if !defined(SUB) || SUB==0
          run_gemm(lds, g, E, G, blk);
#endif
          }
        { pg8::Gemm g = mkgemm((const bf16*)(ws + WS_XNP) + 1024, (const bf16*)(ws + WS_W1B), M, 1792, 2048, 1024, 2048); g.a_skip_shift = 4; g.a_skip_bytes = 2048; g.kwrap = 16; g.wrap_bytes = 4096;
          Epi8<0> E{(bf16*)(ws + WS_Z), ZP, nullptr, nullptr};
#if !defined(SUB) || SUB==1
          run_gemm(lds, g, E, G, blk);
#endif
          }
        GSYNC(); RELAUNDER();
#if defined(STOP_AFTER) && STOP_AFTER==1
        dump_stage(P, 1, blk, G, tid); return;
#endif
#endif
#if !defined(ONLY) || ONLY==2
        { pg8::Gemm g = mkgemm((const bf16*)(ws + WS_US), (const bf16*)(ws + WS_PT), 32768, 256, 256, 384, 256); g.b_shift = 2; g.b_stride_bytes = 128 * 256 * 2;
          Epi8<2> E{(bf16*)(ws + WS_US), 384, nullptr, nullptr}; run_gemm(lds, g, E, G, blk); }
        __syncthreads();
        prep_phase(P, L, lds, gw, NGW, tid, wave, lane);
        GSYNC(); RELAUNDER();
#if defined(STOP_AFTER) && STOP_AFTER==2
        dump_stage(P, 2, blk, G, tid); return;
#endif
#endif
#if !defined(ONLY) || ONLY==3
        if (blk < 128) rwkv_unit(P, L, lds, blk >> 5, (blk >> 2) & 7, blk & 3, tid, wave, lane);
        else if (blk >= G - 16) s5_chunk_scan(P, L, (blk - (G - 16)) * NTHR + tid);
        __syncthreads();
        {
            volatile LAS unsigned* qslot = (volatile LAS unsigned*)(lds + 140000);
            for (;;) {
                if (tid == 0) qslot[0] = atomicAdd(ctl + 64 * L, 1u);
                __syncthreads();
                const unsigned uidx = qslot[0];
                __syncthreads();
                if (uidx >= 1024u) break;
                const int qb = 15 - (int)(uidx >> 6), bhv = uidx & 63, b = bhv >> 4, hv = bhv & 15, hh = hv >> 2, cc = (hv >> 1) & 1, half = hv & 1;
                attn_body::attn_unit<8>(b, (2 * hh + cc) * 64, (2 * hh + cc) * 64, (2 * hh + half) * 64, hv * 64, qb,
                    (const attn_body::bf16*)(ws + WS_QB), (const attn_body::bf16*)(ws + WS_KB), (const attn_body::bf16*)(ws + WS_VB), (attn_body::bf16*)(ws + WS_O), (char*)lds_raw);
            }
        }
        GSYNC(); RELAUNDER();
#if defined(STOP_AFTER) && STOP_AFTER==3
        dump_stage(P, 3, blk, G, tid); return;
#endif
#endif
#if !defined(ONLY) || ONLY==4
        { pg8::Gemm g = mkgemm((const bf16*)(ws + WS_US), (const bf16*)(ws + WS_MT), 32768, 256, 384, 384, 384); g.b_shift = 2; g.b_stride_bytes = 256 * 384 * 2;
          Epi8<3> E{(bf16*)(ws + WS_YL), 512, (const bf16*)(ws + WS_US), P.in[10] + L * 512}; run_gemm(lds, g, E, G, blk); }
        __syncthreads();
        { const float* w_in = P.in[2] + (size_t)L * 1024 * NIN; LAS float* scr = (LAS float*)(lds + wave * 16384);
          for (int it = gw; it < 16 * 96; it += NGW) { const int kb = it / 96, nb = it % 96; tr_item(w_in, NIN, kb * 64, 3744 + nb * 32, (bf16*)(ws + WS_WG), 1024, nb * 32, 0, nullptr, 0, scr, lane); } }
        __syncthreads();
        post_phase(P, L, lds, gw, NGW, tid, wave, lane);
        GSYNC(); RELAUNDER();
#if defined(STOP_AFTER) && STOP_AFTER==4
        dump_stage(P, 4, blk, G, tid); return;
#endif
#endif
#if !defined(ONLY) || ONLY==5
        { pg8::Gemm g = mkgemm((const bf16*)(ws + WS_YL), (const bf16*)(ws + WS_WGLU), M, 512, 512, 512, 512);
          Epi8<4> E{(bf16*)(ws + WS_YA), 512, (const bf16*)(ws + WS_YL), nullptr}; run_gemm(lds, g, E, G, blk); }
        GSYNC(); RELAUNDER();
#if defined(STOP_AFTER) && STOP_AFTER==5
        dump_stage(P, 5, blk, G, tid); return;
#endif
        for (int n = 1; n <= 2; ++n) {
            { pg8::Gemm g = mkgemm((const bf16*)(ws + WS_XN), (const bf16*)(ws + WS_WG) + (size_t)n * 1024 * 1024, M, 1024, 1024, 1024, 1024);
              Epi8<5> E{(bf16*)(ws + WS_G), 1024, nullptr, nullptr}; run_gemm(lds, g, E, G, blk); }
            { pg8::Gemm g = mkgemm((const bf16*)(ws + WS_Z) + (n == 1 ? 512 : 0), (const bf16*)(ws + WS_WB) + (size_t)n * 1024 * 512, M, 1024, 512, ZP, 512);
              if (n == 1) { Epi8<6> E{(bf16*)(ws + WS_MERGED), 1024, (const bf16*)(ws + WS_G), nullptr}; run_gemm(lds, g, E, G, blk); }
              else { Epi8<7> E{(bf16*)(ws + WS_MERGED), 1024, (const bf16*)(ws + WS_G), nullptr}; run_gemm(lds, g, E, G, blk); } }
        }
        GSYNC(); RELAUNDER();
#endif
#if !defined(ONLY) || ONLY==6
        { pg8::Gemm g = mkgemm((const bf16*)(ws + WS_XN), (const bf16*)(ws + WS_WG), M, 1024, 1024, 1024, 1024);
          Epi8<5> E{(bf16*)(ws + WS_G), 1024, nullptr, nullptr}; run_gemm(lds, g, E, G, blk); }
        { pg8::Gemm g = mkgemm((const bf16*)(ws + WS_YA), (const bf16*)(ws + WS_WB), M, 1024, 512, 512, 512);
          Epi8<7> E{(bf16*)(ws + WS_MERGED), 1024, (const bf16*)(ws + WS_G), nullptr}; run_gemm(lds, g, E, G, blk); }
        GSYNC(); RELAUNDER();
#if defined(STOP_AFTER) && STOP_AFTER==6
        dump_stage(P, 6, blk, G, tid); return;
#endif
#endif
#if !defined(ONLY) || ONLY==7
        { pg8::Gemm g = mkgemm((const bf16*)(ws + WS_MERGED), (const bf16*)(ws + WS_WO), M, 1024, 1024, 1024, 1024);
          EpiRes E{xsrc, P.out}; run_gemm(lds, g, E, G, blk); }
        GSYNC(); RELAUNDER();
#endif
#if !defined(ONLY) || ONLY==8
        for (int m = gw; m < M; m += NGW) rms_row(P.out + (size_t)m * 1024, P.in[32] + L * 1024, (bf16*)(ws + WS_H2N) + (size_t)m * 1024, lane);
        GSYNC(); RELAUNDER();
#endif
#if !defined(ONLY) || ONLY==9
        { pg8::Gemm g = mkgemm((const bf16*)(ws + WS_H2N), (const bf16*)(ws + WS_WFI), M, 2 * DFF, 1024, 1024, 1024);
          Epi8<8> E{(bf16*)(ws + WS_HID), DFF, nullptr, nullptr}; run_gemm(lds, g, E, G, blk); }
        GSYNC(); RELAUNDER();
#if defined(STOP_AFTER) && STOP_AFTER==9
        dump_stage(P, 9, blk, G, tid); return;
#endif
#endif
#if !defined(ONLY) || ONLY==10
        { pg8::Gemm g = mkgemm((const bf16*)(ws + WS_HID), (const bf16*)(ws + WS_WFO), M, 1024, DFF, DFF, DFF);
          EpiRes E{P.out, P.out}; run_gemm(lds, g, E, G, blk); }
#endif
        if (L == 0) GSYNC();
    }
}

extern "C" void kernel_launch(void* const* d_in, const int* in_sizes, int n_in, void* d_out, int out_size, void* d_ws, size_t ws_size, hipStream_t stream) {
    static int grid = 0;
    if (grid == 0) {
        if (n_in != 35 || out_size != M * DMOD || ws_size < WS_END) { fprintf(stderr, "kernel_launch: unexpected shapes (n_in %d out %d ws %zu)\n", n_in, out_size, ws_size); grid = -1; return; }
        int dev = 0, cus = 0, per_cu = 0;
        hipGetDevice(&dev); hipDeviceGetAttribute(&cus, hipDeviceAttributeMultiprocessorCount, dev);
        hipFuncSetAttribute((const void*)mega_fwd, hipFuncAttributeMaxDynamicSharedMemorySize, LDS_BYTES);
        hipOccupancyMaxActiveBlocksPerMultiprocessor(&per_cu, (const void*)mega_fwd, NTHR, LDS_BYTES);
        if (per_cu < 1) { fprintf(stderr, "kernel_launch: occupancy query says %d\n", per_cu); grid = -1; return; }
        grid = cus;
        if (grid < 144) { fprintf(stderr, "kernel_launch: grid %d too small\n", grid); grid = -1; return; }
    }
    if (grid < 0) return;
    hipMemsetAsync((char*)d_ws + WS_CTL, 0, 4096, stream);
    Args a{};
    for (int i = 0; i < 35; ++i) a.p.in[i] = (const float*)d_in[i];
    a.p.out = (float*)d_out; a.p.ws = (unsigned char*)d_ws;
    void* kargs[] = {&a};
    hipError_t e = hipLaunchCooperativeKernel((const void*)mega_fwd, dim3(grid), dim3(NTHR), kargs, LDS_BYTES, stream);
    if (e != hipSuccess) fprintf(stderr, "cooperative launch failed: %s (grid %d)\n", hipGetErrorString(e), grid);
}
```

```cpp
#include <hip/hip_runtime.h>
#include <hip/hip_cooperative_groups.h>
#include <cstdio>
#include <cstdint>

namespace pg8 {
#define PG8_LAS __attribute__((address_space(3)))
typedef unsigned short bf16_t;
typedef short bf16x8 __attribute__((ext_vector_type(8)));
typedef float f32x4 __attribute__((ext_vector_type(4)));
typedef unsigned u32x4 __attribute__((ext_vector_type(4)));
constexpr int BM = 256, BK = 64, HALF = 128, HTB = HALF * BK * 2  , STAGE_BYTES = 8 * HTB, NXCD = 8, WGM = 8;

__host__ __device__ __forceinline__ int lds_byte(int r, int c) { const int st = (r >> 4) * 2 + (c >> 5), rr = r & 15, cc = c & 31, ob = rr * 64 + cc * 2; return st * 1024 + (ob ^ (((ob >> 9) & 1) << 5)); }
__host__ __device__ __forceinline__ void stage_rc(int b, int& R, int& C) { const int st = b / 1024, sb = b % 1024, swz = sb ^ (((sb >> 9) & 1) << 5); R = (st >> 1) * 16 + swz / 64; C = (st & 1) * 32 + (swz % 64) / 2; }
__host__ __device__ __forceinline__ int perm32(int rho) { const int n = rho >> 4, i = rho & 15; return 8 * (i >> 2) + 4 * n + (i & 3); }

struct Unit { int pm, pn; };
struct Gemm { const bf16_t* A; const bf16_t* Bt; int M, N, K; int lda, ldb; int a_skip_shift; int a_skip_bytes; int kwrap; int wrap_bytes; int b_shift; int b_stride_bytes;
  __device__ __forceinline__ const char* abase(const Unit& u) const { return (const char*)A + (size_t)u.pm * (size_t)(256 * 2) * lda + (size_t)(u.pm >> a_skip_shift) * a_skip_bytes; }
  __device__ __forceinline__ const char* bbase(const Unit& u) const { return (const char*)Bt + (size_t)u.pn * (size_t)(256 * 2) * ldb + (size_t)(u.pm >> b_shift) * b_stride_bytes; } };

struct StaticOrder {
    int nM, nN, nwg, G, c;
    __host__ __device__ void init(int M, int N, int G_, int c_) { nM = M / BM; nN = N / BM; nwg = nM * nN; G = G_; c = c_; }
    __host__ __device__ bool next(int i, Unit& u) const {
        const long L = (long)i * G + c; if (L >= nwg) return false;
        int wgid = (int)L; { const int q = nwg / NXCD, r = nwg % NXCD, xcd = wgid % NXCD, off = wgid / NXCD; wgid = (xcd < r ? xcd * (q + 1) : r * (q + 1) + (xcd - r) * q) + off; }
        const int nig = WGM * nN, gid = wgid / nig, fm = gid * WGM, gsz = (nM - fm) < WGM ? (nM - fm) : WGM;
        u.pm = fm + ((wgid % nig) % gsz); u.pn = (wgid % nig) / gsz; return true;
    }
    __device__ __forceinline__ void a_ready(const Unit&) const {}
    __device__ __forceinline__ void done(const Unit&) const {}
};

typedef float cvt_f32x2_t __attribute__((ext_vector_type(2))); typedef __bf16 cvt_bf16x2_t __attribute__((ext_vector_type(2)));
__device__ __forceinline__ unsigned cvt_pk_bf16(float lo, float hi) { cvt_f32x2_t v = {lo, hi}; cvt_bf16x2_t b = __builtin_convertvector(v, cvt_bf16x2_t); return __builtin_bit_cast(unsigned, b); }
typedef float f32x2 __attribute__((ext_vector_type(2)));
__device__ __forceinline__ f32x2 gelu_pk(f32x2 v) {
    const f32x2 av = __builtin_elementwise_abs(v), d = av * 0.2316418882f + 1.0f;
    f32x2 t; t.x = __builtin_amdgcn_rcpf(d.x); t.y = __builtin_amdgcn_rcpf(d.y);
    f32x2 q = t * 0.5307027145f + (-0.7265760135f); q = q * t + 0.7107068705f; q = q * t + (-0.142248368f); q = q * t + 0.127414796f; q = q * t;
    const f32x2 s = (v * v) * (-0.72134752044f);
    f32x2 e; e.x = __builtin_amdgcn_exp2f(s.x); e.y = __builtin_amdgcn_exp2f(s.y);
    const f32x2 m = v * (q * e), r = v - m;
    f32x2 o; o.x = v.x < 0.f ? m.x : r.x; o.y = v.y < 0.f ? m.y : r.y; return o;
}

template <int ACT  > struct EpiBf16 {
    static constexpr bool PERM = true, AFTER_DRAIN = false; static_assert(ACT == 0 || ACT == 1, "EpiBf16: ACT is 0 (none) or 1 (gelu_pk)");
    bf16_t* O; int ldc; const float* bias; int split_cols; size_t split_stride; float scale0;
    __device__ __forceinline__ void operator()(const f32x4 (&acc)[2][2][4][2], const Unit& u, int wr, int wc, int fr, int fq) const {
        const int row0 = u.pm * BM + wr * 64 + fr; int colt = u.pn * BM; bf16_t* base = O;
        float sc = 1.f; if (split_cols) { const int t = colt / split_cols; base += (size_t)t * split_stride; colt -= t * split_cols; if (t == 0) sc = scale0; }
        const int col0 = colt + wc * 32 + 8 * fq, bcol0 = u.pn * BM + wc * 32 + 8 * fq;
        f32x4 bv[2][2];
#pragma unroll
        for (int bj = 0; bj < 2; ++bj)
#pragma unroll
            for (int n = 0; n < 2; ++n) bv[bj][n] = bias ? *(const f32x4*)(bias + bcol0 + bj * HALF + 4 * n) : (f32x4){0.f, 0.f, 0.f, 0.f};
#pragma unroll
        for (int ai = 0; ai < 2; ++ai)
#pragma unroll
            for (int m = 0; m < 4; ++m) { bf16_t* rowp = base + (size_t)(row0 + ai * HALF + m * 16) * ldc + col0;
#pragma unroll
                for (int bj = 0; bj < 2; ++bj) { f32x4 v0 = acc[ai][bj][m][0] + bv[bj][0], v1 = acc[ai][bj][m][1] + bv[bj][1];
                    if (ACT == 1) { f32x2 a = gelu_pk((f32x2){v0[0], v0[1]}), b = gelu_pk((f32x2){v0[2], v0[3]}), c = gelu_pk((f32x2){v1[0], v1[1]}), d = gelu_pk((f32x2){v1[2], v1[3]});
                        v0 = (f32x4){a.x, a.y, b.x, b.y}; v1 = (f32x4){c.x, c.y, d.x, d.y}; }
                    v0 = v0 * sc; v1 = v1 * sc; u32x4 w; w.x = cvt_pk_bf16(v0[0], v0[1]); w.y = cvt_pk_bf16(v0[2], v0[3]); w.z = cvt_pk_bf16(v1[0], v1[1]); w.w = cvt_pk_bf16(v1[2], v1[3]);
                    *(u32x4*)(rowp + bj * HALF) = w; } }
    }
};
template <class Epi, class Sched, bool ALIGN_EPI = false, bool SP2 = false>
__device__ __forceinline__ void gemm_phase(PG8_LAS unsigned char* lds, const Gemm g, const Sched& S, const Epi& E) {
    int tid_l = threadIdx.x; asm volatile("" : "+v"(tid_l)); const int tid = tid_l, wid = __builtin_amdgcn_readfirstlane(tid >> 6), lane = tid & 63, wr = wid >> 2, wc = wid & 3, fr = lane & 15, fq = lane >> 4;
    const int K = g.K, nt = K / BK;
    unsigned voffA[2], voffB[2];
#pragma unroll
    for (int i = 0; i < 2; ++i) { int R, C; stage_rc(tid * 16 + i * 8192, R, C); const int Rb = Epi::PERM ? ((R & ~31) + perm32(R & 31)) : R;
        voffA[i] = (unsigned)(R * g.lda + C) * 2u; voffB[i] = (unsigned)(Rb * g.ldb + C) * 2u; }
    const size_t kstep = (size_t)(BK * 2);
    const size_t hstepA = (size_t)HALF * g.lda * 2, hstepB = (size_t)HALF * g.ldb * 2; const size_t wrapb = (size_t)g.wrap_bytes;
    const unsigned ldsw = (unsigned)wid * 1024u;
    const int aoff = lds_byte(wr * 64 + fr, fq * 8), boff = lds_byte(wc * 32 + fr, fq * 8);
#define PG8_SA(b, h) (((b) * 2 + (h)) * HTB)
#define PG8_SB(b, h) ((4 + (b) * 2 + (h)) * HTB)
#define PG8_STAGE(bufoff, gbase, voff) do { _Pragma("unroll") for (int _i = 0; _i < 2; ++_i) \
        __builtin_amdgcn_global_load_lds((const unsigned*)((const char*)(gbase) + (voff)[_i]), (PG8_LAS unsigned*)(lds + (bufoff) + ldsw + _i * 8192), 16, 0, 0); } while (0)
#define PG8_LDA(dst, b, h) do { _Pragma("unroll") for (int m = 0; m < 4; ++m) _Pragma("unroll") for (int k = 0; k < 2; ++k) dst[m][k] = *(const PG8_LAS bf16x8*)(lds + PG8_SA(b, h) + aoff + m * 2048 + k * 1024); } while (0)
#define PG8_LDB(dst, b, h) do { _Pragma("unroll") for (int n = 0; n < 2; ++n) _Pragma("unroll") for (int k = 0; k < 2; ++k) dst[n][k] = *(const PG8_LAS bf16x8*)(lds + PG8_SB(b, h) + boff + n * 2048 + k * 1024); } while (0)
#define PG8_MMA(ai, bj, At, Bt) do { __builtin_amdgcn_s_setprio(1); _Pragma("unroll") for (int m = 0; m < 4; ++m) _Pragma("unroll") for (int n = 0; n < 2; ++n) _Pragma("unroll") for (int k = 0; k < 2; ++k) \
        acc[ai][bj][m][n] = __builtin_amdgcn_mfma_f32_16x16x32_bf16(Bt[n][k], At[m][k], acc[ai][bj][m][n], 0, 0, 0); __builtin_amdgcn_s_setprio(0); } while (0)
#define PG8_WAIT_V(n) asm volatile("s_waitcnt vmcnt(" #n ")" ::: "memory")
#define PG8_WAIT_L(n) asm volatile("s_waitcnt lgkmcnt(" #n ")" ::: "memory")
#define PG8_BAR __builtin_amdgcn_s_barrier()
#define PG8_SCHED __builtin_amdgcn_sched_barrier(0)
    Unit cur, nxt; int ui = 0;
    if (!S.next(0, cur)) return;
    f32x4 acc[2][2][4][2];
#pragma unroll
    for (int a = 0; a < 2; ++a)
#pragma unroll
        for (int b = 0; b < 2; ++b)
#pragma unroll
            for (int m = 0; m < 4; ++m)
#pragma unroll
                for (int n = 0; n < 2; ++n) acc[a][b][m][n] = (f32x4){0.f, 0.f, 0.f, 0.f};
    bf16x8 At[4][2], B0[2][2], B1[2][2];
    const char* cA = g.abase(cur); const char* cB = g.bbase(cur);
    S.a_ready(cur);
    if constexpr (SP2) {
        PG8_STAGE(PG8_SB(0, 0), cB, voffB); PG8_STAGE(PG8_SB(0, 1), cB + hstepB, voffB); PG8_STAGE(PG8_SA(0, 0), cA, voffA); PG8_STAGE(PG8_SA(0, 1), cA + hstepA, voffA);
        if (wr == 1) PG8_BAR;
        PG8_WAIT_V(2); PG8_BAR;
        PG8_STAGE(PG8_SB(1, 0), cB + kstep, voffB); PG8_STAGE(PG8_SA(1, 0), cA + kstep, voffA); PG8_STAGE(PG8_SB(1, 1), cB + hstepB + kstep, voffB);
        PG8_WAIT_V(6); PG8_BAR;
    } else {
        PG8_STAGE(PG8_SB(0, 0), cB, voffB); PG8_STAGE(PG8_SA(0, 0), cA, voffA); PG8_STAGE(PG8_SB(0, 1), cB + hstepB, voffB); PG8_STAGE(PG8_SA(0, 1), cA + hstepA, voffA);
        if (wr == 1) PG8_BAR;
        PG8_WAIT_V(4); PG8_BAR;
        PG8_STAGE(PG8_SB(1, 0), cB + kstep, voffB); PG8_STAGE(PG8_SA(1, 0), cA + kstep, voffA); PG8_STAGE(PG8_SB(1, 1), cB + hstepB + kstep, voffB);
        PG8_WAIT_V(6); PG8_BAR;
    }
    for (;;) {
        const bool has_next = S.next(ui + 1, nxt);
        const char* nA = has_next ? g.abase(nxt) : cA; const char* nB = has_next ? g.bbase(nxt) : cB;
        for (int t = 0; t < nt; t += 2) {
            const bool last = (t == nt - 2);
            const char* a1 = cA + (size_t)(t + 1) * kstep - ((t + 1) >= g.kwrap ? wrapb : (size_t)0);
            const char* a2 = last ? nA : cA + (size_t)(t + 2) * kstep - ((t + 2) >= g.kwrap ? wrapb : (size_t)0); const char* b2 = last ? nB : cB + (size_t)(t + 2) * kstep;
            const char* a3 = a2 + kstep; const char* b3 = b2 + kstep;
            if (last && has_next) S.a_ready(nxt);
            if constexpr (SP2) {
            PG8_LDB(B0, 0, 0); PG8_LDB(B1, 0, 1); PG8_SCHED; PG8_LDA(At, 0, 0); PG8_STAGE(PG8_SA(1, 1), a1 + hstepA, voffA);
            PG8_WAIT_V(8); PG8_WAIT_L(0); PG8_BAR; PG8_MMA(0, 0, At, B0); PG8_MMA(0, 1, At, B1); PG8_BAR; PG8_SCHED;
            PG8_LDA(At, 0, 1); PG8_STAGE(PG8_SB(0, 0), b2, voffB); PG8_STAGE(PG8_SB(0, 1), b2 + hstepB, voffB); PG8_STAGE(PG8_SA(0, 0), a2, voffA);
            PG8_WAIT_V(8); PG8_WAIT_L(0); PG8_BAR; PG8_MMA(1, 0, At, B0); PG8_MMA(1, 1, At, B1); PG8_BAR; PG8_SCHED;
            PG8_LDB(B0, 1, 0); PG8_LDB(B1, 1, 1); PG8_SCHED; PG8_LDA(At, 1, 0); PG8_STAGE(PG8_SA(0, 1), a2 + hstepA, voffA);
            PG8_WAIT_V(8); PG8_WAIT_L(0); PG8_BAR; PG8_MMA(0, 0, At, B0); PG8_MMA(0, 1, At, B1); PG8_BAR; PG8_SCHED;
            PG8_LDA(At, 1, 1); PG8_STAGE(PG8_SB(1, 0), b3, voffB); PG8_STAGE(PG8_SB(1, 1), b3 + hstepB, voffB); PG8_STAGE(PG8_SA(1, 0), a3, voffA);
            PG8_WAIT_V(8); PG8_WAIT_L(0); PG8_BAR; PG8_MMA(1, 0, At, B0); PG8_MMA(1, 1, At, B1); PG8_BAR; PG8_SCHED;
            } else {
            PG8_LDB(B0, 0, 0); PG8_SCHED; PG8_LDA(At, 0, 0); PG8_STAGE(PG8_SA(1, 1), a1 + hstepA, voffA);
            PG8_WAIT_L(8); PG8_BAR; PG8_WAIT_L(0); PG8_MMA(0, 0, At, B0); PG8_BAR; PG8_SCHED;
            PG8_LDB(B1, 0, 1); PG8_STAGE(PG8_SB(0, 0), b2, voffB);
            PG8_BAR; PG8_WAIT_L(0); PG8_MMA(0, 1, At, B1); PG8_BAR;
            PG8_LDA(At, 0, 1); PG8_STAGE(PG8_SA(0, 0), a2, voffA);
            PG8_BAR; PG8_WAIT_L(0); PG8_MMA(1, 0, At, B0); PG8_BAR; PG8_SCHED;
            PG8_STAGE(PG8_SB(0, 1), b2 + hstepB, voffB);
            PG8_WAIT_V(6); PG8_BAR; PG8_MMA(1, 1, At, B1); PG8_BAR;
            PG8_LDB(B0, 1, 0); PG8_SCHED; PG8_LDA(At, 1, 0); PG8_STAGE(PG8_SA(0, 1), a2 + hstepA, voffA);
            PG8_WAIT_L(8); PG8_BAR; PG8_WAIT_L(0); PG8_MMA(0, 0, At, B0); PG8_BAR; PG8_SCHED;
            PG8_LDB(B1, 1, 1); PG8_STAGE(PG8_SB(1, 0), b3, voffB);
            PG8_BAR; PG8_WAIT_L(0); PG8_MMA(0, 1, At, B1); PG8_BAR;
            PG8_LDA(At, 1, 1); PG8_STAGE(PG8_SA(1, 0), a3, voffA);
            PG8_BAR; PG8_WAIT_L(0); PG8_MMA(1, 0, At, B0); PG8_BAR; PG8_SCHED;
            PG8_STAGE(PG8_SB(1, 1), b3 + hstepB, voffB);
            PG8_WAIT_V(6); PG8_BAR; PG8_MMA(1, 1, At, B1); PG8_BAR;
            }
        }
        if constexpr (ALIGN_EPI) { if (wr == 0) PG8_BAR; }
        if constexpr (!Epi::AFTER_DRAIN) { E(acc, cur, wr, wc, fr, fq); S.done(cur); }
        if (!has_next) break;
#pragma unroll
        for (int a = 0; a < 2; ++a)
#pragma unroll
            for (int b = 0; b < 2; ++b)
#pragma unroll
                for (int m = 0; m < 4; ++m)
#pragma unroll
                    for (int n = 0; n < 2; ++n) acc[a][b][m][n] = (f32x4){0.f, 0.f, 0.f, 0.f};
        cur = nxt; cA = nA; cB = nB; ++ui;
        if constexpr (ALIGN_EPI) { if (wr == 1) PG8_BAR; }
    }
    PG8_WAIT_V(0);
    if constexpr (!ALIGN_EPI) { if (wr == 0) PG8_BAR; }
    PG8_BAR;
    if constexpr (Epi::AFTER_DRAIN) { E.fused(acc, cur, wr, wc, fr, fq, lds, wid, lane); S.done(cur); }
#undef PG8_SA
#undef PG8_SB
#undef PG8_STAGE
#undef PG8_LDA
#undef PG8_LDB
#undef PG8_MMA
#undef PG8_WAIT_V
#undef PG8_WAIT_L
#undef PG8_BAR
#undef PG8_SCHED
}
}
#include <hip/hip_bf16.h>
#include <cmath>
namespace attn_body {
using bf16=__hip_bfloat16;
using bf16x8=__attribute__((ext_vector_type(8)))short;
using s16x4=__attribute__((ext_vector_type(4)))short;
using f32x16=__attribute__((ext_vector_type(16)))float;
using u32x4=__attribute__((ext_vector_type(4)))unsigned;
constexpr int BATCH=4,NHEAD=16,SEQ=4096,D=64,DMQ=512,DMO=1024;
constexpr int NW=8,QBLK=32,QB=QBLK*NW,KVBLK=64,NQB=SEQ/QB;
constexpr int ATTN_UNIT_ROWS=QB;
__device__ __forceinline__ int crow(int r,int hi){return (r&3)+8*(r>>2)+4*hi;}
#define SBAR() __builtin_amdgcn_sched_barrier(0)
__device__ __forceinline__ void cmask(f32x16&p0,f32x16&p1,int jb,int qrel,int hi){
  const float NEG=-INFINITY; int kb=64*jb+4*hi;
  #pragma unroll
  for(int r=0;r<16;++r){int kv=kb+(r&3)+8*(r>>2); if(kv>qrel)p0[r]=NEG; if(kv+32>qrel)p1[r]=NEG;}
}

constexpr int NSLOT=3, SLOTB=8192;
constexpr int LDS_K=0, LDS_V=NSLOT*SLOTB, LDS_WS=2*NSLOT*SLOTB, LDS_OST=LDS_WS+NW*64*4, LDS_BYTES=LDS_OST+NW*4096;
constexpr float C2=0.125f*1.4426950408889634f;
__device__ __forceinline__ void glds16(const void*gsrc,unsigned lds_dst){unsigned keep;
  asm volatile("s_mov_b32 %0, m0\n\ts_mov_b32 m0, %2\n\ts_nop 0\n\tglobal_load_lds_dwordx4 %1, off\n\ts_mov_b32 m0, %0":"=&s"(keep):"v"(gsrc),"s"(lds_dst):"memory");}
__device__ __forceinline__ float max3f(float a,float b,float c){float r;asm("v_max3_f32 %0, %1, %2, %3":"=v"(r):"v"(a),"v"(b),"v"(c));return r;}
__device__ __forceinline__ float max2f(float a,float b){float r;asm("v_max_f32_e32 %0, %1, %2":"=v"(r):"v"(a),"v"(b));return r;}
__device__ __forceinline__ float fadd_s(float a,float b){float r;asm("v_add_f32_e32 %0, %1, %2":"=v"(r):"v"(a),"v"(b));return r;}
__device__ __forceinline__ float fsub_s(float a,float b){float r;asm("v_sub_f32_e32 %0, %1, %2":"=v"(r):"v"(a),"v"(b));return r;}
typedef float f32x2_t __attribute__((ext_vector_type(2))); typedef __bf16 bf16x2_t __attribute__((ext_vector_type(2)));
__device__ __forceinline__ unsigned cvtpk_s(float lo,float hi){f32x2_t v={lo,hi};bf16x2_t b=__builtin_convertvector(v,bf16x2_t);return __builtin_bit_cast(unsigned,b);}
#define WAIT_BAR(N) asm volatile("s_waitcnt vmcnt(" #N ") lgkmcnt(0)\n\ts_barrier":::"memory")

__device__ __forceinline__ void qkt(f32x16&p0,f32x16&p1,const char*Kslot,const bf16x8*qr,const f32x16&negm,int r32,int hi){
  const char*kb=Kslot+hi*1024+r32*16;
  #pragma unroll
  for(int d0=0;d0<4;++d0){
    const bf16x8 b0=*reinterpret_cast<const bf16x8*>(kb+d0*2048);
    const bf16x8 b1=*reinterpret_cast<const bf16x8*>(kb+d0*2048+512);
    if(d0==0){p0=__builtin_amdgcn_mfma_f32_32x32x16_bf16(b0,qr[0],negm,0,0,0);p1=__builtin_amdgcn_mfma_f32_32x32x16_bf16(b1,qr[0],negm,0,0,0);}
    else{p0=__builtin_amdgcn_mfma_f32_32x32x16_bf16(b0,qr[d0],p0,0,0,0);p1=__builtin_amdgcn_mfma_f32_32x32x16_bf16(b1,qr[d0],p1,0,0,0);}}
}
typedef __attribute__((address_space(3))) const char* lds_cptr;
typedef short v4i16_t __attribute__((ext_vector_type(4)));
__device__ __forceinline__ void kload8(bf16x8*kf,lds_cptr kp){
  kf[0]=*(const __attribute__((address_space(3))) bf16x8*)(kp);      kf[1]=*(const __attribute__((address_space(3))) bf16x8*)(kp+512);
  kf[2]=*(const __attribute__((address_space(3))) bf16x8*)(kp+2048); kf[3]=*(const __attribute__((address_space(3))) bf16x8*)(kp+2560);
  kf[4]=*(const __attribute__((address_space(3))) bf16x8*)(kp+4096); kf[5]=*(const __attribute__((address_space(3))) bf16x8*)(kp+4608);
  kf[6]=*(const __attribute__((address_space(3))) bf16x8*)(kp+6144); kf[7]=*(const __attribute__((address_space(3))) bf16x8*)(kp+6656);
}
__device__ __forceinline__ void kload2(bf16x8*kf,lds_cptr kp,int j){ kf[2*j]=*(const __attribute__((address_space(3))) bf16x8*)(kp+j*2048); kf[2*j+1]=*(const __attribute__((address_space(3))) bf16x8*)(kp+j*2048+512); }
__device__ __forceinline__ s16x4 vtr(lds_cptr p){ return __builtin_bit_cast(s16x4,__builtin_amdgcn_ds_read_tr16_b64_v4i16((__attribute__((address_space(3))) v4i16_t*)p)); }
__device__ __forceinline__ float rowmax(const f32x16&p0,const f32x16&p1){
  float a=max3f(p0[0],p0[1],p1[0]),b=max3f(p0[2],p0[3],p1[1]);a=max3f(a,p1[2],p1[3]);
  #pragma unroll
  for(int r=4;r<16;r+=4){a=max3f(a,p0[r],p0[r+1]);b=max3f(b,p0[r+2],p0[r+3]);a=max3f(a,p1[r],p1[r+1]);b=max3f(b,p1[r+2],p1[r+3]);}
  const float m=max2f(a,b);
  auto rr=__builtin_amdgcn_permlane32_swap(__float_as_uint(m),__float_as_uint(m),false,false);
  return max2f(__uint_as_float(rr[0]),__uint_as_float(rr[1]));
}
__device__ __forceinline__ void pv(f32x16*o,int vb,bf16x8 pa0,bf16x8 pa1,bf16x8 pa2,bf16x8 pa3){
  #pragma unroll
  for(int d0=0;d0<2;++d0){s16x4 lo[4],hi[4];
    #pragma unroll
    for(int ks=0;ks<4;++ks){
      asm volatile("ds_read_b64_tr_b16 %0,%1 offset:%c2":"=&v"(lo[ks]):"v"(vb),"i"(d0*4096+ks*1024):"memory");
      asm volatile("ds_read_b64_tr_b16 %0,%1 offset:%c2":"=&v"(hi[ks]):"v"(vb),"i"(d0*4096+ks*1024+512):"memory");}
    asm volatile("s_waitcnt lgkmcnt(0)":::"memory");SBAR();
    #define PK(k) (bf16x8){lo[k][0],lo[k][1],lo[k][2],lo[k][3],hi[k][0],hi[k][1],hi[k][2],hi[k][3]}
    o[d0]=__builtin_amdgcn_mfma_f32_32x32x16_bf16(pa0,PK(0),o[d0],0,0,0);
    o[d0]=__builtin_amdgcn_mfma_f32_32x32x16_bf16(pa1,PK(1),o[d0],0,0,0);
    o[d0]=__builtin_amdgcn_mfma_f32_32x32x16_bf16(pa2,PK(2),o[d0],0,0,0);
    o[d0]=__builtin_amdgcn_mfma_f32_32x32x16_bf16(pa3,PK(3),o[d0],0,0,0);
    #undef PK
  }
}

#ifndef ATTN_STORE16
#define ATTN_STORE16(p,v) (*(u32x4*)(p)=(v))
#endif
template<int THRL> __device__ __forceinline__ void attn_unit(int b,int cq,int ck,int cv,int co,int qb,const bf16*Q,const bf16*__restrict__ K,const bf16*__restrict__ V,bf16*O,char*shm){
  int tid_l=threadIdx.x; asm volatile("":"+v"(tid_l)); const int tid=tid_l,lane=tid&63,r32=lane&31,hi=lane>>5; const int wid=__builtin_amdgcn_readfirstlane(tid>>6);
  const long rowbase=(long)b*SEQ; const int q0=qb*QB;
  const bf16*Qw=Q+(rowbase+q0+wid*QBLK)*DMQ+cq;
  const bf16*Kh=K+rowbase*DMQ+ck,*Vh=V+rowbase*DMQ+cv;
  const unsigned lds0=(unsigned)(uintptr_t)shm;
  float*wsf=(float*)(shm+LDS_WS)+wid*64;
  const bf16*ksrc=Kh+(long)lane*DMQ+wid*8;
  const bf16*vsrc=Vh+(long)(16*(wid&3)+(lane>>2))*DMQ+(wid>>2)*32+(lane&3)*8;
  const unsigned kdst=lds0+LDS_K+wid*1024, vdst=lds0+LDS_V+wid*1024;
  #define DMA_K(t,slot) glds16(ksrc+(long)(t)*KVBLK*DMQ,(unsigned)__builtin_amdgcn_readfirstlane(kdst+(slot)))
  #define DMA_V(t,slot) glds16(vsrc+(long)(t)*KVBLK*DMQ,(unsigned)__builtin_amdgcn_readfirstlane(vdst+(slot)))
  const int vb0=(int)(lds0+LDS_V)+((lane>>4)&1)*32+(lane&3)*8+(4*hi+((lane&15)>>2))*64;
  const char*Kbase=shm+LDS_K; bf16x8 kf[8];
  const lds_cptr shm3=(lds_cptr)shm; const lds_cptr kp0=shm3+LDS_K+hi*1024+r32*16; const lds_cptr vp0=shm3+LDS_V+((lane>>4)&1)*32+(lane&3)*8+(4*hi+((lane&15)>>2))*64;
  const int NT=(q0+QB)/KVBLK;
  DMA_K(0,0);DMA_V(0,0);DMA_K(1,SLOTB);
  bf16x8 qr[4];
  #pragma unroll
  for(int d0=0;d0<4;++d0)qr[d0]=*reinterpret_cast<const bf16x8*>(&Qw[(long)r32*DMQ+d0*16+hi*8]);
  float mhat=0.f,l_reg=0.f;f32x16 o[2];o[0]=f32x16{};o[1]=f32x16{};f32x16 negm=f32x16{};asm volatile("":"+v"(negm));
  const int qrel=wid*QBLK+r32;
  #define CMASK(P0,P1,t) do{int jb_=(t)-(NT-4); if(jb_>=0)cmask(P0,P1,jb_,qrel,hi);}while(0)
  bool resc=false;
  #define START(P0,P1) do{ const float rm=rowmax(P0,P1); resc=false; \
    { const float dl=rm; mhat=fadd_s(mhat,dl); \
      _Pragma("unroll") for(int r=0;r<16;++r){P0[r]=fsub_s(P0[r],dl);P1[r]=fsub_s(P1[r],dl);} \
      _Pragma("unroll") for(int r=0;r<16;++r)negm[r]=-mhat; asm volatile("":"+v"(negm)); } \
    _Pragma("unroll") for(int r=0;r<16;++r)P0[r]=__builtin_amdgcn_exp2f(P0[r]); }while(0)
  #define RESC() do{ if(resc){ asm volatile("s_waitcnt lgkmcnt(0)":::"memory"); \
      _Pragma("unroll") for(int d_=0;d_<2;++d_) _Pragma("unroll") for(int r=0;r<16;++r)o[d_][r]*=wsf[crow(r,hi)]; } }while(0)
  f32x16 pA0,pA1,pB0,pB1;
  int sl_prev=0,sl_cur=0,sl_next=SLOTB;
  #define ROT() do{sl_prev=sl_cur;sl_cur=sl_next;sl_next=(sl_next==(NSLOT-1)*SLOTB)?0:sl_next+SLOTB;}while(0)
  DMA_K(2,2*SLOTB);
  WAIT_BAR(3);
  qkt(pA0,pA1,Kbase,qr,negm,r32,hi);asm volatile("s_nop 15\n\ts_nop 7":"+v"(pA0),"+v"(pA1));CMASK(pA0,pA1,0);
  START(pA0,pA1);
  _Pragma("unroll") for(int r=0;r<16;++r)pA1[r]=__builtin_amdgcn_exp2f(pA1[r]);
  WAIT_BAR(0);
  DMA_K(3,0);DMA_V(1,SLOTB);
  ROT();
  kload8(kf,kp0+sl_cur);
  WAIT_BAR(2);
  s16x4 vlo[8],vhi[8]; u32x4 pw0,pw1,pw2,pw3;
  #define PKW(P,B) cvtpk_s(P[B],P[B+1])
  #define PAF(k) __builtin_bit_cast(bf16x8,pw##k)
  #define VFR(i) (bf16x8){vlo[i][0],vlo[i][1],vlo[i][2],vlo[i][3],vhi[i][0],vhi[i][1],vhi[i][2],vhi[i][3]}
  #define PIN(x) asm volatile("":"+v"(x))
  #define MX3(a,b,c) __builtin_fmaxf(__builtin_fmaxf((a),(b)),(c))
  #define GAPA(MF,A0,A1,A2,A3,W0,W1,PW) do{ MF; sacc+=A0; sacc+=A1; sacc+=A2; sacc+=A3; PIN(sacc); W0; W1; PIN(PW); SBAR(); }while(0)
  #define EX(v) __builtin_amdgcn_exp2f(v)
  #define GAPB(MF,X,B) do{ MF; X[B]=EX(X[B]); X[B+1]=EX(X[B+1]); X[B+2]=EX(X[B+2]); X[B+3]=EX(X[B+3]); PIN(X); SBAR(); }while(0)
  #define VRD(i) do{ vlo[i]=vtr(vp_+(((i)>>2)*4096+((i)&3)*1024)); vhi[i]=vtr(vp_+(((i)>>2)*4096+((i)&3)*1024+512)); }while(0)
  #define KRD(G,j) do{ if(G){ kload2(kf,kp0+sl_next,j); SBAR(); } }while(0)
  #define STEP(C0,C1,P0,P1,t,GK,GV,GL) do{ SBAR(); \
    const lds_cptr vp_=vp0+sl_prev; \
    VRD(0); SBAR(); float sacc=(P0[0]+P0[1]); \
    GAPA(C0=__builtin_amdgcn_mfma_f32_32x32x16_bf16(kf[0],qr[0],negm,0,0,0), P0[2],P0[3],P0[4],P0[5],     pw0[0]=PKW(P0,0), pw0[1]=PKW(P0,2), pw0); \
    VRD(4); SBAR(); GAPA(C1=__builtin_amdgcn_mfma_f32_32x32x16_bf16(kf[1],qr[0],negm,0,0,0), P0[6],P0[7],P0[8],P0[9],     pw0[2]=PKW(P0,4), pw0[3]=PKW(P0,6), pw0); \
    VRD(1); SBAR(); GAPA(C0=__builtin_amdgcn_mfma_f32_32x32x16_bf16(kf[2],qr[1],C0,0,0,0),   P0[10],P0[11],P0[12],P0[13], pw1[0]=PKW(P0,8), pw1[1]=PKW(P0,10), pw1); \
    VRD(5); SBAR(); GAPA(C1=__builtin_amdgcn_mfma_f32_32x32x16_bf16(kf[3],qr[1],C1,0,0,0),   P0[14],P0[15],P1[0],P1[1],   pw1[2]=PKW(P0,12),pw1[3]=PKW(P0,14), pw1); \
    VRD(2); SBAR(); GAPA(C0=__builtin_amdgcn_mfma_f32_32x32x16_bf16(kf[4],qr[2],C0,0,0,0),   P1[2],P1[3],P1[4],P1[5],     pw2[0]=PKW(P1,0), pw2[1]=PKW(P1,2), pw2); \
    VRD(6); SBAR(); GAPA(C1=__builtin_amdgcn_mfma_f32_32x32x16_bf16(kf[5],qr[2],C1,0,0,0),   P1[6],P1[7],P1[8],P1[9],     pw2[2]=PKW(P1,4), pw2[3]=PKW(P1,6), pw2); \
    VRD(3); SBAR(); GAPA(C0=__builtin_amdgcn_mfma_f32_32x32x16_bf16(kf[6],qr[3],C0,0,0,0),   P1[10],P1[11],P1[12],P1[13], pw3[0]=PKW(P1,8), pw3[1]=PKW(P1,10), pw3); \
    VRD(7); SBAR(); GAPA(C1=__builtin_amdgcn_mfma_f32_32x32x16_bf16(kf[7],qr[3],C1,0,0,0),   P1[14],P1[15],0.f,0.f,       pw3[2]=PKW(P1,12),pw3[3]=PKW(P1,14), pw3); \
    l_reg+=sacc; \
    if(GK){DMA_K((t)+3,sl_cur);} if(GV){DMA_V((t)+1,sl_next);} \
    CMASK(C0,C1,t); \
    { float a=MX3(C0[0],C0[1],C1[0]),b=MX3(C0[2],C0[3],C1[1]); a=MX3(a,C1[2],C1[3]); \
      _Pragma("unroll") for(int r=4;r<16;r+=4){a=MX3(a,C0[r],C0[r+1]);b=MX3(b,C0[r+2],C0[r+3]);a=MX3(a,C1[r],C1[r+1]);b=MX3(b,C1[r+2],C1[r+3]);} \
      float rm=__builtin_fmaxf(a,b); { auto rr=__builtin_amdgcn_permlane32_swap(__float_as_uint(rm),__float_as_uint(rm),false,false); rm=__builtin_fmaxf(__uint_as_float(rr[0]),__uint_as_float(rr[1])); } \
      resc=false; \
      if(__builtin_expect(__any(rm>(float)THRL),0)){ const float dl=__builtin_fmaxf(rm,0.f); mhat+=dl; \
        _Pragma("unroll") for(int r=0;r<16;++r){C0[r]-=dl;C1[r]-=dl;} \
        _Pragma("unroll") for(int r=0;r<16;++r)negm[r]=-mhat; asm volatile("":"+v"(negm)); \
        const float f=__builtin_amdgcn_exp2f(-dl); l_reg*=f; if(hi==0)wsf[r32]=f; resc=true; } } \
    SBAR(); \
    GAPB(o[0]=__builtin_amdgcn_mfma_f32_32x32x16_bf16(PAF(0),VFR(0),o[0],0,0,0), C0,0); \
    GAPB(o[1]=__builtin_amdgcn_mfma_f32_32x32x16_bf16(PAF(0),VFR(4),o[1],0,0,0), C0,4); \
    KRD(GL,0); GAPB(o[0]=__builtin_amdgcn_mfma_f32_32x32x16_bf16(PAF(1),VFR(1),o[0],0,0,0), C0,8); \
    KRD(GL,1); GAPB(o[1]=__builtin_amdgcn_mfma_f32_32x32x16_bf16(PAF(1),VFR(5),o[1],0,0,0), C0,12); \
    KRD(GL,2); GAPB(o[0]=__builtin_amdgcn_mfma_f32_32x32x16_bf16(PAF(2),VFR(2),o[0],0,0,0), C1,0); \
    KRD(GL,3); GAPB(o[1]=__builtin_amdgcn_mfma_f32_32x32x16_bf16(PAF(2),VFR(6),o[1],0,0,0), C1,4); \
    GAPB(o[0]=__builtin_amdgcn_mfma_f32_32x32x16_bf16(PAF(3),VFR(3),o[0],0,0,0), C1,8); \
    GAPB(o[1]=__builtin_amdgcn_mfma_f32_32x32x16_bf16(PAF(3),VFR(7),o[1],0,0,0), C1,12); \
    }while(0)
  int t=1;
  #undef CMASK
  #define CMASK(P0,P1,t) do{}while(0)
  for(;t+5<NT;t+=2){
    STEP(pB0,pB1,pA0,pA1,t,true,true,true);     WAIT_BAR(2); RESC(); ROT();
    STEP(pA0,pA1,pB0,pB1,t+1,true,true,true);   WAIT_BAR(2); RESC(); ROT();
  }
  #undef CMASK
  #define CMASK(P0,P1,t) do{int jb_=(t)-(NT-4); if(jb_>=0)cmask(P0,P1,jb_,qrel,hi);}while(0)
  #define ENDW(tt) do{ if((tt)+3<NT){WAIT_BAR(2);} else if((tt)+2<NT){WAIT_BAR(1);} else {WAIT_BAR(0);} }while(0)
  for(;t+1<NT;t+=2){
    STEP(pB0,pB1,pA0,pA1,t,(t+3<NT),(t+1<NT),(t+1<NT));       ENDW(t);   RESC(); ROT();
    STEP(pA0,pA1,pB0,pB1,t+1,(t+4<NT),(t+2<NT),(t+2<NT));     ENDW(t+1); RESC(); ROT();
  }
  STEP(pB0,pB1,pA0,pA1,NT-1,false,false,false); RESC();
  { float sacc=pB0[0]+pB0[1]; _Pragma("unroll") for(int r=2;r<16;++r)sacc+=pB0[r]; _Pragma("unroll") for(int r=0;r<16;++r)sacc+=pB1[r]; l_reg+=sacc;
    pw0=(u32x4){PKW(pB0,0),PKW(pB0,2),PKW(pB0,4),PKW(pB0,6)};pw1=(u32x4){PKW(pB0,8),PKW(pB0,10),PKW(pB0,12),PKW(pB0,14)};pw2=(u32x4){PKW(pB1,0),PKW(pB1,2),PKW(pB1,4),PKW(pB1,6)};pw3=(u32x4){PKW(pB1,8),PKW(pB1,10),PKW(pB1,12),PKW(pB1,14)};
    SBAR(); pv(o,vb0+sl_cur,PAF(0),PAF(1),PAF(2),PAF(3)); }
  #undef PKW
  #undef PAF
  #undef VFR
  #undef PIN
  #undef MX3
  #undef GAPA
  #undef GAPB
  #undef EX
  #undef VRD
  #undef KRD
  #undef STEP
  #undef ENDW
  {auto rr=__builtin_amdgcn_permlane32_swap(__float_as_uint(l_reg),__float_as_uint(l_reg),false,false);l_reg=__uint_as_float(rr[0])+__uint_as_float(rr[1]);}
  if(hi==0)wsf[32+r32]=l_reg;asm volatile("s_waitcnt lgkmcnt(0)":::"memory");
  float rli[16];
  #pragma unroll
  for(int r=0;r<16;++r)rli[r]=__builtin_amdgcn_rcpf(wsf[32+crow(r,hi)]);
  bf16*Ow=O+(rowbase+q0+wid*QBLK)*DMO+co;
  { bf16*stg=(bf16*)(shm+LDS_OST)+wid*2048;
    #pragma unroll
    for(int r=0;r<16;++r){const int orow=crow(r,hi);
      #pragma unroll
      for(int d0=0;d0<2;++d0)stg[orow*64+d0*32+r32]=__float2bfloat16(o[d0][r]*rli[r]);}
    asm volatile("s_waitcnt lgkmcnt(0)":::"memory");
    #pragma unroll
    for(int i=0;i<4;++i){const int row=i*8+(lane>>3),ch=lane&7; const u32x4 v=*(const u32x4*)(stg+row*64+ch*8); ATTN_STORE16(Ow+(long)row*DMO+ch*8,v);} }
  asm volatile("s_waitcnt lgkmcnt(0)\n\ts_barrier":::"memory");
  #undef DMA_K
  #undef DMA_V
  #undef CMASK
  #undef START
  #undef RESC
  #undef ROT
}
constexpr int ATTN_LDS_BYTES=LDS_BYTES;
#undef SBAR
#undef WAIT_BAR
}
namespace cg = cooperative_groups;
#define GAS __attribute__((address_space(1)))
#define LAS __attribute__((address_space(3)))
typedef unsigned short bf16;
typedef unsigned v4u __attribute__((ext_vector_type(4)));
typedef unsigned v2u __attribute__((ext_vector_type(2)));
typedef float f32x4 __attribute__((ext_vector_type(4)));
constexpr int NWAVES = 8, NTHR = 512;
constexpr int M = 16384, DMOD = 1024, SEQ = 4096, NIN = 6816, DFF = 2816, ZP = 1728;
constexpr size_t MiB = 1u << 20;
constexpr size_t WS_CTL = 0;
constexpr size_t WS_WGLU = 1 * MiB, WS_WB = WS_WGLU + MiB / 2, WS_WO = WS_WB + 3 * MiB, WS_WFI = WS_WO + 2 * MiB, WS_WFO = WS_WFI + 11 * MiB;
constexpr size_t WS_WX = 23 * MiB, WS_W1A = WS_WX, WS_W1B = WS_WX + 4 * MiB, WS_E = WS_WX, WS_WG = WS_WX;
constexpr size_t WS_VF = 40 * MiB, WS_US = 56 * MiB, WS_YA = 80 * MiB, WS_Z = 96 * MiB, WS_QB = 150 * MiB, WS_KB = 166 * MiB, WS_VB = 182 * MiB;
constexpr size_t WS_XNP = 198 * MiB, WS_O = 198 * MiB, WS_AB = 231 * MiB, WS_PT = 247 * MiB, WS_MT = 249 * MiB, WS_END = 256 * MiB;
constexpr size_t WS_XN = 150 * MiB, WS_YL = 182 * MiB, WS_G = 182 * MiB, WS_MERGED = 214 * MiB, WS_H2N = 96 * MiB, WS_HID = 150 * MiB;
static_assert(WS_WFO + (size_t)1024 * 2816 * 2 <= WS_WX && WS_Z + (size_t)M * ZP * 2 <= WS_QB && WS_XNP + (size_t)4 * 4097 * 1024 * 2 <= WS_AB && WS_MT + (size_t)32 * 256 * 384 * 2 <= WS_END && WS_HID + (size_t)M * DFF * 2 <= WS_END, "ws map");
constexpr int LDS_BYTES = 148480; constexpr int LDS_XB = 147456; constexpr int CW_BAR = 4096;
constexpr float C2Q = 0.125f * 1.4426950408889634f;

__device__ __forceinline__ unsigned f2bf(float f) { unsigned u = __builtin_bit_cast(unsigned, f); return (u + 0x7fffu + ((u >> 16) & 1u)) >> 16; }
__device__ __forceinline__ float bf2f(unsigned b) { return __uint_as_float(b << 16); }
__device__ __forceinline__ void unpack8(const v4u w, float* f) {
    f[0] = __uint_as_float(w.x << 16); f[1] = __uint_as_float(w.x & 0xffff0000u); f[2] = __uint_as_float(w.y << 16); f[3] = __uint_as_float(w.y & 0xffff0000u);
    f[4] = __uint_as_float(w.z << 16); f[5] = __uint_as_float(w.z & 0xffff0000u); f[6] = __uint_as_float(w.w << 16); f[7] = __uint_as_float(w.w & 0xffff0000u); }
__device__ __forceinline__ v4u pack8(const float* f) { v4u w; w.x = pg8::cvt_pk_bf16(f[0], f[1]); w.y = pg8::cvt_pk_bf16(f[2], f[3]); w.z = pg8::cvt_pk_bf16(f[4], f[5]); w.w = pg8::cvt_pk_bf16(f[6], f[7]); return w; }
__device__ __forceinline__ float sigm(float x) { return __builtin_amdgcn_rcpf(1.f + __expf(-x)); }
__device__ __forceinline__ float tanh_f(float x) { return 1.f - 2.f * __builtin_amdgcn_rcpf(1.f + __expf(2.f * x)); }
__device__ __forceinline__ float wave_sum(float v) {
#pragma unroll
    for (int o = 1; o < 64; o <<= 1) v += __shfl_xor(v, o);
    return v; }
__device__ __forceinline__ float dppf(float x, const int ctrl) { return x; }
#define DPP_ADD(x, ctrl) ((x) + __builtin_bit_cast(float, __builtin_amdgcn_update_dpp(0, __builtin_bit_cast(int, (x)), (ctrl), 0xf, 0xf, true)))
__device__ __forceinline__ float row16_sum(float x) { x = DPP_ADD(x, 0xB1); x = DPP_ADD(x, 0x4E); x = DPP_ADD(x, 0x141); x = DPP_ADD(x, 0x140); return x; }

template <int MODE> struct Epi8 {
    static constexpr bool PERM = true, AFTER_DRAIN = false;
    bf16* O; int ldc; const bf16* X; const float* P;
    __device__ __forceinline__ void operator()(const pg8::f32x4 (&acc)[2][2][4][2], const pg8::Unit& u, int wr, int wc, int fr, int fq) const {
#pragma unroll
        for (int ai = 0; ai < 2; ++ai)
#pragma unroll
            for (int m = 0; m < 4; ++m) {
                const int row = u.pm * 256 + ai * 128 + wr * 64 + m * 16 + fr;
                if (MODE == 8) {
                    float o[8];
#pragma unroll
                    for (int i = 0; i < 8; ++i) { const float gte = acc[ai][0][m][i >> 2][i & 3], up = acc[ai][1][m][i >> 2][i & 3]; o[i] = gte * sigm(gte) * up; }
                    *(v4u*)(O + (size_t)row * DFF + u.pn * 128 + wc * 32 + 8 * fq) = pack8(o);
                } else {
#pragma unroll
                for (int bj = 0; bj < 2; ++bj) {
                    const int col = u.pn * 256 + bj * 128 + wc * 32 + 8 * fq;
                    float v[8];
#pragma unroll
                    for (int i = 0; i < 8; ++i) v[i] = acc[ai][bj][m][i >> 2][i & 3];
                    if (MODE == 0) { if (col < ldc) *(v4u*)(O + (size_t)row * ldc + col) = pack8(v); }
                    else if (MODE == 1) {
                        if (u.pn < 2) { const int g = col >> 4, cc = col & 15, b = row >> 12, t = row & 4095, ch = t >> 4, s = t & 15;
                            *(v4u*)((bf16*)X + ((size_t)(g * 1024 + b * 256 + ch) * 384 + s * 16 + cc)) = pack8(v); }
                        else { const int tsel = (col >> 9) - 1, cl = col & 511; *(v4u*)(O + (size_t)tsel * (8u * MiB) + (size_t)row * 512 + cl) = pack8(v); }
                    }
                    else if (MODE == 2) { if (bj == 0) *(v4u*)(O + (size_t)row * 384 + 256 + (col & 255)) = pack8(v); }
                    else if (MODE == 3) {
                        const int g = row >> 10, b = (row >> 8) & 3, ch = row & 255, cl = col & 255, t = cl >> 4, cc = cl & 15;
                        float uu[8]; unpack8(*(const v4u*)(X + (size_t)row * 384 + cl), uu);
#pragma unroll
                        for (int i = 0; i < 8; ++i) { const float y = v[i] + P[g * 16 + cc + i] * uu[i]; v[i] = y * sigm(1.5957691216f * (y + 0.044715f * y * y * y)); }
                        *(v4u*)(O + (size_t)(b * 4096 + ch * 16 + t) * 512 + g * 16 + cc) = pack8(v);
                    }
                    else if (MODE == 4) { float y[8]; unpack8(*(const v4u*)(X + (size_t)row * 512 + col), y);
#pragma unroll
                        for (int i = 0; i < 8; ++i) v[i] = y[i] * sigm(v[i]);
                        *(v4u*)(O + (size_t)row * 512 + col) = pack8(v); }
                    else if (MODE == 5) {
#pragma unroll
                        for (int i = 0; i < 8; ++i) v[i] = sigm(v[i]);
                        *(v4u*)(O + (size_t)row * 1024 + col) = pack8(v); }
                    else if (MODE == 6 || MODE == 7) { float gt[8]; unpack8(*(const v4u*)(X + (size_t)row * 1024 + col), gt);
                        float pm_[8];
                        if (MODE == 7) unpack8(*(const v4u*)(O + (size_t)row * 1024 + col), pm_);
#pragma unroll
                        for (int i = 0; i < 8; ++i) v[i] = (MODE == 7 ? pm_[i] : 0.f) + gt[i] * v[i];
                        *(v4u*)(O + (size_t)row * 1024 + col) = pack8(v); }
                }
                }
            }
    }
};
struct EpiRes {
    static constexpr bool PERM = false, AFTER_DRAIN = false;
    const float* xin; float* xout;
    __device__ __forceinline__ void operator()(const pg8::f32x4 (&acc)[2][2][4][2], const pg8::Unit& u, int wr, int wc, int fr, int fq) const {
#pragma unroll
        for (int ai = 0; ai < 2; ++ai)
#pragma unroll
            for (int m = 0; m < 4; ++m) { const size_t off = (size_t)(u.pm * 256 + ai * 128 + wr * 64 + m * 16 + fr) * 1024 + u.pn * 256 + wc * 32 + 4 * fq;
#pragma unroll
                for (int bj = 0; bj < 2; ++bj)
#pragma unroll
                    for (int n = 0; n < 2; ++n) { const f32x4 b = *(const f32x4*)(xin + off + bj * 128 + n * 16); f32x4 o; o.x = b.x + acc[ai][bj][m][n][0]; o.y = b.y + acc[ai][bj][m][n][1]; o.z = b.z + acc[ai][bj][m][n][2]; o.w = b.w + acc[ai][bj][m][n][3];
                        *(f32x4*)(xout + off + bj * 128 + n * 16) = o; } }
    }
};
__device__ __forceinline__ pg8::Gemm mkgemm(const bf16* A, const bf16* Bt, int Mr, int N, int K, int lda, int ldb) {
    pg8::Gemm g; g.A = A; g.Bt = Bt; g.M = Mr; g.N = N; g.K = K; g.lda = lda; g.ldb = ldb; g.a_skip_shift = 30; g.a_skip_bytes = 0; g.kwrap = 1 << 20; g.wrap_bytes = 0; g.b_shift = 30; g.b_stride_bytes = 0; return g; }
template <class Epi> __device__ __forceinline__ void run_gemm(LAS unsigned char* lds, const pg8::Gemm& g, const Epi& E, int G, int c) {
    asm volatile("" : "+s"(G), "+s"(c));
    pg8::StaticOrder S; S.init(g.M, g.N, G, c);
    pg8::gemm_phase<Epi, pg8::StaticOrder, true, true>(lds, g, S, E);
}

__device__ __forceinline__ void tr_item(const float* W, int ldw, int k0, int c0, bf16* WT, int ldt, int drow, int koff, const float* mu, int smode, LAS float* scr, int lane) {
#pragma unroll 8
    for (int i = 0; i < 32; ++i) { const int kk = 2 * i + (lane >> 5); scr[kk * 33 + (lane & 31)] = W[(size_t)(k0 + kk) * ldw + c0 + (lane & 31)]; }
    asm volatile("s_waitcnt lgkmcnt(0)" ::: "memory");
    const int c = lane & 7;
#pragma unroll
    for (int j = 0; j < 4; ++j) { const int n = (lane >> 3) + 8 * j; const LAS float* s = scr + (8 * c) * 33 + n;
        float sc = 1.f; if (smode) { const float m_ = mu[n]; sc = (smode == 1) ? 1.f - m_ : m_; }
        v4u o; o.x = pg8::cvt_pk_bf16(s[0 * 33] * sc, s[1 * 33] * sc); o.y = pg8::cvt_pk_bf16(s[2 * 33] * sc, s[3 * 33] * sc); o.z = pg8::cvt_pk_bf16(s[4 * 33] * sc, s[5 * 33] * sc); o.w = pg8::cvt_pk_bf16(s[6 * 33] * sc, s[7 * 33] * sc);
        *(v4u*)(WT + (size_t)(drow + n) * ldt + koff + k0 + 8 * c) = o; }
    asm volatile("s_waitcnt lgkmcnt(0)" ::: "memory");
}
__device__ __forceinline__ void rms_row(const float* xrow, const float* gain, bf16* orow, int lane) {
    const f32x4* xr = (const f32x4*)xrow + lane; const f32x4* gr = (const f32x4*)gain + lane;
    f32x4 v[4]; float s = 0.f;
#pragma unroll
    for (int j = 0; j < 4; ++j) { v[j] = xr[64 * j]; s += (v[j].x * v[j].x + v[j].y * v[j].y) + (v[j].z * v[j].z + v[j].w * v[j].w); }
    const float rstd = 1.f / sqrtf(wave_sum(s) * (1.f / 1024.f) + 1e-6f);
    v2u* o8 = (v2u*)orow + lane;
#pragma unroll
    for (int j = 0; j < 4; ++j) { const f32x4 g = gr[64 * j]; v2u w; w.x = pg8::cvt_pk_bf16(v[j].x * rstd * g.x, v[j].y * rstd * g.y); w.y = pg8::cvt_pk_bf16(v[j].z * rstd * g.z, v[j].w * rstd * g.w); o8[64 * j] = w; }
}
struct Ptrs { const float* in[35]; float* out; unsigned char* ws; };

__device__ __forceinline__ void weight_items(const Ptrs& P, int L, int gw, int NGW, LAS float* scr, int lane) {
    unsigned char* ws = P.ws;
    const float* w_in = P.in[2] + (size_t)L * 1024 * NIN; const float* mu = P.in[16] + (size_t)L * 1696;
    constexpr int I1A = 16 * 64, I1B = 16 * 53, IGLU = 8 * 16, IWB = 8 * 32, IWO = 16 * 32, IFI = 16 * 176, IFO = 44 * 32;
    constexpr int NIT = I1A + 2 * I1B + IGLU + 3 * IWB + IWO + IFI + IFO;
    for (int it = gw; it < NIT; it += NGW) {
        int r = it;
        if (r < I1A) { const int kb = r / 64, nb = r % 64; tr_item(w_in, NIN, kb * 64, nb * 32, (bf16*)(ws + WS_W1A), 1024, nb * 32, 0, nullptr, 0, scr, lane); continue; } r -= I1A;
        if (r < I1B) { const int kb = r / 53, nb = r % 53; tr_item(w_in, NIN, kb * 64, 2048 + nb * 32, (bf16*)(ws + WS_W1B), 2048, nb * 32, 0, mu + nb * 32, 1, scr, lane); continue; } r -= I1B;
        if (r < I1B) { const int kb = r / 53, nb = r % 53; tr_item(w_in, NIN, kb * 64, 2048 + nb * 32, (bf16*)(ws + WS_W1B), 2048, nb * 32, 1024, mu + nb * 32, 2, scr, lane); continue; } r -= I1B;
        if (r < IGLU) { const int kb = r / 16, nb = r % 16; tr_item(P.in[11] + (size_t)L * 512 * 512, 512, kb * 64, nb * 32, (bf16*)(ws + WS_WGLU), 512, nb * 32, 0, nullptr, 0, scr, lane); continue; } r -= IGLU;
        if (r < 3 * IWB) { const int n = r / IWB, q = r % IWB, kb = q / 32, nb = q % 32; tr_item(P.in[30] + ((size_t)L * 3 + n) * 512 * 1024, 1024, kb * 64, nb * 32, (bf16*)(ws + WS_WB) + (size_t)n * 1024 * 512, 512, nb * 32, 0, nullptr, 0, scr, lane); continue; } r -= 3 * IWB;
        if (r < IWO) { const int kb = r / 32, nb = r % 32; tr_item(P.in[31] + (size_t)L * 1024 * 1024, 1024, kb * 64, nb * 32, (bf16*)(ws + WS_WO), 1024, nb * 32, 0, nullptr, 0, scr, lane); continue; } r -= IWO;
        if (r < IFI) { const int kb = r / 176, nb = r % 176; const int n0 = nb * 32; const int drow = (n0 < DFF) ? (n0 / 128) * 256 + (n0 % 128) : ((n0 - DFF) / 128) * 256 + 128 + ((n0 - DFF) % 128);
            tr_item(P.in[33] + (size_t)L * 1024 * 2 * DFF, 2 * DFF, kb * 64, n0, (bf16*)(ws + WS_WFI), 1024, drow, 0, nullptr, 0, scr, lane); continue; } r -= IFI;
        { const int kb = r / 32, nb = r % 32; tr_item(P.in[34] + (size_t)L * DFF * 1024, 1024, kb * 64, nb * 32, (bf16*)(ws + WS_WFO), DFF, nb * 32, 0, nullptr, 0, scr, lane); }
    }
}
__device__ __forceinline__ void s5_tables(const Ptrs& P, int L, int g, LAS float* sm, int tid) {
    LAS float* apr = sm; LAS float* api = sm + 17 * 64; LAS float* bbr = sm + 2 * 17 * 64; LAS float* bbi = bbr + 1024; LAS float* Ks = bbi + 1024;
    const float* lre = P.in[3] + (size_t)L * 2048; const float* lim = P.in[4] + (size_t)L * 2048; const float* ldt = P.in[5] + L * 32;
    const float* bre = P.in[6] + (size_t)L * 32768; const float* bim = P.in[7] + (size_t)L * 32768; const float* cre = P.in[8] + (size_t)L * 32768; const float* cim = P.in[9] + (size_t)L * 32768;
    if (tid < 64) { const int p = tid; const float dt = __expf(ldt[g]); const float lr = lre[g * 64 + p], li = lim[g * 64 + p];
        for (int j = 0; j <= 16; ++j) { const double ang = (double)j * (double)li * (double)dt * 0.15915494309189535; const float rev = (float)(ang - __builtin_floor(ang));
            const float mg = __expf((float)j * lr * dt); apr[j * 64 + p] = mg * __builtin_amdgcn_cosf(rev); api[j * 64 + p] = mg * __builtin_amdgcn_sinf(rev); }
        const float ar = apr[64 + p], ai = api[64 + p], den = lr * lr + li * li, nr = ar - 1.f, kr = (nr * lr + ai * li) / den, ki = (ai * lr - nr * li) / den;
        for (int c = 0; c < 16; ++c) { const float br = bre[(g * 64 + p) * 16 + c], bi = bim[(g * 64 + p) * 16 + c]; bbr[p * 16 + c] = kr * br - ki * bi; bbi[p * 16 + c] = kr * bi + ki * br; } }
    __syncthreads();
    { const int cc = tid & 255, cp = cc >> 4, c = cc & 15, j0 = (tid >> 8) * 8;
        for (int j = j0; j < j0 + 8; ++j) { float s = 0.f;
            for (int p = 0; p < 64; ++p) { const float tr = apr[j * 64 + p] * bbr[p * 16 + c] - api[j * 64 + p] * bbi[p * 16 + c], ti = apr[j * 64 + p] * bbi[p * 16 + c] + api[j * 64 + p] * bbr[p * 16 + c];
                s += cre[(g * 16 + cp) * 64 + p] * tr - cim[(g * 16 + cp) * 64 + p] * ti; }
            Ks[j * 256 + cc] = s; } }
    __syncthreads();
    bf16* Mt = (bf16*)(P.ws + WS_MT) + (size_t)g * 256 * 384; bf16* Pt = (bf16*)(P.ws + WS_PT) + (size_t)g * 128 * 256;
    for (int idx = tid; idx < 256 * 48; idx += NTHR) { const int n = idx / 48, kg = idx % 48, t = n >> 4, cp = n & 15; float v[8];
        if (kg < 32) { const int s = kg >> 1, c0 = (kg & 1) * 8;
#pragma unroll
            for (int i = 0; i < 8; ++i) v[i] = (s <= t) ? Ks[(t - s) * 256 + cp * 16 + c0 + i] : 0.f; }
        else {
#pragma unroll
            for (int i = 0; i < 8; ++i) { const int jj = (kg - 32) * 8 + i, p = jj & 63; const float cr = cre[(g * 16 + cp) * 64 + p], ci = cim[(g * 16 + cp) * 64 + p], ar = apr[(t + 1) * 64 + p], ai = api[(t + 1) * 64 + p];
                v[i] = (jj < 64) ? (cr * ar - ci * ai) : -(cr * ai + ci * ar); } }
        *(v4u*)(Mt + (size_t)n * 384 + kg * 8) = pack8(v); }
    for (int idx = tid; idx < 128 * 32; idx += NTHR) { const int jj = idx >> 5, kg = idx & 31, p = jj & 63, s = kg >> 1, c0 = (kg & 1) * 8; float v[8];
        const float ar = apr[(15 - s) * 64 + p], ai = api[(15 - s) * 64 + p];
#pragma unroll
        for (int i = 0; i < 8; ++i) { const float br = bbr[p * 16 + c0 + i], bi = bbi[p * 16 + c0 + i]; v[i] = (jj < 64) ? (ar * br - ai * bi) : (ar * bi + ai * br); }
        *(v4u*)(Pt + (size_t)jj * 256 + kg * 8) = pack8(v); }
    __syncthreads();
}
__device__ __forceinline__ void s5_chunk_scan(const Ptrs& P, int L, int gidx) {
    const int p = gidx & 63, g = (gidx >> 6) & 31, b = gidx >> 11;
    const float dt = __expf(P.in[5][L * 32 + g]); const float lr = P.in[3][(size_t)L * 2048 + g * 64 + p], li = P.in[4][(size_t)L * 2048 + g * 64 + p];
    const double ang = 16.0 * (double)li * (double)dt * 0.15915494309189535; const float rev = (float)(ang - __builtin_floor(ang)); const float mg = __expf(16.f * lr * dt);
    const float ar = mg * __builtin_amdgcn_cosf(rev), ai = mg * __builtin_amdgcn_sinf(rev);
    bf16* base = (bf16*)(P.ws + WS_US) + (size_t)(g * 1024 + b * 256) * 384 + 256 + p;
    float xr = 0.f, xi = 0.f;
#pragma unroll 8
    for (int c = 0; c < 256; ++c) { bf16* q = base + (size_t)c * 384; const float sr = bf2f(q[0]), si = bf2f(q[64]); q[0] = (bf16)f2bf(xr); q[64] = (bf16)f2bf(xi);
        const float nr = ar * xr - ai * xi + sr, ni = ar * xi + ai * xr + si; xr = nr; xi = ni; }
}

__device__ __forceinline__ void prep_phase(const Ptrs& P, int L, LAS unsigned char* lds, int gw, int NGW, int tid, int wave, int lane) {
    asm volatile("" : "+v"(tid), "+v"(lane)); asm volatile("" : "+s"(wave));
    unsigned char* ws = P.ws;
    LAS bf16* w2s = (LAS bf16*)lds; LAS bf16* a2s = w2s + 32 * 512; LAS bf16* v2s = a2s + 32 * 512; LAS unsigned* v1s = (LAS unsigned*)(v2s + 32 * 512);
    LAS float* vrow = (LAS float*)(lds + 131072) + wave * 512;
    const float* w2 = P.in[18] + (size_t)L * 32 * 512; const float* a2 = P.in[20] + (size_t)L * 32 * 512;
    for (int i = tid; i < 32 * 512; i += NTHR) { w2s[i] = (bf16)f2bf(w2[i]); a2s[i] = (bf16)f2bf(a2[i]); }
    if (L == 1) { const float* v2 = P.in[29]; const float* v1 = P.in[28];
        for (int i = tid; i < 32 * 512; i += NTHR) v2s[i] = (bf16)f2bf(v2[i]);
        for (int i = tid; i < 256 * 32; i += NTHR) { const int c2 = i >> 5, j = i & 31; v1s[i] = f2bf(v1[(2 * c2) * 32 + j]) | (f2bf(v1[(2 * c2 + 1) * 32 + j]) << 16); } }
    __syncthreads();
    const int c0 = lane * 8;
    float qg[8], kg[8], w0r[8], a0r[8], v0r[8];
#pragma unroll
    for (int i = 0; i < 8; ++i) { qg[i] = P.in[12][L * 128 + ((c0 + i) & 127)] * C2Q; kg[i] = P.in[13][L * 128 + ((c0 + i) & 127)]; w0r[i] = P.in[17][L * 512 + c0 + i]; a0r[i] = P.in[19][L * 512 + c0 + i]; v0r[i] = (L == 1) ? P.in[27][c0 + i] : 0.f; }
    for (int m = gw; m < M; m += NGW) {
        {
            bf16* qp = (bf16*)(ws + WS_QB) + (size_t)m * 512 + c0; bf16* kp = (bf16*)(ws + WS_KB) + (size_t)m * 512 + c0;
            float q[8], k[8]; unpack8(*(const v4u*)qp, q); unpack8(*(const v4u*)kp, k);
            float sq = 0.f, sk = 0.f;
#pragma unroll
            for (int i = 0; i < 8; ++i) { sq += q[i] * q[i]; sk += k[i] * k[i]; }
            sq += __shfl_xor(sq, 1); sq += __shfl_xor(sq, 2); sq += __shfl_xor(sq, 4); sk += __shfl_xor(sk, 1); sk += __shfl_xor(sk, 2); sk += __shfl_xor(sk, 4);
            const float rq = 1.f / sqrtf(sq * (1.f / 64.f) + 1e-6f), rk = 1.f / sqrtf(sk * (1.f / 64.f) + 1e-6f);
#pragma unroll
            for (int i = 0; i < 8; ++i) { q[i] *= rq * qg[i]; k[i] *= rk * kg[i]; }
            *(v4u*)qp = pack8(q); *(v4u*)kp = pack8(k);
        }
        bf16* zr = (bf16*)(ws + WS_Z) + (size_t)m * ZP;
        const float zz = bf2f(zr[1536 + lane]);
        const float tz = (lane < 32) ? tanh_f(zz) : zz;
        float aw[8], aa[8];
#pragma unroll
        for (int i = 0; i < 8; ++i) { aw[i] = w0r[i]; aa[i] = a0r[i]; }
#pragma unroll
        for (int j = 0; j < 32; ++j) { const float tw = __shfl(tz, j), ta = __shfl(tz, 32 + j); float w8[8], a8[8]; unpack8(*(const LAS v4u*)(w2s + j * 512 + c0), w8); unpack8(*(const LAS v4u*)(a2s + j * 512 + c0), a8);
#pragma unroll
            for (int i = 0; i < 8; ++i) { aw[i] += tw * w8[i]; aa[i] += ta * a8[i]; } }
#pragma unroll
        for (int i = 0; i < 8; ++i) { aw[i] = 0.6065306597f * sigm(aw[i]); aa[i] = sigm(aa[i]); }
        *(v4u*)((bf16*)(ws + WS_E) + (size_t)m * 512 + c0) = pack8(aw); *(v4u*)((bf16*)(ws + WS_AB) + (size_t)m * 512 + c0) = pack8(aa);
        const v4u vraw = *(const v4u*)(zr + 1024 + c0);
        if (L == 0) { *(v4u*)((bf16*)(ws + WS_VF) + (size_t)m * 512 + c0) = vraw; }
        else { float v[8], vf[8]; unpack8(vraw, v); unpack8(*(const v4u*)((const bf16*)(ws + WS_VF) + (size_t)m * 512 + c0), vf);
#pragma unroll
            for (int i = 0; i < 8; ++i) vrow[c0 + i] = v[i];
            asm volatile("s_waitcnt lgkmcnt(0)" ::: "memory");
            const int j = lane & 31, hf = lane >> 5; float s = 0.f;
#pragma unroll 8
            for (int c2 = 0; c2 < 128; ++c2) { const unsigned pk = v1s[(hf * 128 + c2) * 32 + j]; s += vrow[hf * 256 + 2 * c2] * __uint_as_float(pk << 16) + vrow[hf * 256 + 2 * c2 + 1] * __uint_as_float(pk & 0xffff0000u); }
            s += __shfl_xor(s, 32);
            float am[8];
#pragma unroll
            for (int i = 0; i < 8; ++i) am[i] = v0r[i];
#pragma unroll
            for (int jj = 0; jj < 32; ++jj) { const float sj = __shfl(s, jj); float w8[8]; unpack8(*(const LAS v4u*)(v2s + jj * 512 + c0), w8);
#pragma unroll
                for (int i = 0; i < 8; ++i) am[i] += sj * w8[i]; }
#pragma unroll
            for (int i = 0; i < 8; ++i) v[i] = v[i] + (vf[i] - v[i]) * sigm(am[i]);
            *(v4u*)(zr + 1024 + c0) = pack8(v);
            asm volatile("s_waitcnt lgkmcnt(0)" ::: "memory"); }
    }
    __syncthreads();
}

__device__ __forceinline__ void rwkv_unit(const Ptrs& P, int L, LAS unsigned char* lds, int b, int h, int qr, int tid, int wave, int lane) {
    constexpr int T = 32, TOKF = 336;
    asm volatile("" : "+v"(tid), "+v"(lane)); asm volatile("" : "+s"(wave));
    unsigned char* ws = P.ws;
    const bf16* Z = (const bf16*)(ws + WS_Z); const bf16* AB = (const bf16*)(ws + WS_AB); const bf16* EB = (const bf16*)(ws + WS_E); bf16* YC = (bf16*)(ws + WS_YA);
    LAS float* buf0 = (LAS float*)lds; LAS float* buf1 = buf0 + T * TOKF;
    const bool producer = wave >= 4;
    const int pt = tid - 256, tok = pt >> 3, ks = (pt & 7) * 8;
    float kkk[8], kka[8];
    if (producer) {
#pragma unroll
        for (int i = 0; i < 8; ++i) { kkk[i] = P.in[22][L * 512 + h * 64 + ks + i]; kka[i] = P.in[23][L * 512 + h * 64 + ks + i]; } }
    const int row = wave * 4 + (lane >> 4), kq = lane & 15;
    f32x4 S = {0.f, 0.f, 0.f, 0.f};
    const size_t m00 = (size_t)b * SEQ;
#define RW_PRODUCE(c, buf) do { const size_t m_ = m00 + (size_t)(c) * T + tok; const bf16* zr_ = Z + m_ * ZP; \
        float r_[8], k_[8], a_[8], e_[8]; unpack8(*(const v4u*)(zr_ + h * 64 + ks), r_); unpack8(*(const v4u*)(zr_ + 512 + h * 64 + ks), k_); \
        unpack8(*(const v4u*)(AB + m_ * 512 + h * 64 + ks), a_); unpack8(*(const v4u*)(EB + m_ * 512 + h * 64 + ks), e_); \
        float kk_[8], ss_ = 0.f; _Pragma("unroll") for (int i = 0; i < 8; ++i) { kk_[i] = k_[i] * kkk[i]; ss_ += kk_[i] * kk_[i]; } \
        ss_ += __shfl_xor(ss_, 1); ss_ += __shfl_xor(ss_, 2); ss_ += __shfl_xor(ss_, 4); const float inv_ = 1.f / fmaxf(sqrtf(ss_), 1e-12f); \
        LAS float* d_ = (buf) + tok * TOKF + ks; f32x4 o0, o1; \
        o0 = (f32x4){-kk_[0] * inv_, -kk_[1] * inv_, -kk_[2] * inv_, -kk_[3] * inv_}; o1 = (f32x4){-kk_[4] * inv_, -kk_[5] * inv_, -kk_[6] * inv_, -kk_[7] * inv_}; *(LAS f32x4*)(d_) = o0; *(LAS f32x4*)(d_ + 4) = o1; \
        o0 = (f32x4){kk_[0] * inv_ * a_[0], kk_[1] * inv_ * a_[1], kk_[2] * inv_ * a_[2], kk_[3] * inv_ * a_[3]}; o1 = (f32x4){kk_[4] * inv_ * a_[4], kk_[5] * inv_ * a_[5], kk_[6] * inv_ * a_[6], kk_[7] * inv_ * a_[7]}; *(LAS f32x4*)(d_ + 64) = o0; *(LAS f32x4*)(d_ + 68) = o1; \
        o0 = (f32x4){__expf(-e_[0]), __expf(-e_[1]), __expf(-e_[2]), __expf(-e_[3])}; o1 = (f32x4){__expf(-e_[4]), __expf(-e_[5]), __expf(-e_[6]), __expf(-e_[7])}; *(LAS f32x4*)(d_ + 128) = o0; *(LAS f32x4*)(d_ + 132) = o1; \
        o0 = (f32x4){k_[0] * (1.f + (a_[0] - 1.f) * kka[0]), k_[1] * (1.f + (a_[1] - 1.f) * kka[1]), k_[2] * (1.f + (a_[2] - 1.f) * kka[2]), k_[3] * (1.f + (a_[3] - 1.f) * kka[3])}; \
        o1 = (f32x4){k_[4] * (1.f + (a_[4] - 1.f) * kka[4]), k_[5] * (1.f + (a_[5] - 1.f) * kka[5]), k_[6] * (1.f + (a_[6] - 1.f) * kka[6]), k_[7] * (1.f + (a_[7] - 1.f) * kka[7])}; *(LAS f32x4*)(d_ + 192) = o0; *(LAS f32x4*)(d_ + 196) = o1; \
        o0 = (f32x4){r_[0], r_[1], r_[2], r_[3]}; o1 = (f32x4){r_[4], r_[5], r_[6], r_[7]}; *(LAS f32x4*)(d_ + 256) = o0; *(LAS f32x4*)(d_ + 260) = o1; \
        if ((pt & 7) < 2) { float v_[8]; unpack8(*(const v4u*)(zr_ + 1024 + h * 64 + qr * 16 + ks), v_); LAS float* dv_ = (buf) + tok * TOKF + 320 + ks; \
            *(LAS f32x4*)(dv_) = (f32x4){v_[0], v_[1], v_[2], v_[3]}; *(LAS f32x4*)(dv_ + 4) = (f32x4){v_[4], v_[5], v_[6], v_[7]}; } } while (0)
    if (producer) RW_PRODUCE(0, buf0);
    __syncthreads();
    for (int c = 0; c < SEQ / T; ++c) {
        LAS float* cur = (c & 1) ? buf1 : buf0; LAS float* nxt = (c & 1) ? buf0 : buf1;
        if (producer) { if (c + 1 < SEQ / T) RW_PRODUCE(c + 1, nxt); }
        else {
            bf16* yo = YC + (m00 + (size_t)c * T) * 512 + h * 64 + qr * 16 + row;
            const LAS float* bs = cur + kq * 4; const LAS float* vs = cur + 320 + row;
            f32x4 a4 = *(const LAS f32x4*)(bs), b4 = *(const LAS f32x4*)(bs + 64), w4 = *(const LAS f32x4*)(bs + 128), k4 = *(const LAS f32x4*)(bs + 192), r4 = *(const LAS f32x4*)(bs + 256);
            float vv = vs[0]; float yp = 0.f;
#pragma unroll 4
            for (int t = 0; t < T; ++t) {
                const LAS float* nb = bs + (t + 1) * TOKF;
                const f32x4 na4 = *(const LAS f32x4*)(nb), nb4 = *(const LAS f32x4*)(nb + 64), nw4 = *(const LAS f32x4*)(nb + 128), nk4 = *(const LAS f32x4*)(nb + 192), nr4 = *(const LAS f32x4*)(nb + 256);
                const float nvv = vs[(t + 1) * TOKF];
                float sa = (S.x * a4.x + S.y * a4.y) + (S.z * a4.z + S.w * a4.w);
                sa = DPP_ADD(sa, 0xB1); yp = DPP_ADD(yp, 0xB1); sa = DPP_ADD(sa, 0x4E); yp = DPP_ADD(yp, 0x4E); sa = DPP_ADD(sa, 0x141); yp = DPP_ADD(yp, 0x141); sa = DPP_ADD(sa, 0x140); yp = DPP_ADD(yp, 0x140);
                if (t > 0 && kq == 0) yo[(size_t)(t - 1) * 512] = (bf16)f2bf(yp);
                S = S * w4 + (b4 * sa + k4 * vv);
                yp = (S.x * r4.x + S.y * r4.y) + (S.z * r4.z + S.w * r4.w);
                a4 = na4; b4 = nb4; w4 = nw4; k4 = nk4; r4 = nr4; vv = nvv; }
            yp = row16_sum(yp);
            if (kq == 0) yo[(size_t)(T - 1) * 512] = (bf16)f2bf(yp);
        }
        __syncthreads();
    }
#undef RW_PRODUCE
}

__device__ __forceinline__ void post_phase(const Ptrs& P, int L, LAS unsigned char* lds, int gw, int NGW, int tid, int wave, int lane) {
    asm volatile("" : "+v"(tid), "+v"(lane)); asm volatile("" : "+s"(wave));
    unsigned char* ws = P.ws;
    LAS bf16* g2s = (LAS bf16*)lds;
    const float* g2 = P.in[21] + (size_t)L * 96 * 512;
    for (int i = tid; i < 96 * 512; i += NTHR) g2s[i] = (bf16)f2bf(g2[i]);
    __syncthreads();
    const float lam_init = (L == 0) ? 0.2f : 0.35550906f;
    const float* lv = P.in[14] + L * 256;
    const float lam = __expf(wave_sum(lv[lane] * lv[64 + lane])) - __expf(wave_sum(lv[128 + lane] * lv[192 + lane])) + lam_init;
    const int c0 = lane * 8;
    float sg[8], lng[8], lnb[8], rk[8], ka[8];
#pragma unroll
    for (int i = 0; i < 8; ++i) { sg[i] = P.in[15][L * 128 + ((c0 + i) & 127)] * (1.f - lam_init); lng[i] = P.in[25][L * 512 + c0 + i]; lnb[i] = P.in[26][L * 512 + c0 + i]; rk[i] = P.in[24][L * 512 + c0 + i]; ka[i] = P.in[23][L * 512 + c0 + i]; }
    const float* xsrc = (L == 0) ? P.in[0] : P.out;
    for (int m = gw; m < M; m += NGW) {
        bf16* zr = (bf16*)(ws + WS_Z) + (size_t)m * ZP;
        float r[8], k[8], v[8], a[8], yr[8];
        unpack8(*(const v4u*)(zr + c0), r); unpack8(*(const v4u*)(zr + 512 + c0), k); unpack8(*(const v4u*)(zr + 1024 + c0), v);
        unpack8(*(const v4u*)((const bf16*)(ws + WS_AB) + (size_t)m * 512 + c0), a); unpack8(*(const v4u*)((const bf16*)(ws + WS_YA) + (size_t)m * 512 + c0), yr);
        const float z0 = sigm(bf2f(zr[1600 + (lane & 31)])), z1 = sigm(bf2f(zr[1632 + (lane & 31)])), z2 = sigm(bf2f(zr[1664 + (lane & 31)]));
        float s1 = 0.f;
#pragma unroll
        for (int i = 0; i < 8; ++i) s1 += yr[i];
        s1 += __shfl_xor(s1, 1); s1 += __shfl_xor(s1, 2); s1 += __shfl_xor(s1, 4); const float mean = s1 * (1.f / 64.f);
        float s2 = 0.f, bd = 0.f;
#pragma unroll
        for (int i = 0; i < 8; ++i) { const float d = yr[i] - mean; s2 += d * d; bd += r[i] * (k[i] * (1.f + (a[i] - 1.f) * ka[i])) * rk[i]; }
        s2 += __shfl_xor(s2, 1); s2 += __shfl_xor(s2, 2); s2 += __shfl_xor(s2, 4); bd += __shfl_xor(bd, 1); bd += __shfl_xor(bd, 2); bd += __shfl_xor(bd, 4);
        const float rstd = 1.f / sqrtf(s2 * (1.f / 64.f) + 64e-5f);
        float gacc[8];
#pragma unroll
        for (int i = 0; i < 8; ++i) gacc[i] = 0.f;
#pragma unroll 8
        for (int j = 0; j < 32; ++j) { const float t0 = __shfl(z0, j), t1 = __shfl(z1, j), t2 = __shfl(z2, j); float w0[8], w1[8], w2[8];
            unpack8(*(const LAS v4u*)(g2s + j * 512 + c0), w0); unpack8(*(const LAS v4u*)(g2s + (32 + j) * 512 + c0), w1); unpack8(*(const LAS v4u*)(g2s + (64 + j) * 512 + c0), w2);
#pragma unroll
            for (int i = 0; i < 8; ++i) gacc[i] += t0 * w0[i] + t1 * w1[i] + t2 * w2[i]; }
        float yc[8];
#pragma unroll
        for (int i = 0; i < 8; ++i) yc[i] = ((yr[i] - mean) * rstd * lng[i] + lnb[i] + bd * v[i]) * gacc[i];
        const int hd = lane >> 4, j0 = (lane & 15) * 8; const bf16* orow = (const bf16*)(ws + WS_O) + (size_t)m * 1024 + hd * 256 + j0;
        float o0[8], o1[8]; unpack8(*(const v4u*)orow, o0); unpack8(*(const v4u*)(orow + 128), o1);
        float so = 0.f;
#pragma unroll
        for (int i = 0; i < 8; ++i) { o0[i] = o0[i] - lam * o1[i]; so += o0[i] * o0[i]; }
        so += __shfl_xor(so, 1); so += __shfl_xor(so, 2); so += __shfl_xor(so, 4); so += __shfl_xor(so, 8);
        const float ro = 1.f / sqrtf(so * (1.f / 128.f) + 1e-5f);
#pragma unroll
        for (int i = 0; i < 8; ++i) o0[i] *= ro * sg[i];
        *(v4u*)(zr + c0) = pack8(yc); *(v4u*)(zr + 512 + c0) = pack8(o0);
        rms_row(xsrc + (size_t)m * 1024, P.in[1] + L * 1024, (bf16*)(ws + WS_XN) + (size_t)m * 1024, lane);
    }
    __syncthreads();
}


__device__ __forceinline__ void dump_stage(const Ptrs& P, int k, int blk, int G, int tid) {
    unsigned char* ws = P.ws; float* out = P.out;
    for (size_t i = (size_t)blk * NTHR + tid; i < (size_t)M * 1024; i += (size_t)G * NTHR) {
        const size_t m = i >> 10; const int c = (int)(i & 1023); float v = 0.f;
        const bf16* Z = (const bf16*)(ws + WS_Z); const bf16* US = (const bf16*)(ws + WS_US);
        if (k == 1) v = bf2f(Z[m * ZP + c]) + bf2f(Z[m * ZP + 704 + c]) + bf2f(((const bf16*)(ws + WS_QB))[m * 512 + (c & 511)]) + bf2f(((const bf16*)(ws + WS_KB))[m * 512 + (c & 511)]) + bf2f(((const bf16*)(ws + WS_VB))[m * 512 + (c & 511)]) + bf2f(US[m * 768 + (c % 768)]);
        else if (k == 2) {
#if !defined(DSEL) || DSEL==1
            v += bf2f(US[m * 768 + (c % 768)]);
#endif
#if !defined(DSEL) || DSEL==2
            v += bf2f(((const bf16*)(ws + WS_E))[m * 512 + (c & 511)]) + bf2f(((const bf16*)(ws + WS_AB))[m * 512 + (c & 511)]);
#endif
#if !defined(DSEL) || DSEL==3
            v += bf2f(((const bf16*)(ws + WS_QB))[m * 512 + (c & 511)]) + bf2f(((const bf16*)(ws + WS_KB))[m * 512 + (c & 511)]);
#endif
#if !defined(DSEL) || DSEL==4
            v += bf2f(Z[m * ZP + 1024 + (c & 511)]) + bf2f(((const bf16*)(ws + WS_VF))[m * 512 + (c & 511)]);
#endif
        }
        else if (k == 3) v = bf2f(((const bf16*)(ws + WS_O))[m * 1024 + c]) + bf2f(((const bf16*)(ws + WS_YA))[m * 512 + (c & 511)]) + bf2f(US[m * 768 + (c % 768)]);
        else if (k == 4) v = bf2f(Z[m * ZP + c]) + bf2f(((const bf16*)(ws + WS_XN))[m * 1024 + c]) + bf2f(((const bf16*)(ws + WS_YL))[m * 512 + (c & 511)]);
        else if (k == 5) v = bf2f(((const bf16*)(ws + WS_YA))[m * 512 + (c & 511)]);
        else if (k == 6) v = bf2f(((const bf16*)(ws + WS_MERGED))[m * 1024 + c]);
        else if (k == 9) v = bf2f(((const bf16*)(ws + WS_HID))[m * DFF + c]) + bf2f(((const bf16*)(ws + WS_HID))[m * DFF + 1024 + c]) + bf2f(((const bf16*)(ws + WS_H2N))[m * 1024 + c]);
        out[i] = v;
    }
}
#define XB_TMO      128
#define XB_XCNT(j)  (256  + 64 * (j))
#define XB_XSUB(j)  (1280 + 64 * (j))
#define XB_XGEN(j)  (2304 + 64 * (j))
#define XB_TOP      3328
#define XB_TOPGEN   3392
#define XCD_BAR_WORDS 3456
#define XB_SPIN_CAP (1u << 18)

__device__ __forceinline__ unsigned xb_ld(unsigned* p)              { return __hip_atomic_load(p, __ATOMIC_RELAXED, __HIP_MEMORY_SCOPE_AGENT); }
__device__ __forceinline__ unsigned xb_add(unsigned* p, unsigned v) { return __hip_atomic_fetch_add(p, v, __ATOMIC_RELAXED, __HIP_MEMORY_SCOPE_AGENT); }
__device__ __forceinline__ unsigned xb_xcc_id() { return (unsigned)__builtin_amdgcn_s_getreg((3 << 11) | 20) & 0xFu; }
#define XB_SPIN(cond, bar) do { unsigned _sp = 0; while (cond) { __builtin_amdgcn_s_sleep(1); \
    if ((++_sp & 255u) == 0u) { if (xb_ld(&(bar)[XB_TMO])) break; if (_sp > XB_SPIN_CAP) { atomicAdd(&(bar)[XB_TMO], 1u); break; } } } } while (0)

struct XcdBarrier {
    unsigned* bar; unsigned x;
    volatile LAS unsigned* st;
};

__device__ __forceinline__ XcdBarrier xcd_barrier_post(unsigned* bar, volatile LAS unsigned* st) {
    XcdBarrier b; b.bar = bar; b.x = xb_xcc_id(); b.st = st;
    if (threadIdx.x == 0) (void)xb_add(&bar[XB_XCNT(b.x)], 1u);
    return b;
}
__device__ __forceinline__ void xcd_barrier_complete(unsigned* bar, unsigned x, unsigned& nloc, unsigned& nx) {
    const unsigned G = gridDim.x * gridDim.y * gridDim.z;
    unsigned sum, cnt, mine, sp = 0u;
    for (;;) {
        sum = 0u; cnt = 0u; mine = 0u;
#pragma unroll
        for (unsigned j = 0; j < 16; ++j) { const unsigned c = xb_ld(&bar[XB_XCNT(j)]); sum += c; cnt += (c > 0u) ? 1u : 0u; mine = (j == x) ? c : mine; }
        if (sum == G) break;
        __builtin_amdgcn_s_sleep(1);
        if ((++sp & 255u) == 0u) { if (xb_ld(&bar[XB_TMO])) break; if (sp > XB_SPIN_CAP) { atomicAdd(&bar[XB_TMO], 1u); break; } }
    }
    nloc = mine > 0u ? mine : 1u; nx = cnt > 0u ? cnt : 1u;
}

__device__ __forceinline__ void xcd_barrier(const XcdBarrier& b) {
    asm volatile("s_waitcnt vmcnt(0)" ::: "memory");
    __syncthreads();
    if (threadIdx.x == 0) {
        unsigned* bar = b.bar;
        __builtin_amdgcn_s_waitcnt(0);
        unsigned nloc = b.st[0], nx = b.st[1];
        if (nloc == 0u) { xcd_barrier_complete(bar, b.x, nloc, nx); b.st[0] = nloc; b.st[1] = nx; }
        const unsigned old = xb_add(&bar[XB_XSUB(b.x)], 1u);
        const unsigned gen = old / nloc;
        if (old + 1u == (gen + 1u) * nloc) {
            __builtin_amdgcn_fence(__ATOMIC_RELEASE, "agent");
            asm volatile("s_waitcnt vmcnt(0)" ::: "memory");
            const unsigned og = xb_add(&bar[XB_TOP], 1u);
            const unsigned tg = og / nx;
            if (og + 1u == (tg + 1u) * nx) xb_add(&bar[XB_TOPGEN], 1u);
            else XB_SPIN(xb_ld(&bar[XB_TOPGEN]) == tg, bar);
            __builtin_amdgcn_fence(__ATOMIC_ACQUIRE, "agent");
            xb_add(&bar[XB_XGEN(b.x)], 1u);
            asm volatile("s_waitcnt vmcnt(0)" ::: "memory");
        } else {
            XB_SPIN(xb_ld(&bar[XB_XGEN(b.x)]) == gen, bar);
            __builtin_amdgcn_fence(__ATOMIC_ACQUIRE, "agent");
            asm volatile("s_waitcnt vmcnt(0)" ::: "memory");
        }
    }
    __syncthreads();
}


#define GSYNC() do { xcd_barrier(xbar); } while (0)
struct Args { Ptrs p; int pad0, pad1; };
__global__ void __launch_bounds__(NTHR, 2) mega_fwd(Args args) {
    extern __shared__ __attribute__((aligned(16))) unsigned char lds_raw[];
    LAS unsigned char* lds = (LAS unsigned char*)lds_raw;
    cg::grid_group grid = cg::this_grid();
    const Ptrs& P = args.p;
    unsigned char* ws = P.ws;
    const int tid0 = threadIdx.x, wave0 = __builtin_amdgcn_readfirstlane(tid0 >> 6);
    const int wave = wave0;
    const int G0 = gridDim.x, blk0 = blockIdx.x;
    const int gw0 = blk0 * NWAVES + wave, NGW0 = G0 * NWAVES;
    unsigned* ctl = (unsigned*)(ws + WS_CTL);
    if (tid0 < 64) ((LAS unsigned*)(lds + LDS_XB))[tid0] = 0u;
    __syncthreads();
    XcdBarrier xbar = xcd_barrier_post(ctl + CW_BAR, (volatile LAS unsigned*)(lds + LDS_XB));
    grid.sync();
    for (int L = 0; L < 2; ++L) {
        int gw = gw0, NGW = NGW0, blk = blk0, G = G0; asm volatile("" : "+s"(gw), "+s"(NGW), "+s"(blk), "+s"(G));
        int tid = tid0; asm volatile("" : "+v"(tid)); int lane = tid & 63;
#define RELAUNDER() do { asm volatile("" : "+v"(tid)); lane = tid & 63; asm volatile("" : "+s"(gw), "+s"(NGW), "+s"(blk), "+s"(G)); } while (0)
        const float* xsrc = (L == 0) ? P.in[0] : P.out;
#if !defined(ONLY) || ONLY==0
        if (blk < 32) s5_tables(P, L, blk, (LAS float*)lds, tid);
        weight_items(P, L, gw, NGW, (LAS float*)(lds + wave * 16384), lane);
        for (int i = blk * NTHR + tid; i < 96 * 2048 / 8; i += G * NTHR) ((v4u*)((bf16*)(ws + WS_W1B) + (size_t)1696 * 2048))[i] = (v4u){0u, 0u, 0u, 0u};
        if (blk < 4) { for (int i = tid; i < 128; i += NTHR) ((v4u*)((bf16*)(ws + WS_XNP) + (size_t)blk * 4097 * 1024))[i] = (v4u){0u, 0u, 0u, 0u}; }
        for (int m = gw; m < M; m += NGW) rms_row(xsrc + (size_t)m * 1024, P.in[1] + L * 1024, (bf16*)(ws + WS_XNP) + ((size_t)(m >> 12) * 4097 + 1 + (m & 4095)) * 1024, lane);
        GSYNC(); RELAUNDER();
#endif
#if !defined(ONLY) || ONLY==1
        { pg8::Gemm g = mkgemm((const bf16*)(ws + WS_XNP) + 1024, (const bf16*)(ws + WS_W1A), M, 2048, 1024, 1024, 1024); g.a_skip_shift = 4; g.a_skip_bytes = 2048;
          Epi8<1> E{(bf16*)(ws + WS_QB), 512, (const bf16*)(ws + WS_US), nullptr};
#if !defined(SUB) || SUB==0
          run_gemm(lds, g, E, G, blk);
#endif
          }
        { pg8::Gemm g = mkgemm((const bf16*)(ws + WS_XNP) + 1024, (const bf16*)(ws + WS_W1B), M, 1792, 2048, 1024, 2048); g.a_skip_shift = 4; g.a_skip_bytes = 2048; g.kwrap = 16; g.wrap_bytes = 4096;
          Epi8<0> E{(bf16*)(ws + WS_Z), ZP, nullptr, nullptr};
#if !defined(SUB) || SUB==1
          run_gemm(lds, g, E, G, blk);
#endif
          }
        GSYNC(); RELAUNDER();
#if defined(STOP_AFTER) && STOP_AFTER==1
        dump_stage(P, 1, blk, G, tid); return;
#endif
#endif
#if !defined(ONLY) || ONLY==2
        { pg8::Gemm g = mkgemm((const bf16*)(ws + WS_US), (const bf16*)(ws + WS_PT), 32768, 256, 256, 384, 256); g.b_shift = 2; g.b_stride_bytes = 128 * 256 * 2;
          Epi8<2> E{(bf16*)(ws + WS_US), 384, nullptr, nullptr}; run_gemm(lds, g, E, G, blk); }
        __syncthreads();
        prep_phase(P, L, lds, gw, NGW, tid, wave, lane);
        GSYNC(); RELAUNDER();
#if defined(STOP_AFTER) && STOP_AFTER==2
        dump_stage(P, 2, blk, G, tid); return;
#endif
#endif
#if !defined(ONLY) || ONLY==3
        if (blk < 128) rwkv_unit(P, L, lds, blk >> 5, (blk >> 2) & 7, blk & 3, tid, wave, lane);
        else if (blk >= G - 16) s5_chunk_scan(P, L, (blk - (G - 16)) * NTHR + tid);
        __syncthreads();
        {
            volatile LAS unsigned* qslot = (volatile LAS unsigned*)(lds + 140000);
            for (;;) {
                if (tid == 0) qslot[0] = atomicAdd(ctl + 64 * L, 1u);
                __syncthreads();
                const unsigned uidx = qslot[0];
                __syncthreads();
                if (uidx >= 1024u) break;
                const int qb = 15 - (int)(uidx >> 6), bhv = uidx & 63, b = bhv >> 4, hv = bhv & 15, hh = hv >> 2, cc = (hv >> 1) & 1, half = hv & 1;
                attn_body::attn_unit<8>(b, (2 * hh + cc) * 64, (2 * hh + cc) * 64, (2 * hh + half) * 64, hv * 64, qb,
                    (const attn_body::bf16*)(ws + WS_QB), (const attn_body::bf16*)(ws + WS_KB), (const attn_body::bf16*)(ws + WS_VB), (attn_body::bf16*)(ws + WS_O), (char*)lds_raw);
            }
        }
        GSYNC(); RELAUNDER();
#if defined(STOP_AFTER) && STOP_AFTER==3
        dump_stage(P, 3, blk, G, tid); return;
#endif
#endif
#if !defined(ONLY) || ONLY==4
        { pg8::Gemm g = mkgemm((const bf16*)(ws + WS_US), (const bf16*)(ws + WS_MT), 32768, 256, 384, 384, 384); g.b_shift = 2; g.b_stride_bytes = 256 * 384 * 2;
          Epi8<3> E{(bf16*)(ws + WS_YL), 512, (const bf16*)(ws + WS_US), P.in[10] + L * 512}; run_gemm(lds, g, E, G, blk); }
        __syncthreads();
        { const float* w_in = P.in[2] + (size_t)L * 1024 * NIN; LAS float* scr = (LAS float*)(lds + wave * 16384);
          for (int it = gw; it < 16 * 96; it += NGW) { const int kb = it / 96, nb = it % 96; tr_item(w_in, NIN, kb * 64, 3744 + nb * 32, (bf16*)(ws + WS_WG), 1024, nb * 32, 0, nullptr, 0, scr, lane); } }
        __syncthreads();
        post_phase(P, L, lds, gw, NGW, tid, wave, lane);
        GSYNC(); RELAUNDER();
#if defined(STOP_AFTER) && STOP_AFTER==4
        dump_stage(P, 4, blk, G, tid); return;
#endif
#endif
#if !defined(ONLY) || ONLY==5
        { pg8::Gemm g = mkgemm((const bf16*)(ws + WS_YL), (const bf16*)(ws + WS_WGLU), M, 512, 512, 512, 512);
          Epi8<4> E{(bf16*)(ws + WS_YA), 512, (const bf16*)(ws + WS_YL), nullptr}; run_gemm(lds, g, E, G, blk); }
        GSYNC(); RELAUNDER();
#if defined(STOP_AFTER) && STOP_AFTER==5
        dump_stage(P, 5, blk, G, tid); return;
#endif
        for (int n = 1; n <= 2; ++n) {
            { pg8::Gemm g = mkgemm((const bf16*)(ws + WS_XN), (const bf16*)(ws + WS_WG) + (size_t)n * 1024 * 1024, M, 1024, 1024, 1024, 1024);
              Epi8<5> E{(bf16*)(ws + WS_G), 1024, nullptr, nullptr}; run_gemm(lds, g, E, G, blk); }
            { pg8::Gemm g = mkgemm((const bf16*)(ws + WS_Z) + (n == 1 ? 512 : 0), (const bf16*)(ws + WS_WB) + (size_t)n * 1024 * 512, M, 1024, 512, ZP, 512);
              if (n == 1) { Epi8<6> E{(bf16*)(ws + WS_MERGED), 1024, (const bf16*)(ws + WS_G), nullptr}; run_gemm(lds, g, E, G, blk); }
              else { Epi8<7> E{(bf16*)(ws + WS_MERGED), 1024, (const bf16*)(ws + WS_G), nullptr}; run_gemm(lds, g, E, G, blk); } }
        }
        GSYNC(); RELAUNDER();
#endif
#if !defined(ONLY) || ONLY==6
        { pg8::Gemm g = mkgemm((const bf16*)(ws + WS_XN), (const bf16*)(ws + WS_WG), M, 1024, 1024, 1024, 1024);
          Epi8<5> E{(bf16*)(ws + WS_G), 1024, nullptr, nullptr}; run_gemm(lds, g, E, G, blk); }
        { pg8::Gemm g = mkgemm((const bf16*)(ws + WS_YA), (const bf16*)(ws + WS_WB), M, 1024, 512, 512, 512);
          Epi8<7> E{(bf16*)(ws + WS_MERGED), 1024, (const bf16*)(ws + WS_G), nullptr}; run_gemm(lds, g, E, G, blk); }
        GSYNC(); RELAUNDER();
#if defined(STOP_AFTER) && STOP_AFTER==6
        dump_stage(P, 6, blk, G, tid); return;
#endif
#endif
#if !defined(ONLY) || ONLY==7
        { pg8::Gemm g = mkgemm((const bf16*)(ws + WS_MERGED), (const bf16*)(ws + WS_WO), M, 1024, 1024, 1024, 1024);
          EpiRes E{xsrc, P.out}; run_gemm(lds, g, E, G, blk); }
        GSYNC(); RELAUNDER();
#endif
#if !defined(ONLY) || ONLY==8
        for (int m = gw; m < M; m += NGW) rms_row(P.out + (size_t)m * 1024, P.in[32] + L * 1024, (bf16*)(ws + WS_H2N) + (size_t)m * 1024, lane);
        GSYNC(); RELAUNDER();
#endif
#if !defined(ONLY) || ONLY==9
        { pg8::Gemm g = mkgemm((const bf16*)(ws + WS_H2N), (const bf16*)(ws + WS_WFI), M, 2 * DFF, 1024, 1024, 1024);
          Epi8<8> E{(bf16*)(ws + WS_HID), DFF, nullptr, nullptr}; run_gemm(lds, g, E, G, blk); }
        GSYNC(); RELAUNDER();
#if defined(STOP_AFTER) && STOP_AFTER==9
        dump_stage(P, 9, blk, G, tid); return;
#endif
#endif
#if !defined(ONLY) || ONLY==10
        { pg8::Gemm g = mkgemm((const bf16*)(ws + WS_HID), (const bf16*)(ws + WS_WFO), M, 1024, DFF, DFF, DFF);
          EpiRes E{P.out, P.out}; run_gemm(lds, g, E, G, blk); }
#endif
        if (L == 0) GSYNC();
    }
}

extern "C" void kernel_launch(void* const* d_in, const int* in_sizes, int n_in, void* d_out, int out_size, void* d_ws, size_t ws_size, hipStream_t stream) {
    static int grid = 0;
    if (grid == 0) {
        if (n_in != 35 || out_size != M * DMOD || ws_size < WS_END) { fprintf(stderr, "kernel_launch: unexpected shapes (n_in %d out %d ws %zu)\n", n_in, out_size, ws_size); grid = -1; return; }
        int dev = 0, cus = 0, per_cu = 0;
        hipGetDevice(&dev); hipDeviceGetAttribute(&cus, hipDeviceAttributeMultiprocessorCount, dev);
        hipFuncSetAttribute((const void*)mega_fwd, hipFuncAttributeMaxDynamicSharedMemorySize, LDS_BYTES);
        hipOccupancyMaxActiveBlocksPerMultiprocessor(&per_cu, (const void*)mega_fwd, NTHR, LDS_BYTES);
        if (per_cu < 1) { fprintf(stderr, "kernel_launch: occupancy query says %d\n", per_cu); grid = -1; return; }
        grid = cus;
        if (grid < 144) { fprintf(stderr, "kernel_launch: grid %d too small\n", grid); grid = -1; return; }
    }
    if (grid < 0) return;
    hipMemsetAsync((char*)d_ws + WS_CTL, 0, 65536, stream);
    Args a{};
    for (int i = 0; i < 35; ++i) a.p.in[i] = (const float*)d_in[i];
    a.p.out = (float*)d_out; a.p.ws = (unsigned char*)d_ws;
    void* kargs[] = {&a};
    hipError_t e = hipLaunchCooperativeKernel((const void*)mega_fwd, dim3(grid), dim3(NTHR), kargs, LDS_BYTES, stream);
    if (e != hipSuccess) fprintf(stderr, "cooperative launch failed: %s (grid %d)\n", hipGetErrorString(e), grid);
}
```

```cpp
#include <hip/hip_runtime.h>
#include <hip/hip_cooperative_groups.h>
#include <cstdio>
#include <cstdint>

namespace pg8 {
#define PG8_LAS __attribute__((address_space(3)))
typedef unsigned short bf16_t;
typedef short bf16x8 __attribute__((ext_vector_type(8)));
typedef float f32x4 __attribute__((ext_vector_type(4)));
typedef unsigned u32x4 __attribute__((ext_vector_type(4)));
constexpr int BM = 256, BK = 64, HALF = 128, HTB = HALF * BK * 2  , STAGE_BYTES = 8 * HTB, NXCD = 8, WGM = 8;

__host__ __device__ __forceinline__ int lds_byte(int r, int c) { const int st = (r >> 4) * 2 + (c >> 5), rr = r & 15, cc = c & 31, ob = rr * 64 + cc * 2; return st * 1024 + (ob ^ (((ob >> 9) & 1) << 5)); }
__host__ __device__ __forceinline__ void stage_rc(int b, int& R, int& C) { const int st = b / 1024, sb = b % 1024, swz = sb ^ (((sb >> 9) & 1) << 5); R = (st >> 1) * 16 + swz / 64; C = (st & 1) * 32 + (swz % 64) / 2; }
__host__ __device__ __forceinline__ int perm32(int rho) { const int n = rho >> 4, i = rho & 15; return 8 * (i >> 2) + 4 * n + (i & 3); }

struct Unit { int pm, pn; };
struct Gemm { const bf16_t* A; const bf16_t* Bt; int M, N, K; int lda, ldb; int a_skip_shift; int a_skip_bytes; int kwrap; int wrap_bytes; int b_shift; int b_stride_bytes; int a_pn_shift; int a_pn_bytes;
  __device__ __forceinline__ const char* abase(const Unit& u) const { return (const char*)A + (size_t)u.pm * (size_t)(256 * 2) * lda + (size_t)(u.pm >> a_skip_shift) * a_skip_bytes + (long)(u.pn >> a_pn_shift) * (long)a_pn_bytes; }
  __device__ __forceinline__ const char* bbase(const Unit& u) const { return (const char*)Bt + (size_t)u.pn * (size_t)(256 * 2) * ldb + (size_t)(u.pm >> b_shift) * b_stride_bytes; } };

struct StaticOrder {
    int nM, nN, nwg, G, c;
    __host__ __device__ void init(int M, int N, int G_, int c_) { nM = M / BM; nN = N / BM; nwg = nM * nN; G = G_; c = c_; }
    __host__ __device__ bool next(int i, Unit& u) const {
        const long L = (long)i * G + c; if (L >= nwg) return false;
        int wgid = (int)L; { const int q = nwg / NXCD, r = nwg % NXCD, xcd = wgid % NXCD, off = wgid / NXCD; wgid = (xcd < r ? xcd * (q + 1) : r * (q + 1) + (xcd - r) * q) + off; }
        const int nig = WGM * nN, gid = wgid / nig, fm = gid * WGM, gsz = (nM - fm) < WGM ? (nM - fm) : WGM;
        u.pm = fm + ((wgid % nig) % gsz); u.pn = (wgid % nig) / gsz; return true;
    }
    __device__ __forceinline__ void a_ready(const Unit&) const {}
    __device__ __forceinline__ void done(const Unit&) const {}
};

typedef float cvt_f32x2_t __attribute__((ext_vector_type(2))); typedef __bf16 cvt_bf16x2_t __attribute__((ext_vector_type(2)));
__device__ __forceinline__ unsigned cvt_pk_bf16(float lo, float hi) { cvt_f32x2_t v = {lo, hi}; cvt_bf16x2_t b = __builtin_convertvector(v, cvt_bf16x2_t); return __builtin_bit_cast(unsigned, b); }
typedef float f32x2 __attribute__((ext_vector_type(2)));
__device__ __forceinline__ f32x2 gelu_pk(f32x2 v) {
    const f32x2 av = __builtin_elementwise_abs(v), d = av * 0.2316418882f + 1.0f;
    f32x2 t; t.x = __builtin_amdgcn_rcpf(d.x); t.y = __builtin_amdgcn_rcpf(d.y);
    f32x2 q = t * 0.5307027145f + (-0.7265760135f); q = q * t + 0.7107068705f; q = q * t + (-0.142248368f); q = q * t + 0.127414796f; q = q * t;
    const f32x2 s = (v * v) * (-0.72134752044f);
    f32x2 e; e.x = __builtin_amdgcn_exp2f(s.x); e.y = __builtin_amdgcn_exp2f(s.y);
    const f32x2 m = v * (q * e), r = v - m;
    f32x2 o; o.x = v.x < 0.f ? m.x : r.x; o.y = v.y < 0.f ? m.y : r.y; return o;
}

template <int ACT  > struct EpiBf16 {
    static constexpr bool PERM = true, AFTER_DRAIN = false; static_assert(ACT == 0 || ACT == 1, "EpiBf16: ACT is 0 (none) or 1 (gelu_pk)");
    bf16_t* O; int ldc; const float* bias; int split_cols; size_t split_stride; float scale0;
    __device__ __forceinline__ void operator()(const f32x4 (&acc)[2][2][4][2], const Unit& u, int wr, int wc, int fr, int fq) const {
        const int row0 = u.pm * BM + wr * 64 + fr; int colt = u.pn * BM; bf16_t* base = O;
        float sc = 1.f; if (split_cols) { const int t = colt / split_cols; base += (size_t)t * split_stride; colt -= t * split_cols; if (t == 0) sc = scale0; }
        const int col0 = colt + wc * 32 + 8 * fq, bcol0 = u.pn * BM + wc * 32 + 8 * fq;
        f32x4 bv[2][2];
#pragma unroll
        for (int bj = 0; bj < 2; ++bj)
#pragma unroll
            for (int n = 0; n < 2; ++n) bv[bj][n] = bias ? *(const f32x4*)(bias + bcol0 + bj * HALF + 4 * n) : (f32x4){0.f, 0.f, 0.f, 0.f};
#pragma unroll
        for (int ai = 0; ai < 2; ++ai)
#pragma unroll
            for (int m = 0; m < 4; ++m) { bf16_t* rowp = base + (size_t)(row0 + ai * HALF + m * 16) * ldc + col0;
#pragma unroll
                for (int bj = 0; bj < 2; ++bj) { f32x4 v0 = acc[ai][bj][m][0] + bv[bj][0], v1 = acc[ai][bj][m][1] + bv[bj][1];
                    if (ACT == 1) { f32x2 a = gelu_pk((f32x2){v0[0], v0[1]}), b = gelu_pk((f32x2){v0[2], v0[3]}), c = gelu_pk((f32x2){v1[0], v1[1]}), d = gelu_pk((f32x2){v1[2], v1[3]});
                        v0 = (f32x4){a.x, a.y, b.x, b.y}; v1 = (f32x4){c.x, c.y, d.x, d.y}; }
                    v0 = v0 * sc; v1 = v1 * sc; u32x4 w; w.x = cvt_pk_bf16(v0[0], v0[1]); w.y = cvt_pk_bf16(v0[2], v0[3]); w.z = cvt_pk_bf16(v1[0], v1[1]); w.w = cvt_pk_bf16(v1[2], v1[3]);
                    *(u32x4*)(rowp + bj * HALF) = w; } }
    }
};
template <class Epi, class Sched, bool ALIGN_EPI = false, bool SP2 = false>
__device__ __forceinline__ void gemm_phase(PG8_LAS unsigned char* lds, const Gemm g, const Sched& S, const Epi& E, int wave_hint) {
    int tid_l = wave_hint * 64 + (int)__builtin_amdgcn_mbcnt_hi(~0u, __builtin_amdgcn_mbcnt_lo(~0u, 0u)); asm volatile("" : "+v"(tid_l)); const int tid = tid_l, wid = __builtin_amdgcn_readfirstlane(tid >> 6), lane = tid & 63, wr = wid >> 2, wc = wid & 3, fr = lane & 15, fq = lane >> 4;
    const int K = g.K, nt = K / BK;
    unsigned voffA[2], voffB[2];
#pragma unroll
    for (int i = 0; i < 2; ++i) { int R, C; stage_rc(tid * 16 + i * 8192, R, C); const int Rb = Epi::PERM ? ((R & ~31) + perm32(R & 31)) : R;
        voffA[i] = (unsigned)(R * g.lda + C) * 2u; voffB[i] = (unsigned)(Rb * g.ldb + C) * 2u; }
    const size_t kstep = (size_t)(BK * 2);
    const size_t hstepA = (size_t)HALF * g.lda * 2, hstepB = (size_t)HALF * g.ldb * 2; const size_t wrapb = (size_t)g.wrap_bytes;
    const unsigned ldsw = (unsigned)wid * 1024u;
    const int aoff = lds_byte(wr * 64 + fr, fq * 8), boff = lds_byte(wc * 32 + fr, fq * 8);
#define PG8_SA(b, h) (((b) * 2 + (h)) * HTB)
#define PG8_SB(b, h) ((4 + (b) * 2 + (h)) * HTB)
#define PG8_STAGE(bufoff, gbase, voff) do { _Pragma("unroll") for (int _i = 0; _i < 2; ++_i) \
        __builtin_amdgcn_global_load_lds((const unsigned*)((const char*)(gbase) + (voff)[_i]), (PG8_LAS unsigned*)(lds + (bufoff) + ldsw + _i * 8192), 16, 0, 0); } while (0)
#define PG8_LDA(dst, b, h) do { _Pragma("unroll") for (int m = 0; m < 4; ++m) _Pragma("unroll") for (int k = 0; k < 2; ++k) dst[m][k] = *(const PG8_LAS bf16x8*)(lds + PG8_SA(b, h) + aoff + m * 2048 + k * 1024); } while (0)
#define PG8_LDB(dst, b, h) do { _Pragma("unroll") for (int n = 0; n < 2; ++n) _Pragma("unroll") for (int k = 0; k < 2; ++k) dst[n][k] = *(const PG8_LAS bf16x8*)(lds + PG8_SB(b, h) + boff + n * 2048 + k * 1024); } while (0)
#define PG8_MMA(ai, bj, At, Bt) do { __builtin_amdgcn_s_setprio(1); _Pragma("unroll") for (int m = 0; m < 4; ++m) _Pragma("unroll") for (int n = 0; n < 2; ++n) _Pragma("unroll") for (int k = 0; k < 2; ++k) \
        acc[ai][bj][m][n] = __builtin_amdgcn_mfma_f32_16x16x32_bf16(Bt[n][k], At[m][k], acc[ai][bj][m][n], 0, 0, 0); __builtin_amdgcn_s_setprio(0); } while (0)
#define PG8_WAIT_V(n) asm volatile("s_waitcnt vmcnt(" #n ")" ::: "memory")
#define PG8_WAIT_L(n) asm volatile("s_waitcnt lgkmcnt(" #n ")" ::: "memory")
#define PG8_BAR __builtin_amdgcn_s_barrier()
#define PG8_SCHED __builtin_amdgcn_sched_barrier(0)
    Unit cur, nxt; int ui = 0;
    if (!S.next(0, cur)) return;
    f32x4 acc[2][2][4][2];
#pragma unroll
    for (int a = 0; a < 2; ++a)
#pragma unroll
        for (int b = 0; b < 2; ++b)
#pragma unroll
            for (int m = 0; m < 4; ++m)
#pragma unroll
                for (int n = 0; n < 2; ++n) acc[a][b][m][n] = (f32x4){0.f, 0.f, 0.f, 0.f};
    bf16x8 At[4][2], B0[2][2], B1[2][2];
    const char* cA = g.abase(cur); const char* cB = g.bbase(cur);
    S.a_ready(cur);
    if constexpr (SP2) {
        PG8_STAGE(PG8_SB(0, 0), cB, voffB); PG8_STAGE(PG8_SB(0, 1), cB + hstepB, voffB); PG8_STAGE(PG8_SA(0, 0), cA, voffA); PG8_STAGE(PG8_SA(0, 1), cA + hstepA, voffA);
        if (wr == 1) PG8_BAR;
        PG8_WAIT_V(2); PG8_BAR;
        PG8_STAGE(PG8_SB(1, 0), cB + kstep, voffB); PG8_STAGE(PG8_SA(1, 0), cA + kstep, voffA); PG8_STAGE(PG8_SB(1, 1), cB + hstepB + kstep, voffB);
        PG8_WAIT_V(6); PG8_BAR;
    } else {
        PG8_STAGE(PG8_SB(0, 0), cB, voffB); PG8_STAGE(PG8_SA(0, 0), cA, voffA); PG8_STAGE(PG8_SB(0, 1), cB + hstepB, voffB); PG8_STAGE(PG8_SA(0, 1), cA + hstepA, voffA);
        if (wr == 1) PG8_BAR;
        PG8_WAIT_V(4); PG8_BAR;
        PG8_STAGE(PG8_SB(1, 0), cB + kstep, voffB); PG8_STAGE(PG8_SA(1, 0), cA + kstep, voffA); PG8_STAGE(PG8_SB(1, 1), cB + hstepB + kstep, voffB);
        PG8_WAIT_V(6); PG8_BAR;
    }
    for (;;) {
        const bool has_next = S.next(ui + 1, nxt);
        const char* nA = has_next ? g.abase(nxt) : cA; const char* nB = has_next ? g.bbase(nxt) : cB;
        for (int t = 0; t < nt; t += 2) {
            const bool last = (t == nt - 2);
            const char* a1 = cA + (size_t)(t + 1) * kstep - ((t + 1) >= g.kwrap ? wrapb : (size_t)0);
            const char* a2 = last ? nA : cA + (size_t)(t + 2) * kstep - ((t + 2) >= g.kwrap ? wrapb : (size_t)0); const char* b2 = last ? nB : cB + (size_t)(t + 2) * kstep;
            const char* a3 = a2 + kstep; const char* b3 = b2 + kstep;
            if (last && has_next) S.a_ready(nxt);
            if constexpr (SP2) {
            PG8_LDB(B0, 0, 0); PG8_LDB(B1, 0, 1); PG8_SCHED; PG8_LDA(At, 0, 0); PG8_STAGE(PG8_SA(1, 1), a1 + hstepA, voffA);
            PG8_WAIT_V(8); PG8_WAIT_L(0); PG8_BAR; PG8_MMA(0, 0, At, B0); PG8_MMA(0, 1, At, B1); PG8_BAR; PG8_SCHED;
            PG8_LDA(At, 0, 1); PG8_STAGE(PG8_SB(0, 0), b2, voffB); PG8_STAGE(PG8_SB(0, 1), b2 + hstepB, voffB); PG8_STAGE(PG8_SA(0, 0), a2, voffA);
            PG8_WAIT_V(8); PG8_WAIT_L(0); PG8_BAR; PG8_MMA(1, 0, At, B0); PG8_MMA(1, 1, At, B1); PG8_BAR; PG8_SCHED;
            PG8_LDB(B0, 1, 0); PG8_LDB(B1, 1, 1); PG8_SCHED; PG8_LDA(At, 1, 0); PG8_STAGE(PG8_SA(0, 1), a2 + hstepA, voffA);
            PG8_WAIT_V(8); PG8_WAIT_L(0); PG8_BAR; PG8_MMA(0, 0, At, B0); PG8_MMA(0, 1, At, B1); PG8_BAR; PG8_SCHED;
            PG8_LDA(At, 1, 1); PG8_STAGE(PG8_SB(1, 0), b3, voffB); PG8_STAGE(PG8_SB(1, 1), b3 + hstepB, voffB); PG8_STAGE(PG8_SA(1, 0), a3, voffA);
            PG8_WAIT_V(8); PG8_WAIT_L(0); PG8_BAR; PG8_MMA(1, 0, At, B0); PG8_MMA(1, 1, At, B1); PG8_BAR; PG8_SCHED;
            } else {
            PG8_LDB(B0, 0, 0); PG8_SCHED; PG8_LDA(At, 0, 0); PG8_STAGE(PG8_SA(1, 1), a1 + hstepA, voffA);
            PG8_WAIT_L(8); PG8_BAR; PG8_WAIT_L(0); PG8_MMA(0, 0, At, B0); PG8_BAR; PG8_SCHED;
            PG8_LDB(B1, 0, 1); PG8_STAGE(PG8_SB(0, 0), b2, voffB);
            PG8_BAR; PG8_WAIT_L(0); PG8_MMA(0, 1, At, B1); PG8_BAR;
            PG8_LDA(At, 0, 1); PG8_STAGE(PG8_SA(0, 0), a2, voffA);
            PG8_BAR; PG8_WAIT_L(0); PG8_MMA(1, 0, At, B0); PG8_BAR; PG8_SCHED;
            PG8_STAGE(PG8_SB(0, 1), b2 + hstepB, voffB);
            PG8_WAIT_V(6); PG8_BAR; PG8_MMA(1, 1, At, B1); PG8_BAR;
            PG8_LDB(B0, 1, 0); PG8_SCHED; PG8_LDA(At, 1, 0); PG8_STAGE(PG8_SA(0, 1), a2 + hstepA, voffA);
            PG8_WAIT_L(8); PG8_BAR; PG8_WAIT_L(0); PG8_MMA(0, 0, At, B0); PG8_BAR; PG8_SCHED;
            PG8_LDB(B1, 1, 1); PG8_STAGE(PG8_SB(1, 0), b3, voffB);
            PG8_BAR; PG8_WAIT_L(0); PG8_MMA(0, 1, At, B1); PG8_BAR;
            PG8_LDA(At, 1, 1); PG8_STAGE(PG8_SA(1, 0), a3, voffA);
            PG8_BAR; PG8_WAIT_L(0); PG8_MMA(1, 0, At, B0); PG8_BAR; PG8_SCHED;
            PG8_STAGE(PG8_SB(1, 1), b3 + hstepB, voffB);
            PG8_WAIT_V(6); PG8_BAR; PG8_MMA(1, 1, At, B1); PG8_BAR;
            }
        }
        if constexpr (ALIGN_EPI) { if (wr == 0) PG8_BAR; }
        if constexpr (!Epi::AFTER_DRAIN) { E(acc, cur, wr, wc, fr, fq); S.done(cur); }
        if (!has_next) break;
#pragma unroll
        for (int a = 0; a < 2; ++a)
#pragma unroll
            for (int b = 0; b < 2; ++b)
#pragma unroll
                for (int m = 0; m < 4; ++m)
#pragma unroll
                    for (int n = 0; n < 2; ++n) acc[a][b][m][n] = (f32x4){0.f, 0.f, 0.f, 0.f};
        cur = nxt; cA = nA; cB = nB; ++ui;
        if constexpr (ALIGN_EPI) { if (wr == 1) PG8_BAR; }
    }
    PG8_WAIT_V(0);
    if constexpr (!ALIGN_EPI) { if (wr == 0) PG8_BAR; }
    PG8_BAR;
    if constexpr (Epi::AFTER_DRAIN) { E.fused(acc, cur, wr, wc, fr, fq, lds, wid, lane); S.done(cur); }
#undef PG8_SA
#undef PG8_SB
#undef PG8_STAGE
#undef PG8_LDA
#undef PG8_LDB
#undef PG8_MMA
#undef PG8_WAIT_V
#undef PG8_WAIT_L
#undef PG8_BAR
#undef PG8_SCHED
}
}
#include <hip/hip_bf16.h>
#include <cmath>
namespace attn_body {
using bf16=__hip_bfloat16;
using bf16x8=__attribute__((ext_vector_type(8)))short;
using s16x4=__attribute__((ext_vector_type(4)))short;
using f32x16=__attribute__((ext_vector_type(16)))float;
using u32x4=__attribute__((ext_vector_type(4)))unsigned;
constexpr int BATCH=4,NHEAD=16,SEQ=4096,D=64,DMQ=512,DMO=1024;
constexpr int NW=8,QBLK=32,QB=QBLK*NW,KVBLK=64,NQB=SEQ/QB;
constexpr int ATTN_UNIT_ROWS=QB;
__device__ __forceinline__ int crow(int r,int hi){return (r&3)+8*(r>>2)+4*hi;}
#define SBAR() __builtin_amdgcn_sched_barrier(0)
__device__ __forceinline__ void cmask(f32x16&p0,f32x16&p1,int jb,int qrel,int hi){
  const float NEG=-INFINITY; int kb=64*jb+4*hi;
  #pragma unroll
  for(int r=0;r<16;++r){int kv=kb+(r&3)+8*(r>>2); if(kv>qrel)p0[r]=NEG; if(kv+32>qrel)p1[r]=NEG;}
}

constexpr int NSLOT=3, SLOTB=8192;
constexpr int LDS_K=0, LDS_V=NSLOT*SLOTB, LDS_WS=2*NSLOT*SLOTB, LDS_OST=LDS_WS+NW*64*4, LDS_BYTES=LDS_OST+NW*4096;
constexpr float C2=0.125f*1.4426950408889634f;
__device__ __forceinline__ void glds16(const void*gsrc,unsigned lds_dst){unsigned keep;
  asm volatile("s_mov_b32 %0, m0\n\ts_mov_b32 m0, %2\n\ts_nop 0\n\tglobal_load_lds_dwordx4 %1, off\n\ts_mov_b32 m0, %0":"=&s"(keep):"v"(gsrc),"s"(lds_dst):"memory");}
__device__ __forceinline__ float max3f(float a,float b,float c){float r;asm("v_max3_f32 %0, %1, %2, %3":"=v"(r):"v"(a),"v"(b),"v"(c));return r;}
__device__ __forceinline__ float max2f(float a,float b){float r;asm("v_max_f32_e32 %0, %1, %2":"=v"(r):"v"(a),"v"(b));return r;}
__device__ __forceinline__ float fadd_s(float a,float b){float r;asm("v_add_f32_e32 %0, %1, %2":"=v"(r):"v"(a),"v"(b));return r;}
__device__ __forceinline__ float fsub_s(float a,float b){float r;asm("v_sub_f32_e32 %0, %1, %2":"=v"(r):"v"(a),"v"(b));return r;}
typedef float f32x2_t __attribute__((ext_vector_type(2))); typedef __bf16 bf16x2_t __attribute__((ext_vector_type(2)));
__device__ __forceinline__ unsigned cvtpk_s(float lo,float hi){f32x2_t v={lo,hi};bf16x2_t b=__builtin_convertvector(v,bf16x2_t);return __builtin_bit_cast(unsigned,b);}
#define WAIT_BAR(N) asm volatile("s_waitcnt vmcnt(" #N ") lgkmcnt(0)\n\ts_barrier":::"memory")

__device__ __forceinline__ void qkt(f32x16&p0,f32x16&p1,const char*Kslot,const bf16x8*qr,const f32x16&negm,int r32,int hi){
  const char*kb=Kslot+hi*1024+r32*16;
  #pragma unroll
  for(int d0=0;d0<4;++d0){
    const bf16x8 b0=*reinterpret_cast<const bf16x8*>(kb+d0*2048);
    const bf16x8 b1=*reinterpret_cast<const bf16x8*>(kb+d0*2048+512);
    if(d0==0){p0=__builtin_amdgcn_mfma_f32_32x32x16_bf16(b0,qr[0],negm,0,0,0);p1=__builtin_amdgcn_mfma_f32_32x32x16_bf16(b1,qr[0],negm,0,0,0);}
    else{p0=__builtin_amdgcn_mfma_f32_32x32x16_bf16(b0,qr[d0],p0,0,0,0);p1=__builtin_amdgcn_mfma_f32_32x32x16_bf16(b1,qr[d0],p1,0,0,0);}}
}
typedef __attribute__((address_space(3))) const char* lds_cptr;
typedef short v4i16_t __attribute__((ext_vector_type(4)));
__device__ __forceinline__ void kload8(bf16x8*kf,lds_cptr kp){
  kf[0]=*(const __attribute__((address_space(3))) bf16x8*)(kp);      kf[1]=*(const __attribute__((address_space(3))) bf16x8*)(kp+512);
  kf[2]=*(const __attribute__((address_space(3))) bf16x8*)(kp+2048); kf[3]=*(const __attribute__((address_space(3))) bf16x8*)(kp+2560);
  kf[4]=*(const __attribute__((address_space(3))) bf16x8*)(kp+4096); kf[5]=*(const __attribute__((address_space(3))) bf16x8*)(kp+4608);
  kf[6]=*(const __attribute__((address_space(3))) bf16x8*)(kp+6144); kf[7]=*(const __attribute__((address_space(3))) bf16x8*)(kp+6656);
}
__device__ __forceinline__ void kload2(bf16x8*kf,lds_cptr kp,int j){ kf[2*j]=*(const __attribute__((address_space(3))) bf16x8*)(kp+j*2048); kf[2*j+1]=*(const __attribute__((address_space(3))) bf16x8*)(kp+j*2048+512); }
__device__ __forceinline__ s16x4 vtr(lds_cptr p){ return __builtin_bit_cast(s16x4,__builtin_amdgcn_ds_read_tr16_b64_v4i16((__attribute__((address_space(3))) v4i16_t*)p)); }
__device__ __forceinline__ float rowmax(const f32x16&p0,const f32x16&p1){
  float a=max3f(p0[0],p0[1],p1[0]),b=max3f(p0[2],p0[3],p1[1]);a=max3f(a,p1[2],p1[3]);
  #pragma unroll
  for(int r=4;r<16;r+=4){a=max3f(a,p0[r],p0[r+1]);b=max3f(b,p0[r+2],p0[r+3]);a=max3f(a,p1[r],p1[r+1]);b=max3f(b,p1[r+2],p1[r+3]);}
  const float m=max2f(a,b);
  auto rr=__builtin_amdgcn_permlane32_swap(__float_as_uint(m),__float_as_uint(m),false,false);
  return max2f(__uint_as_float(rr[0]),__uint_as_float(rr[1]));
}
__device__ __forceinline__ void pv(f32x16*o,int vb,bf16x8 pa0,bf16x8 pa1,bf16x8 pa2,bf16x8 pa3){
  #pragma unroll
  for(int d0=0;d0<2;++d0){s16x4 lo[4],hi[4];
    #pragma unroll
    for(int ks=0;ks<4;++ks){
      asm volatile("ds_read_b64_tr_b16 %0,%1 offset:%c2":"=&v"(lo[ks]):"v"(vb),"i"(d0*4096+ks*1024):"memory");
      asm volatile("ds_read_b64_tr_b16 %0,%1 offset:%c2":"=&v"(hi[ks]):"v"(vb),"i"(d0*4096+ks*1024+512):"memory");}
    asm volatile("s_waitcnt lgkmcnt(0)":::"memory");SBAR();
    #define PK(k) (bf16x8){lo[k][0],lo[k][1],lo[k][2],lo[k][3],hi[k][0],hi[k][1],hi[k][2],hi[k][3]}
    o[d0]=__builtin_amdgcn_mfma_f32_32x32x16_bf16(pa0,PK(0),o[d0],0,0,0);
    o[d0]=__builtin_amdgcn_mfma_f32_32x32x16_bf16(pa1,PK(1),o[d0],0,0,0);
    o[d0]=__builtin_amdgcn_mfma_f32_32x32x16_bf16(pa2,PK(2),o[d0],0,0,0);
    o[d0]=__builtin_amdgcn_mfma_f32_32x32x16_bf16(pa3,PK(3),o[d0],0,0,0);
    #undef PK
  }
}

#ifndef ATTN_STORE16
#define ATTN_STORE16(p,v) (*(u32x4*)(p)=(v))
#endif
template<int THRL> __device__ __forceinline__ void attn_unit(int b,int cq,int ck,int cv,int co,int qb,const bf16*Q,const bf16*__restrict__ K,const bf16*__restrict__ V,bf16*O,char*shm,int wave_hint){
  int tid_l=wave_hint*64+(int)__builtin_amdgcn_mbcnt_hi(~0u,__builtin_amdgcn_mbcnt_lo(~0u,0u)); asm volatile("":"+v"(tid_l)); const int tid=tid_l,lane=tid&63,r32=lane&31,hi=lane>>5; const int wid=__builtin_amdgcn_readfirstlane(tid>>6);
  const long rowbase=(long)b*SEQ; const int q0=qb*QB;
  const bf16*Qw=Q+(rowbase+q0+wid*QBLK)*DMQ+cq;
  const bf16*Kh=K+rowbase*DMQ+ck,*Vh=V+rowbase*DMQ+cv;
  const unsigned lds0=(unsigned)(uintptr_t)shm;
  float*wsf=(float*)(shm+LDS_WS)+wid*64;
  const bf16*ksrc=Kh+(long)lane*DMQ+wid*8;
  const bf16*vsrc=Vh+(long)(16*(wid&3)+(lane>>2))*DMQ+(wid>>2)*32+(lane&3)*8;
  const unsigned kdst=lds0+LDS_K+wid*1024, vdst=lds0+LDS_V+wid*1024;
  #define DMA_K(t,slot) glds16(ksrc+(long)(t)*KVBLK*DMQ,(unsigned)__builtin_amdgcn_readfirstlane(kdst+(slot)))
  #define DMA_V(t,slot) glds16(vsrc+(long)(t)*KVBLK*DMQ,(unsigned)__builtin_amdgcn_readfirstlane(vdst+(slot)))
  const int vb0=(int)(lds0+LDS_V)+((lane>>4)&1)*32+(lane&3)*8+(4*hi+((lane&15)>>2))*64;
  const char*Kbase=shm+LDS_K; bf16x8 kf[8];
  const lds_cptr shm3=(lds_cptr)shm; const lds_cptr kp0=shm3+LDS_K+hi*1024+r32*16; const lds_cptr vp0=shm3+LDS_V+((lane>>4)&1)*32+(lane&3)*8+(4*hi+((lane&15)>>2))*64;
  const int NT=(q0+QB)/KVBLK;
  DMA_K(0,0);DMA_V(0,0);DMA_K(1,SLOTB);
  bf16x8 qr[4];
  #pragma unroll
  for(int d0=0;d0<4;++d0)qr[d0]=*reinterpret_cast<const bf16x8*>(&Qw[(long)r32*DMQ+d0*16+hi*8]);
  float mhat=0.f,l_reg=0.f;f32x16 o[2];o[0]=f32x16{};o[1]=f32x16{};f32x16 negm=f32x16{};asm volatile("":"+v"(negm));
  const int qrel=wid*QBLK+r32;
  #define CMASK(P0,P1,t) do{int jb_=(t)-(NT-4); if(jb_>=0)cmask(P0,P1,jb_,qrel,hi);}while(0)
  bool resc=false;
  #define START(P0,P1) do{ const float rm=rowmax(P0,P1); resc=false; \
    { const float dl=rm; mhat=fadd_s(mhat,dl); \
      _Pragma("unroll") for(int r=0;r<16;++r){P0[r]=fsub_s(P0[r],dl);P1[r]=fsub_s(P1[r],dl);} \
      _Pragma("unroll") for(int r=0;r<16;++r)negm[r]=-mhat; asm volatile("":"+v"(negm)); } \
    _Pragma("unroll") for(int r=0;r<16;++r)P0[r]=__builtin_amdgcn_exp2f(P0[r]); }while(0)
  #define RESC() do{ if(resc){ asm volatile("s_waitcnt lgkmcnt(0)":::"memory"); \
      _Pragma("unroll") for(int d_=0;d_<2;++d_) _Pragma("unroll") for(int r=0;r<16;++r)o[d_][r]*=wsf[crow(r,hi)]; } }while(0)
  f32x16 pA0,pA1,pB0,pB1;
  int sl_prev=0,sl_cur=0,sl_next=SLOTB;
  #define ROT() do{sl_prev=sl_cur;sl_cur=sl_next;sl_next=(sl_next==(NSLOT-1)*SLOTB)?0:sl_next+SLOTB;}while(0)
  DMA_K(2,2*SLOTB);
  WAIT_BAR(3);
  qkt(pA0,pA1,Kbase,qr,negm,r32,hi);asm volatile("s_nop 15\n\ts_nop 7":"+v"(pA0),"+v"(pA1));CMASK(pA0,pA1,0);
  START(pA0,pA1);
  _Pragma("unroll") for(int r=0;r<16;++r)pA1[r]=__builtin_amdgcn_exp2f(pA1[r]);
  WAIT_BAR(0);
  DMA_K(3,0);DMA_V(1,SLOTB);
  ROT();
  kload8(kf,kp0+sl_cur);
  WAIT_BAR(2);
  s16x4 vlo[8],vhi[8]; u32x4 pw0,pw1,pw2,pw3;
  #define PKW(P,B) cvtpk_s(P[B],P[B+1])
  #define PAF(k) __builtin_bit_cast(bf16x8,pw##k)
  #define VFR(i) (bf16x8){vlo[i][0],vlo[i][1],vlo[i][2],vlo[i][3],vhi[i][0],vhi[i][1],vhi[i][2],vhi[i][3]}
  #define PIN(x) asm volatile("":"+v"(x))
  #define MX3(a,b,c) __builtin_fmaxf(__builtin_fmaxf((a),(b)),(c))
  #define GAPA(MF,A0,A1,A2,A3,W0,W1,PW) do{ MF; sacc+=A0; sacc+=A1; sacc+=A2; sacc+=A3; PIN(sacc); W0; W1; PIN(PW); SBAR(); }while(0)
  #define EX(v) __builtin_amdgcn_exp2f(v)
  #define GAPB(MF,X,B) do{ MF; X[B]=EX(X[B]); X[B+1]=EX(X[B+1]); X[B+2]=EX(X[B+2]); X[B+3]=EX(X[B+3]); PIN(X); SBAR(); }while(0)
  #define VRD(i) do{ vlo[i]=vtr(vp_+(((i)>>2)*4096+((i)&3)*1024)); vhi[i]=vtr(vp_+(((i)>>2)*4096+((i)&3)*1024+512)); }while(0)
  #define KRD(G,j) do{ if(G){ kload2(kf,kp0+sl_next,j); SBAR(); } }while(0)
  #define STEP(C0,C1,P0,P1,t,GK,GV,GL) do{ SBAR(); \
    const lds_cptr vp_=vp0+sl_prev; \
    VRD(0); SBAR(); float sacc=(P0[0]+P0[1]); \
    GAPA(C0=__builtin_amdgcn_mfma_f32_32x32x16_bf16(kf[0],qr[0],negm,0,0,0), P0[2],P0[3],P0[4],P0[5],     pw0[0]=PKW(P0,0), pw0[1]=PKW(P0,2), pw0); \
    VRD(4); SBAR(); GAPA(C1=__builtin_amdgcn_mfma_f32_32x32x16_bf16(kf[1],qr[0],negm,0,0,0), P0[6],P0[7],P0[8],P0[9],     pw0[2]=PKW(P0,4), pw0[3]=PKW(P0,6), pw0); \
    VRD(1); SBAR(); GAPA(C0=__builtin_amdgcn_mfma_f32_32x32x16_bf16(kf[2],qr[1],C0,0,0,0),   P0[10],P0[11],P0[12],P0[13], pw1[0]=PKW(P0,8), pw1[1]=PKW(P0,10), pw1); \
    VRD(5); SBAR(); GAPA(C1=__builtin_amdgcn_mfma_f32_32x32x16_bf16(kf[3],qr[1],C1,0,0,0),   P0[14],P0[15],P1[0],P1[1],   pw1[2]=PKW(P0,12),pw1[3]=PKW(P0,14), pw1); \
    VRD(2); SBAR(); GAPA(C0=__builtin_amdgcn_mfma_f32_32x32x16_bf16(kf[4],qr[2],C0,0,0,0),   P1[2],P1[3],P1[4],P1[5],     pw2[0]=PKW(P1,0), pw2[1]=PKW(P1,2), pw2); \
    VRD(6); SBAR(); GAPA(C1=__builtin_amdgcn_mfma_f32_32x32x16_bf16(kf[5],qr[2],C1,0,0,0),   P1[6],P1[7],P1[8],P1[9],     pw2[2]=PKW(P1,4), pw2[3]=PKW(P1,6), pw2); \
    VRD(3); SBAR(); GAPA(C0=__builtin_amdgcn_mfma_f32_32x32x16_bf16(kf[6],qr[3],C0,0,0,0),   P1[10],P1[11],P1[12],P1[13], pw3[0]=PKW(P1,8), pw3[1]=PKW(P1,10), pw3); \
    VRD(7); SBAR(); GAPA(C1=__builtin_amdgcn_mfma_f32_32x32x16_bf16(kf[7],qr[3],C1,0,0,0),   P1[14],P1[15],0.f,0.f,       pw3[2]=PKW(P1,12),pw3[3]=PKW(P1,14), pw3); \
    l_reg+=sacc; \
    if(GK){DMA_K((t)+3,sl_cur);} if(GV){DMA_V((t)+1,sl_next);} \
    CMASK(C0,C1,t); \
    { float a=MX3(C0[0],C0[1],C1[0]),b=MX3(C0[2],C0[3],C1[1]); a=MX3(a,C1[2],C1[3]); \
      _Pragma("unroll") for(int r=4;r<16;r+=4){a=MX3(a,C0[r],C0[r+1]);b=MX3(b,C0[r+2],C0[r+3]);a=MX3(a,C1[r],C1[r+1]);b=MX3(b,C1[r+2],C1[r+3]);} \
      float rm=__builtin_fmaxf(a,b); { auto rr=__builtin_amdgcn_permlane32_swap(__float_as_uint(rm),__float_as_uint(rm),false,false); rm=__builtin_fmaxf(__uint_as_float(rr[0]),__uint_as_float(rr[1])); } \
      resc=false; \
      if(__builtin_expect(__any(rm>(float)THRL),0)){ const float dl=__builtin_fmaxf(rm,0.f); mhat+=dl; \
        _Pragma("unroll") for(int r=0;r<16;++r){C0[r]-=dl;C1[r]-=dl;} \
        _Pragma("unroll") for(int r=0;r<16;++r)negm[r]=-mhat; asm volatile("":"+v"(negm)); \
        const float f=__builtin_amdgcn_exp2f(-dl); l_reg*=f; if(hi==0)wsf[r32]=f; resc=true; } } \
    SBAR(); \
    GAPB(o[0]=__builtin_amdgcn_mfma_f32_32x32x16_bf16(PAF(0),VFR(0),o[0],0,0,0), C0,0); \
    GAPB(o[1]=__builtin_amdgcn_mfma_f32_32x32x16_bf16(PAF(0),VFR(4),o[1],0,0,0), C0,4); \
    KRD(GL,0); GAPB(o[0]=__builtin_amdgcn_mfma_f32_32x32x16_bf16(PAF(1),VFR(1),o[0],0,0,0), C0,8); \
    KRD(GL,1); GAPB(o[1]=__builtin_amdgcn_mfma_f32_32x32x16_bf16(PAF(1),VFR(5),o[1],0,0,0), C0,12); \
    KRD(GL,2); GAPB(o[0]=__builtin_amdgcn_mfma_f32_32x32x16_bf16(PAF(2),VFR(2),o[0],0,0,0), C1,0); \
    KRD(GL,3); GAPB(o[1]=__builtin_amdgcn_mfma_f32_32x32x16_bf16(PAF(2),VFR(6),o[1],0,0,0), C1,4); \
    GAPB(o[0]=__builtin_amdgcn_mfma_f32_32x32x16_bf16(PAF(3),VFR(3),o[0],0,0,0), C1,8); \
    GAPB(o[1]=__builtin_amdgcn_mfma_f32_32x32x16_bf16(PAF(3),VFR(7),o[1],0,0,0), C1,12); \
    }while(0)
  int t=1;
  #undef CMASK
  #define CMASK(P0,P1,t) do{}while(0)
  for(;t+5<NT;t+=2){
    STEP(pB0,pB1,pA0,pA1,t,true,true,true);     WAIT_BAR(2); RESC(); ROT();
    STEP(pA0,pA1,pB0,pB1,t+1,true,true,true);   WAIT_BAR(2); RESC(); ROT();
  }
  #undef CMASK
  #define CMASK(P0,P1,t) do{int jb_=(t)-(NT-4); if(jb_>=0)cmask(P0,P1,jb_,qrel,hi);}while(0)
  #define ENDW(tt) do{ if((tt)+3<NT){WAIT_BAR(2);} else if((tt)+2<NT){WAIT_BAR(1);} else {WAIT_BAR(0);} }while(0)
  for(;t+1<NT;t+=2){
    STEP(pB0,pB1,pA0,pA1,t,(t+3<NT),(t+1<NT),(t+1<NT));       ENDW(t);   RESC(); ROT();
    STEP(pA0,pA1,pB0,pB1,t+1,(t+4<NT),(t+2<NT),(t+2<NT));     ENDW(t+1); RESC(); ROT();
  }
  STEP(pB0,pB1,pA0,pA1,NT-1,false,false,false); RESC();
  { float sacc=pB0[0]+pB0[1]; _Pragma("unroll") for(int r=2;r<16;++r)sacc+=pB0[r]; _Pragma("unroll") for(int r=0;r<16;++r)sacc+=pB1[r]; l_reg+=sacc;
    pw0=(u32x4){PKW(pB0,0),PKW(pB0,2),PKW(pB0,4),PKW(pB0,6)};pw1=(u32x4){PKW(pB0,8),PKW(pB0,10),PKW(pB0,12),PKW(pB0,14)};pw2=(u32x4){PKW(pB1,0),PKW(pB1,2),PKW(pB1,4),PKW(pB1,6)};pw3=(u32x4){PKW(pB1,8),PKW(pB1,10),PKW(pB1,12),PKW(pB1,14)};
    SBAR(); pv(o,vb0+sl_cur,PAF(0),PAF(1),PAF(2),PAF(3)); }
  #undef PKW
  #undef PAF
  #undef VFR
  #undef PIN
  #undef MX3
  #undef GAPA
  #undef GAPB
  #undef EX
  #undef VRD
  #undef KRD
  #undef STEP
  #undef ENDW
  {auto rr=__builtin_amdgcn_permlane32_swap(__float_as_uint(l_reg),__float_as_uint(l_reg),false,false);l_reg=__uint_as_float(rr[0])+__uint_as_float(rr[1]);}
  if(hi==0)wsf[32+r32]=l_reg;asm volatile("s_waitcnt lgkmcnt(0)":::"memory");
  float rli[16];
  #pragma unroll
  for(int r=0;r<16;++r)rli[r]=__builtin_amdgcn_rcpf(wsf[32+crow(r,hi)]);
  bf16*Ow=O+(rowbase+q0+wid*QBLK)*DMO+co;
  { bf16*stg=(bf16*)(shm+LDS_OST)+wid*2048;
    #pragma unroll
    for(int r=0;r<16;++r){const int orow=crow(r,hi);
      #pragma unroll
      for(int d0=0;d0<2;++d0)stg[orow*64+d0*32+r32]=__float2bfloat16(o[d0][r]*rli[r]);}
    asm volatile("s_waitcnt lgkmcnt(0)":::"memory");
    #pragma unroll
    for(int i=0;i<4;++i){const int row=i*8+(lane>>3),ch=lane&7; const u32x4 v=*(const u32x4*)(stg+row*64+ch*8); ATTN_STORE16(Ow+(long)row*DMO+ch*8,v);} }
  asm volatile("s_waitcnt lgkmcnt(0)\n\ts_barrier":::"memory");
  #undef DMA_K
  #undef DMA_V
  #undef CMASK
  #undef START
  #undef RESC
  #undef ROT
}
constexpr int ATTN_LDS_BYTES=LDS_BYTES;
#undef SBAR
#undef WAIT_BAR
}
namespace cg = cooperative_groups;
#define GAS __attribute__((address_space(1)))
#define LAS __attribute__((address_space(3)))
typedef unsigned short bf16;
typedef unsigned v4u __attribute__((ext_vector_type(4)));
typedef unsigned v2u __attribute__((ext_vector_type(2)));
typedef float f32x4 __attribute__((ext_vector_type(4)));
constexpr int NWAVES = 8, NTHR = 512;
constexpr int M = 16384, DMOD = 1024, SEQ = 4096, NIN = 6816, DFF = 2816, ZP = 1728;
constexpr size_t MiB = 1u << 20;
constexpr size_t WS_CTL = 0;
constexpr size_t WS_WGLU = 1 * MiB, WS_WB = WS_WGLU + MiB / 2, WS_WO = WS_WB + 3 * MiB, WS_WFI = WS_WO + 2 * MiB, WS_WFO = WS_WFI + 11 * MiB;
constexpr size_t WS_WX = 23 * MiB, WS_W1A = WS_WX, WS_W1B = WS_WX + 4 * MiB, WS_E = WS_WX, WS_WG = WS_WX;
constexpr size_t WS_VF = 40 * MiB, WS_US = 56 * MiB, WS_YA = 80 * MiB, WS_Z = 96 * MiB, WS_QB = 150 * MiB, WS_KB = 166 * MiB, WS_VB = 182 * MiB;
constexpr size_t WS_XNP = 198 * MiB, WS_O = 198 * MiB, WS_AB = 231 * MiB, WS_PT = 247 * MiB, WS_MT = 249 * MiB, WS_END = 256 * MiB;
constexpr size_t WS_XN = 150 * MiB, WS_YL = 182 * MiB, WS_P12 = 182 * MiB, WS_G0 = 214 * MiB, WS_H2N = 96 * MiB, WS_HID = 150 * MiB;
static_assert(WS_WFO + (size_t)1024 * 2816 * 2 <= WS_WX && WS_Z + (size_t)M * ZP * 2 <= WS_QB && WS_XNP + (size_t)4 * 4097 * 1024 * 2 <= WS_AB && WS_MT + (size_t)32 * 256 * 384 * 2 <= WS_END && WS_HID + (size_t)M * DFF * 2 <= WS_END, "ws map");
constexpr int LDS_BYTES = 148480; constexpr int LDS_XB = 147456; constexpr int CW_BAR = 4096;
constexpr float C2Q = 0.125f * 1.4426950408889634f;

__device__ __forceinline__ unsigned f2bf(float f) { unsigned u = __builtin_bit_cast(unsigned, f); return (u + 0x7fffu + ((u >> 16) & 1u)) >> 16; }
__device__ __forceinline__ float bf2f(unsigned b) { return __uint_as_float(b << 16); }
__device__ __forceinline__ void unpack8(const v4u w, float* f) {
    f[0] = __uint_as_float(w.x << 16); f[1] = __uint_as_float(w.x & 0xffff0000u); f[2] = __uint_as_float(w.y << 16); f[3] = __uint_as_float(w.y & 0xffff0000u);
    f[4] = __uint_as_float(w.z << 16); f[5] = __uint_as_float(w.z & 0xffff0000u); f[6] = __uint_as_float(w.w << 16); f[7] = __uint_as_float(w.w & 0xffff0000u); }
__device__ __forceinline__ v4u pack8(const float* f) { v4u w; w.x = pg8::cvt_pk_bf16(f[0], f[1]); w.y = pg8::cvt_pk_bf16(f[2], f[3]); w.z = pg8::cvt_pk_bf16(f[4], f[5]); w.w = pg8::cvt_pk_bf16(f[6], f[7]); return w; }
__device__ __forceinline__ float sigm(float x) { return __builtin_amdgcn_rcpf(1.f + __expf(-x)); }
__device__ __forceinline__ float tanh_f(float x) { return 1.f - 2.f * __builtin_amdgcn_rcpf(1.f + __expf(2.f * x)); }
__device__ __forceinline__ float wave_sum(float v) {
#pragma unroll
    for (int o = 1; o < 64; o <<= 1) v += __shfl_xor(v, o);
    return v; }
__device__ __forceinline__ float dppf(float x, const int ctrl) { return x; }
#define DPP_ADD(x, ctrl) ((x) + __builtin_bit_cast(float, __builtin_amdgcn_update_dpp(0, __builtin_bit_cast(int, (x)), (ctrl), 0xf, 0xf, true)))
__device__ __forceinline__ float row16_sum(float x) { x = DPP_ADD(x, 0xB1); x = DPP_ADD(x, 0x4E); x = DPP_ADD(x, 0x141); x = DPP_ADD(x, 0x140); return x; }

template <int MODE> struct Epi8 {
    static constexpr bool PERM = true, AFTER_DRAIN = false;
    bf16* O; int ldc; const bf16* X; const float* P;
    __device__ __forceinline__ void operator()(const pg8::f32x4 (&acc)[2][2][4][2], const pg8::Unit& u, int wr, int wc, int fr, int fq) const {
#pragma unroll
        for (int ai = 0; ai < 2; ++ai)
#pragma unroll
            for (int m = 0; m < 4; ++m) {
                const int row = u.pm * 256 + ai * 128 + wr * 64 + m * 16 + fr;
                if (MODE == 8) {
                    float o[8];
#pragma unroll
                    for (int i = 0; i < 8; ++i) { const float gte = acc[ai][0][m][i >> 2][i & 3], up = acc[ai][1][m][i >> 2][i & 3]; o[i] = gte * sigm(gte) * up; }
                    *(v4u*)(O + (size_t)row * DFF + u.pn * 128 + wc * 32 + 8 * fq) = pack8(o);
                } else {
#pragma unroll
                for (int bj = 0; bj < 2; ++bj) {
                    const int col = u.pn * 256 + bj * 128 + wc * 32 + 8 * fq;
                    float v[8];
#pragma unroll
                    for (int i = 0; i < 8; ++i) v[i] = acc[ai][bj][m][i >> 2][i & 3];
                    if (MODE == 0) { if (col < ldc) *(v4u*)(O + (size_t)row * ldc + col) = pack8(v); }
                    else if (MODE == 1) {
                        if (u.pn < 2) { const int g = col >> 4, cc = col & 15, b = row >> 12, t = row & 4095, ch = t >> 4, s = t & 15;
                            *(v4u*)((bf16*)X + ((size_t)(g * 1024 + b * 256 + ch) * 384 + s * 16 + cc)) = pack8(v); }
                        else { const int tsel = (col >> 9) - 1, cl = col & 511; *(v4u*)(O + (size_t)tsel * (8u * MiB) + (size_t)row * 512 + cl) = pack8(v); }
                    }
                    else if (MODE == 2) { if (bj == 0) *(v4u*)(O + (size_t)row * 384 + 256 + (col & 255)) = pack8(v); }
                    else if (MODE == 3) {
                        const int g = row >> 10, b = (row >> 8) & 3, ch = row & 255, cl = col & 255, t = cl >> 4, cc = cl & 15;
                        float uu[8]; unpack8(*(const v4u*)(X + (size_t)row * 384 + cl), uu);
#pragma unroll
                        for (int i = 0; i < 8; ++i) { const float y = v[i] + P[g * 16 + cc + i] * uu[i]; v[i] = y * sigm(1.5957691216f * (y + 0.044715f * y * y * y)); }
                        *(v4u*)(O + (size_t)(b * 4096 + ch * 16 + t) * 512 + g * 16 + cc) = pack8(v);
                    }
                    else if (MODE == 4) { float y[8]; unpack8(*(const v4u*)(X + (size_t)row * 512 + col), y);
#pragma unroll
                        for (int i = 0; i < 8; ++i) v[i] = y[i] * sigm(v[i]);
                        *(v4u*)(O + (size_t)row * 512 + col) = pack8(v); }
                    else if (MODE == 5) {
#pragma unroll
                        for (int i = 0; i < 8; ++i) v[i] = sigm(v[i]);
                        *(v4u*)(O + (size_t)row * 1024 + col) = pack8(v); }
                    else if (MODE == 10) {
#pragma unroll
                        for (int i = 0; i < 8; ++i) v[i] = sigm(v[i]);
                        *(v4u*)(O + (size_t)(col >> 10) * ((size_t)M * 1024) + (size_t)row * 1024 + (col & 1023)) = pack8(v); }
                    else if (MODE == 11) {
                        const int np = col >> 10, d = col & 1023; float gt[8], pp[8];
                        unpack8(*(const v4u*)(O + (size_t)np * ((size_t)M * 1024) + (size_t)row * 1024 + d), gt);
                        if (np) unpack8(*(const v4u*)(O + (size_t)row * 1024 + d), pp);
#pragma unroll
                        for (int i = 0; i < 8; ++i) v[i] = (np ? pp[i] : 0.f) + gt[i] * v[i];
                        *(v4u*)(O + (size_t)row * 1024 + d) = pack8(v); }
                    else if (MODE == 6 || MODE == 7) { float gt[8]; unpack8(*(const v4u*)(X + (size_t)row * 1024 + col), gt);
                        float pm_[8];
                        if (MODE == 7) unpack8(*(const v4u*)(O + (size_t)row * 1024 + col), pm_);
#pragma unroll
                        for (int i = 0; i < 8; ++i) v[i] = (MODE == 7 ? pm_[i] : 0.f) + gt[i] * v[i];
                        *(v4u*)(O + (size_t)row * 1024 + col) = pack8(v); }
                }
                }
            }
    }
};
struct EpiRes {
    static constexpr bool PERM = false, AFTER_DRAIN = false;
    const float* xin; float* xout;
    __device__ __forceinline__ void operator()(const pg8::f32x4 (&acc)[2][2][4][2], const pg8::Unit& u, int wr, int wc, int fr, int fq) const {
#pragma unroll
        for (int ai = 0; ai < 2; ++ai)
#pragma unroll
            for (int m = 0; m < 4; ++m) { const size_t off = (size_t)(u.pm * 256 + ai * 128 + wr * 64 + m * 16 + fr) * 1024 + u.pn * 256 + wc * 32 + 4 * fq;
#pragma unroll
                for (int bj = 0; bj < 2; ++bj)
#pragma unroll
                    for (int n = 0; n < 2; ++n) { const f32x4 b = *(const f32x4*)(xin + off + bj * 128 + n * 16); f32x4 o; o.x = b.x + acc[ai][bj][m][n][0]; o.y = b.y + acc[ai][bj][m][n][1]; o.z = b.z + acc[ai][bj][m][n][2]; o.w = b.w + acc[ai][bj][m][n][3];
                        *(f32x4*)(xout + off + bj * 128 + n * 16) = o; } }
    }
};
__device__ __forceinline__ pg8::Gemm mkgemm(const bf16* A, const bf16* Bt, int Mr, int N, int K, int lda, int ldb) {
    pg8::Gemm g; g.A = A; g.Bt = Bt; g.M = Mr; g.N = N; g.K = K; g.lda = lda; g.ldb = ldb; g.a_skip_shift = 30; g.a_skip_bytes = 0; g.kwrap = 1 << 20; g.wrap_bytes = 0; g.b_shift = 30; g.b_stride_bytes = 0; g.a_pn_shift = 30; g.a_pn_bytes = 0; return g; }
template <class Epi> __device__ __forceinline__ void run_gemm_w(int wave_hint, LAS unsigned char* lds, const pg8::Gemm& g, const Epi& E, int G, int c) {
    asm volatile("" : "+s"(G), "+s"(c));
    pg8::StaticOrder S; S.init(g.M, g.N, G, c);
    pg8::gemm_phase<Epi, pg8::StaticOrder, true, true>(lds, g, S, E, wave_hint);
}

struct PairOrder { pg8::StaticOrder S0;
    __device__ void init(int Mr, int G, int c) { S0.init(Mr, 1024, G, c); }
    __device__ bool next(int i, pg8::Unit& u) const { if (!S0.next(i >> 1, u)) return false; u.pn += 4 * (i & 1); return true; }
    __device__ __forceinline__ void a_ready(const pg8::Unit&) const {}
    __device__ __forceinline__ void done(const pg8::Unit&) const {} };
template <class Epi> __device__ __forceinline__ void run_gemm_pair_w(int wave_hint, LAS unsigned char* lds, const pg8::Gemm& g, const Epi& E, int G, int c) {
    asm volatile("" : "+s"(G), "+s"(c));
    PairOrder S; S.init(g.M, G, c);
    pg8::gemm_phase<Epi, PairOrder, true, true>(lds, g, S, E, wave_hint);
}

#define run_gemm(...) run_gemm_w(wave, __VA_ARGS__)
#define run_gemm_pair(...) run_gemm_pair_w(wave, __VA_ARGS__)
__device__ __forceinline__ void tr_item(const float* W, int ldw, int k0, int c0, bf16* WT, int ldt, int drow, int koff, const float* mu, int smode, LAS float* scr, int lane) {
    { const int kr = lane >> 3, nq = (lane & 7) * 4; f32x4 t[8];
#pragma unroll
      for (int i = 0; i < 8; ++i) t[i] = *(const f32x4*)(W + (size_t)(k0 + i * 8 + kr) * ldw + c0 + nq);
#pragma unroll
      for (int i = 0; i < 8; ++i) { LAS float* d = scr + (i * 8 + kr) * 33 + nq; d[0] = t[i].x; d[1] = t[i].y; d[2] = t[i].z; d[3] = t[i].w; } }
    asm volatile("s_waitcnt lgkmcnt(0)" ::: "memory");
    const int c = lane & 7;
#pragma unroll
    for (int j = 0; j < 4; ++j) { const int n = (lane >> 3) + 8 * j; const LAS float* s = scr + (8 * c) * 33 + n;
        float sc = 1.f; if (smode) { const float m_ = mu[n]; sc = (smode == 1) ? 1.f - m_ : m_; }
        v4u o; o.x = pg8::cvt_pk_bf16(s[0 * 33] * sc, s[1 * 33] * sc); o.y = pg8::cvt_pk_bf16(s[2 * 33] * sc, s[3 * 33] * sc); o.z = pg8::cvt_pk_bf16(s[4 * 33] * sc, s[5 * 33] * sc); o.w = pg8::cvt_pk_bf16(s[6 * 33] * sc, s[7 * 33] * sc);
        *(v4u*)(WT + (size_t)(drow + n) * ldt + koff + k0 + 8 * c) = o; }
    asm volatile("s_waitcnt lgkmcnt(0)" ::: "memory");
}
__device__ __forceinline__ void rms_row(const float* xrow, const float* gain, bf16* orow, int lane) {
    const f32x4* xr = (const f32x4*)xrow + lane; const f32x4* gr = (const f32x4*)gain + lane;
    f32x4 v[4]; float s = 0.f;
#pragma unroll
    for (int j = 0; j < 4; ++j) { v[j] = xr[64 * j]; s += (v[j].x * v[j].x + v[j].y * v[j].y) + (v[j].z * v[j].z + v[j].w * v[j].w); }
    const float rstd = 1.f / sqrtf(wave_sum(s) * (1.f / 1024.f) + 1e-6f);
    v2u* o8 = (v2u*)orow + lane;
#pragma unroll
    for (int j = 0; j < 4; ++j) { const f32x4 g = gr[64 * j]; v2u w; w.x = pg8::cvt_pk_bf16(v[j].x * rstd * g.x, v[j].y * rstd * g.y); w.y = pg8::cvt_pk_bf16(v[j].z * rstd * g.z, v[j].w * rstd * g.w); o8[64 * j] = w; }
}
struct Ptrs { const float* in[35]; float* out; unsigned char* ws; };

__device__ __forceinline__ void weight_items(const Ptrs& P, int L, int gw, int NGW, LAS float* scr, int lane, int it_lo, int it_hi) {
    unsigned char* ws = P.ws;
    const float* w_in = P.in[2] + (size_t)L * 1024 * NIN; const float* mu = P.in[16] + (size_t)L * 1696;
    constexpr int I1A = 16 * 64, I1B = 16 * 53, IGLU = 8 * 16, IWB = 8 * 32, IWO = 16 * 32, IFI = 16 * 176, IFO = 44 * 32;
    constexpr int NIT = I1A + 2 * I1B + IGLU + 3 * IWB + IWO + IFI + IFO;
    for (int it = it_lo + gw; it < it_hi; it += NGW) {
        int r = it;
        if (r < I1A) { const int kb = r / 64, nb = r % 64; tr_item(w_in, NIN, kb * 64, nb * 32, (bf16*)(ws + WS_W1A), 1024, nb * 32, 0, nullptr, 0, scr, lane); continue; } r -= I1A;
        if (r < I1B) { const int kb = r / 53, nb = r % 53; tr_item(w_in, NIN, kb * 64, 2048 + nb * 32, (bf16*)(ws + WS_W1B), 2048, nb * 32, 0, mu + nb * 32, 1, scr, lane); continue; } r -= I1B;
        if (r < I1B) { const int kb = r / 53, nb = r % 53; tr_item(w_in, NIN, kb * 64, 2048 + nb * 32, (bf16*)(ws + WS_W1B), 2048, nb * 32, 1024, mu + nb * 32, 2, scr, lane); continue; } r -= I1B;
        if (r < IGLU) { const int kb = r / 16, nb = r % 16; tr_item(P.in[11] + (size_t)L * 512 * 512, 512, kb * 64, nb * 32, (bf16*)(ws + WS_WGLU), 512, nb * 32, 0, nullptr, 0, scr, lane); continue; } r -= IGLU;
        if (r < 3 * IWB) { const int n = r / IWB, q = r % IWB, kb = q / 32, nb = q % 32; tr_item(P.in[30] + ((size_t)L * 3 + n) * 512 * 1024, 1024, kb * 64, nb * 32, (bf16*)(ws + WS_WB) + (size_t)n * 1024 * 512, 512, nb * 32, 0, nullptr, 0, scr, lane); continue; } r -= 3 * IWB;
        if (r < IWO) { const int kb = r / 32, nb = r % 32; tr_item(P.in[31] + (size_t)L * 1024 * 1024, 1024, kb * 64, nb * 32, (bf16*)(ws + WS_WO), 1024, nb * 32, 0, nullptr, 0, scr, lane); continue; } r -= IWO;
        if (r < IFI) { const int kb = r / 176, nb = r % 176; const int n0 = nb * 32; const int drow = (n0 < DFF) ? (n0 / 128) * 256 + (n0 % 128) : ((n0 - DFF) / 128) * 256 + 128 + ((n0 - DFF) % 128);
            tr_item(P.in[33] + (size_t)L * 1024 * 2 * DFF, 2 * DFF, kb * 64, n0, (bf16*)(ws + WS_WFI), 1024, drow, 0, nullptr, 0, scr, lane); continue; } r -= IFI;
        { const int kb = r / 32, nb = r % 32; tr_item(P.in[34] + (size_t)L * DFF * 1024, 1024, kb * 64, nb * 32, (bf16*)(ws + WS_WFO), DFF, nb * 32, 0, nullptr, 0, scr, lane); }
    }
}
__device__ __forceinline__ void s5_tables(const Ptrs& P, int L, int g, int part, LAS float* sm, int tid) {
    LAS float* apr = sm; LAS float* api = sm + 17 * 64; LAS float* bbr = sm + 2 * 17 * 64; LAS float* bbi = bbr + 1024; LAS float* Ks = bbi + 1024;
    const float* lre = P.in[3] + (size_t)L * 2048; const float* lim = P.in[4] + (size_t)L * 2048; const float* ldt = P.in[5] + L * 32;
    const float* bre = P.in[6] + (size_t)L * 32768; const float* bim = P.in[7] + (size_t)L * 32768; const float* cre = P.in[8] + (size_t)L * 32768; const float* cim = P.in[9] + (size_t)L * 32768;
    if (tid < 64) { const int p = tid; const float dt = __expf(ldt[g]); const float lr = lre[g * 64 + p], li = lim[g * 64 + p];
        for (int j = 0; j <= 16; ++j) { const double ang = (double)j * (double)li * (double)dt * 0.15915494309189535; const float rev = (float)(ang - __builtin_floor(ang));
            const float mg = __expf((float)j * lr * dt); apr[j * 64 + p] = mg * __builtin_amdgcn_cosf(rev); api[j * 64 + p] = mg * __builtin_amdgcn_sinf(rev); }
        const float ar = apr[64 + p], ai = api[64 + p], den = lr * lr + li * li, nr = ar - 1.f, kr = (nr * lr + ai * li) / den, ki = (ai * lr - nr * li) / den;
        for (int c = 0; c < 16; ++c) { const float br = bre[(g * 64 + p) * 16 + c], bi = bim[(g * 64 + p) * 16 + c]; bbr[p * 16 + c] = kr * br - ki * bi; bbi[p * 16 + c] = kr * bi + ki * br; } }
    __syncthreads();
    { const int j = tid >> 5, cl = tid & 31, cp = 2 * part + (cl >> 4), c = cl & 15; float s = 0.f;
        for (int p = 0; p < 64; ++p) { const float tr = apr[j * 64 + p] * bbr[p * 16 + c] - api[j * 64 + p] * bbi[p * 16 + c], ti = apr[j * 64 + p] * bbi[p * 16 + c] + api[j * 64 + p] * bbr[p * 16 + c];
            s += cre[(g * 16 + cp) * 64 + p] * tr - cim[(g * 16 + cp) * 64 + p] * ti; }
        Ks[j * 32 + cl] = s; }
    __syncthreads();
    bf16* Mt = (bf16*)(P.ws + WS_MT) + (size_t)g * 256 * 384; bf16* Pt = (bf16*)(P.ws + WS_PT) + (size_t)g * 128 * 256;
    for (int idx = tid; idx < 32 * 48; idx += NTHR) { const int rl = idx / 48, kg = idx % 48, t = rl >> 1, cpl = rl & 1, cp = 2 * part + cpl, n = t * 16 + cp; float v[8];
        if (kg < 32) { const int s = kg >> 1, c0 = (kg & 1) * 8;
#pragma unroll
            for (int i = 0; i < 8; ++i) v[i] = (s <= t) ? Ks[(t - s) * 32 + cpl * 16 + c0 + i] : 0.f; }
        else {
#pragma unroll
            for (int i = 0; i < 8; ++i) { const int jj = (kg - 32) * 8 + i, p = jj & 63; const float cr = cre[(g * 16 + cp) * 64 + p], ci = cim[(g * 16 + cp) * 64 + p], ar = apr[(t + 1) * 64 + p], ai = api[(t + 1) * 64 + p];
                v[i] = (jj < 64) ? (cr * ar - ci * ai) : -(cr * ai + ci * ar); } }
        *(v4u*)(Mt + (size_t)n * 384 + kg * 8) = pack8(v); }
    { const int jj = part * 16 + (tid >> 5), kg = tid & 31, p = jj & 63, s = kg >> 1, c0 = (kg & 1) * 8; float v[8];
        const float ar = apr[(15 - s) * 64 + p], ai = api[(15 - s) * 64 + p];
#pragma unroll
        for (int i = 0; i < 8; ++i) { const float br = bbr[p * 16 + c0 + i], bi = bbi[p * 16 + c0 + i]; v[i] = (jj < 64) ? (ar * br - ai * bi) : (ar * bi + ai * br); }
        *(v4u*)(Pt + (size_t)jj * 256 + kg * 8) = pack8(v); }
    __syncthreads();
}
__device__ __forceinline__ void s5_chunk_scan(const Ptrs& P, int L, int gidx) {
    const int p = gidx & 63, g = (gidx >> 6) & 31, b = gidx >> 11;
    const float dt = __expf(P.in[5][L * 32 + g]); const float lr = P.in[3][(size_t)L * 2048 + g * 64 + p], li = P.in[4][(size_t)L * 2048 + g * 64 + p];
    const double ang = 16.0 * (double)li * (double)dt * 0.15915494309189535; const float rev = (float)(ang - __builtin_floor(ang)); const float mg = __expf(16.f * lr * dt);
    const float ar = mg * __builtin_amdgcn_cosf(rev), ai = mg * __builtin_amdgcn_sinf(rev);
    bf16* base = (bf16*)(P.ws + WS_US) + (size_t)(g * 1024 + b * 256) * 384 + 256 + p;
    float xr = 0.f, xi = 0.f;
#pragma unroll 8
    for (int c = 0; c < 256; ++c) { bf16* q = base + (size_t)c * 384; const float sr = bf2f(q[0]), si = bf2f(q[64]); q[0] = (bf16)f2bf(xr); q[64] = (bf16)f2bf(xi);
        const float nr = ar * xr - ai * xi + sr, ni = ar * xi + ai * xr + si; xr = nr; xi = ni; }
}

typedef float f2p __attribute__((ext_vector_type(2)));
#define RDL(x, l) __builtin_bit_cast(float, __builtin_amdgcn_readlane(__builtin_bit_cast(int, (x)), (l)))
#define LORA2(acc, tA, tB, off, wptr) do { _Pragma("unroll") for (int j_ = 0; j_ < 32; ++j_) { const f2p s_ = {RDL(tA, j_ + (off)), RDL(tB, j_ + (off))}; \
        float w8_[8]; unpack8(*(const LAS v4u*)((wptr) + j_ * 512 + c0), w8_); \
        _Pragma("unroll") for (int i_ = 0; i_ < 8; ++i_) acc[i_] = __builtin_elementwise_fma((f2p){w8_[i_], w8_[i_]}, s_, acc[i_]); \
 } } while (0)
#define LORA2F(acc, tA, tB, off, wptr) do { _Pragma("unroll") for (int j_ = 0; j_ < 32; ++j_) { const f2p s_ = {RDL(tA, j_ + (off)), RDL(tB, j_ + (off))}; \
        float w8_[8]; unpack8(*(const LAS v4u*)((wptr) + j_ * 512 + c0), w8_); \
        _Pragma("unroll") for (int i_ = 0; i_ < 8; ++i_) acc[i_] = __builtin_elementwise_fma((f2p){w8_[i_], w8_[i_]}, s_, acc[i_]); \
        if ((j_ & 3) == 3) asm volatile("" ::: "memory"); } } while (0)
__device__ __forceinline__ void prep_phase(const Ptrs& P, int L, LAS unsigned char* lds, int gw, int NGW, int tid, int wave, int lane) {
    asm volatile("" : "+v"(tid), "+v"(lane)); asm volatile("" : "+s"(wave));
    unsigned char* ws = P.ws;
    LAS bf16* w2s = (LAS bf16*)lds; LAS bf16* a2s = w2s + 32 * 512; LAS bf16* v2s = a2s + 32 * 512; LAS unsigned* v1s = (LAS unsigned*)(v2s + 32 * 512);
    LAS unsigned* vrow = (LAS unsigned*)(lds + 131072) + wave * 512;
    const float* w2 = P.in[18] + (size_t)L * 32 * 512; const float* a2 = P.in[20] + (size_t)L * 32 * 512;
    for (int i = tid; i < 32 * 512; i += NTHR) { w2s[i] = (bf16)f2bf(w2[i]); a2s[i] = (bf16)f2bf(a2[i]); }
    if (L == 1) { const float* v2 = P.in[29]; const float* v1 = P.in[28];
        for (int i = tid; i < 32 * 512; i += NTHR) v2s[i] = (bf16)f2bf(v2[i]);
        for (int i = tid; i < 256 * 32; i += NTHR) { const int c2 = i >> 5, j = i & 31; v1s[i] = f2bf(v1[(2 * c2) * 32 + j]) | (f2bf(v1[(2 * c2 + 1) * 32 + j]) << 16); } }
    __syncthreads();
    const int c0 = lane * 8;
    float qg[8], kg[8], w0r[8], a0r[8], v0r[8];
#pragma unroll
    for (int i = 0; i < 8; ++i) { qg[i] = P.in[12][L * 128 + ((c0 + i) & 127)] * C2Q; kg[i] = P.in[13][L * 128 + ((c0 + i) & 127)]; w0r[i] = P.in[17][L * 512 + c0 + i]; a0r[i] = P.in[19][L * 512 + c0 + i]; v0r[i] = (L == 1) ? P.in[27][c0 + i] : 0.f; }
    for (int pr = gw; pr < M / 2; pr += NGW) {
        const size_t m0 = (size_t)pr * 2;
        float tz[2];
#pragma unroll
        for (int t = 0; t < 2; ++t) {
            const size_t m = m0 + t;
            bf16* qp = (bf16*)(ws + WS_QB) + m * 512 + c0; bf16* kp = (bf16*)(ws + WS_KB) + m * 512 + c0;
            float q[8], k[8]; unpack8(*(const v4u*)qp, q); unpack8(*(const v4u*)kp, k);
            float sq = 0.f, sk = 0.f;
#pragma unroll
            for (int i = 0; i < 8; ++i) { sq += q[i] * q[i]; sk += k[i] * k[i]; }
            sq += __shfl_xor(sq, 1); sq += __shfl_xor(sq, 2); sq += __shfl_xor(sq, 4); sk += __shfl_xor(sk, 1); sk += __shfl_xor(sk, 2); sk += __shfl_xor(sk, 4);
            const float rq = 1.f / sqrtf(sq * (1.f / 64.f) + 1e-6f), rk = 1.f / sqrtf(sk * (1.f / 64.f) + 1e-6f);
#pragma unroll
            for (int i = 0; i < 8; ++i) { q[i] *= rq * qg[i]; k[i] *= rk * kg[i]; }
            *(v4u*)qp = pack8(q); *(v4u*)kp = pack8(k);
            const float zz = bf2f(((const bf16*)(ws + WS_Z))[m * ZP + 1536 + lane]);
            tz[t] = (lane < 32) ? tanh_f(zz) : zz;
        }
        f2p aw[8], aa[8];
#pragma unroll
        for (int i = 0; i < 8; ++i) { aw[i] = (f2p){w0r[i], w0r[i]}; aa[i] = (f2p){a0r[i], a0r[i]}; }
        LORA2(aw, tz[0], tz[1], 0, w2s);
        LORA2(aa, tz[0], tz[1], 32, a2s);
#pragma unroll
        for (int t = 0; t < 2; ++t) { float e8[8], a8[8];
#pragma unroll
            for (int i = 0; i < 8; ++i) { e8[i] = 0.6065306597f * sigm(t ? aw[i].y : aw[i].x); a8[i] = sigm(t ? aa[i].y : aa[i].x); }
            *(v4u*)((bf16*)(ws + WS_E) + (m0 + t) * 512 + c0) = pack8(e8); *(v4u*)((bf16*)(ws + WS_AB) + (m0 + t) * 512 + c0) = pack8(a8); }
        bf16* zr0 = (bf16*)(ws + WS_Z) + m0 * ZP; bf16* zr1 = zr0 + ZP;
        const v4u vA = *(const v4u*)(zr0 + 1024 + c0), vB = *(const v4u*)(zr1 + 1024 + c0);
        if (L == 0) { *(v4u*)((bf16*)(ws + WS_VF) + m0 * 512 + c0) = vA; *(v4u*)((bf16*)(ws + WS_VF) + (m0 + 1) * 512 + c0) = vB; }
        else {
            *(LAS v4u*)(vrow + c0) = (v4u){(vA.x & 0xffffu) | (vB.x << 16), (vA.x >> 16) | (vB.x & 0xffff0000u), (vA.y & 0xffffu) | (vB.y << 16), (vA.y >> 16) | (vB.y & 0xffff0000u)};
            *(LAS v4u*)(vrow + c0 + 4) = (v4u){(vA.z & 0xffffu) | (vB.z << 16), (vA.z >> 16) | (vB.z & 0xffff0000u), (vA.w & 0xffffu) | (vB.w << 16), (vA.w >> 16) | (vB.w & 0xffff0000u)};
            asm volatile("s_waitcnt lgkmcnt(0)" ::: "memory");
            const int j = lane & 31, hf = lane >> 5; f2p s = {0.f, 0.f};
#pragma unroll 8
            for (int c2 = 0; c2 < 128; ++c2) { const unsigned pk = v1s[(hf * 128 + c2) * 32 + j]; const v2u d = *(const LAS v2u*)(vrow + hf * 256 + 2 * c2);
                const float wl = __uint_as_float(pk << 16), wh = __uint_as_float(pk & 0xffff0000u);
                s = __builtin_elementwise_fma((f2p){__uint_as_float(d.x << 16), __uint_as_float(d.x & 0xffff0000u)}, (f2p){wl, wl}, s);
                s = __builtin_elementwise_fma((f2p){__uint_as_float(d.y << 16), __uint_as_float(d.y & 0xffff0000u)}, (f2p){wh, wh}, s); }
            float sx = s.x + __shfl_xor(s.x, 32), sy = s.y + __shfl_xor(s.y, 32);
            f2p am[8];
#pragma unroll
            for (int i = 0; i < 8; ++i) am[i] = (f2p){v0r[i], v0r[i]};
            LORA2(am, sx, sy, 0, v2s);
            float va[8], vb[8], fa[8], fb[8]; unpack8(vA, va); unpack8(vB, vb);
            unpack8(*(const v4u*)((const bf16*)(ws + WS_VF) + m0 * 512 + c0), fa); unpack8(*(const v4u*)((const bf16*)(ws + WS_VF) + (m0 + 1) * 512 + c0), fb);
#pragma unroll
            for (int i = 0; i < 8; ++i) { va[i] = va[i] + (fa[i] - va[i]) * sigm(am[i].x); vb[i] = vb[i] + (fb[i] - vb[i]) * sigm(am[i].y); }
            *(v4u*)(zr0 + 1024 + c0) = pack8(va); *(v4u*)(zr1 + 1024 + c0) = pack8(vb);
            asm volatile("s_waitcnt lgkmcnt(0)" ::: "memory"); }
    }
    __syncthreads();
}

__device__ __forceinline__ void rwkv_unit(const Ptrs& P, int L, LAS unsigned char* lds, int b, int h, int qr, int tid, int wave, int lane) {
    constexpr int T = 32, TOKF = 336;
    asm volatile("" : "+v"(tid), "+v"(lane)); asm volatile("" : "+s"(wave));
    unsigned char* ws = P.ws;
    const bf16* Z = (const bf16*)(ws + WS_Z); const bf16* AB = (const bf16*)(ws + WS_AB); const bf16* EB = (const bf16*)(ws + WS_E); bf16* YC = (bf16*)(ws + WS_YA);
    LAS float* buf0 = (LAS float*)lds; LAS float* buf1 = buf0 + T * TOKF;
    const bool producer = wave >= 4;
    const int pt = tid - 256, tok = pt >> 3, ks = (pt & 7) * 8;
    float kkk[8], kka[8];
    if (producer) {
#pragma unroll
        for (int i = 0; i < 8; ++i) { kkk[i] = P.in[22][L * 512 + h * 64 + ks + i]; kka[i] = P.in[23][L * 512 + h * 64 + ks + i]; } }
    const int row = wave * 4 + (lane >> 4), kq = lane & 15;
    typedef float f2s __attribute__((ext_vector_type(2)));
    f2s Slo = {0.f, 0.f}, Shi = {0.f, 0.f};
    const size_t m00 = (size_t)b * SEQ;
#define RW_PRODUCE(c, buf) do { const size_t m_ = m00 + (size_t)(c) * T + tok; const bf16* zr_ = Z + m_ * ZP; \
        float r_[8], k_[8], a_[8], e_[8]; unpack8(*(const v4u*)(zr_ + h * 64 + ks), r_); unpack8(*(const v4u*)(zr_ + 512 + h * 64 + ks), k_); \
        unpack8(*(const v4u*)(AB + m_ * 512 + h * 64 + ks), a_); unpack8(*(const v4u*)(EB + m_ * 512 + h * 64 + ks), e_); \
        float kk_[8], ss_ = 0.f; _Pragma("unroll") for (int i = 0; i < 8; ++i) { kk_[i] = k_[i] * kkk[i]; ss_ += kk_[i] * kk_[i]; } \
        ss_ += __shfl_xor(ss_, 1); ss_ += __shfl_xor(ss_, 2); ss_ += __shfl_xor(ss_, 4); const float inv_ = 1.f / fmaxf(sqrtf(ss_), 1e-12f); \
        LAS float* d_ = (buf) + tok * TOKF + ks; f32x4 o0, o1; \
        o0 = (f32x4){-kk_[0] * inv_, -kk_[1] * inv_, -kk_[2] * inv_, -kk_[3] * inv_}; o1 = (f32x4){-kk_[4] * inv_, -kk_[5] * inv_, -kk_[6] * inv_, -kk_[7] * inv_}; *(LAS f32x4*)(d_) = o0; *(LAS f32x4*)(d_ + 4) = o1; \
        o0 = (f32x4){kk_[0] * inv_ * a_[0], kk_[1] * inv_ * a_[1], kk_[2] * inv_ * a_[2], kk_[3] * inv_ * a_[3]}; o1 = (f32x4){kk_[4] * inv_ * a_[4], kk_[5] * inv_ * a_[5], kk_[6] * inv_ * a_[6], kk_[7] * inv_ * a_[7]}; *(LAS f32x4*)(d_ + 64) = o0; *(LAS f32x4*)(d_ + 68) = o1; \
        o0 = (f32x4){__expf(-e_[0]), __expf(-e_[1]), __expf(-e_[2]), __expf(-e_[3])}; o1 = (f32x4){__expf(-e_[4]), __expf(-e_[5]), __expf(-e_[6]), __expf(-e_[7])}; *(LAS f32x4*)(d_ + 128) = o0; *(LAS f32x4*)(d_ + 132) = o1; \
        o0 = (f32x4){k_[0] * (1.f + (a_[0] - 1.f) * kka[0]), k_[1] * (1.f + (a_[1] - 1.f) * kka[1]), k_[2] * (1.f + (a_[2] - 1.f) * kka[2]), k_[3] * (1.f + (a_[3] - 1.f) * kka[3])}; \
        o1 = (f32x4){k_[4] * (1.f + (a_[4] - 1.f) * kka[4]), k_[5] * (1.f + (a_[5] - 1.f) * kka[5]), k_[6] * (1.f + (a_[6] - 1.f) * kka[6]), k_[7] * (1.f + (a_[7] - 1.f) * kka[7])}; *(LAS f32x4*)(d_ + 192) = o0; *(LAS f32x4*)(d_ + 196) = o1; \
        o0 = (f32x4){r_[0], r_[1], r_[2], r_[3]}; o1 = (f32x4){r_[4], r_[5], r_[6], r_[7]}; *(LAS f32x4*)(d_ + 256) = o0; *(LAS f32x4*)(d_ + 260) = o1; \
        if ((pt & 7) < 2) { float v_[8]; unpack8(*(const v4u*)(zr_ + 1024 + h * 64 + qr * 16 + ks), v_); LAS float* dv_ = (buf) + tok * TOKF + 320 + ks; \
            *(LAS f32x4*)(dv_) = (f32x4){v_[0], v_[1], v_[2], v_[3]}; *(LAS f32x4*)(dv_ + 4) = (f32x4){v_[4], v_[5], v_[6], v_[7]}; } } while (0)
    if (producer) RW_PRODUCE(0, buf0);
    __syncthreads();
    if (!producer) __builtin_amdgcn_s_setprio(3);
    for (int c = 0; c < SEQ / T; ++c) {
        LAS float* cur = (c & 1) ? buf1 : buf0; LAS float* nxt = (c & 1) ? buf0 : buf1;
        if (producer) { if (c + 1 < SEQ / T) RW_PRODUCE(c + 1, nxt); }
        else {
            typedef float f2 __attribute__((ext_vector_type(2)));
            bf16* yo = YC + (m00 + (size_t)c * T) * 512 + h * 64 + qr * 16 + row;
            const LAS float* bs = cur + kq * 4; const LAS float* vs = cur + 320 + row;
            f32x4 a4 = *(const LAS f32x4*)(bs), b4 = *(const LAS f32x4*)(bs + 64), w4 = *(const LAS f32x4*)(bs + 128), k4 = *(const LAS f32x4*)(bs + 192), r4 = *(const LAS f32x4*)(bs + 256);
            float vv = vs[0]; float yp = 0.f, ykeep = 0.f;
#pragma unroll
            for (int t = 0; t < T; ++t) {
                const LAS float* nb = bs + (t + 1) * TOKF;
                const f32x4 na4 = *(const LAS f32x4*)(nb), nb4 = *(const LAS f32x4*)(nb + 64), nw4 = *(const LAS f32x4*)(nb + 128), nk4 = *(const LAS f32x4*)(nb + 192), nr4 = *(const LAS f32x4*)(nb + 256);
                const float nvv = vs[(t + 1) * TOKF];
                f2 p = Slo * (f2){a4.x, a4.y}; p = __builtin_elementwise_fma(Shi, (f2){a4.z, a4.w}, p);
                float sa = p.x + p.y;
                sa = DPP_ADD(sa, 0xB1); yp = DPP_ADD(yp, 0xB1); sa = DPP_ADD(sa, 0x4E); yp = DPP_ADD(yp, 0x4E); sa = DPP_ADD(sa, 0x141); yp = DPP_ADD(yp, 0x141); sa = DPP_ADD(sa, 0x140); yp = DPP_ADD(yp, 0x140);
                if (t > 0) ykeep = __builtin_bit_cast(float, __builtin_amdgcn_update_dpp(__builtin_bit_cast(int, yp), __builtin_bit_cast(int, ykeep), 0x111, 0xf, 0xf, false));
                if (t == 16) yo[(size_t)(15 - kq) * 512] = (bf16)f2bf(ykeep);
                const f2 sa2 = {sa, sa}, vv2 = {vv, vv};
                f2 tl = (f2){k4.x, k4.y} * vv2, th = (f2){k4.z, k4.w} * vv2;
                tl = __builtin_elementwise_fma((f2){b4.x, b4.y}, sa2, tl); th = __builtin_elementwise_fma((f2){b4.z, b4.w}, sa2, th);
                Slo = __builtin_elementwise_fma(Slo, (f2){w4.x, w4.y}, tl); Shi = __builtin_elementwise_fma(Shi, (f2){w4.z, w4.w}, th);
                f2 q = Slo * (f2){r4.x, r4.y}; q = __builtin_elementwise_fma(Shi, (f2){r4.z, r4.w}, q);
                yp = q.x + q.y;
                a4 = na4; b4 = nb4; w4 = nw4; k4 = nk4; r4 = nr4; vv = nvv; }
            yp = row16_sum(yp);
            ykeep = __builtin_bit_cast(float, __builtin_amdgcn_update_dpp(__builtin_bit_cast(int, yp), __builtin_bit_cast(int, ykeep), 0x111, 0xf, 0xf, false));
            yo[(size_t)(31 - kq) * 512] = (bf16)f2bf(ykeep);
        }
        __syncthreads();
    }
    __builtin_amdgcn_s_setprio(0);
#undef RW_PRODUCE
}

__device__ __forceinline__ void post_phase(const Ptrs& P, int L, LAS unsigned char* lds, int gw, int NGW, int tid, int wave, int lane) {
    asm volatile("" : "+v"(tid), "+v"(lane)); asm volatile("" : "+s"(wave));
    unsigned char* ws = P.ws;
    LAS bf16* g2s = (LAS bf16*)lds;
    const float* g2 = P.in[21] + (size_t)L * 96 * 512;
    for (int i = tid; i < 96 * 512; i += NTHR) g2s[i] = (bf16)f2bf(g2[i]);
    __syncthreads();
    const float lam_init = (L == 0) ? 0.2f : 0.35550906f;
    const float* lv = P.in[14] + L * 256;
    const float lam = __expf(wave_sum(lv[lane] * lv[64 + lane])) - __expf(wave_sum(lv[128 + lane] * lv[192 + lane])) + lam_init;
    const int c0 = lane * 8;
    float sg[8], lng[8], lnb[8], rk[8], ka[8];
#pragma unroll
    for (int i = 0; i < 8; ++i) { sg[i] = P.in[15][L * 128 + ((c0 + i) & 127)] * (1.f - lam_init); lng[i] = P.in[25][L * 512 + c0 + i]; lnb[i] = P.in[26][L * 512 + c0 + i]; rk[i] = P.in[24][L * 512 + c0 + i]; ka[i] = P.in[23][L * 512 + c0 + i]; }
    const float* xsrc = (L == 0) ? P.in[0] : P.out;
    for (int pr = gw; pr < M / 2; pr += NGW) {
        const size_t m0 = (size_t)pr * 2;
        float z0[2], z1[2], z2[2];
#pragma unroll
        for (int t = 0; t < 2; ++t) { const bf16* zr = (const bf16*)(ws + WS_Z) + (m0 + t) * ZP;
            z0[t] = sigm(bf2f(zr[1600 + (lane & 31)])); z1[t] = sigm(bf2f(zr[1632 + (lane & 31)])); z2[t] = sigm(bf2f(zr[1664 + (lane & 31)])); }
        f2p gacc[8];
#pragma unroll
        for (int i = 0; i < 8; ++i) gacc[i] = (f2p){0.f, 0.f};
        LORA2F(gacc, z0[0], z0[1], 0, g2s);
        LORA2F(gacc, z1[0], z1[1], 0, g2s + 32 * 512);
        LORA2F(gacc, z2[0], z2[1], 0, g2s + 64 * 512);
#pragma unroll
        for (int t = 0; t < 2; ++t) {
        const size_t m = m0 + t;
        bf16* zr = (bf16*)(ws + WS_Z) + m * ZP;
        float r[8], k[8], v[8], a[8], yr[8];
        unpack8(*(const v4u*)(zr + c0), r); unpack8(*(const v4u*)(zr + 512 + c0), k); unpack8(*(const v4u*)(zr + 1024 + c0), v);
        unpack8(*(const v4u*)((const bf16*)(ws + WS_AB) + m * 512 + c0), a); unpack8(*(const v4u*)((const bf16*)(ws + WS_YA) + m * 512 + c0), yr);
        float s1 = 0.f;
#pragma unroll
        for (int i = 0; i < 8; ++i) s1 += yr[i];
        s1 += __shfl_xor(s1, 1); s1 += __shfl_xor(s1, 2); s1 += __shfl_xor(s1, 4); const float mean = s1 * (1.f / 64.f);
        float s2 = 0.f, bd = 0.f;
#pragma unroll
        for (int i = 0; i < 8; ++i) { const float d = yr[i] - mean; s2 += d * d; bd += r[i] * (k[i] * (1.f + (a[i] - 1.f) * ka[i])) * rk[i]; }
        s2 += __shfl_xor(s2, 1); s2 += __shfl_xor(s2, 2); s2 += __shfl_xor(s2, 4); bd += __shfl_xor(bd, 1); bd += __shfl_xor(bd, 2); bd += __shfl_xor(bd, 4);
        const float rstd = 1.f / sqrtf(s2 * (1.f / 64.f) + 64e-5f);
        float yc[8];
#pragma unroll
        for (int i = 0; i < 8; ++i) yc[i] = ((yr[i] - mean) * rstd * lng[i] + lnb[i] + bd * v[i]) * (t ? gacc[i].y : gacc[i].x);
        const int hd = lane >> 4, j0 = (lane & 15) * 8; const bf16* orow = (const bf16*)(ws + WS_O) + m * 1024 + hd * 256 + j0;
        float o0[8], o1[8]; unpack8(*(const v4u*)orow, o0); unpack8(*(const v4u*)(orow + 128), o1);
        float so = 0.f;
#pragma unroll
        for (int i = 0; i < 8; ++i) { o0[i] = o0[i] - lam * o1[i]; so += o0[i] * o0[i]; }
        so += __shfl_xor(so, 1); so += __shfl_xor(so, 2); so += __shfl_xor(so, 4); so += __shfl_xor(so, 8);
        const float ro = 1.f / sqrtf(so * (1.f / 128.f) + 1e-5f);
#pragma unroll
        for (int i = 0; i < 8; ++i) o0[i] *= ro * sg[i];
        *(v4u*)(zr + c0) = pack8(yc); *(v4u*)(zr + 512 + c0) = pack8(o0);
        }
    }
    __syncthreads();
}


__device__ __forceinline__ void dump_stage(const Ptrs& P, int k, int blk, int G, int tid) {
    unsigned char* ws = P.ws; float* out = P.out;
    for (size_t i = (size_t)blk * NTHR + tid; i < (size_t)M * 1024; i += (size_t)G * NTHR) {
        const size_t m = i >> 10; const int c = (int)(i & 1023); float v = 0.f;
        const bf16* Z = (const bf16*)(ws + WS_Z); const bf16* US = (const bf16*)(ws + WS_US);
        if (k == 1) v = bf2f(Z[m * ZP + c]) + bf2f(Z[m * ZP + 704 + c]) + bf2f(((const bf16*)(ws + WS_QB))[m * 512 + (c & 511)]) + bf2f(((const bf16*)(ws + WS_KB))[m * 512 + (c & 511)]) + bf2f(((const bf16*)(ws + WS_VB))[m * 512 + (c & 511)]) + bf2f(US[m * 768 + (c % 768)]);
        else if (k == 2) {
#if !defined(DSEL) || DSEL==1
            v += bf2f(US[m * 768 + (c % 768)]);
#endif
#if !defined(DSEL) || DSEL==2
            v += bf2f(((const bf16*)(ws + WS_E))[m * 512 + (c & 511)]) + bf2f(((const bf16*)(ws + WS_AB))[m * 512 + (c & 511)]);
#endif
#if !defined(DSEL) || DSEL==3
            v += bf2f(((const bf16*)(ws + WS_QB))[m * 512 + (c & 511)]) + bf2f(((const bf16*)(ws + WS_KB))[m * 512 + (c & 511)]);
#endif
#if !defined(DSEL) || DSEL==4
            v += bf2f(Z[m * ZP + 1024 + (c & 511)]) + bf2f(((const bf16*)(ws + WS_VF))[m * 512 + (c & 511)]);
#endif
        }
        else if (k == 3) v = bf2f(((const bf16*)(ws + WS_O))[m * 1024 + c]) + bf2f(((const bf16*)(ws + WS_YA))[m * 512 + (c & 511)]) + bf2f(US[m * 768 + (c % 768)]);
        else if (k == 4) v = bf2f(Z[m * ZP + c]) + bf2f(((const bf16*)(ws + WS_XN))[m * 1024 + c]) + bf2f(((const bf16*)(ws + WS_YL))[m * 512 + (c & 511)]);
        else if (k == 5) v = bf2f(((const bf16*)(ws + WS_YA))[m * 512 + (c & 511)]);
        else if (k == 6) v = bf2f(((const bf16*)(ws + WS_P12))[m * 1024 + c]);
        else if (k == 9) v = bf2f(((const bf16*)(ws + WS_HID))[m * DFF + c]) + bf2f(((const bf16*)(ws + WS_HID))[m * DFF + 1024 + c]) + bf2f(((const bf16*)(ws + WS_H2N))[m * 1024 + c]);
        out[i] = v;
    }
}
#define XB_TMO      128
#define XB_XCNT(j)  (256  + 64 * (j))
#define XB_XSUB(j)  (1280 + 64 * (j))
#define XB_XGEN(j)  (2304 + 64 * (j))
#define XB_TOP      3328
#define XB_TOPGEN   3392
#define XCD_BAR_WORDS 3456
#define XB_SPIN_CAP (1u << 18)

__device__ __forceinline__ unsigned xb_ld(unsigned* p)              { return __hip_atomic_load(p, __ATOMIC_RELAXED, __HIP_MEMORY_SCOPE_AGENT); }
__device__ __forceinline__ unsigned xb_add(unsigned* p, unsigned v) { return __hip_atomic_fetch_add(p, v, __ATOMIC_RELAXED, __HIP_MEMORY_SCOPE_AGENT); }
__device__ __forceinline__ unsigned xb_xcc_id() { return (unsigned)__builtin_amdgcn_s_getreg((3 << 11) | 20) & 0xFu; }
#define XB_SPIN(cond, bar) do { unsigned _sp = 0; while (cond) { __builtin_amdgcn_s_sleep(1); \
    if ((++_sp & 255u) == 0u) { if (xb_ld(&(bar)[XB_TMO])) break; if (_sp > XB_SPIN_CAP) { atomicAdd(&(bar)[XB_TMO], 1u); break; } } } } while (0)

struct XcdBarrier {
    unsigned* bar; unsigned x;
    volatile LAS unsigned* st;
};

__device__ __forceinline__ XcdBarrier xcd_barrier_post(unsigned* bar, volatile LAS unsigned* st) {
    XcdBarrier b; b.bar = bar; b.x = xb_xcc_id(); b.st = st;
    if (threadIdx.x == 0) (void)xb_add(&bar[XB_XCNT(b.x)], 1u);
    return b;
}
__device__ __forceinline__ void xcd_barrier_complete(unsigned* bar, unsigned x, unsigned& nloc, unsigned& nx) {
    const unsigned G = gridDim.x * gridDim.y * gridDim.z;
    unsigned sum, cnt, mine, sp = 0u;
    for (;;) {
        sum = 0u; cnt = 0u; mine = 0u;
#pragma unroll
        for (unsigned j = 0; j < 16; ++j) { const unsigned c = xb_ld(&bar[XB_XCNT(j)]); sum += c; cnt += (c > 0u) ? 1u : 0u; mine = (j == x) ? c : mine; }
        if (sum == G) break;
        __builtin_amdgcn_s_sleep(1);
        if ((++sp & 255u) == 0u) { if (xb_ld(&bar[XB_TMO])) break; if (sp > XB_SPIN_CAP) { atomicAdd(&bar[XB_TMO], 1u); break; } }
    }
    nloc = mine > 0u ? mine : 1u; nx = cnt > 0u ? cnt : 1u;
}

__device__ __forceinline__ void xcd_barrier(const XcdBarrier& b, const int tid_hint) {
    asm volatile("s_waitcnt vmcnt(0)" ::: "memory");
    __syncthreads();
    if (tid_hint == 0) {
        unsigned* bar = b.bar;
        __builtin_amdgcn_s_waitcnt(0);
        unsigned nloc = b.st[0], nx = b.st[1];
        if (nloc == 0u) { xcd_barrier_complete(bar, b.x, nloc, nx); b.st[0] = nloc; b.st[1] = nx; }
        const unsigned old = xb_add(&bar[XB_XSUB(b.x)], 1u);
        const unsigned gen = old / nloc;
        if (old + 1u == (gen + 1u) * nloc) {
            __builtin_amdgcn_fence(__ATOMIC_RELEASE, "agent");
            asm volatile("s_waitcnt vmcnt(0)" ::: "memory");
            const unsigned og = xb_add(&bar[XB_TOP], 1u);
            const unsigned tg = og / nx;
            if (og + 1u == (tg + 1u) * nx) xb_add(&bar[XB_TOPGEN], 1u);
            else XB_SPIN(xb_ld(&bar[XB_TOPGEN]) == tg, bar);
            __builtin_amdgcn_fence(__ATOMIC_ACQUIRE, "agent");
            xb_add(&bar[XB_XGEN(b.x)], 1u);
            asm volatile("s_waitcnt vmcnt(0)" ::: "memory");
        } else {
            XB_SPIN(xb_ld(&bar[XB_XGEN(b.x)]) == gen, bar);
            __builtin_amdgcn_fence(__ATOMIC_ACQUIRE, "agent");
            asm volatile("s_waitcnt vmcnt(0)" ::: "memory");
        }
    }
    __syncthreads();
}


#define GSYNC() do { xcd_barrier(xbar, tid); } while (0)
#if defined(PROBE_A)
#define STAMP(k) do { if (blk0 == 0 && tid0 == 0) ((LAS unsigned long long*)(lds + LDS_XB + 256))[(k)] = __builtin_amdgcn_s_memrealtime(); } while (0)
#else
#define STAMP(k) do { } while (0)
#endif
struct Args { Ptrs p; int pad0, pad1; };
__global__ void __launch_bounds__(NTHR, 2) mega_fwd(Args args) {
    extern __shared__ __attribute__((aligned(16))) unsigned char lds_raw[];
    LAS unsigned char* lds = (LAS unsigned char*)lds_raw;
    cg::grid_group grid = cg::this_grid();
    const Ptrs& P = args.p;
    unsigned char* ws = P.ws;
    const int tid0 = threadIdx.x, wave0 = __builtin_amdgcn_readfirstlane(tid0 >> 6);
    const int wave = wave0;
    const int G0 = gridDim.x, blk0 = blockIdx.x;
    const int gw0 = blk0 * NWAVES + wave, NGW0 = G0 * NWAVES;
    unsigned* ctl = (unsigned*)(ws + WS_CTL);
    if (tid0 < 64) ((LAS unsigned*)(lds + LDS_XB))[tid0] = 0u;
    __syncthreads();
    if (tid0 < 64) __hip_atomic_store(ctl + blk0 * 64 + tid0, 0u, __ATOMIC_RELAXED, __HIP_MEMORY_SCOPE_AGENT);
    __threadfence();
    grid.sync();
    XcdBarrier xbar = xcd_barrier_post(ctl + CW_BAR, (volatile LAS unsigned*)(lds + LDS_XB));
    for (int L = 0; L < 2; ++L) {
        int gw = gw0, NGW = NGW0, blk = blk0, G = G0; asm volatile("" : "+s"(gw), "+s"(NGW), "+s"(blk), "+s"(G));
        int tid = wave * 64 + (int)__builtin_amdgcn_mbcnt_hi(~0u, __builtin_amdgcn_mbcnt_lo(~0u, 0u)); asm volatile("" : "+v"(tid)); int lane = tid & 63;
#define RELAUNDER() do { tid = wave * 64 + (int)__builtin_amdgcn_mbcnt_hi(~0u, __builtin_amdgcn_mbcnt_lo(~0u, 0u)); asm volatile("" : "+v"(tid)); lane = tid & 63; asm volatile("" : "+s"(gw), "+s"(NGW), "+s"(blk), "+s"(G)); } while (0)
        STAMP(13 * L);
        const float* xsrc = (L == 0) ? P.in[0] : P.out;
#if !defined(ONLY) || ONLY==0
#if defined(DUP_PH0)
        for (int rep = 0; rep < 2; ++rep)
#endif
        {
        s5_tables(P, L, blk >> 3, blk & 7, (LAS float*)lds, tid);
        if (L == 0) weight_items(P, L, gw, NGW, (LAS float*)(lds + wave * 16384), lane, 0, 4128);
        weight_items(P, L, gw, NGW, (LAS float*)(lds + wave * 16384), lane, 6944, 8352);
        for (int i = blk * NTHR + tid; i < 96 * 2048 / 8; i += G * NTHR) ((v4u*)((bf16*)(ws + WS_W1B) + (size_t)1696 * 2048))[i] = (v4u){0u, 0u, 0u, 0u};
        if (blk < 4) { for (int i = tid; i < 128; i += NTHR) ((v4u*)((bf16*)(ws + WS_XNP) + (size_t)blk * 4097 * 1024))[i] = (v4u){0u, 0u, 0u, 0u}; }
        for (int m = gw; m < M; m += NGW) rms_row(xsrc + (size_t)m * 1024, P.in[1] + L * 1024, (bf16*)(ws + WS_XNP) + ((size_t)(m >> 12) * 4097 + 1 + (m & 4095)) * 1024, lane);
        }
        GSYNC(); RELAUNDER(); STAMP(1 + 13 * L);
#endif
#if !defined(ONLY) || ONLY==1
#if defined(DUP_PH1)
        for (int rep = 0; rep < 2; ++rep)
#endif
        {
        { pg8::Gemm g = mkgemm((const bf16*)(ws + WS_XNP) + 1024, (const bf16*)(ws + WS_W1A), M, 2048, 1024, 1024, 1024); g.a_skip_shift = 4; g.a_skip_bytes = 2048;
          Epi8<1> E{(bf16*)(ws + WS_QB), 512, (const bf16*)(ws + WS_US), nullptr};
#if !defined(SUB) || SUB==0
          run_gemm(lds, g, E, G, blk);
#endif
          }
        { pg8::Gemm g = mkgemm((const bf16*)(ws + WS_XNP) + 1024, (const bf16*)(ws + WS_W1B), M, 1792, 2048, 1024, 2048); g.a_skip_shift = 4; g.a_skip_bytes = 2048; g.kwrap = 16; g.wrap_bytes = 4096;
          Epi8<0> E{(bf16*)(ws + WS_Z), ZP, nullptr, nullptr};
#if !defined(SUB) || SUB==1
          run_gemm(lds, g, E, G, blk);
#endif
          }
        if (blk >= 192) { __syncthreads(); weight_items(P, L, (blk - 192) * NWAVES + wave, 64 * NWAVES, (LAS float*)(lds + wave * 16384), lane, 4128, 6944); }
        }
        GSYNC(); RELAUNDER(); STAMP(2 + 13 * L);
#if defined(STOP_AFTER) && STOP_AFTER==1
        dump_stage(P, 1, blk, G, tid); return;
#endif
#endif
#if !defined(ONLY) || ONLY==2
        { pg8::Gemm g = mkgemm((const bf16*)(ws + WS_US), (const bf16*)(ws + WS_PT), 32768, 256, 256, 384, 256); g.b_shift = 2; g.b_stride_bytes = 128 * 256 * 2;
          Epi8<2> E{(bf16*)(ws + WS_US), 384, nullptr, nullptr}; run_gemm(lds, g, E, G, blk);
#if defined(DUP_S5G)
          run_gemm(lds, g, E, G, blk);
#endif
          }
        __syncthreads();
        prep_phase(P, L, lds, gw, NGW, tid, wave, lane);
        GSYNC(); RELAUNDER(); STAMP(3 + 13 * L);
#if defined(STOP_AFTER) && STOP_AFTER==2
        dump_stage(P, 2, blk, G, tid); return;
#endif
#endif
#if !defined(ONLY) || ONLY==3
        if (blk < 128) rwkv_unit(P, L, lds, blk >> 5, (blk >> 2) & 7, blk & 3, tid, wave, lane);
#if defined(DUP_RWKV)
        if (blk < 128) rwkv_unit(P, L, lds, blk >> 5, (blk >> 2) & 7, blk & 3, tid, wave, lane);
#endif
        else if (blk >= G - 16) s5_chunk_scan(P, L, (blk - (G - 16)) * NTHR + tid);
        __syncthreads();
        {
            volatile LAS unsigned* qslot = (volatile LAS unsigned*)(lds + 140000);
            for (;;) {
                if (tid == 0) qslot[0] = atomicAdd(ctl + 64 * L, 1u);
                __syncthreads();
                const unsigned uidx = qslot[0];
                __syncthreads();
                if (uidx >= 1024u) break;
                const int qb = 15 - (int)(uidx >> 6), bhv = uidx & 63, b = bhv >> 4, hv = bhv & 15, hh = hv >> 2, cc = (hv >> 1) & 1, half = hv & 1;
                attn_body::attn_unit<8>(b, (2 * hh + cc) * 64, (2 * hh + cc) * 64, (2 * hh + half) * 64, hv * 64, qb,
                    (const attn_body::bf16*)(ws + WS_QB), (const attn_body::bf16*)(ws + WS_KB), (const attn_body::bf16*)(ws + WS_VB), (attn_body::bf16*)(ws + WS_O), (char*)lds_raw, wave);
#if defined(DUP_ATT)
                attn_body::attn_unit<8>(b, (2 * hh + cc) * 64, (2 * hh + cc) * 64, (2 * hh + half) * 64, hv * 64, qb,
                    (const attn_body::bf16*)(ws + WS_QB), (const attn_body::bf16*)(ws + WS_KB), (const attn_body::bf16*)(ws + WS_VB), (attn_body::bf16*)(ws + WS_O), (char*)lds_raw, wave);
#endif
            }
        }
        GSYNC(); RELAUNDER(); STAMP(4 + 13 * L);
#if defined(STOP_AFTER) && STOP_AFTER==3
        dump_stage(P, 3, blk, G, tid); return;
#endif
#endif
#if !defined(ONLY) || ONLY==4
        { pg8::Gemm g = mkgemm((const bf16*)(ws + WS_US), (const bf16*)(ws + WS_MT), 32768, 256, 384, 384, 384); g.b_shift = 2; g.b_stride_bytes = 256 * 384 * 2;
          Epi8<3> E{(bf16*)(ws + WS_YL), 512, (const bf16*)(ws + WS_US), P.in[10] + L * 512}; run_gemm(lds, g, E, G, blk);
#if defined(DUP_S5G)
          run_gemm(lds, g, E, G, blk);
#endif
          }
        __syncthreads();
        post_phase(P, L, lds, gw, NGW, tid, wave, lane);
        GSYNC(); RELAUNDER(); STAMP(5 + 13 * L);
#if defined(STOP_AFTER) && STOP_AFTER==4
        dump_stage(P, 4, blk, G, tid); return;
#endif
#endif
#if !defined(ONLY) || ONLY==5
        { pg8::Gemm g = mkgemm((const bf16*)(ws + WS_YL), (const bf16*)(ws + WS_WGLU), M, 512, 512, 512, 512);
          Epi8<4> E{(bf16*)(ws + WS_YA), 512, (const bf16*)(ws + WS_YL), nullptr}; run_gemm(lds, g, E, G, blk);
#if defined(DUP_S5G)
          run_gemm(lds, g, E, G, blk);
#endif
          }
        __syncthreads();
        { const float* w_in = P.in[2] + (size_t)L * 1024 * NIN; LAS float* scr = (LAS float*)(lds + wave * 16384);
          for (int it = gw; it < 16 * 96; it += NGW) { const int kb = it / 96, nb = it % 96; tr_item(w_in, NIN, kb * 64, 3744 + nb * 32, (bf16*)(ws + WS_WG), 1024, nb * 32, 0, nullptr, 0, scr, lane); } }
        { const int nsh = (blk < 128) ? 1 : 2; const int vw0 = (blk < 128) ? blk * NWAVES + wave : 1024 + ((blk - 128) * NWAVES + wave) * 2;
          for (int s = 0; s < nsh; ++s) for (int m = vw0 + s; m < M; m += 3072) rms_row(xsrc + (size_t)m * 1024, P.in[1] + L * 1024, (bf16*)(ws + WS_XN) + (size_t)m * 1024, lane); }
        GSYNC(); RELAUNDER(); STAMP(6 + 13 * L);
#if defined(STOP_AFTER) && STOP_AFTER==5
        dump_stage(P, 5, blk, G, tid); return;
#endif
        { pg8::Gemm g = mkgemm((const bf16*)(ws + WS_XN), (const bf16*)(ws + WS_WG) + (size_t)1024 * 1024, M, 2048, 1024, 1024, 1024);
          Epi8<10> E{(bf16*)(ws + WS_P12), 1024, nullptr, nullptr}; run_gemm_pair(lds, g, E, G, blk); }
        { pg8::Gemm g = mkgemm((const bf16*)(ws + WS_Z) + 512, (const bf16*)(ws + WS_WB) + (size_t)1024 * 512, M, 2048, 512, ZP, 512); g.a_pn_shift = 2; g.a_pn_bytes = -1024;
          Epi8<11> E{(bf16*)(ws + WS_P12), 1024, nullptr, nullptr}; run_gemm_pair(lds, g, E, G, blk); }
        GSYNC(); RELAUNDER(); STAMP(7 + 13 * L);
#endif
#if !defined(ONLY) || ONLY==6
        { pg8::Gemm g = mkgemm((const bf16*)(ws + WS_XN), (const bf16*)(ws + WS_WG), M, 1024, 1024, 1024, 1024);
          Epi8<5> E{(bf16*)(ws + WS_G0), 1024, nullptr, nullptr}; run_gemm(lds, g, E, G, blk); }
        { pg8::Gemm g = mkgemm((const bf16*)(ws + WS_YA), (const bf16*)(ws + WS_WB), M, 1024, 512, 512, 512);
          Epi8<7> E{(bf16*)(ws + WS_P12), 1024, (const bf16*)(ws + WS_G0), nullptr}; run_gemm(lds, g, E, G, blk); }
        GSYNC(); RELAUNDER(); STAMP(8 + 13 * L);
#if defined(STOP_AFTER) && STOP_AFTER==6
        dump_stage(P, 6, blk, G, tid); return;
#endif
#endif
#if !defined(ONLY) || ONLY==7
        { pg8::Gemm g = mkgemm((const bf16*)(ws + WS_P12), (const bf16*)(ws + WS_WO), M, 1024, 1024, 1024, 1024);
          EpiRes E{xsrc, P.out}; run_gemm(lds, g, E, G, blk); }
        GSYNC(); RELAUNDER(); STAMP(9 + 13 * L);
#endif
#if !defined(ONLY) || ONLY==8
#if defined(DUP_SYNC)
        for (int rep = 0; rep < 10; ++rep) { GSYNC(); }
#endif
        for (int m = gw; m < M; m += NGW) rms_row(P.out + (size_t)m * 1024, P.in[32] + L * 1024, (bf16*)(ws + WS_H2N) + (size_t)m * 1024, lane);
#if defined(DUP_PH8)
        for (int m = gw; m < M; m += NGW) rms_row(P.out + (size_t)m * 1024, P.in[32] + L * 1024, (bf16*)(ws + WS_H2N) + (size_t)m * 1024, lane);
#endif
        GSYNC(); RELAUNDER(); STAMP(10 + 13 * L);
#endif
#if !defined(ONLY) || ONLY==9
        { pg8::Gemm g = mkgemm((const bf16*)(ws + WS_H2N), (const bf16*)(ws + WS_WFI), M, 2 * DFF, 1024, 1024, 1024);
          Epi8<8> E{(bf16*)(ws + WS_HID), DFF, nullptr, nullptr}; run_gemm(lds, g, E, G, blk);
#if defined(DUP_FFN1)
          run_gemm(lds, g, E, G, blk);
#endif
          }
        if (L == 0 && blk >= 128) { __syncthreads(); weight_items(P, 1, (blk - 128) * NWAVES + wave, 128 * NWAVES, (LAS float*)(lds + wave * 16384), lane, 0, 4128); }
        GSYNC(); RELAUNDER(); STAMP(11 + 13 * L);
#if defined(STOP_AFTER) && STOP_AFTER==9
        dump_stage(P, 9, blk, G, tid); return;
#endif
#endif
#if !defined(ONLY) || ONLY==10
        { pg8::Gemm g = mkgemm((const bf16*)(ws + WS_HID), (const bf16*)(ws + WS_WFO), M, 1024, DFF, DFF, DFF);
          EpiRes E{P.out, P.out}; run_gemm(lds, g, E, G, blk); }
#endif
        if (L == 0) { GSYNC(); STAMP(12); }
    }
#if defined(PROBE_A)
    GSYNC();
    if (blk0 == 0) { STAMP(25); __syncthreads(); LAS unsigned long long* st = (LAS unsigned long long*)(lds + LDS_XB + 256);
        float dA = 0.f, dB = 0.f;
        for (int L = 0; L < 2; ++L) { for (int k = 0; k < 12; ++k) { const int k1 = (L == 1 && k == 11) ? 25 : 13 * L + k + 1; const float d = (float)(long long)(st[k1] - st[13 * L + k]); if ((PROBE_A >> k) & 1) dA += d; if ((PROBE_B >> k) & 1) dB += d; } }
#if defined(PROBE_CAL)
        dB = 50000.f;
#endif
        const float qa = __expf(0.04f * rintf(__logf(fmaxf(dA, 1.f)) * 25.f)), qb = __expf(0.04f * rintf(__logf(fmaxf(dB, 1.f)) * 25.f));
        if (tid0 == 0) { P.out[3] += qa * 0.01f; } }
#endif
}

extern "C" void kernel_launch(void* const* d_in, const int* in_sizes, int n_in, void* d_out, int out_size, void* d_ws, size_t ws_size, hipStream_t stream) {
    static int grid = 0;
    if (grid == 0) {
        if (n_in != 35 || out_size != M * DMOD || ws_size < WS_END) { fprintf(stderr, "kernel_launch: unexpected shapes (n_in %d out %d ws %zu)\n", n_in, out_size, ws_size); grid = -1; return; }
        int dev = 0, cus = 0, per_cu = 0;
        hipGetDevice(&dev); hipDeviceGetAttribute(&cus, hipDeviceAttributeMultiprocessorCount, dev);
        hipFuncSetAttribute((const void*)mega_fwd, hipFuncAttributeMaxDynamicSharedMemorySize, LDS_BYTES);
        hipOccupancyMaxActiveBlocksPerMultiprocessor(&per_cu, (const void*)mega_fwd, NTHR, LDS_BYTES);
        if (per_cu < 1) { fprintf(stderr, "kernel_launch: occupancy query says %d\n", per_cu); grid = -1; return; }
        grid = cus;
        if (grid != 256) { fprintf(stderr, "kernel_launch: built for a 256-CU device (one workgroup per CU); got %d\n", grid); grid = -1; return; }
    }
    if (grid < 0) return;
    Args a{};
    for (int i = 0; i < 35; ++i) a.p.in[i] = (const float*)d_in[i];
    a.p.out = (float*)d_out; a.p.ws = (unsigned char*)d_ws;
    void* kargs[] = {&a};
    hipError_t e = hipLaunchCooperativeKernel((const void*)mega_fwd, dim3(grid), dim3(NTHR), kargs, LDS_BYTES, stream);
    if (e != hipSuccess) fprintf(stderr, "cooperative launch failed: %s (grid %d)\n", hipGetErrorString(e), grid);
}
```

```cpp
#include <hip/hip_runtime.h>
#include <hip/hip_cooperative_groups.h>
#include <cstdio>
#include <cstdint>

namespace pg8 {
#define PG8_LAS __attribute__((address_space(3)))
typedef unsigned short bf16_t;
typedef short bf16x8 __attribute__((ext_vector_type(8)));
typedef float f32x4 __attribute__((ext_vector_type(4)));
typedef unsigned u32x4 __attribute__((ext_vector_type(4)));
constexpr int BM = 256, BK = 64, HALF = 128, HTB = HALF * BK * 2  , STAGE_BYTES = 8 * HTB, NXCD = 8, WGM = 8;

__host__ __device__ __forceinline__ int lds_byte(int r, int c) { const int st = (r >> 4) * 2 + (c >> 5), rr = r & 15, cc = c & 31, ob = rr * 64 + cc * 2; return st * 1024 + (ob ^ (((ob >> 9) & 1) << 5)); }
__host__ __device__ __forceinline__ void stage_rc(int b, int& R, int& C) { const int st = b / 1024, sb = b % 1024, swz = sb ^ (((sb >> 9) & 1) << 5); R = (st >> 1) * 16 + swz / 64; C = (st & 1) * 32 + (swz % 64) / 2; }
__host__ __device__ __forceinline__ int perm32(int rho) { const int n = rho >> 4, i = rho & 15; return 8 * (i >> 2) + 4 * n + (i & 3); }

struct Unit { int pm, pn; };
struct Gemm { const bf16_t* A; const bf16_t* Bt; int M, N, K; int lda, ldb; int a_skip_shift; int a_skip_bytes; int kwrap; int wrap_bytes; int b_shift; int b_stride_bytes; int a_pn_shift; int a_pn_bytes;
  __device__ __forceinline__ const char* abase(const Unit& u) const { return (const char*)A + (size_t)u.pm * (size_t)(256 * 2) * lda + (size_t)(u.pm >> a_skip_shift) * a_skip_bytes + (long)(u.pn >> a_pn_shift) * (long)a_pn_bytes; }
  __device__ __forceinline__ const char* bbase(const Unit& u) const { return (const char*)Bt + (size_t)u.pn * (size_t)(256 * 2) * ldb + (size_t)(u.pm >> b_shift) * b_stride_bytes; } };

struct StaticOrder {
    int nM, nN, nwg, G, c;
    __host__ __device__ void init(int M, int N, int G_, int c_) { nM = M / BM; nN = N / BM; nwg = nM * nN; G = G_; c = c_; }
    __host__ __device__ bool next(int i, Unit& u) const {
        const long L = (long)i * G + c; if (L >= nwg) return false;
        int wgid = (int)L; { const int q = nwg / NXCD, r = nwg % NXCD, xcd = wgid % NXCD, off = wgid / NXCD; wgid = (xcd < r ? xcd * (q + 1) : r * (q + 1) + (xcd - r) * q) + off; }
        const int nig = WGM * nN, gid = wgid / nig, fm = gid * WGM, gsz = (nM - fm) < WGM ? (nM - fm) : WGM;
        u.pm = fm + ((wgid % nig) % gsz); u.pn = (wgid % nig) / gsz; return true;
    }
    __device__ __forceinline__ void a_ready(const Unit&) const {}
    __device__ __forceinline__ void done(const Unit&) const {}
};

typedef float cvt_f32x2_t __attribute__((ext_vector_type(2))); typedef __bf16 cvt_bf16x2_t __attribute__((ext_vector_type(2)));
__device__ __forceinline__ unsigned cvt_pk_bf16(float lo, float hi) { cvt_f32x2_t v = {lo, hi}; cvt_bf16x2_t b = __builtin_convertvector(v, cvt_bf16x2_t); return __builtin_bit_cast(unsigned, b); }
typedef float f32x2 __attribute__((ext_vector_type(2)));
__device__ __forceinline__ f32x2 gelu_pk(f32x2 v) {
    const f32x2 av = __builtin_elementwise_abs(v), d = av * 0.2316418882f + 1.0f;
    f32x2 t; t.x = __builtin_amdgcn_rcpf(d.x); t.y = __builtin_amdgcn_rcpf(d.y);
    f32x2 q = t * 0.5307027145f + (-0.7265760135f); q = q * t + 0.7107068705f; q = q * t + (-0.142248368f); q = q * t + 0.127414796f; q = q * t;
    const f32x2 s = (v * v) * (-0.72134752044f);
    f32x2 e; e.x = __builtin_amdgcn_exp2f(s.x); e.y = __builtin_amdgcn_exp2f(s.y);
    const f32x2 m = v * (q * e), r = v - m;
    f32x2 o; o.x = v.x < 0.f ? m.x : r.x; o.y = v.y < 0.f ? m.y : r.y; return o;
}

template <int ACT  > struct EpiBf16 {
    static constexpr bool PERM = true, AFTER_DRAIN = false; static_assert(ACT == 0 || ACT == 1, "EpiBf16: ACT is 0 (none) or 1 (gelu_pk)");
    bf16_t* O; int ldc; const float* bias; int split_cols; size_t split_stride; float scale0;
    __device__ __forceinline__ void operator()(const f32x4 (&acc)[2][2][4][2], const Unit& u, int wr, int wc, int fr, int fq) const {
        const int row0 = u.pm * BM + wr * 64 + fr; int colt = u.pn * BM; bf16_t* base = O;
        float sc = 1.f; if (split_cols) { const int t = colt / split_cols; base += (size_t)t * split_stride; colt -= t * split_cols; if (t == 0) sc = scale0; }
        const int col0 = colt + wc * 32 + 8 * fq, bcol0 = u.pn * BM + wc * 32 + 8 * fq;
        f32x4 bv[2][2];
#pragma unroll
        for (int bj = 0; bj < 2; ++bj)
#pragma unroll
            for (int n = 0; n < 2; ++n) bv[bj][n] = bias ? *(const f32x4*)(bias + bcol0 + bj * HALF + 4 * n) : (f32x4){0.f, 0.f, 0.f, 0.f};
#pragma unroll
        for (int ai = 0; ai < 2; ++ai)
#pragma unroll
            for (int m = 0; m < 4; ++m) { bf16_t* rowp = base + (size_t)(row0 + ai * HALF + m * 16) * ldc + col0;
#pragma unroll
                for (int bj = 0; bj < 2; ++bj) { f32x4 v0 = acc[ai][bj][m][0] + bv[bj][0], v1 = acc[ai][bj][m][1] + bv[bj][1];
                    if (ACT == 1) { f32x2 a = gelu_pk((f32x2){v0[0], v0[1]}), b = gelu_pk((f32x2){v0[2], v0[3]}), c = gelu_pk((f32x2){v1[0], v1[1]}), d = gelu_pk((f32x2){v1[2], v1[3]});
                        v0 = (f32x4){a.x, a.y, b.x, b.y}; v1 = (f32x4){c.x, c.y, d.x, d.y}; }
                    v0 = v0 * sc; v1 = v1 * sc; u32x4 w; w.x = cvt_pk_bf16(v0[0], v0[1]); w.y = cvt_pk_bf16(v0[2], v0[3]); w.z = cvt_pk_bf16(v1[0], v1[1]); w.w = cvt_pk_bf16(v1[2], v1[3]);
                    *(u32x4*)(rowp + bj * HALF) = w; } }
    }
};
template <class Epi, class Sched, bool ALIGN_EPI = false, bool SP2 = false>
__device__ __forceinline__ void gemm_phase(PG8_LAS unsigned char* lds, const Gemm g, const Sched& S, const Epi& E, int wave_hint) {
    int tid_l = wave_hint * 64 + (int)__builtin_amdgcn_mbcnt_hi(~0u, __builtin_amdgcn_mbcnt_lo(~0u, 0u)); asm volatile("" : "+v"(tid_l)); const int tid = tid_l, wid = __builtin_amdgcn_readfirstlane(tid >> 6), lane = tid & 63, wr = wid >> 2, wc = wid & 3, fr = lane & 15, fq = lane >> 4;
    const int K = g.K, nt = K / BK;
    unsigned voffA[2], voffB[2];
#pragma unroll
    for (int i = 0; i < 2; ++i) { int R, C; stage_rc(tid * 16 + i * 8192, R, C); const int Rb = Epi::PERM ? ((R & ~31) + perm32(R & 31)) : R;
        voffA[i] = (unsigned)(R * g.lda + C) * 2u; voffB[i] = (unsigned)(Rb * g.ldb + C) * 2u; }
    const size_t kstep = (size_t)(BK * 2);
    const size_t hstepA = (size_t)HALF * g.lda * 2, hstepB = (size_t)HALF * g.ldb * 2; const size_t wrapb = (size_t)g.wrap_bytes;
    const unsigned ldsw = (unsigned)wid * 1024u;
    const int aoff = lds_byte(wr * 64 + fr, fq * 8), boff = lds_byte(wc * 32 + fr, fq * 8);
#define PG8_SA(b, h) (((b) * 2 + (h)) * HTB)
#define PG8_SB(b, h) ((4 + (b) * 2 + (h)) * HTB)
#define PG8_STAGE(bufoff, gbase, voff) do { _Pragma("unroll") for (int _i = 0; _i < 2; ++_i) \
        __builtin_amdgcn_global_load_lds((const unsigned*)((const char*)(gbase) + (voff)[_i]), (PG8_LAS unsigned*)(lds + (bufoff) + ldsw + _i * 8192), 16, 0, 0); } while (0)
#define PG8_LDA(dst, b, h) do { _Pragma("unroll") for (int m = 0; m < 4; ++m) _Pragma("unroll") for (int k = 0; k < 2; ++k) dst[m][k] = *(const PG8_LAS bf16x8*)(lds + PG8_SA(b, h) + aoff + m * 2048 + k * 1024); } while (0)
#define PG8_LDB(dst, b, h) do { _Pragma("unroll") for (int n = 0; n < 2; ++n) _Pragma("unroll") for (int k = 0; k < 2; ++k) dst[n][k] = *(const PG8_LAS bf16x8*)(lds + PG8_SB(b, h) + boff + n * 2048 + k * 1024); } while (0)
#define PG8_MMA(ai, bj, At, Bt) do { __builtin_amdgcn_s_setprio(1); _Pragma("unroll") for (int m = 0; m < 4; ++m) _Pragma("unroll") for (int n = 0; n < 2; ++n) _Pragma("unroll") for (int k = 0; k < 2; ++k) \
        acc[ai][bj][m][n] = __builtin_amdgcn_mfma_f32_16x16x32_bf16(Bt[n][k], At[m][k], acc[ai][bj][m][n], 0, 0, 0); __builtin_amdgcn_s_setprio(0); } while (0)
#define PG8_WAIT_V(n) asm volatile("s_waitcnt vmcnt(" #n ")" ::: "memory")
#define PG8_WAIT_L(n) asm volatile("s_waitcnt lgkmcnt(" #n ")" ::: "memory")
#define PG8_BAR __builtin_amdgcn_s_barrier()
#define PG8_SCHED __builtin_amdgcn_sched_barrier(0)
    Unit cur, nxt; int ui = 0;
    if (!S.next(0, cur)) return;
    f32x4 acc[2][2][4][2];
#pragma unroll
    for (int a = 0; a < 2; ++a)
#pragma unroll
        for (int b = 0; b < 2; ++b)
#pragma unroll
            for (int m = 0; m < 4; ++m)
#pragma unroll
                for (int n = 0; n < 2; ++n) acc[a][b][m][n] = (f32x4){0.f, 0.f, 0.f, 0.f};
    bf16x8 At[4][2], B0[2][2], B1[2][2];
    const char* cA = g.abase(cur); const char* cB = g.bbase(cur);
    S.a_ready(cur);
    if constexpr (SP2) {
        PG8_STAGE(PG8_SB(0, 0), cB, voffB); PG8_STAGE(PG8_SB(0, 1), cB + hstepB, voffB); PG8_STAGE(PG8_SA(0, 0), cA, voffA); PG8_STAGE(PG8_SA(0, 1), cA + hstepA, voffA);
        if (wr == 1) PG8_BAR;
        PG8_WAIT_V(2); PG8_BAR;
        PG8_STAGE(PG8_SB(1, 0), cB + kstep, voffB); PG8_STAGE(PG8_SA(1, 0), cA + kstep, voffA); PG8_STAGE(PG8_SB(1, 1), cB + hstepB + kstep, voffB);
        PG8_WAIT_V(6); PG8_BAR;
    } else {
        PG8_STAGE(PG8_SB(0, 0), cB, voffB); PG8_STAGE(PG8_SA(0, 0), cA, voffA); PG8_STAGE(PG8_SB(0, 1), cB + hstepB, voffB); PG8_STAGE(PG8_SA(0, 1), cA + hstepA, voffA);
        if (wr == 1) PG8_BAR;
        PG8_WAIT_V(4); PG8_BAR;
        PG8_STAGE(PG8_SB(1, 0), cB + kstep, voffB); PG8_STAGE(PG8_SA(1, 0), cA + kstep, voffA); PG8_STAGE(PG8_SB(1, 1), cB + hstepB + kstep, voffB);
        PG8_WAIT_V(6); PG8_BAR;
    }
    for (;;) {
        const bool has_next = S.next(ui + 1, nxt);
        const char* nA = has_next ? g.abase(nxt) : cA; const char* nB = has_next ? g.bbase(nxt) : cB;
        for (int t = 0; t < nt; t += 2) {
            const bool last = (t == nt - 2);
            const char* a1 = cA + (size_t)(t + 1) * kstep - ((t + 1) >= g.kwrap ? wrapb : (size_t)0);
            const char* a2 = last ? nA : cA + (size_t)(t + 2) * kstep - ((t + 2) >= g.kwrap ? wrapb : (size_t)0); const char* b2 = last ? nB : cB + (size_t)(t + 2) * kstep;
            const char* a3 = a2 + kstep; const char* b3 = b2 + kstep;
            if (last && has_next) S.a_ready(nxt);
            if constexpr (SP2) {
            PG8_LDB(B0, 0, 0); PG8_LDB(B1, 0, 1); PG8_SCHED; PG8_LDA(At, 0, 0); PG8_STAGE(PG8_SA(1, 1), a1 + hstepA, voffA);
            PG8_WAIT_V(8); PG8_WAIT_L(0); PG8_BAR; PG8_MMA(0, 0, At, B0); PG8_MMA(0, 1, At, B1); PG8_BAR; PG8_SCHED;
            PG8_LDA(At, 0, 1); PG8_STAGE(PG8_SB(0, 0), b2, voffB); PG8_STAGE(PG8_SB(0, 1), b2 + hstepB, voffB); PG8_STAGE(PG8_SA(0, 0), a2, voffA);
            PG8_WAIT_V(8); PG8_WAIT_L(0); PG8_BAR; PG8_MMA(1, 0, At, B0); PG8_MMA(1, 1, At, B1); PG8_BAR; PG8_SCHED;
            PG8_LDB(B0, 1, 0); PG8_LDB(B1, 1, 1); PG8_SCHED; PG8_LDA(At, 1, 0); PG8_STAGE(PG8_SA(0, 1), a2 + hstepA, voffA);
            PG8_WAIT_V(8); PG8_WAIT_L(0); PG8_BAR; PG8_MMA(0, 0, At, B0); PG8_MMA(0, 1, At, B1); PG8_BAR; PG8_SCHED;
            PG8_LDA(At, 1, 1); PG8_STAGE(PG8_SB(1, 0), b3, voffB); PG8_STAGE(PG8_SB(1, 1), b3 + hstepB, voffB); PG8_STAGE(PG8_SA(1, 0), a3, voffA);
            PG8_WAIT_V(8); PG8_WAIT_L(0); PG8_BAR; PG8_MMA(1, 0, At, B0); PG8_MMA(1, 1, At, B1); PG8_BAR; PG8_SCHED;
            } else {
            PG8_LDB(B0, 0, 0); PG8_SCHED; PG8_LDA(At, 0, 0); PG8_STAGE(PG8_SA(1, 1), a1 + hstepA, voffA);
            PG8_WAIT_L(8); PG8_BAR; PG8_WAIT_L(0); PG8_MMA(0, 0, At, B0); PG8_BAR; PG8_SCHED;
            PG8_LDB(B1, 0, 1); PG8_STAGE(PG8_SB(0, 0), b2, voffB);
            PG8_BAR; PG8_WAIT_L(0); PG8_MMA(0, 1, At, B1); PG8_BAR;
            PG8_LDA(At, 0, 1); PG8_STAGE(PG8_SA(0, 0), a2, voffA);
            PG8_BAR; PG8_WAIT_L(0); PG8_MMA(1, 0, At, B0); PG8_BAR; PG8_SCHED;
            PG8_STAGE(PG8_SB(0, 1), b2 + hstepB, voffB);
            PG8_WAIT_V(6); PG8_BAR; PG8_MMA(1, 1, At, B1); PG8_BAR;
            PG8_LDB(B0, 1, 0); PG8_SCHED; PG8_LDA(At, 1, 0); PG8_STAGE(PG8_SA(0, 1), a2 + hstepA, voffA);
            PG8_WAIT_L(8); PG8_BAR; PG8_WAIT_L(0); PG8_MMA(0, 0, At, B0); PG8_BAR; PG8_SCHED;
            PG8_LDB(B1, 1, 1); PG8_STAGE(PG8_SB(1, 0), b3, voffB);
            PG8_BAR; PG8_WAIT_L(0); PG8_MMA(0, 1, At, B1); PG8_BAR;
            PG8_LDA(At, 1, 1); PG8_STAGE(PG8_SA(1, 0), a3, voffA);
            PG8_BAR; PG8_WAIT_L(0); PG8_MMA(1, 0, At, B0); PG8_BAR; PG8_SCHED;
            PG8_STAGE(PG8_SB(1, 1), b3 + hstepB, voffB);
            PG8_WAIT_V(6); PG8_BAR; PG8_MMA(1, 1, At, B1); PG8_BAR;
            }
        }
        if constexpr (ALIGN_EPI) { if (wr == 0) PG8_BAR; }
        if constexpr (!Epi::AFTER_DRAIN) { E(acc, cur, wr, wc, fr, fq); S.done(cur); }
        if (!has_next) break;
#pragma unroll
        for (int a = 0; a < 2; ++a)
#pragma unroll
            for (int b = 0; b < 2; ++b)
#pragma unroll
                for (int m = 0; m < 4; ++m)
#pragma unroll
                    for (int n = 0; n < 2; ++n) acc[a][b][m][n] = (f32x4){0.f, 0.f, 0.f, 0.f};
        cur = nxt; cA = nA; cB = nB; ++ui;
        if constexpr (ALIGN_EPI) { if (wr == 1) PG8_BAR; }
    }
    PG8_WAIT_V(0);
    if constexpr (!ALIGN_EPI) { if (wr == 0) PG8_BAR; }
    PG8_BAR;
    if constexpr (Epi::AFTER_DRAIN) { E.fused(acc, cur, wr, wc, fr, fq, lds, wid, lane); S.done(cur); }
#undef PG8_SA
#undef PG8_SB
#undef PG8_STAGE
#undef PG8_LDA
#undef PG8_LDB
#undef PG8_MMA
#undef PG8_WAIT_V
#undef PG8_WAIT_L
#undef PG8_BAR
#undef PG8_SCHED
}
}
#include <hip/hip_bf16.h>
#include <cmath>
namespace attn_body {
using bf16=__hip_bfloat16;
using bf16x8=__attribute__((ext_vector_type(8)))short;
using s16x4=__attribute__((ext_vector_type(4)))short;
using f32x16=__attribute__((ext_vector_type(16)))float;
using u32x4=__attribute__((ext_vector_type(4)))unsigned;
constexpr int BATCH=4,NHEAD=16,SEQ=4096,D=64,DMQ=512,DMO=1024;
constexpr int NW=8,QBLK=32,QB=QBLK*NW,KVBLK=64,NQB=SEQ/QB;
constexpr int ATTN_UNIT_ROWS=QB;
__device__ __forceinline__ int crow(int r,int hi){return (r&3)+8*(r>>2)+4*hi;}
#define SBAR() __builtin_amdgcn_sched_barrier(0)
__device__ __forceinline__ void cmask(f32x16&p0,f32x16&p1,int jb,int qrel,int hi){
  const float NEG=-INFINITY; int kb=64*jb+4*hi;
  #pragma unroll
  for(int r=0;r<16;++r){int kv=kb+(r&3)+8*(r>>2); if(kv>qrel)p0[r]=NEG; if(kv+32>qrel)p1[r]=NEG;}
}

constexpr int NSLOT=3, SLOTB=8192;
constexpr int LDS_K=0, LDS_V=NSLOT*SLOTB, LDS_WS=2*NSLOT*SLOTB, LDS_OST=LDS_WS+NW*64*4, LDS_BYTES=LDS_OST+NW*4096;
constexpr float C2=0.125f*1.4426950408889634f;
__device__ __forceinline__ void glds16(const void*gsrc,unsigned lds_dst){unsigned keep;
  asm volatile("s_mov_b32 %0, m0\n\ts_mov_b32 m0, %2\n\ts_nop 0\n\tglobal_load_lds_dwordx4 %1, off\n\ts_mov_b32 m0, %0":"=&s"(keep):"v"(gsrc),"s"(lds_dst):"memory");}
__device__ __forceinline__ float max3f(float a,float b,float c){float r;asm("v_max3_f32 %0, %1, %2, %3":"=v"(r):"v"(a),"v"(b),"v"(c));return r;}
__device__ __forceinline__ float max2f(float a,float b){float r;asm("v_max_f32_e32 %0, %1, %2":"=v"(r):"v"(a),"v"(b));return r;}
__device__ __forceinline__ float fadd_s(float a,float b){float r;asm("v_add_f32_e32 %0, %1, %2":"=v"(r):"v"(a),"v"(b));return r;}
__device__ __forceinline__ float fsub_s(float a,float b){float r;asm("v_sub_f32_e32 %0, %1, %2":"=v"(r):"v"(a),"v"(b));return r;}
typedef float f32x2_t __attribute__((ext_vector_type(2))); typedef __bf16 bf16x2_t __attribute__((ext_vector_type(2)));
__device__ __forceinline__ unsigned cvtpk_s(float lo,float hi){f32x2_t v={lo,hi};bf16x2_t b=__builtin_convertvector(v,bf16x2_t);return __builtin_bit_cast(unsigned,b);}
#define WAIT_BAR(N) asm volatile("s_waitcnt vmcnt(" #N ") lgkmcnt(0)\n\ts_barrier":::"memory")

__device__ __forceinline__ void qkt(f32x16&p0,f32x16&p1,const char*Kslot,const bf16x8*qr,const f32x16&negm,int r32,int hi){
  const char*kb=Kslot+hi*1024+r32*16;
  #pragma unroll
  for(int d0=0;d0<4;++d0){
    const bf16x8 b0=*reinterpret_cast<const bf16x8*>(kb+d0*2048);
    const bf16x8 b1=*reinterpret_cast<const bf16x8*>(kb+d0*2048+512);
    if(d0==0){p0=__builtin_amdgcn_mfma_f32_32x32x16_bf16(b0,qr[0],negm,0,0,0);p1=__builtin_amdgcn_mfma_f32_32x32x16_bf16(b1,qr[0],negm,0,0,0);}
    else{p0=__builtin_amdgcn_mfma_f32_32x32x16_bf16(b0,qr[d0],p0,0,0,0);p1=__builtin_amdgcn_mfma_f32_32x32x16_bf16(b1,qr[d0],p1,0,0,0);}}
}
typedef __attribute__((address_space(3))) const char* lds_cptr;
typedef short v4i16_t __attribute__((ext_vector_type(4)));
__device__ __forceinline__ void kload8(bf16x8*kf,lds_cptr kp){
  kf[0]=*(const __attribute__((address_space(3))) bf16x8*)(kp);      kf[1]=*(const __attribute__((address_space(3))) bf16x8*)(kp+512);
  kf[2]=*(const __attribute__((address_space(3))) bf16x8*)(kp+2048); kf[3]=*(const __attribute__((address_space(3))) bf16x8*)(kp+2560);
  kf[4]=*(const __attribute__((address_space(3))) bf16x8*)(kp+4096); kf[5]=*(const __attribute__((address_space(3))) bf16x8*)(kp+4608);
  kf[6]=*(const __attribute__((address_space(3))) bf16x8*)(kp+6144); kf[7]=*(const __attribute__((address_space(3))) bf16x8*)(kp+6656);
}
__device__ __forceinline__ void kload2(bf16x8*kf,lds_cptr kp,int j){ kf[2*j]=*(const __attribute__((address_space(3))) bf16x8*)(kp+j*2048); kf[2*j+1]=*(const __attribute__((address_space(3))) bf16x8*)(kp+j*2048+512); }
__device__ __forceinline__ s16x4 vtr(lds_cptr p){ return __builtin_bit_cast(s16x4,__builtin_amdgcn_ds_read_tr16_b64_v4i16((__attribute__((address_space(3))) v4i16_t*)p)); }
__device__ __forceinline__ float rowmax(const f32x16&p0,const f32x16&p1){
  float a=max3f(p0[0],p0[1],p1[0]),b=max3f(p0[2],p0[3],p1[1]);a=max3f(a,p1[2],p1[3]);
  #pragma unroll
  for(int r=4;r<16;r+=4){a=max3f(a,p0[r],p0[r+1]);b=max3f(b,p0[r+2],p0[r+3]);a=max3f(a,p1[r],p1[r+1]);b=max3f(b,p1[r+2],p1[r+3]);}
  const float m=max2f(a,b);
  auto rr=__builtin_amdgcn_permlane32_swap(__float_as_uint(m),__float_as_uint(m),false,false);
  return max2f(__uint_as_float(rr[0]),__uint_as_float(rr[1]));
}
__device__ __forceinline__ void pv(f32x16*o,int vb,bf16x8 pa0,bf16x8 pa1,bf16x8 pa2,bf16x8 pa3){
  #pragma unroll
  for(int d0=0;d0<2;++d0){s16x4 lo[4],hi[4];
    #pragma unroll
    for(int ks=0;ks<4;++ks){
      asm volatile("ds_read_b64_tr_b16 %0,%1 offset:%c2":"=&v"(lo[ks]):"v"(vb),"i"(d0*4096+ks*1024):"memory");
      asm volatile("ds_read_b64_tr_b16 %0,%1 offset:%c2":"=&v"(hi[ks]):"v"(vb),"i"(d0*4096+ks*1024+512):"memory");}
    asm volatile("s_waitcnt lgkmcnt(0)":::"memory");SBAR();
    #define PK(k) (bf16x8){lo[k][0],lo[k][1],lo[k][2],lo[k][3],hi[k][0],hi[k][1],hi[k][2],hi[k][3]}
    o[d0]=__builtin_amdgcn_mfma_f32_32x32x16_bf16(pa0,PK(0),o[d0],0,0,0);
    o[d0]=__builtin_amdgcn_mfma_f32_32x32x16_bf16(pa1,PK(1),o[d0],0,0,0);
    o[d0]=__builtin_amdgcn_mfma_f32_32x32x16_bf16(pa2,PK(2),o[d0],0,0,0);
    o[d0]=__builtin_amdgcn_mfma_f32_32x32x16_bf16(pa3,PK(3),o[d0],0,0,0);
    #undef PK
  }
}

#ifndef ATTN_STORE16
#define ATTN_STORE16(p,v) (*(u32x4*)(p)=(v))
#endif
template<int THRL> __device__ __forceinline__ void attn_unit(int b,int cq,int ck,int cv,int co,int qb,const bf16*Q,const bf16*__restrict__ K,const bf16*__restrict__ V,bf16*O,char*shm,int wave_hint){
  int tid_l=wave_hint*64+(int)__builtin_amdgcn_mbcnt_hi(~0u,__builtin_amdgcn_mbcnt_lo(~0u,0u)); asm volatile("":"+v"(tid_l)); const int tid=tid_l,lane=tid&63,r32=lane&31,hi=lane>>5; const int wid=__builtin_amdgcn_readfirstlane(tid>>6);
  const long rowbase=(long)b*SEQ; const int q0=qb*QB;
  const bf16*Qw=Q+(rowbase+q0+wid*QBLK)*DMQ+cq;
  const bf16*Kh=K+rowbase*DMQ+ck,*Vh=V+rowbase*DMQ+cv;
  const unsigned lds0=(unsigned)(uintptr_t)shm;
  float*wsf=(float*)(shm+LDS_WS)+wid*64;
  const bf16*ksrc=Kh+(long)lane*DMQ+wid*8;
  const bf16*vsrc=Vh+(long)(16*(wid&3)+(lane>>2))*DMQ+(wid>>2)*32+(lane&3)*8;
  const unsigned kdst=lds0+LDS_K+wid*1024, vdst=lds0+LDS_V+wid*1024;
  #define DMA_K(t,slot) glds16(ksrc+(long)(t)*KVBLK*DMQ,(unsigned)__builtin_amdgcn_readfirstlane(kdst+(slot)))
  #define DMA_V(t,slot) glds16(vsrc+(long)(t)*KVBLK*DMQ,(unsigned)__builtin_amdgcn_readfirstlane(vdst+(slot)))
  const int vb0=(int)(lds0+LDS_V)+((lane>>4)&1)*32+(lane&3)*8+(4*hi+((lane&15)>>2))*64;
  const char*Kbase=shm+LDS_K; bf16x8 kf[8];
  const lds_cptr shm3=(lds_cptr)shm; const lds_cptr kp0=shm3+LDS_K+hi*1024+r32*16; const lds_cptr vp0=shm3+LDS_V+((lane>>4)&1)*32+(lane&3)*8+(4*hi+((lane&15)>>2))*64;
  const int NT=(q0+QB)/KVBLK;
  DMA_K(0,0);DMA_V(0,0);DMA_K(1,SLOTB);
  bf16x8 qr[4];
  #pragma unroll
  for(int d0=0;d0<4;++d0)qr[d0]=*reinterpret_cast<const bf16x8*>(&Qw[(long)r32*DMQ+d0*16+hi*8]);
  float mhat=0.f,l_reg=0.f;f32x16 o[2];o[0]=f32x16{};o[1]=f32x16{};f32x16 negm=f32x16{};asm volatile("":"+v"(negm));
  const int qrel=wid*QBLK+r32;
  #define CMASK(P0,P1,t) do{int jb_=(t)-(NT-4); if(jb_>=0)cmask(P0,P1,jb_,qrel,hi);}while(0)
  bool resc=false;
  #define START(P0,P1) do{ const float rm=rowmax(P0,P1); resc=false; \
    { const float dl=rm; mhat=fadd_s(mhat,dl); \
      _Pragma("unroll") for(int r=0;r<16;++r){P0[r]=fsub_s(P0[r],dl);P1[r]=fsub_s(P1[r],dl);} \
      _Pragma("unroll") for(int r=0;r<16;++r)negm[r]=-mhat; asm volatile("":"+v"(negm)); } \
    _Pragma("unroll") for(int r=0;r<16;++r)P0[r]=__builtin_amdgcn_exp2f(P0[r]); }while(0)
  #define RESC() do{ if(resc){ asm volatile("s_waitcnt lgkmcnt(0)":::"memory"); \
      _Pragma("unroll") for(int d_=0;d_<2;++d_) _Pragma("unroll") for(int r=0;r<16;++r)o[d_][r]*=wsf[crow(r,hi)]; } }while(0)
  f32x16 pA0,pA1,pB0,pB1;
  int sl_prev=0,sl_cur=0,sl_next=SLOTB;
  #define ROT() do{sl_prev=sl_cur;sl_cur=sl_next;sl_next=(sl_next==(NSLOT-1)*SLOTB)?0:sl_next+SLOTB;}while(0)
  DMA_K(2,2*SLOTB);
  WAIT_BAR(3);
  qkt(pA0,pA1,Kbase,qr,negm,r32,hi);asm volatile("s_nop 15\n\ts_nop 7":"+v"(pA0),"+v"(pA1));CMASK(pA0,pA1,0);
  START(pA0,pA1);
  _Pragma("unroll") for(int r=0;r<16;++r)pA1[r]=__builtin_amdgcn_exp2f(pA1[r]);
  WAIT_BAR(0);
  DMA_K(3,0);DMA_V(1,SLOTB);
  ROT();
  kload8(kf,kp0+sl_cur);
  WAIT_BAR(2);
  s16x4 vlo[8],vhi[8]; u32x4 pw0,pw1,pw2,pw3;
  #define PKW(P,B) cvtpk_s(P[B],P[B+1])
  #define PAF(k) __builtin_bit_cast(bf16x8,pw##k)
  #define VFR(i) (bf16x8){vlo[i][0],vlo[i][1],vlo[i][2],vlo[i][3],vhi[i][0],vhi[i][1],vhi[i][2],vhi[i][3]}
  #define PIN(x) asm volatile("":"+v"(x))
  #define MX3(a,b,c) __builtin_fmaxf(__builtin_fmaxf((a),(b)),(c))
  #define GAPA(MF,A0,A1,A2,A3,W0,W1,PW) do{ MF; sacc+=A0; sacc+=A1; sacc+=A2; sacc+=A3; PIN(sacc); W0; W1; PIN(PW); SBAR(); }while(0)
  #define EX(v) __builtin_amdgcn_exp2f(v)
  #define GAPB(MF,X,B) do{ MF; X[B]=EX(X[B]); X[B+1]=EX(X[B+1]); X[B+2]=EX(X[B+2]); X[B+3]=EX(X[B+3]); PIN(X); SBAR(); }while(0)
  #define VRD(i) do{ vlo[i]=vtr(vp_+(((i)>>2)*4096+((i)&3)*1024)); vhi[i]=vtr(vp_+(((i)>>2)*4096+((i)&3)*1024+512)); }while(0)
  #define KRD(G,j) do{ if(G){ kload2(kf,kp0+sl_next,j); SBAR(); } }while(0)
  #define STEP(C0,C1,P0,P1,t,GK,GV,GL) do{ SBAR(); \
    const lds_cptr vp_=vp0+sl_prev; \
    VRD(0); SBAR(); float sacc=(P0[0]+P0[1]); \
    GAPA(C0=__builtin_amdgcn_mfma_f32_32x32x16_bf16(kf[0],qr[0],negm,0,0,0), P0[2],P0[3],P0[4],P0[5],     pw0[0]=PKW(P0,0), pw0[1]=PKW(P0,2), pw0); \
    VRD(4); SBAR(); GAPA(C1=__builtin_amdgcn_mfma_f32_32x32x16_bf16(kf[1],qr[0],negm,0,0,0), P0[6],P0[7],P0[8],P0[9],     pw0[2]=PKW(P0,4), pw0[3]=PKW(P0,6), pw0); \
    VRD(1); SBAR(); GAPA(C0=__builtin_amdgcn_mfma_f32_32x32x16_bf16(kf[2],qr[1],C0,0,0,0),   P0[10],P0[11],P0[12],P0[13], pw1[0]=PKW(P0,8), pw1[1]=PKW(P0,10), pw1); \
    VRD(5); SBAR(); GAPA(C1=__builtin_amdgcn_mfma_f32_32x32x16_bf16(kf[3],qr[1],C1,0,0,0),   P0[14],P0[15],P1[0],P1[1],   pw1[2]=PKW(P0,12),pw1[3]=PKW(P0,14), pw1); \
    VRD(2); SBAR(); GAPA(C0=__builtin_amdgcn_mfma_f32_32x32x16_bf16(kf[4],qr[2],C0,0,0,0),   P1[2],P1[3],P1[4],P1[5],     pw2[0]=PKW(P1,0), pw2[1]=PKW(P1,2), pw2); \
    VRD(6); SBAR(); GAPA(C1=__builtin_amdgcn_mfma_f32_32x32x16_bf16(kf[5],qr[2],C1,0,0,0),   P1[6],P1[7],P1[8],P1[9],     pw2[2]=PKW(P1,4), pw2[3]=PKW(P1,6), pw2); \
    VRD(3); SBAR(); GAPA(C0=__builtin_amdgcn_mfma_f32_32x32x16_bf16(kf[6],qr[3],C0,0,0,0),   P1[10],P1[11],P1[12],P1[13], pw3[0]=PKW(P1,8), pw3[1]=PKW(P1,10), pw3); \
    VRD(7); SBAR(); GAPA(C1=__builtin_amdgcn_mfma_f32_32x32x16_bf16(kf[7],qr[3],C1,0,0,0),   P1[14],P1[15],0.f,0.f,       pw3[2]=PKW(P1,12),pw3[3]=PKW(P1,14), pw3); \
    l_reg+=sacc; \
    if(GK){DMA_K((t)+3,sl_cur);} if(GV){DMA_V((t)+1,sl_next);} \
    CMASK(C0,C1,t); \
    { float a=MX3(C0[0],C0[1],C1[0]),b=MX3(C0[2],C0[3],C1[1]); a=MX3(a,C1[2],C1[3]); \
      _Pragma("unroll") for(int r=4;r<16;r+=4){a=MX3(a,C0[r],C0[r+1]);b=MX3(b,C0[r+2],C0[r+3]);a=MX3(a,C1[r],C1[r+1]);b=MX3(b,C1[r+2],C1[r+3]);} \
      float rm=__builtin_fmaxf(a,b); { auto rr=__builtin_amdgcn_permlane32_swap(__float_as_uint(rm),__float_as_uint(rm),false,false); rm=__builtin_fmaxf(__uint_as_float(rr[0]),__uint_as_float(rr[1])); } \
      resc=false; \
      if(__builtin_expect(__any(rm>(float)THRL),0)){ const float dl=__builtin_fmaxf(rm,0.f); mhat+=dl; \
        _Pragma("unroll") for(int r=0;r<16;++r){C0[r]-=dl;C1[r]-=dl;} \
        _Pragma("unroll") for(int r=0;r<16;++r)negm[r]=-mhat; asm volatile("":"+v"(negm)); \
        const float f=__builtin_amdgcn_exp2f(-dl); l_reg*=f; if(hi==0)wsf[r32]=f; resc=true; } } \
    SBAR(); \
    GAPB(o[0]=__builtin_amdgcn_mfma_f32_32x32x16_bf16(PAF(0),VFR(0),o[0],0,0,0), C0,0); \
    GAPB(o[1]=__builtin_amdgcn_mfma_f32_32x32x16_bf16(PAF(0),VFR(4),o[1],0,0,0), C0,4); \
    KRD(GL,0); GAPB(o[0]=__builtin_amdgcn_mfma_f32_32x32x16_bf16(PAF(1),VFR(1),o[0],0,0,0), C0,8); \
    KRD(GL,1); GAPB(o[1]=__builtin_amdgcn_mfma_f32_32x32x16_bf16(PAF(1),VFR(5),o[1],0,0,0), C0,12); \
    KRD(GL,2); GAPB(o[0]=__builtin_amdgcn_mfma_f32_32x32x16_bf16(PAF(2),VFR(2),o[0],0,0,0), C1,0); \
    KRD(GL,3); GAPB(o[1]=__builtin_amdgcn_mfma_f32_32x32x16_bf16(PAF(2),VFR(6),o[1],0,0,0), C1,4); \
    GAPB(o[0]=__builtin_amdgcn_mfma_f32_32x32x16_bf16(PAF(3),VFR(3),o[0],0,0,0), C1,8); \
    GAPB(o[1]=__builtin_amdgcn_mfma_f32_32x32x16_bf16(PAF(3),VFR(7),o[1],0,0,0), C1,12); \
    }while(0)
  int t=1;
  #undef CMASK
  #define CMASK(P0,P1,t) do{}while(0)
  for(;t+5<NT;t+=2){
    STEP(pB0,pB1,pA0,pA1,t,true,true,true);     WAIT_BAR(2); RESC(); ROT();
    STEP(pA0,pA1,pB0,pB1,t+1,true,true,true);   WAIT_BAR(2); RESC(); ROT();
  }
  #undef CMASK
  #define CMASK(P0,P1,t) do{int jb_=(t)-(NT-4); if(jb_>=0)cmask(P0,P1,jb_,qrel,hi);}while(0)
  #define ENDW(tt) do{ if((tt)+3<NT){WAIT_BAR(2);} else if((tt)+2<NT){WAIT_BAR(1);} else {WAIT_BAR(0);} }while(0)
  for(;t+1<NT;t+=2){
    STEP(pB0,pB1,pA0,pA1,t,(t+3<NT),(t+1<NT),(t+1<NT));       ENDW(t);   RESC(); ROT();
    STEP(pA0,pA1,pB0,pB1,t+1,(t+4<NT),(t+2<NT),(t+2<NT));     ENDW(t+1); RESC(); ROT();
  }
  STEP(pB0,pB1,pA0,pA1,NT-1,false,false,false); RESC();
  { float sacc=pB0[0]+pB0[1]; _Pragma("unroll") for(int r=2;r<16;++r)sacc+=pB0[r]; _Pragma("unroll") for(int r=0;r<16;++r)sacc+=pB1[r]; l_reg+=sacc;
    pw0=(u32x4){PKW(pB0,0),PKW(pB0,2),PKW(pB0,4),PKW(pB0,6)};pw1=(u32x4){PKW(pB0,8),PKW(pB0,10),PKW(pB0,12),PKW(pB0,14)};pw2=(u32x4){PKW(pB1,0),PKW(pB1,2),PKW(pB1,4),PKW(pB1,6)};pw3=(u32x4){PKW(pB1,8),PKW(pB1,10),PKW(pB1,12),PKW(pB1,14)};
    SBAR(); pv(o,vb0+sl_cur,PAF(0),PAF(1),PAF(2),PAF(3)); }
  #undef PKW
  #undef PAF
  #undef VFR
  #undef PIN
  #undef MX3
  #undef GAPA
  #undef GAPB
  #undef EX
  #undef VRD
  #undef KRD
  #undef STEP
  #undef ENDW
  {auto rr=__builtin_amdgcn_permlane32_swap(__float_as_uint(l_reg),__float_as_uint(l_reg),false,false);l_reg=__uint_as_float(rr[0])+__uint_as_float(rr[1]);}
  if(hi==0)wsf[32+r32]=l_reg;asm volatile("s_waitcnt lgkmcnt(0)":::"memory");
  float rli[16];
  #pragma unroll
  for(int r=0;r<16;++r)rli[r]=__builtin_amdgcn_rcpf(wsf[32+crow(r,hi)]);
  bf16*Ow=O+(rowbase+q0+wid*QBLK)*DMO+co;
  { bf16*stg=(bf16*)(shm+LDS_OST)+wid*2048;
    #pragma unroll
    for(int r=0;r<16;++r){const int orow=crow(r,hi);
      #pragma unroll
      for(int d0=0;d0<2;++d0)stg[orow*64+d0*32+r32]=__float2bfloat16(o[d0][r]*rli[r]);}
    asm volatile("s_waitcnt lgkmcnt(0)":::"memory");
    #pragma unroll
    for(int i=0;i<4;++i){const int row=i*8+(lane>>3),ch=lane&7; const u32x4 v=*(const u32x4*)(stg+row*64+ch*8); ATTN_STORE16(Ow+(long)row*DMO+ch*8,v);} }
  asm volatile("s_waitcnt lgkmcnt(0)\n\ts_barrier":::"memory");
  #undef DMA_K
  #undef DMA_V
  #undef CMASK
  #undef START
  #undef RESC
  #undef ROT
}
constexpr int ATTN_LDS_BYTES=LDS_BYTES;
#undef SBAR
#undef WAIT_BAR
}
namespace cg = cooperative_groups;
#define GAS __attribute__((address_space(1)))
#define LAS __attribute__((address_space(3)))
typedef unsigned short bf16;
typedef unsigned v4u __attribute__((ext_vector_type(4)));
typedef unsigned v2u __attribute__((ext_vector_type(2)));
typedef float f32x4 __attribute__((ext_vector_type(4)));
constexpr int NWAVES = 8, NTHR = 512;
constexpr int M = 16384, DMOD = 1024, SEQ = 4096, NIN = 6816, DFF = 2816, ZP = 1728;
constexpr size_t MiB = 1u << 20;
constexpr size_t WS_CTL = 0;
constexpr size_t WS_WGLU = 1 * MiB, WS_WB = WS_WGLU + MiB / 2, WS_WO = WS_WB + 3 * MiB, WS_WFI = WS_WO + 2 * MiB, WS_WFO = WS_WFI + 11 * MiB;
constexpr size_t WS_WX = 23 * MiB, WS_W1A = WS_WX, WS_W1B = WS_WX + 4 * MiB, WS_E = WS_WX, WS_WG = WS_WX;
constexpr size_t WS_VF = 40 * MiB, WS_US = 56 * MiB, WS_YA = 80 * MiB, WS_Z = 96 * MiB, WS_QB = 150 * MiB, WS_KB = 166 * MiB, WS_VB = 182 * MiB;
constexpr size_t WS_XNP = 198 * MiB, WS_O = 198 * MiB, WS_AB = 231 * MiB, WS_PT = 247 * MiB, WS_MT = 249 * MiB, WS_END = 256 * MiB;
constexpr size_t WS_XN = 150 * MiB, WS_YL = 182 * MiB, WS_P12 = 182 * MiB, WS_G0 = 214 * MiB, WS_H2N = 96 * MiB, WS_HID = 150 * MiB;
static_assert(WS_WFO + (size_t)1024 * 2816 * 2 <= WS_WX && WS_Z + (size_t)M * ZP * 2 <= WS_QB && WS_XNP + (size_t)4 * 4097 * 1024 * 2 <= WS_AB && WS_MT + (size_t)32 * 256 * 384 * 2 <= WS_END && WS_HID + (size_t)M * DFF * 2 <= WS_END, "ws map");
constexpr int LDS_BYTES = 148480; constexpr int LDS_XB = 147456; constexpr int CW_BAR = 4096;
constexpr float C2Q = 0.125f * 1.4426950408889634f;

__device__ __forceinline__ unsigned f2bf(float f) { unsigned u = __builtin_bit_cast(unsigned, f); return (u + 0x7fffu + ((u >> 16) & 1u)) >> 16; }
__device__ __forceinline__ float bf2f(unsigned b) { return __uint_as_float(b << 16); }
__device__ __forceinline__ void unpack8(const v4u w, float* f) {
    f[0] = __uint_as_float(w.x << 16); f[1] = __uint_as_float(w.x & 0xffff0000u); f[2] = __uint_as_float(w.y << 16); f[3] = __uint_as_float(w.y & 0xffff0000u);
    f[4] = __uint_as_float(w.z << 16); f[5] = __uint_as_float(w.z & 0xffff0000u); f[6] = __uint_as_float(w.w << 16); f[7] = __uint_as_float(w.w & 0xffff0000u); }
__device__ __forceinline__ v4u pack8(const float* f) { v4u w; w.x = pg8::cvt_pk_bf16(f[0], f[1]); w.y = pg8::cvt_pk_bf16(f[2], f[3]); w.z = pg8::cvt_pk_bf16(f[4], f[5]); w.w = pg8::cvt_pk_bf16(f[6], f[7]); return w; }
__device__ __forceinline__ float sigm(float x) { return __builtin_amdgcn_rcpf(1.f + __expf(-x)); }
__device__ __forceinline__ float tanh_f(float x) { return 1.f - 2.f * __builtin_amdgcn_rcpf(1.f + __expf(2.f * x)); }
__device__ __forceinline__ float wave_sum(float v) {
#pragma unroll
    for (int o = 1; o < 64; o <<= 1) v += __shfl_xor(v, o);
    return v; }
__device__ __forceinline__ float dppf(float x, const int ctrl) { return x; }
#define DPP_ADD(x, ctrl) ((x) + __builtin_bit_cast(float, __builtin_amdgcn_update_dpp(0, __builtin_bit_cast(int, (x)), (ctrl), 0xf, 0xf, true)))
__device__ __forceinline__ float row16_sum(float x) { x = DPP_ADD(x, 0xB1); x = DPP_ADD(x, 0x4E); x = DPP_ADD(x, 0x141); x = DPP_ADD(x, 0x140); return x; }

template <int MODE> struct Epi8 {
    static constexpr bool PERM = true, AFTER_DRAIN = false;
    bf16* O; int ldc; const bf16* X; const float* P;
    __device__ __forceinline__ void operator()(const pg8::f32x4 (&acc)[2][2][4][2], const pg8::Unit& u, int wr, int wc, int fr, int fq) const {
#pragma unroll
        for (int ai = 0; ai < 2; ++ai)
#pragma unroll
            for (int m = 0; m < 4; ++m) {
                const int row = u.pm * 256 + ai * 128 + wr * 64 + m * 16 + fr;
                if (MODE == 8) {
                    float o[8];
#pragma unroll
                    for (int i = 0; i < 8; ++i) { const float gte = acc[ai][0][m][i >> 2][i & 3], up = acc[ai][1][m][i >> 2][i & 3]; o[i] = gte * sigm(gte) * up; }
                    *(v4u*)(O + (size_t)row * DFF + u.pn * 128 + wc * 32 + 8 * fq) = pack8(o);
                } else {
#pragma unroll
                for (int bj = 0; bj < 2; ++bj) {
                    const int col = u.pn * 256 + bj * 128 + wc * 32 + 8 * fq;
                    float v[8];
#pragma unroll
                    for (int i = 0; i < 8; ++i) v[i] = acc[ai][bj][m][i >> 2][i & 3];
                    if (MODE == 0) { if (col < ldc) *(v4u*)(O + (size_t)row * ldc + col) = pack8(v); }
                    else if (MODE == 1) {
                        if (u.pn < 2) { const int g = col >> 4, cc = col & 15, b = row >> 12, t = row & 4095, ch = t >> 4, s = t & 15;
                            *(v4u*)((bf16*)X + ((size_t)(g * 1024 + b * 256 + ch) * 384 + s * 16 + cc)) = pack8(v); }
                        else { const int tsel = (col >> 9) - 1, cl = col & 511; *(v4u*)(O + (size_t)tsel * (8u * MiB) + (size_t)row * 512 + cl) = pack8(v); }
                    }
                    else if (MODE == 2) { if (bj == 0) *(v4u*)(O + (size_t)row * 384 + 256 + (col & 255)) = pack8(v); }
                    else if (MODE == 3) {
                        const int g = row >> 10, b = (row >> 8) & 3, ch = row & 255, cl = col & 255, t = cl >> 4, cc = cl & 15;
                        float uu[8]; unpack8(*(const v4u*)(X + (size_t)row * 384 + cl), uu);
#pragma unroll
                        for (int i = 0; i < 8; ++i) { const float y = v[i] + P[g * 16 + cc + i] * uu[i]; v[i] = y * sigm(1.5957691216f * (y + 0.044715f * y * y * y)); }
                        *(v4u*)(O + (size_t)(b * 4096 + ch * 16 + t) * 512 + g * 16 + cc) = pack8(v);
                    }
                    else if (MODE == 4) { float y[8]; unpack8(*(const v4u*)(X + (size_t)row * 512 + col), y);
#pragma unroll
                        for (int i = 0; i < 8; ++i) v[i] = y[i] * sigm(v[i]);
                        *(v4u*)(O + (size_t)row * 512 + col) = pack8(v); }
                    else if (MODE == 5) {
#pragma unroll
                        for (int i = 0; i < 8; ++i) v[i] = sigm(v[i]);
                        *(v4u*)(O + (size_t)row * 1024 + col) = pack8(v); }
                    else if (MODE == 10) {
#pragma unroll
                        for (int i = 0; i < 8; ++i) v[i] = sigm(v[i]);
                        *(v4u*)(O + (size_t)(col >> 10) * ((size_t)M * 1024) + (size_t)row * 1024 + (col & 1023)) = pack8(v); }
                    else if (MODE == 11) {
                        const int np = col >> 10, d = col & 1023; float gt[8], pp[8];
                        unpack8(*(const v4u*)(O + (size_t)np * ((size_t)M * 1024) + (size_t)row * 1024 + d), gt);
                        if (np) unpack8(*(const v4u*)(O + (size_t)row * 1024 + d), pp);
#pragma unroll
                        for (int i = 0; i < 8; ++i) v[i] = (np ? pp[i] : 0.f) + gt[i] * v[i];
                        *(v4u*)(O + (size_t)row * 1024 + d) = pack8(v); }
                    else if (MODE == 6 || MODE == 7) { float gt[8]; unpack8(*(const v4u*)(X + (size_t)row * 1024 + col), gt);
                        float pm_[8];
                        if (MODE == 7) unpack8(*(const v4u*)(O + (size_t)row * 1024 + col), pm_);
#pragma unroll
                        for (int i = 0; i < 8; ++i) v[i] = (MODE == 7 ? pm_[i] : 0.f) + gt[i] * v[i];
                        *(v4u*)(O + (size_t)row * 1024 + col) = pack8(v); }
                }
                }
            }
    }
};
struct EpiRes {
    static constexpr bool PERM = false, AFTER_DRAIN = false;
    const float* xin; float* xout;
    __device__ __forceinline__ void operator()(const pg8::f32x4 (&acc)[2][2][4][2], const pg8::Unit& u, int wr, int wc, int fr, int fq) const {
#pragma unroll
        for (int ai = 0; ai < 2; ++ai)
#pragma unroll
            for (int m = 0; m < 4; ++m) { const size_t off = (size_t)(u.pm * 256 + ai * 128 + wr * 64 + m * 16 + fr) * 1024 + u.pn * 256 + wc * 32 + 4 * fq;
#pragma unroll
                for (int bj = 0; bj < 2; ++bj)
#pragma unroll
                    for (int n = 0; n < 2; ++n) { const f32x4 b = *(const f32x4*)(xin + off + bj * 128 + n * 16); f32x4 o; o.x = b.x + acc[ai][bj][m][n][0]; o.y = b.y + acc[ai][bj][m][n][1]; o.z = b.z + acc[ai][bj][m][n][2]; o.w = b.w + acc[ai][bj][m][n][3];
                        *(f32x4*)(xout + off + bj * 128 + n * 16) = o; } }
    }
};
__device__ __forceinline__ pg8::Gemm mkgemm(const bf16* A, const bf16* Bt, int Mr, int N, int K, int lda, int ldb) {
    pg8::Gemm g; g.A = A; g.Bt = Bt; g.M = Mr; g.N = N; g.K = K; g.lda = lda; g.ldb = ldb; g.a_skip_shift = 30; g.a_skip_bytes = 0; g.kwrap = 1 << 20; g.wrap_bytes = 0; g.b_shift = 30; g.b_stride_bytes = 0; g.a_pn_shift = 30; g.a_pn_bytes = 0; return g; }
template <class Epi> __device__ __forceinline__ void run_gemm_w(int wave_hint, LAS unsigned char* lds, const pg8::Gemm& g, const Epi& E, int G, int c) {
    asm volatile("" : "+s"(G), "+s"(c));
    pg8::StaticOrder S; S.init(g.M, g.N, G, c);
    pg8::gemm_phase<Epi, pg8::StaticOrder, true, true>(lds, g, S, E, wave_hint);
}

struct PairOrder { pg8::StaticOrder S0;
    __device__ void init(int Mr, int G, int c) { S0.init(Mr, 1024, G, c); }
    __device__ bool next(int i, pg8::Unit& u) const { if (!S0.next(i >> 1, u)) return false; u.pn += 4 * (i & 1); return true; }
    __device__ __forceinline__ void a_ready(const pg8::Unit&) const {}
    __device__ __forceinline__ void done(const pg8::Unit&) const {} };
template <class Epi> __device__ __forceinline__ void run_gemm_pair_w(int wave_hint, LAS unsigned char* lds, const pg8::Gemm& g, const Epi& E, int G, int c) {
    asm volatile("" : "+s"(G), "+s"(c));
    PairOrder S; S.init(g.M, G, c);
    pg8::gemm_phase<Epi, PairOrder, true, true>(lds, g, S, E, wave_hint);
}

#define run_gemm(...) run_gemm_w(wave, __VA_ARGS__)
#define run_gemm_pair(...) run_gemm_pair_w(wave, __VA_ARGS__)
__device__ __forceinline__ void tr_item(const float* W, int ldw, int k0, int c0, bf16* WT, int ldt, int drow, int koff, const float* mu, int smode, LAS float* scr, int lane) {
    { const int kr = lane >> 3, nq = (lane & 7) * 4; f32x4 t[8];
#pragma unroll
      for (int i = 0; i < 8; ++i) t[i] = *(const f32x4*)(W + (size_t)(k0 + i * 8 + kr) * ldw + c0 + nq);
#pragma unroll
      for (int i = 0; i < 8; ++i) { LAS float* d = scr + (i * 8 + kr) * 33 + nq; d[0] = t[i].x; d[1] = t[i].y; d[2] = t[i].z; d[3] = t[i].w; } }
    asm volatile("s_waitcnt lgkmcnt(0)" ::: "memory");
    const int c = lane & 7;
#pragma unroll
    for (int j = 0; j < 4; ++j) { const int n = (lane >> 3) + 8 * j; const LAS float* s = scr + (8 * c) * 33 + n;
        float sc = 1.f; if (smode) { const float m_ = mu[n]; sc = (smode == 1) ? 1.f - m_ : m_; }
        v4u o; o.x = pg8::cvt_pk_bf16(s[0 * 33] * sc, s[1 * 33] * sc); o.y = pg8::cvt_pk_bf16(s[2 * 33] * sc, s[3 * 33] * sc); o.z = pg8::cvt_pk_bf16(s[4 * 33] * sc, s[5 * 33] * sc); o.w = pg8::cvt_pk_bf16(s[6 * 33] * sc, s[7 * 33] * sc);
        *(v4u*)(WT + (size_t)(drow + n) * ldt + koff + k0 + 8 * c) = o; }
    asm volatile("s_waitcnt lgkmcnt(0)" ::: "memory");
}
__device__ __forceinline__ void rms_row(const float* xrow, const float* gain, bf16* orow, int lane) {
    const f32x4* xr = (const f32x4*)xrow + lane; const f32x4* gr = (const f32x4*)gain + lane;
    f32x4 v[4]; float s = 0.f;
#pragma unroll
    for (int j = 0; j < 4; ++j) { v[j] = xr[64 * j]; s += (v[j].x * v[j].x + v[j].y * v[j].y) + (v[j].z * v[j].z + v[j].w * v[j].w); }
    const float rstd = 1.f / sqrtf(wave_sum(s) * (1.f / 1024.f) + 1e-6f);
    v2u* o8 = (v2u*)orow + lane;
#pragma unroll
    for (int j = 0; j < 4; ++j) { const f32x4 g = gr[64 * j]; v2u w; w.x = pg8::cvt_pk_bf16(v[j].x * rstd * g.x, v[j].y * rstd * g.y); w.y = pg8::cvt_pk_bf16(v[j].z * rstd * g.z, v[j].w * rstd * g.w); o8[64 * j] = w; }
}
struct Ptrs { const float* in[35]; float* out; unsigned char* ws; };

__device__ __forceinline__ void weight_items(const Ptrs& P, int L, int gw, int NGW, LAS float* scr, int lane, int it_lo, int it_hi) {
    unsigned char* ws = P.ws;
    const float* w_in = P.in[2] + (size_t)L * 1024 * NIN; const float* mu = P.in[16] + (size_t)L * 1696;
    constexpr int I1A = 16 * 64, I1B = 16 * 53, IGLU = 8 * 16, IWB = 8 * 32, IWO = 16 * 32, IFI = 16 * 176, IFO = 44 * 32;
    constexpr int NIT = I1A + 2 * I1B + IGLU + 3 * IWB + IWO + IFI + IFO;
    for (int it = it_lo + gw; it < it_hi; it += NGW) {
        int r = it;
        if (r < I1A) { const int kb = r / 64, nb = r % 64; tr_item(w_in, NIN, kb * 64, nb * 32, (bf16*)(ws + WS_W1A), 1024, nb * 32, 0, nullptr, 0, scr, lane); continue; } r -= I1A;
        if (r < I1B) { const int kb = r / 53, nb = r % 53; tr_item(w_in, NIN, kb * 64, 2048 + nb * 32, (bf16*)(ws + WS_W1B), 2048, nb * 32, 0, mu + nb * 32, 1, scr, lane); continue; } r -= I1B;
        if (r < I1B) { const int kb = r / 53, nb = r % 53; tr_item(w_in, NIN, kb * 64, 2048 + nb * 32, (bf16*)(ws + WS_W1B), 2048, nb * 32, 1024, mu + nb * 32, 2, scr, lane); continue; } r -= I1B;
        if (r < IGLU) { const int kb = r / 16, nb = r % 16; tr_item(P.in[11] + (size_t)L * 512 * 512, 512, kb * 64, nb * 32, (bf16*)(ws + WS_WGLU), 512, nb * 32, 0, nullptr, 0, scr, lane); continue; } r -= IGLU;
        if (r < 3 * IWB) { const int n = r / IWB, q = r % IWB, kb = q / 32, nb = q % 32; tr_item(P.in[30] + ((size_t)L * 3 + n) * 512 * 1024, 1024, kb * 64, nb * 32, (bf16*)(ws + WS_WB) + (size_t)n * 1024 * 512, 512, nb * 32, 0, nullptr, 0, scr, lane); continue; } r -= 3 * IWB;
        if (r < IWO) { const int kb = r / 32, nb = r % 32; tr_item(P.in[31] + (size_t)L * 1024 * 1024, 1024, kb * 64, nb * 32, (bf16*)(ws + WS_WO), 1024, nb * 32, 0, nullptr, 0, scr, lane); continue; } r -= IWO;
        if (r < IFI) { const int kb = r / 176, nb = r % 176; const int n0 = nb * 32; const int drow = (n0 < DFF) ? (n0 / 128) * 256 + (n0 % 128) : ((n0 - DFF) / 128) * 256 + 128 + ((n0 - DFF) % 128);
            tr_item(P.in[33] + (size_t)L * 1024 * 2 * DFF, 2 * DFF, kb * 64, n0, (bf16*)(ws + WS_WFI), 1024, drow, 0, nullptr, 0, scr, lane); continue; } r -= IFI;
        { const int kb = r / 32, nb = r % 32; tr_item(P.in[34] + (size_t)L * DFF * 1024, 1024, kb * 64, nb * 32, (bf16*)(ws + WS_WFO), DFF, nb * 32, 0, nullptr, 0, scr, lane); }
    }
}
__device__ __forceinline__ void s5_tables(const Ptrs& P, int L, int g, int part, LAS float* sm, int tid) {
    LAS float* apr = sm; LAS float* api = sm + 17 * 64; LAS float* bbr = sm + 2 * 17 * 64; LAS float* bbi = bbr + 1024; LAS float* Ks = bbi + 1024;
    const float* lre = P.in[3] + (size_t)L * 2048; const float* lim = P.in[4] + (size_t)L * 2048; const float* ldt = P.in[5] + L * 32;
    const float* bre = P.in[6] + (size_t)L * 32768; const float* bim = P.in[7] + (size_t)L * 32768; const float* cre = P.in[8] + (size_t)L * 32768; const float* cim = P.in[9] + (size_t)L * 32768;
    if (tid < 64) { const int p = tid; const float dt = __expf(ldt[g]); const float lr = lre[g * 64 + p], li = lim[g * 64 + p];
        for (int j = 0; j <= 16; ++j) { const double ang = (double)j * (double)li * (double)dt * 0.15915494309189535; const float rev = (float)(ang - __builtin_floor(ang));
            const float mg = __expf((float)j * lr * dt); apr[j * 64 + p] = mg * __builtin_amdgcn_cosf(rev); api[j * 64 + p] = mg * __builtin_amdgcn_sinf(rev); }
        const float ar = apr[64 + p], ai = api[64 + p], den = lr * lr + li * li, nr = ar - 1.f, kr = (nr * lr + ai * li) / den, ki = (ai * lr - nr * li) / den;
        for (int c = 0; c < 16; ++c) { const float br = bre[(g * 64 + p) * 16 + c], bi = bim[(g * 64 + p) * 16 + c]; bbr[p * 16 + c] = kr * br - ki * bi; bbi[p * 16 + c] = kr * bi + ki * br; } }
    __syncthreads();
    { const int j = tid >> 5, cl = tid & 31, cp = 2 * part + (cl >> 4), c = cl & 15; float s = 0.f;
        for (int p = 0; p < 64; ++p) { const float tr = apr[j * 64 + p] * bbr[p * 16 + c] - api[j * 64 + p] * bbi[p * 16 + c], ti = apr[j * 64 + p] * bbi[p * 16 + c] + api[j * 64 + p] * bbr[p * 16 + c];
            s += cre[(g * 16 + cp) * 64 + p] * tr - cim[(g * 16 + cp) * 64 + p] * ti; }
        Ks[j * 32 + cl] = s; }
    __syncthreads();
    bf16* Mt = (bf16*)(P.ws + WS_MT) + (size_t)g * 256 * 384; bf16* Pt = (bf16*)(P.ws + WS_PT) + (size_t)g * 128 * 256;
    for (int idx = tid; idx < 32 * 48; idx += NTHR) { const int rl = idx / 48, kg = idx % 48, t = rl >> 1, cpl = rl & 1, cp = 2 * part + cpl, n = t * 16 + cp; float v[8];
        if (kg < 32) { const int s = kg >> 1, c0 = (kg & 1) * 8;
#pragma unroll
            for (int i = 0; i < 8; ++i) v[i] = (s <= t) ? Ks[(t - s) * 32 + cpl * 16 + c0 + i] : 0.f; }
        else {
#pragma unroll
            for (int i = 0; i < 8; ++i) { const int jj = (kg - 32) * 8 + i, p = jj & 63; const float cr = cre[(g * 16 + cp) * 64 + p], ci = cim[(g * 16 + cp) * 64 + p], ar = apr[(t + 1) * 64 + p], ai = api[(t + 1) * 64 + p];
                v[i] = (jj < 64) ? (cr * ar - ci * ai) : -(cr * ai + ci * ar); } }
        *(v4u*)(Mt + (size_t)n * 384 + kg * 8) = pack8(v); }
    { const int jj = part * 16 + (tid >> 5), kg = tid & 31, p = jj & 63, s = kg >> 1, c0 = (kg & 1) * 8; float v[8];
        const float ar = apr[(15 - s) * 64 + p], ai = api[(15 - s) * 64 + p];
#pragma unroll
        for (int i = 0; i < 8; ++i) { const float br = bbr[p * 16 + c0 + i], bi = bbi[p * 16 + c0 + i]; v[i] = (jj < 64) ? (ar * br - ai * bi) : (ar * bi + ai * br); }
        *(v4u*)(Pt + (size_t)jj * 256 + kg * 8) = pack8(v); }
    __syncthreads();
}
__device__ __forceinline__ void s5_chunk_scan(const Ptrs& P, int L, int gidx) {
    const int p = gidx & 63, g = (gidx >> 6) & 31, b = gidx >> 11;
    const float dt = __expf(P.in[5][L * 32 + g]); const float lr = P.in[3][(size_t)L * 2048 + g * 64 + p], li = P.in[4][(size_t)L * 2048 + g * 64 + p];
    const double ang = 16.0 * (double)li * (double)dt * 0.15915494309189535; const float rev = (float)(ang - __builtin_floor(ang)); const float mg = __expf(16.f * lr * dt);
    const float ar = mg * __builtin_amdgcn_cosf(rev), ai = mg * __builtin_amdgcn_sinf(rev);
    bf16* base = (bf16*)(P.ws + WS_US) + (size_t)(g * 1024 + b * 256) * 384 + 256 + p;
    float xr = 0.f, xi = 0.f;
#pragma unroll 8
    for (int c = 0; c < 256; ++c) { bf16* q = base + (size_t)c * 384; const float sr = bf2f(q[0]), si = bf2f(q[64]); q[0] = (bf16)f2bf(xr); q[64] = (bf16)f2bf(xi);
        const float nr = ar * xr - ai * xi + sr, ni = ar * xi + ai * xr + si; xr = nr; xi = ni; }
}

typedef float f2p __attribute__((ext_vector_type(2)));
#define RDL(x, l) __builtin_bit_cast(float, __builtin_amdgcn_readlane(__builtin_bit_cast(int, (x)), (l)))
#define LORA2(acc, tA, tB, off, wptr) do { _Pragma("unroll") for (int j_ = 0; j_ < 32; ++j_) { const f2p s_ = {RDL(tA, j_ + (off)), RDL(tB, j_ + (off))}; \
        float w8_[8]; unpack8(*(const LAS v4u*)((wptr) + j_ * 512 + c0), w8_); \
        _Pragma("unroll") for (int i_ = 0; i_ < 8; ++i_) acc[i_] = __builtin_elementwise_fma((f2p){w8_[i_], w8_[i_]}, s_, acc[i_]); \
 } } while (0)
#define LORA2F(acc, tA, tB, off, wptr) do { _Pragma("unroll") for (int j_ = 0; j_ < 32; ++j_) { const f2p s_ = {RDL(tA, j_ + (off)), RDL(tB, j_ + (off))}; \
        float w8_[8]; unpack8(*(const LAS v4u*)((wptr) + j_ * 512 + c0), w8_); \
        _Pragma("unroll") for (int i_ = 0; i_ < 8; ++i_) acc[i_] = __builtin_elementwise_fma((f2p){w8_[i_], w8_[i_]}, s_, acc[i_]); \
        if ((j_ & 3) == 3) asm volatile("" ::: "memory"); } } while (0)
__device__ __forceinline__ void prep_phase(const Ptrs& P, int L, LAS unsigned char* lds, int gw, int NGW, int tid, int wave, int lane) {
    asm volatile("" : "+v"(tid), "+v"(lane)); asm volatile("" : "+s"(wave));
    unsigned char* ws = P.ws;
    LAS bf16* w2s = (LAS bf16*)lds; LAS bf16* a2s = w2s + 32 * 512; LAS bf16* v2s = a2s + 32 * 512; LAS unsigned* v1s = (LAS unsigned*)(v2s + 32 * 512);
    LAS unsigned* vrow = (LAS unsigned*)(lds + 131072) + wave * 512;
    const float* w2 = P.in[18] + (size_t)L * 32 * 512; const float* a2 = P.in[20] + (size_t)L * 32 * 512;
    for (int i = tid; i < 32 * 512; i += NTHR) { w2s[i] = (bf16)f2bf(w2[i]); a2s[i] = (bf16)f2bf(a2[i]); }
    if (L == 1) { const float* v2 = P.in[29]; const float* v1 = P.in[28];
        for (int i = tid; i < 32 * 512; i += NTHR) v2s[i] = (bf16)f2bf(v2[i]);
        for (int i = tid; i < 256 * 32; i += NTHR) { const int c2 = i >> 5, j = i & 31; v1s[i] = f2bf(v1[(2 * c2) * 32 + j]) | (f2bf(v1[(2 * c2 + 1) * 32 + j]) << 16); } }
    __syncthreads();
    const int c0 = lane * 8;
    float qg[8], kg[8], w0r[8], a0r[8], v0r[8];
#pragma unroll
    for (int i = 0; i < 8; ++i) { qg[i] = P.in[12][L * 128 + ((c0 + i) & 127)] * C2Q; kg[i] = P.in[13][L * 128 + ((c0 + i) & 127)]; w0r[i] = P.in[17][L * 512 + c0 + i]; a0r[i] = P.in[19][L * 512 + c0 + i]; v0r[i] = (L == 1) ? P.in[27][c0 + i] : 0.f; }
    for (int pr = gw; pr < M / 2; pr += NGW) {
        const size_t m0 = (size_t)pr * 2;
        float tz[2];
#pragma unroll
        for (int t = 0; t < 2; ++t) {
            const size_t m = m0 + t;
            bf16* qp = (bf16*)(ws + WS_QB) + m * 512 + c0; bf16* kp = (bf16*)(ws + WS_KB) + m * 512 + c0;
            float q[8], k[8]; unpack8(*(const v4u*)qp, q); unpack8(*(const v4u*)kp, k);
            float sq = 0.f, sk = 0.f;
#pragma unroll
            for (int i = 0; i < 8; ++i) { sq += q[i] * q[i]; sk += k[i] * k[i]; }
            sq += __shfl_xor(sq, 1); sq += __shfl_xor(sq, 2); sq += __shfl_xor(sq, 4); sk += __shfl_xor(sk, 1); sk += __shfl_xor(sk, 2); sk += __shfl_xor(sk, 4);
            const float rq = 1.f / sqrtf(sq * (1.f / 64.f) + 1e-6f), rk = 1.f / sqrtf(sk * (1.f / 64.f) + 1e-6f);
#pragma unroll
            for (int i = 0; i < 8; ++i) { q[i] *= rq * qg[i]; k[i] *= rk * kg[i]; }
            *(v4u*)qp = pack8(q); *(v4u*)kp = pack8(k);
            const float zz = bf2f(((const bf16*)(ws + WS_Z))[m * ZP + 1536 + lane]);
            tz[t] = (lane < 32) ? tanh_f(zz) : zz;
        }
        f2p aw[8], aa[8];
#pragma unroll
        for (int i = 0; i < 8; ++i) { aw[i] = (f2p){w0r[i], w0r[i]}; aa[i] = (f2p){a0r[i], a0r[i]}; }
        LORA2(aw, tz[0], tz[1], 0, w2s);
        LORA2(aa, tz[0], tz[1], 32, a2s);
#pragma unroll
        for (int t = 0; t < 2; ++t) { float e8[8], a8[8];
#pragma unroll
            for (int i = 0; i < 8; ++i) { e8[i] = 0.6065306597f * sigm(t ? aw[i].y : aw[i].x); a8[i] = sigm(t ? aa[i].y : aa[i].x); }
            *(v4u*)((bf16*)(ws + WS_E) + (m0 + t) * 512 + c0) = pack8(e8); *(v4u*)((bf16*)(ws + WS_AB) + (m0 + t) * 512 + c0) = pack8(a8); }
        bf16* zr0 = (bf16*)(ws + WS_Z) + m0 * ZP; bf16* zr1 = zr0 + ZP;
        const v4u vA = *(const v4u*)(zr0 + 1024 + c0), vB = *(const v4u*)(zr1 + 1024 + c0);
        if (L == 0) { *(v4u*)((bf16*)(ws + WS_VF) + m0 * 512 + c0) = vA; *(v4u*)((bf16*)(ws + WS_VF) + (m0 + 1) * 512 + c0) = vB; }
        else {
            *(LAS v4u*)(vrow + c0) = (v4u){(vA.x & 0xffffu) | (vB.x << 16), (vA.x >> 16) | (vB.x & 0xffff0000u), (vA.y & 0xffffu) | (vB.y << 16), (vA.y >> 16) | (vB.y & 0xffff0000u)};
            *(LAS v4u*)(vrow + c0 + 4) = (v4u){(vA.z & 0xffffu) | (vB.z << 16), (vA.z >> 16) | (vB.z & 0xffff0000u), (vA.w & 0xffffu) | (vB.w << 16), (vA.w >> 16) | (vB.w & 0xffff0000u)};
            asm volatile("s_waitcnt lgkmcnt(0)" ::: "memory");
            const int j = lane & 31, hf = lane >> 5; f2p s = {0.f, 0.f};
#pragma unroll 8
            for (int c2 = 0; c2 < 128; ++c2) { const unsigned pk = v1s[(hf * 128 + c2) * 32 + j]; const v2u d = *(const LAS v2u*)(vrow + hf * 256 + 2 * c2);
                const float wl = __uint_as_float(pk << 16), wh = __uint_as_float(pk & 0xffff0000u);
                s = __builtin_elementwise_fma((f2p){__uint_as_float(d.x << 16), __uint_as_float(d.x & 0xffff0000u)}, (f2p){wl, wl}, s);
                s = __builtin_elementwise_fma((f2p){__uint_as_float(d.y << 16), __uint_as_float(d.y & 0xffff0000u)}, (f2p){wh, wh}, s); }
            float sx = s.x + __shfl_xor(s.x, 32), sy = s.y + __shfl_xor(s.y, 32);
            f2p am[8];
#pragma unroll
            for (int i = 0; i < 8; ++i) am[i] = (f2p){v0r[i], v0r[i]};
            LORA2(am, sx, sy, 0, v2s);
            float va[8], vb[8], fa[8], fb[8]; unpack8(vA, va); unpack8(vB, vb);
            unpack8(*(const v4u*)((const bf16*)(ws + WS_VF) + m0 * 512 + c0), fa); unpack8(*(const v4u*)((const bf16*)(ws + WS_VF) + (m0 + 1) * 512 + c0), fb);
#pragma unroll
            for (int i = 0; i < 8; ++i) { va[i] = va[i] + (fa[i] - va[i]) * sigm(am[i].x); vb[i] = vb[i] + (fb[i] - vb[i]) * sigm(am[i].y); }
            *(v4u*)(zr0 + 1024 + c0) = pack8(va); *(v4u*)(zr1 + 1024 + c0) = pack8(vb);
            asm volatile("s_waitcnt lgkmcnt(0)" ::: "memory"); }
    }
    __syncthreads();
}

__device__ __forceinline__ void rwkv_unit(const Ptrs& P, int L, LAS unsigned char* lds, int b, int h, int qr, int tid, int wave, int lane) {
    constexpr int T = 32, TOKF = 336;
    asm volatile("" : "+v"(tid), "+v"(lane)); asm volatile("" : "+s"(wave));
    unsigned char* ws = P.ws;
    const bf16* Z = (const bf16*)(ws + WS_Z); const bf16* AB = (const bf16*)(ws + WS_AB); const bf16* EB = (const bf16*)(ws + WS_E); bf16* YC = (bf16*)(ws + WS_YA);
    LAS float* buf0 = (LAS float*)lds; LAS float* buf1 = buf0 + T * TOKF;
    const bool producer = wave >= 4;
    const int pt = tid - 256, tok = pt >> 3, ks = (pt & 7) * 8;
    float kkk[8], kka[8];
    if (producer) {
#pragma unroll
        for (int i = 0; i < 8; ++i) { kkk[i] = P.in[22][L * 512 + h * 64 + ks + i]; kka[i] = P.in[23][L * 512 + h * 64 + ks + i]; } }
    const int row = wave * 4 + (lane >> 4), kq = lane & 15;
    typedef float f2s __attribute__((ext_vector_type(2)));
    f2s Slo = {0.f, 0.f}, Shi = {0.f, 0.f};
    const size_t m00 = (size_t)b * SEQ;
#define RW_PRODUCE(c, buf) do { const size_t m_ = m00 + (size_t)(c) * T + tok; const bf16* zr_ = Z + m_ * ZP; \
        float r_[8], k_[8], a_[8], e_[8]; unpack8(*(const v4u*)(zr_ + h * 64 + ks), r_); unpack8(*(const v4u*)(zr_ + 512 + h * 64 + ks), k_); \
        unpack8(*(const v4u*)(AB + m_ * 512 + h * 64 + ks), a_); unpack8(*(const v4u*)(EB + m_ * 512 + h * 64 + ks), e_); \
        float kk_[8], ss_ = 0.f; _Pragma("unroll") for (int i = 0; i < 8; ++i) { kk_[i] = k_[i] * kkk[i]; ss_ += kk_[i] * kk_[i]; } \
        ss_ += __shfl_xor(ss_, 1); ss_ += __shfl_xor(ss_, 2); ss_ += __shfl_xor(ss_, 4); const float inv_ = 1.f / fmaxf(sqrtf(ss_), 1e-12f); \
        LAS float* d_ = (buf) + tok * TOKF + ks; f32x4 o0, o1; \
        o0 = (f32x4){-kk_[0] * inv_, -kk_[1] * inv_, -kk_[2] * inv_, -kk_[3] * inv_}; o1 = (f32x4){-kk_[4] * inv_, -kk_[5] * inv_, -kk_[6] * inv_, -kk_[7] * inv_}; *(LAS f32x4*)(d_) = o0; *(LAS f32x4*)(d_ + 4) = o1; \
        o0 = (f32x4){kk_[0] * inv_ * a_[0], kk_[1] * inv_ * a_[1], kk_[2] * inv_ * a_[2], kk_[3] * inv_ * a_[3]}; o1 = (f32x4){kk_[4] * inv_ * a_[4], kk_[5] * inv_ * a_[5], kk_[6] * inv_ * a_[6], kk_[7] * inv_ * a_[7]}; *(LAS f32x4*)(d_ + 64) = o0; *(LAS f32x4*)(d_ + 68) = o1; \
        o0 = (f32x4){__expf(-e_[0]), __expf(-e_[1]), __expf(-e_[2]), __expf(-e_[3])}; o1 = (f32x4){__expf(-e_[4]), __expf(-e_[5]), __expf(-e_[6]), __expf(-e_[7])}; *(LAS f32x4*)(d_ + 128) = o0; *(LAS f32x4*)(d_ + 132) = o1; \
        o0 = (f32x4){k_[0] * (1.f + (a_[0] - 1.f) * kka[0]), k_[1] * (1.f + (a_[1] - 1.f) * kka[1]), k_[2] * (1.f + (a_[2] - 1.f) * kka[2]), k_[3] * (1.f + (a_[3] - 1.f) * kka[3])}; \
        o1 = (f32x4){k_[4] * (1.f + (a_[4] - 1.f) * kka[4]), k_[5] * (1.f + (a_[5] - 1.f) * kka[5]), k_[6] * (1.f + (a_[6] - 1.f) * kka[6]), k_[7] * (1.f + (a_[7] - 1.f) * kka[7])}; *(LAS f32x4*)(d_ + 192) = o0; *(LAS f32x4*)(d_ + 196) = o1; \
        o0 = (f32x4){r_[0], r_[1], r_[2], r_[3]}; o1 = (f32x4){r_[4], r_[5], r_[6], r_[7]}; *(LAS f32x4*)(d_ + 256) = o0; *(LAS f32x4*)(d_ + 260) = o1; \
        if ((pt & 7) < 2) { float v_[8]; unpack8(*(const v4u*)(zr_ + 1024 + h * 64 + qr * 16 + ks), v_); LAS float* dv_ = (buf) + tok * TOKF + 320 + ks; \
            *(LAS f32x4*)(dv_) = (f32x4){v_[0], v_[1], v_[2], v_[3]}; *(LAS f32x4*)(dv_ + 4) = (f32x4){v_[4], v_[5], v_[6], v_[7]}; } } while (0)
    if (producer) RW_PRODUCE(0, buf0);
    __syncthreads();
    if (!producer) __builtin_amdgcn_s_setprio(3);
    for (int c = 0; c < SEQ / T; ++c) {
        LAS float* cur = (c & 1) ? buf1 : buf0; LAS float* nxt = (c & 1) ? buf0 : buf1;
        if (producer) { if (c + 1 < SEQ / T) RW_PRODUCE(c + 1, nxt); }
        else {
            typedef float f2 __attribute__((ext_vector_type(2)));
            bf16* yo = YC + (m00 + (size_t)c * T) * 512 + h * 64 + qr * 16 + row;
            const LAS float* bs = cur + kq * 4; const LAS float* vs = cur + 320 + row;
            f32x4 a4 = *(const LAS f32x4*)(bs), b4 = *(const LAS f32x4*)(bs + 64), w4 = *(const LAS f32x4*)(bs + 128), k4 = *(const LAS f32x4*)(bs + 192), r4 = *(const LAS f32x4*)(bs + 256);
            float vv = vs[0]; float yp = 0.f, ykeep = 0.f;
#pragma unroll
            for (int t = 0; t < T; ++t) {
                const LAS float* nb = bs + (t + 1) * TOKF;
                const f32x4 na4 = *(const LAS f32x4*)(nb), nb4 = *(const LAS f32x4*)(nb + 64), nw4 = *(const LAS f32x4*)(nb + 128), nk4 = *(const LAS f32x4*)(nb + 192), nr4 = *(const LAS f32x4*)(nb + 256);
                const float nvv = vs[(t + 1) * TOKF];
                f2 p = Slo * (f2){a4.x, a4.y}; p = __builtin_elementwise_fma(Shi, (f2){a4.z, a4.w}, p);
                float sa = p.x + p.y;
                sa = DPP_ADD(sa, 0xB1); yp = DPP_ADD(yp, 0xB1); sa = DPP_ADD(sa, 0x4E); yp = DPP_ADD(yp, 0x4E); sa = DPP_ADD(sa, 0x141); yp = DPP_ADD(yp, 0x141); sa = DPP_ADD(sa, 0x140); yp = DPP_ADD(yp, 0x140);
                if (t > 0) ykeep = __builtin_bit_cast(float, __builtin_amdgcn_update_dpp(__builtin_bit_cast(int, yp), __builtin_bit_cast(int, ykeep), 0x111, 0xf, 0xf, false));
                if (t == 16) yo[(size_t)(15 - kq) * 512] = (bf16)f2bf(ykeep);
                const f2 sa2 = {sa, sa}, vv2 = {vv, vv};
                f2 tl = (f2){k4.x, k4.y} * vv2, th = (f2){k4.z, k4.w} * vv2;
                tl = __builtin_elementwise_fma((f2){b4.x, b4.y}, sa2, tl); th = __builtin_elementwise_fma((f2){b4.z, b4.w}, sa2, th);
                Slo = __builtin_elementwise_fma(Slo, (f2){w4.x, w4.y}, tl); Shi = __builtin_elementwise_fma(Shi, (f2){w4.z, w4.w}, th);
                f2 q = Slo * (f2){r4.x, r4.y}; q = __builtin_elementwise_fma(Shi, (f2){r4.z, r4.w}, q);
                yp = q.x + q.y;
                a4 = na4; b4 = nb4; w4 = nw4; k4 = nk4; r4 = nr4; vv = nvv; }
            yp = row16_sum(yp);
            ykeep = __builtin_bit_cast(float, __builtin_amdgcn_update_dpp(__builtin_bit_cast(int, yp), __builtin_bit_cast(int, ykeep), 0x111, 0xf, 0xf, false));
            yo[(size_t)(31 - kq) * 512] = (bf16)f2bf(ykeep);
        }
        __syncthreads();
    }
    __builtin_amdgcn_s_setprio(0);
#undef RW_PRODUCE
}

__device__ __forceinline__ void post_phase(const Ptrs& P, int L, LAS unsigned char* lds, int gw, int NGW, int tid, int wave, int lane) {
    asm volatile("" : "+v"(tid), "+v"(lane)); asm volatile("" : "+s"(wave));
    unsigned char* ws = P.ws;
    LAS bf16* g2s = (LAS bf16*)lds;
    const float* g2 = P.in[21] + (size_t)L * 96 * 512;
    for (int i = tid; i < 96 * 512; i += NTHR) g2s[i] = (bf16)f2bf(g2[i]);
    __syncthreads();
    const float lam_init = (L == 0) ? 0.2f : 0.35550906f;
    const float* lv = P.in[14] + L * 256;
    const float lam = __expf(wave_sum(lv[lane] * lv[64 + lane])) - __expf(wave_sum(lv[128 + lane] * lv[192 + lane])) + lam_init;
    const int c0 = lane * 8;
    float sg[8], lng[8], lnb[8], rk[8], ka[8];
#pragma unroll
    for (int i = 0; i < 8; ++i) { sg[i] = P.in[15][L * 128 + ((c0 + i) & 127)] * (1.f - lam_init); lng[i] = P.in[25][L * 512 + c0 + i]; lnb[i] = P.in[26][L * 512 + c0 + i]; rk[i] = P.in[24][L * 512 + c0 + i]; ka[i] = P.in[23][L * 512 + c0 + i]; }
    const float* xsrc = (L == 0) ? P.in[0] : P.out;
    for (int pr = gw; pr < M / 2; pr += NGW) {
        const size_t m0 = (size_t)pr * 2;
        float z0[2], z1[2], z2[2];
#pragma unroll
        for (int t = 0; t < 2; ++t) { const bf16* zr = (const bf16*)(ws + WS_Z) + (m0 + t) * ZP;
            z0[t] = sigm(bf2f(zr[1600 + (lane & 31)])); z1[t] = sigm(bf2f(zr[1632 + (lane & 31)])); z2[t] = sigm(bf2f(zr[1664 + (lane & 31)])); }
        f2p gacc[8];
#pragma unroll
        for (int i = 0; i < 8; ++i) gacc[i] = (f2p){0.f, 0.f};
        LORA2F(gacc, z0[0], z0[1], 0, g2s);
        LORA2F(gacc, z1[0], z1[1], 0, g2s + 32 * 512);
        LORA2F(gacc, z2[0], z2[1], 0, g2s + 64 * 512);
#pragma unroll
        for (int t = 0; t < 2; ++t) {
        const size_t m = m0 + t;
        bf16* zr = (bf16*)(ws + WS_Z) + m * ZP;
        float r[8], k[8], v[8], a[8], yr[8];
        unpack8(*(const v4u*)(zr + c0), r); unpack8(*(const v4u*)(zr + 512 + c0), k); unpack8(*(const v4u*)(zr + 1024 + c0), v);
        unpack8(*(const v4u*)((const bf16*)(ws + WS_AB) + m * 512 + c0), a); unpack8(*(const v4u*)((const bf16*)(ws + WS_YA) + m * 512 + c0), yr);
        float s1 = 0.f;
#pragma unroll
        for (int i = 0; i < 8; ++i) s1 += yr[i];
        s1 += __shfl_xor(s1, 1); s1 += __shfl_xor(s1, 2); s1 += __shfl_xor(s1, 4); const float mean = s1 * (1.f / 64.f);
        float s2 = 0.f, bd = 0.f;
#pragma unroll
        for (int i = 0; i < 8; ++i) { const float d = yr[i] - mean; s2 += d * d; bd += r[i] * (k[i] * (1.f + (a[i] - 1.f) * ka[i])) * rk[i]; }
        s2 += __shfl_xor(s2, 1); s2 += __shfl_xor(s2, 2); s2 += __shfl_xor(s2, 4); bd += __shfl_xor(bd, 1); bd += __shfl_xor(bd, 2); bd += __shfl_xor(bd, 4);
        const float rstd = 1.f / sqrtf(s2 * (1.f / 64.f) + 64e-5f);
        float yc[8];
#pragma unroll
        for (int i = 0; i < 8; ++i) yc[i] = ((yr[i] - mean) * rstd * lng[i] + lnb[i] + bd * v[i]) * (t ? gacc[i].y : gacc[i].x);
        const int hd = lane >> 4, j0 = (lane & 15) * 8; const bf16* orow = (const bf16*)(ws + WS_O) + m * 1024 + hd * 256 + j0;
        float o0[8], o1[8]; unpack8(*(const v4u*)orow, o0); unpack8(*(const v4u*)(orow + 128), o1);
        float so = 0.f;
#pragma unroll
        for (int i = 0; i < 8; ++i) { o0[i] = o0[i] - lam * o1[i]; so += o0[i] * o0[i]; }
        so += __shfl_xor(so, 1); so += __shfl_xor(so, 2); so += __shfl_xor(so, 4); so += __shfl_xor(so, 8);
        const float ro = 1.f / sqrtf(so * (1.f / 128.f) + 1e-5f);
#pragma unroll
        for (int i = 0; i < 8; ++i) o0[i] *= ro * sg[i];
        *(v4u*)(zr + c0) = pack8(yc); *(v4u*)(zr + 512 + c0) = pack8(o0);
        }
    }
    __syncthreads();
}


__device__ __forceinline__ void dump_stage(const Ptrs& P, int k, int blk, int G, int tid) {
    unsigned char* ws = P.ws; float* out = P.out;
    for (size_t i = (size_t)blk * NTHR + tid; i < (size_t)M * 1024; i += (size_t)G * NTHR) {
        const size_t m = i >> 10; const int c = (int)(i & 1023); float v = 0.f;
        const bf16* Z = (const bf16*)(ws + WS_Z); const bf16* US = (const bf16*)(ws + WS_US);
        if (k == 1) v = bf2f(Z[m * ZP + c]) + bf2f(Z[m * ZP + 704 + c]) + bf2f(((const bf16*)(ws + WS_QB))[m * 512 + (c & 511)]) + bf2f(((const bf16*)(ws + WS_KB))[m * 512 + (c & 511)]) + bf2f(((const bf16*)(ws + WS_VB))[m * 512 + (c & 511)]) + bf2f(US[m * 768 + (c % 768)]);
        else if (k == 2) {
#if !defined(DSEL) || DSEL==1
            v += bf2f(US[m * 768 + (c % 768)]);
#endif
#if !defined(DSEL) || DSEL==2
            v += bf2f(((const bf16*)(ws + WS_E))[m * 512 + (c & 511)]) + bf2f(((const bf16*)(ws + WS_AB))[m * 512 + (c & 511)]);
#endif
#if !defined(DSEL) || DSEL==3
            v += bf2f(((const bf16*)(ws + WS_QB))[m * 512 + (c & 511)]) + bf2f(((const bf16*)(ws + WS_KB))[m * 512 + (c & 511)]);
#endif
#if !defined(DSEL) || DSEL==4
            v += bf2f(Z[m * ZP + 1024 + (c & 511)]) + bf2f(((const bf16*)(ws + WS_VF))[m * 512 + (c & 511)]);
#endif
        }
        else if (k == 3) v = bf2f(((const bf16*)(ws + WS_O))[m * 1024 + c]) + bf2f(((const bf16*)(ws + WS_YA))[m * 512 + (c & 511)]) + bf2f(US[m * 768 + (c % 768)]);
        else if (k == 4) v = bf2f(Z[m * ZP + c]) + bf2f(((const bf16*)(ws + WS_XN))[m * 1024 + c]) + bf2f(((const bf16*)(ws + WS_YL))[m * 512 + (c & 511)]);
        else if (k == 5) v = bf2f(((const bf16*)(ws + WS_YA))[m * 512 + (c & 511)]);
        else if (k == 6) v = bf2f(((const bf16*)(ws + WS_P12))[m * 1024 + c]);
        else if (k == 9) v = bf2f(((const bf16*)(ws + WS_HID))[m * DFF + c]) + bf2f(((const bf16*)(ws + WS_HID))[m * DFF + 1024 + c]) + bf2f(((const bf16*)(ws + WS_H2N))[m * 1024 + c]);
        out[i] = v;
    }
}
#define XB_TMO      128
#define XB_XCNT(j)  (256  + 64 * (j))
#define XB_XSUB(j)  (1280 + 64 * (j))
#define XB_XGEN(j)  (2304 + 64 * (j))
#define XB_TOP      3328
#define XB_TOPGEN   3392
#define XCD_BAR_WORDS 3456
#define XB_SPIN_CAP (1u << 18)

__device__ __forceinline__ unsigned xb_ld(unsigned* p)              { return __hip_atomic_load(p, __ATOMIC_RELAXED, __HIP_MEMORY_SCOPE_AGENT); }
__device__ __forceinline__ unsigned xb_add(unsigned* p, unsigned v) { return __hip_atomic_fetch_add(p, v, __ATOMIC_RELAXED, __HIP_MEMORY_SCOPE_AGENT); }
__device__ __forceinline__ unsigned xb_xcc_id() { return (unsigned)__builtin_amdgcn_s_getreg((3 << 11) | 20) & 0xFu; }
#define XB_SPIN(cond, bar) do { unsigned _sp = 0; while (cond) { __builtin_amdgcn_s_sleep(1); \
    if ((++_sp & 255u) == 0u) { if (xb_ld(&(bar)[XB_TMO])) break; if (_sp > XB_SPIN_CAP) { atomicAdd(&(bar)[XB_TMO], 1u); break; } } } } while (0)

struct XcdBarrier {
    unsigned* bar; unsigned x;
    volatile LAS unsigned* st;
};

__device__ __forceinline__ XcdBarrier xcd_barrier_post(unsigned* bar, volatile LAS unsigned* st) {
    XcdBarrier b; b.bar = bar; b.x = xb_xcc_id(); b.st = st;
    if (threadIdx.x == 0) (void)xb_add(&bar[XB_XCNT(b.x)], 1u);
    return b;
}
__device__ __forceinline__ void xcd_barrier_complete(unsigned* bar, unsigned x, unsigned& nloc, unsigned& nx) {
    const unsigned G = gridDim.x * gridDim.y * gridDim.z;
    unsigned sum, cnt, mine, sp = 0u;
    for (;;) {
        sum = 0u; cnt = 0u; mine = 0u;
#pragma unroll
        for (unsigned j = 0; j < 16; ++j) { const unsigned c = xb_ld(&bar[XB_XCNT(j)]); sum += c; cnt += (c > 0u) ? 1u : 0u; mine = (j == x) ? c : mine; }
        if (sum == G) break;
        __builtin_amdgcn_s_sleep(1);
        if ((++sp & 255u) == 0u) { if (xb_ld(&bar[XB_TMO])) break; if (sp > XB_SPIN_CAP) { atomicAdd(&bar[XB_TMO], 1u); break; } }
    }
    nloc = mine > 0u ? mine : 1u; nx = cnt > 0u ? cnt : 1u;
}

__device__ __forceinline__ void xcd_barrier(const XcdBarrier& b, const int tid_hint) {
    asm volatile("s_waitcnt vmcnt(0)" ::: "memory");
    __syncthreads();
    if (tid_hint == 0) {
        unsigned* bar = b.bar;
        __builtin_amdgcn_s_waitcnt(0);
        unsigned nloc = b.st[0], nx = b.st[1];
        if (nloc == 0u) { xcd_barrier_complete(bar, b.x, nloc, nx); b.st[0] = nloc; b.st[1] = nx; }
        const unsigned old = xb_add(&bar[XB_XSUB(b.x)], 1u);
        const unsigned gen = old / nloc;
        if (old + 1u == (gen + 1u) * nloc) {
            __builtin_amdgcn_fence(__ATOMIC_RELEASE, "agent");
            asm volatile("s_waitcnt vmcnt(0)" ::: "memory");
            const unsigned og = xb_add(&bar[XB_TOP], 1u);
            const unsigned tg = og / nx;
            if (og + 1u == (tg + 1u) * nx) xb_add(&bar[XB_TOPGEN], 1u);
            else XB_SPIN(xb_ld(&bar[XB_TOPGEN]) == tg, bar);
            __builtin_amdgcn_fence(__ATOMIC_ACQUIRE, "agent");
            xb_add(&bar[XB_XGEN(b.x)], 1u);
            asm volatile("s_waitcnt vmcnt(0)" ::: "memory");
        } else {
            XB_SPIN(xb_ld(&bar[XB_XGEN(b.x)]) == gen, bar);
            __builtin_amdgcn_fence(__ATOMIC_ACQUIRE, "agent");
            asm volatile("s_waitcnt vmcnt(0)" ::: "memory");
        }
    }
    __syncthreads();
}


#define GSYNC() do { xcd_barrier(xbar, tid); } while (0)
#if defined(PROBE_A)
#define STAMP(k) do { if (blk0 == 0 && tid0 == 0) ((LAS unsigned long long*)(lds + LDS_XB + 256))[(k)] = __builtin_amdgcn_s_memrealtime(); } while (0)
#else
#define STAMP(k) do { } while (0)
#endif
struct Args { Ptrs p; int pad0, pad1; };
__global__ void __launch_bounds__(NTHR, 2) mega_fwd(Args args) {
    extern __shared__ __attribute__((aligned(16))) unsigned char lds_raw[];
    LAS unsigned char* lds = (LAS unsigned char*)lds_raw;
    cg::grid_group grid = cg::this_grid();
    const Ptrs& P = args.p;
    unsigned char* ws = P.ws;
    const int tid0 = threadIdx.x, wave0 = __builtin_amdgcn_readfirstlane(tid0 >> 6);
    const int wave = wave0;
    const int G0 = gridDim.x, blk0 = blockIdx.x;
    const int gw0 = blk0 * NWAVES + wave, NGW0 = G0 * NWAVES;
    unsigned* ctl = (unsigned*)(ws + WS_CTL);
    if (tid0 < 64) ((LAS unsigned*)(lds + LDS_XB))[tid0] = 0u;
    __syncthreads();
    XcdBarrier xbar = xcd_barrier_post(ctl + CW_BAR, (volatile LAS unsigned*)(lds + LDS_XB));
    grid.sync();
    for (int L = 0; L < 2; ++L) {
        int gw = gw0, NGW = NGW0, blk = blk0, G = G0; asm volatile("" : "+s"(gw), "+s"(NGW), "+s"(blk), "+s"(G));
        int tid = wave * 64 + (int)__builtin_amdgcn_mbcnt_hi(~0u, __builtin_amdgcn_mbcnt_lo(~0u, 0u)); asm volatile("" : "+v"(tid)); int lane = tid & 63;
#define RELAUNDER() do { tid = wave * 64 + (int)__builtin_amdgcn_mbcnt_hi(~0u, __builtin_amdgcn_mbcnt_lo(~0u, 0u)); asm volatile("" : "+v"(tid)); lane = tid & 63; asm volatile("" : "+s"(gw), "+s"(NGW), "+s"(blk), "+s"(G)); } while (0)
        STAMP(13 * L);
        const float* xsrc = (L == 0) ? P.in[0] : P.out;
#if !defined(ONLY) || ONLY==0
#if defined(DUP_PH0)
        for (int rep = 0; rep < 2; ++rep)
#endif
        {
        s5_tables(P, L, blk >> 3, blk & 7, (LAS float*)lds, tid);
        if (L == 0) weight_items(P, L, gw, NGW, (LAS float*)(lds + wave * 16384), lane, 0, 4128);
        weight_items(P, L, gw, NGW, (LAS float*)(lds + wave * 16384), lane, 6944, 8352);
        for (int i = blk * NTHR + tid; i < 96 * 2048 / 8; i += G * NTHR) ((v4u*)((bf16*)(ws + WS_W1B) + (size_t)1696 * 2048))[i] = (v4u){0u, 0u, 0u, 0u};
        if (blk < 4) { for (int i = tid; i < 128; i += NTHR) ((v4u*)((bf16*)(ws + WS_XNP) + (size_t)blk * 4097 * 1024))[i] = (v4u){0u, 0u, 0u, 0u}; }
        for (int m = gw; m < M; m += NGW) rms_row(xsrc + (size_t)m * 1024, P.in[1] + L * 1024, (bf16*)(ws + WS_XNP) + ((size_t)(m >> 12) * 4097 + 1 + (m & 4095)) * 1024, lane);
        }
        GSYNC(); RELAUNDER(); STAMP(1 + 13 * L);
#endif
#if !defined(ONLY) || ONLY==1
#if defined(DUP_PH1)
        for (int rep = 0; rep < 2; ++rep)
#endif
        {
        { pg8::Gemm g = mkgemm((const bf16*)(ws + WS_XNP) + 1024, (const bf16*)(ws + WS_W1A), M, 2048, 1024, 1024, 1024); g.a_skip_shift = 4; g.a_skip_bytes = 2048;
          Epi8<1> E{(bf16*)(ws + WS_QB), 512, (const bf16*)(ws + WS_US), nullptr};
#if !defined(SUB) || SUB==0
          run_gemm(lds, g, E, G, blk);
#endif
          }
        { pg8::Gemm g = mkgemm((const bf16*)(ws + WS_XNP) + 1024, (const bf16*)(ws + WS_W1B), M, 1792, 2048, 1024, 2048); g.a_skip_shift = 4; g.a_skip_bytes = 2048; g.kwrap = 16; g.wrap_bytes = 4096;
          Epi8<0> E{(bf16*)(ws + WS_Z), ZP, nullptr, nullptr};
#if !defined(SUB) || SUB==1
          run_gemm(lds, g, E, G, blk);
#endif
          }
        if (blk >= 192) { __syncthreads(); weight_items(P, L, (blk - 192) * NWAVES + wave, 64 * NWAVES, (LAS float*)(lds + wave * 16384), lane, 4128, 6944); }
        }
        GSYNC(); RELAUNDER(); STAMP(2 + 13 * L);
#if defined(STOP_AFTER) && STOP_AFTER==1
        dump_stage(P, 1, blk, G, tid); return;
#endif
#endif
#if !defined(ONLY) || ONLY==2
        { pg8::Gemm g = mkgemm((const bf16*)(ws + WS_US), (const bf16*)(ws + WS_PT), 32768, 256, 256, 384, 256); g.b_shift = 2; g.b_stride_bytes = 128 * 256 * 2;
          Epi8<2> E{(bf16*)(ws + WS_US), 384, nullptr, nullptr}; run_gemm(lds, g, E, G, blk);
#if defined(DUP_S5G)
          run_gemm(lds, g, E, G, blk);
#endif
          }
        __syncthreads();
        prep_phase(P, L, lds, gw, NGW, tid, wave, lane);
        GSYNC(); RELAUNDER(); STAMP(3 + 13 * L);
#if defined(STOP_AFTER) && STOP_AFTER==2
        dump_stage(P, 2, blk, G, tid); return;
#endif
#endif
#if !defined(ONLY) || ONLY==3
        if (blk < 128) rwkv_unit(P, L, lds, blk >> 5, (blk >> 2) & 7, blk & 3, tid, wave, lane);
#if defined(DUP_RWKV)
        if (blk < 128) rwkv_unit(P, L, lds, blk >> 5, (blk >> 2) & 7, blk & 3, tid, wave, lane);
#endif
        else if (blk >= G - 16) s5_chunk_scan(P, L, (blk - (G - 16)) * NTHR + tid);
        __syncthreads();
        {
            volatile LAS unsigned* qslot = (volatile LAS unsigned*)(lds + 140000);
            for (;;) {
                if (tid == 0) qslot[0] = atomicAdd(ctl + 64 * L, 1u);
                __syncthreads();
                const unsigned uidx = qslot[0];
                __syncthreads();
                if (uidx >= 1024u) break;
                const int qb = 15 - (int)(uidx >> 6), bhv = uidx & 63, b = bhv >> 4, hv = bhv & 15, hh = hv >> 2, cc = (hv >> 1) & 1, half = hv & 1;
                attn_body::attn_unit<8>(b, (2 * hh + cc) * 64, (2 * hh + cc) * 64, (2 * hh + half) * 64, hv * 64, qb,
                    (const attn_body::bf16*)(ws + WS_QB), (const attn_body::bf16*)(ws + WS_KB), (const attn_body::bf16*)(ws + WS_VB), (attn_body::bf16*)(ws + WS_O), (char*)lds_raw, wave);
#if defined(DUP_ATT)
                attn_body::attn_unit<8>(b, (2 * hh + cc) * 64, (2 * hh + cc) * 64, (2 * hh + half) * 64, hv * 64, qb,
                    (const attn_body::bf16*)(ws + WS_QB), (const attn_body::bf16*)(ws + WS_KB), (const attn_body::bf16*)(ws + WS_VB), (attn_body::bf16*)(ws + WS_O), (char*)lds_raw, wave);
#endif
            }
        }
        GSYNC(); RELAUNDER(); STAMP(4 + 13 * L);
#if defined(STOP_AFTER) && STOP_AFTER==3
        dump_stage(P, 3, blk, G, tid); return;
#endif
#endif
#if !defined(ONLY) || ONLY==4
        { pg8::Gemm g = mkgemm((const bf16*)(ws + WS_US), (const bf16*)(ws + WS_MT), 32768, 256, 384, 384, 384); g.b_shift = 2; g.b_stride_bytes = 256 * 384 * 2;
          Epi8<3> E{(bf16*)(ws + WS_YL), 512, (const bf16*)(ws + WS_US), P.in[10] + L * 512}; run_gemm(lds, g, E, G, blk);
#if defined(DUP_S5G)
          run_gemm(lds, g, E, G, blk);
#endif
          }
        __syncthreads();
        post_phase(P, L, lds, gw, NGW, tid, wave, lane);
        GSYNC(); RELAUNDER(); STAMP(5 + 13 * L);
#if defined(STOP_AFTER) && STOP_AFTER==4
        dump_stage(P, 4, blk, G, tid); return;
#endif
#endif
#if !defined(ONLY) || ONLY==5
        { pg8::Gemm g = mkgemm((const bf16*)(ws + WS_YL), (const bf16*)(ws + WS_WGLU), M, 512, 512, 512, 512);
          Epi8<4> E{(bf16*)(ws + WS_YA), 512, (const bf16*)(ws + WS_YL), nullptr}; run_gemm(lds, g, E, G, blk);
#if defined(DUP_S5G)
          run_gemm(lds, g, E, G, blk);
#endif
          }
        __syncthreads();
        { const float* w_in = P.in[2] + (size_t)L * 1024 * NIN; LAS float* scr = (LAS float*)(lds + wave * 16384);
          for (int it = gw; it < 16 * 96; it += NGW) { const int kb = it / 96, nb = it % 96; tr_item(w_in, NIN, kb * 64, 3744 + nb * 32, (bf16*)(ws + WS_WG), 1024, nb * 32, 0, nullptr, 0, scr, lane); } }
        { const int nsh = (blk < 128) ? 1 : 2; const int vw0 = (blk < 128) ? blk * NWAVES + wave : 1024 + ((blk - 128) * NWAVES + wave) * 2;
          for (int s = 0; s < nsh; ++s) for (int m = vw0 + s; m < M; m += 3072) rms_row(xsrc + (size_t)m * 1024, P.in[1] + L * 1024, (bf16*)(ws + WS_XN) + (size_t)m * 1024, lane); }
        GSYNC(); RELAUNDER(); STAMP(6 + 13 * L);
#if defined(STOP_AFTER) && STOP_AFTER==5
        dump_stage(P, 5, blk, G, tid); return;
#endif
        { pg8::Gemm g = mkgemm((const bf16*)(ws + WS_XN), (const bf16*)(ws + WS_WG) + (size_t)1024 * 1024, M, 2048, 1024, 1024, 1024);
          Epi8<10> E{(bf16*)(ws + WS_P12), 1024, nullptr, nullptr}; run_gemm_pair(lds, g, E, G, blk); }
        { pg8::Gemm g = mkgemm((const bf16*)(ws + WS_Z) + 512, (const bf16*)(ws + WS_WB) + (size_t)1024 * 512, M, 2048, 512, ZP, 512); g.a_pn_shift = 2; g.a_pn_bytes = -1024;
          Epi8<11> E{(bf16*)(ws + WS_P12), 1024, nullptr, nullptr}; run_gemm_pair(lds, g, E, G, blk); }
        RELAUNDER(); STAMP(7 + 13 * L);
#endif
#if !defined(ONLY) || ONLY==6
        { pg8::Gemm g = mkgemm((const bf16*)(ws + WS_XN), (const bf16*)(ws + WS_WG), M, 1024, 1024, 1024, 1024);
          Epi8<5> E{(bf16*)(ws + WS_G0), 1024, nullptr, nullptr}; run_gemm(lds, g, E, G, blk); }
        { pg8::Gemm g = mkgemm((const bf16*)(ws + WS_YA), (const bf16*)(ws + WS_WB), M, 1024, 512, 512, 512);
          Epi8<7> E{(bf16*)(ws + WS_P12), 1024, (const bf16*)(ws + WS_G0), nullptr}; run_gemm(lds, g, E, G, blk); }
        GSYNC(); RELAUNDER(); STAMP(8 + 13 * L);
#if defined(STOP_AFTER) && STOP_AFTER==6
        dump_stage(P, 6, blk, G, tid); return;
#endif
#endif
#if !defined(ONLY) || ONLY==7
        { pg8::Gemm g = mkgemm((const bf16*)(ws + WS_P12), (const bf16*)(ws + WS_WO), M, 1024, 1024, 1024, 1024);
          EpiRes E{xsrc, P.out}; run_gemm(lds, g, E, G, blk); }
        GSYNC(); RELAUNDER(); STAMP(9 + 13 * L);
#endif
#if !defined(ONLY) || ONLY==8
#if defined(DUP_SYNC)
        for (int rep = 0; rep < 10; ++rep) { GSYNC(); }
#endif
        for (int m = gw; m < M; m += NGW) rms_row(P.out + (size_t)m * 1024, P.in[32] + L * 1024, (bf16*)(ws + WS_H2N) + (size_t)m * 1024, lane);
#if defined(DUP_PH8)
        for (int m = gw; m < M; m += NGW) rms_row(P.out + (size_t)m * 1024, P.in[32] + L * 1024, (bf16*)(ws + WS_H2N) + (size_t)m * 1024, lane);
#endif
        GSYNC(); RELAUNDER(); STAMP(10 + 13 * L);
#endif
#if !defined(ONLY) || ONLY==9
        { pg8::Gemm g = mkgemm((const bf16*)(ws + WS_H2N), (const bf16*)(ws + WS_WFI), M, 2 * DFF, 1024, 1024, 1024);
          Epi8<8> E{(bf16*)(ws + WS_HID), DFF, nullptr, nullptr}; run_gemm(lds, g, E, G, blk);
#if defined(DUP_FFN1)
          run_gemm(lds, g, E, G, blk);
#endif
          }
        if (L == 0 && blk >= 128) { __syncthreads(); weight_items(P, 1, (blk - 128) * NWAVES + wave, 128 * NWAVES, (LAS float*)(lds + wave * 16384), lane, 0, 4128); }
        GSYNC(); RELAUNDER(); STAMP(11 + 13 * L);
#if defined(STOP_AFTER) && STOP_AFTER==9
        dump_stage(P, 9, blk, G, tid); return;
#endif
#endif
#if !defined(ONLY) || ONLY==10
        { pg8::Gemm g = mkgemm((const bf16*)(ws + WS_HID), (const bf16*)(ws + WS_WFO), M, 1024, DFF, DFF, DFF);
          EpiRes E{P.out, P.out}; run_gemm(lds, g, E, G, blk); }
#endif
        if (L == 0) { GSYNC(); STAMP(12); }
    }
#if defined(PROBE_A)
    GSYNC();
    if (blk0 == 0) { STAMP(25); __syncthreads(); LAS unsigned long long* st = (LAS unsigned long long*)(lds + LDS_XB + 256);
        float dA = 0.f, dB = 0.f;
        for (int L = 0; L < 2; ++L) { for (int k = 0; k < 12; ++k) { const int k1 = (L == 1 && k == 11) ? 25 : 13 * L + k + 1; const float d = (float)(long long)(st[k1] - st[13 * L + k]); if ((PROBE_A >> k) & 1) dA += d; if ((PROBE_B >> k) & 1) dB += d; } }
#if defined(PROBE_CAL)
        dB = 50000.f;
#endif
        const float qa = __expf(0.04f * rintf(__logf(fmaxf(dA, 1.f)) * 25.f)), qb = __expf(0.04f * rintf(__logf(fmaxf(dB, 1.f)) * 25.f));
        if (tid0 == 0) { P.out[3] += qa * 0.01f; } }
#endif
}

extern "C" void kernel_launch(void* const* d_in, const int* in_sizes, int n_in, void* d_out, int out_size, void* d_ws, size_t ws_size, hipStream_t stream) {
    static int grid = 0;
    if (grid == 0) {
        if (n_in != 35 || out_size != M * DMOD || ws_size < WS_END) { fprintf(stderr, "kernel_launch: unexpected shapes (n_in %d out %d ws %zu)\n", n_in, out_size, ws_size); grid = -1; return; }
        int dev = 0, cus = 0, per_cu = 0;
        hipGetDevice(&dev); hipDeviceGetAttribute(&cus, hipDeviceAttributeMultiprocessorCount, dev);
        hipFuncSetAttribute((const void*)mega_fwd, hipFuncAttributeMaxDynamicSharedMemorySize, LDS_BYTES);
        hipOccupancyMaxActiveBlocksPerMultiprocessor(&per_cu, (const void*)mega_fwd, NTHR, LDS_BYTES);
        if (per_cu < 1) { fprintf(stderr, "kernel_launch: occupancy query says %d\n", per_cu); grid = -1; return; }
        grid = cus;
        if (grid != 256) { fprintf(stderr, "kernel_launch: built for a 256-CU device (one workgroup per CU); got %d\n", grid); grid = -1; return; }
    }
    if (grid < 0) return;
    hipMemsetAsync((char*)d_ws + WS_CTL, 0, 65536, stream);
    Args a{};
    for (int i = 0; i < 35; ++i) a.p.in[i] = (const float*)d_in[i];
    a.p.out = (float*)d_out; a.p.ws = (unsigned char*)d_ws;
    void* kargs[] = {&a};
    hipError_t e = hipLaunchCooperativeKernel((const void*)mega_fwd, dim3(grid), dim3(NTHR), kargs, LDS_BYTES, stream);
    if (e != hipSuccess) fprintf(stderr, "cooperative launch failed: %s (grid %d)\n", hipGetErrorString(e), grid);
}
```

```cpp
#include <hip/hip_runtime.h>
#include <hip/hip_cooperative_groups.h>
#include <cstdio>
#include <cstdint>

namespace pg8 {
#define PG8_LAS __attribute__((address_space(3)))
typedef unsigned short bf16_t;
typedef short bf16x8 __attribute__((ext_vector_type(8)));
typedef float f32x4 __attribute__((ext_vector_type(4)));
typedef unsigned u32x4 __attribute__((ext_vector_type(4)));
constexpr int BM = 256, BK = 64, HALF = 128, HTB = HALF * BK * 2  , STAGE_BYTES = 8 * HTB, NXCD = 8, WGM = 8;

__host__ __device__ __forceinline__ int lds_byte(int r, int c) { const int st = (r >> 4) * 2 + (c >> 5), rr = r & 15, cc = c & 31, ob = rr * 64 + cc * 2; return st * 1024 + (ob ^ (((ob >> 9) & 1) << 5)); }
__host__ __device__ __forceinline__ void stage_rc(int b, int& R, int& C) { const int st = b / 1024, sb = b % 1024, swz = sb ^ (((sb >> 9) & 1) << 5); R = (st >> 1) * 16 + swz / 64; C = (st & 1) * 32 + (swz % 64) / 2; }
__host__ __device__ __forceinline__ int perm32(int rho) { const int n = rho >> 4, i = rho & 15; return 8 * (i >> 2) + 4 * n + (i & 3); }

struct Unit { int pm, pn; };
struct Gemm { const bf16_t* A; const bf16_t* Bt; int M, N, K; int lda, ldb; int a_skip_shift; int a_skip_bytes; int kwrap; int wrap_bytes; int b_shift; int b_stride_bytes; int a_pn_shift; int a_pn_bytes;
  __device__ __forceinline__ const char* abase(const Unit& u) const { return (const char*)A + (size_t)u.pm * (size_t)(256 * 2) * lda + (size_t)(u.pm >> a_skip_shift) * a_skip_bytes + (long)(u.pn >> a_pn_shift) * (long)a_pn_bytes; }
  __device__ __forceinline__ const char* bbase(const Unit& u) const { return (const char*)Bt + (size_t)u.pn * (size_t)(256 * 2) * ldb + (size_t)(u.pm >> b_shift) * b_stride_bytes; } };

struct StaticOrder {
    int nM, nN, nwg, G, c;
    __host__ __device__ void init(int M, int N, int G_, int c_) { nM = M / BM; nN = N / BM; nwg = nM * nN; G = G_; c = c_; }
    __host__ __device__ bool next(int i, Unit& u) const {
        const long L = (long)i * G + c; if (L >= nwg) return false;
        int wgid = (int)L; { const int q = nwg / NXCD, r = nwg % NXCD, xcd = wgid % NXCD, off = wgid / NXCD; wgid = (xcd < r ? xcd * (q + 1) : r * (q + 1) + (xcd - r) * q) + off; }
        const int nig = WGM * nN, gid = wgid / nig, fm = gid * WGM, gsz = (nM - fm) < WGM ? (nM - fm) : WGM;
        u.pm = fm + ((wgid % nig) % gsz); u.pn = (wgid % nig) / gsz; return true;
    }
    __device__ __forceinline__ void a_ready(const Unit&) const {}
    __device__ __forceinline__ void done(const Unit&) const {}
};

typedef float cvt_f32x2_t __attribute__((ext_vector_type(2))); typedef __bf16 cvt_bf16x2_t __attribute__((ext_vector_type(2)));
__device__ __forceinline__ unsigned cvt_pk_bf16(float lo, float hi) { cvt_f32x2_t v = {lo, hi}; cvt_bf16x2_t b = __builtin_convertvector(v, cvt_bf16x2_t); return __builtin_bit_cast(unsigned, b); }
typedef float f32x2 __attribute__((ext_vector_type(2)));
__device__ __forceinline__ f32x2 gelu_pk(f32x2 v) {
    const f32x2 av = __builtin_elementwise_abs(v), d = av * 0.2316418882f + 1.0f;
    f32x2 t; t.x = __builtin_amdgcn_rcpf(d.x); t.y = __builtin_amdgcn_rcpf(d.y);
    f32x2 q = t * 0.5307027145f + (-0.7265760135f); q = q * t + 0.7107068705f; q = q * t + (-0.142248368f); q = q * t + 0.127414796f; q = q * t;
    const f32x2 s = (v * v) * (-0.72134752044f);
    f32x2 e; e.x = __builtin_amdgcn_exp2f(s.x); e.y = __builtin_amdgcn_exp2f(s.y);
    const f32x2 m = v * (q * e), r = v - m;
    f32x2 o; o.x = v.x < 0.f ? m.x : r.x; o.y = v.y < 0.f ? m.y : r.y; return o;
}

template <int ACT  > struct EpiBf16 {
    static constexpr bool PERM = true, AFTER_DRAIN = false; static_assert(ACT == 0 || ACT == 1, "EpiBf16: ACT is 0 (none) or 1 (gelu_pk)");
    bf16_t* O; int ldc; const float* bias; int split_cols; size_t split_stride; float scale0;
    __device__ __forceinline__ void operator()(const f32x4 (&acc)[2][2][4][2], const Unit& u, int wr, int wc, int fr, int fq) const {
        const int row0 = u.pm * BM + wr * 64 + fr; int colt = u.pn * BM; bf16_t* base = O;
        float sc = 1.f; if (split_cols) { const int t = colt / split_cols; base += (size_t)t * split_stride; colt -= t * split_cols; if (t == 0) sc = scale0; }
        const int col0 = colt + wc * 32 + 8 * fq, bcol0 = u.pn * BM + wc * 32 + 8 * fq;
        f32x4 bv[2][2];
#pragma unroll
        for (int bj = 0; bj < 2; ++bj)
#pragma unroll
            for (int n = 0; n < 2; ++n) bv[bj][n] = bias ? *(const f32x4*)(bias + bcol0 + bj * HALF + 4 * n) : (f32x4){0.f, 0.f, 0.f, 0.f};
#pragma unroll
        for (int ai = 0; ai < 2; ++ai)
#pragma unroll
            for (int m = 0; m < 4; ++m) { bf16_t* rowp = base + (size_t)(row0 + ai * HALF + m * 16) * ldc + col0;
#pragma unroll
                for (int bj = 0; bj < 2; ++bj) { f32x4 v0 = acc[ai][bj][m][0] + bv[bj][0], v1 = acc[ai][bj][m][1] + bv[bj][1];
                    if (ACT == 1) { f32x2 a = gelu_pk((f32x2){v0[0], v0[1]}), b = gelu_pk((f32x2){v0[2], v0[3]}), c = gelu_pk((f32x2){v1[0], v1[1]}), d = gelu_pk((f32x2){v1[2], v1[3]});
                        v0 = (f32x4){a.x, a.y, b.x, b.y}; v1 = (f32x4){c.x, c.y, d.x, d.y}; }
                    v0 = v0 * sc; v1 = v1 * sc; u32x4 w; w.x = cvt_pk_bf16(v0[0], v0[1]); w.y = cvt_pk_bf16(v0[2], v0[3]); w.z = cvt_pk_bf16(v1[0], v1[1]); w.w = cvt_pk_bf16(v1[2], v1[3]);
                    *(u32x4*)(rowp + bj * HALF) = w; } }
    }
};
template <class Epi, class Sched, bool ALIGN_EPI = false, bool SP2 = false>
__device__ __forceinline__ void gemm_phase(PG8_LAS unsigned char* lds, const Gemm g, const Sched& S, const Epi& E, int wave_hint) {
    int tid_l = wave_hint * 64 + (int)__builtin_amdgcn_mbcnt_hi(~0u, __builtin_amdgcn_mbcnt_lo(~0u, 0u)); asm volatile("" : "+v"(tid_l)); const int tid = tid_l, wid = __builtin_amdgcn_readfirstlane(tid >> 6), lane = tid & 63, wr = wid >> 2, wc = wid & 3, fr = lane & 15, fq = lane >> 4;
    const int K = g.K, nt = K / BK;
    unsigned voffA[2], voffB[2];
#pragma unroll
    for (int i = 0; i < 2; ++i) { int R, C; stage_rc(tid * 16 + i * 8192, R, C); const int Rb = Epi::PERM ? ((R & ~31) + perm32(R & 31)) : R;
        voffA[i] = (unsigned)(R * g.lda + C) * 2u; voffB[i] = (unsigned)(Rb * g.ldb + C) * 2u; }
    const size_t kstep = (size_t)(BK * 2);
    const size_t hstepA = (size_t)HALF * g.lda * 2, hstepB = (size_t)HALF * g.ldb * 2; const size_t wrapb = (size_t)g.wrap_bytes;
    const unsigned ldsw = (unsigned)wid * 1024u;
    const int aoff = lds_byte(wr * 64 + fr, fq * 8), boff = lds_byte(wc * 32 + fr, fq * 8);
#define PG8_SA(b, h) (((b) * 2 + (h)) * HTB)
#define PG8_SB(b, h) ((4 + (b) * 2 + (h)) * HTB)
#define PG8_STAGE(bufoff, gbase, voff) do { _Pragma("unroll") for (int _i = 0; _i < 2; ++_i) \
        __builtin_amdgcn_global_load_lds((const unsigned*)((const char*)(gbase) + (voff)[_i]), (PG8_LAS unsigned*)(lds + (bufoff) + ldsw + _i * 8192), 16, 0, 0); } while (0)
#define PG8_LDA(dst, b, h) do { _Pragma("unroll") for (int m = 0; m < 4; ++m) _Pragma("unroll") for (int k = 0; k < 2; ++k) dst[m][k] = *(const PG8_LAS bf16x8*)(lds + PG8_SA(b, h) + aoff + m * 2048 + k * 1024); } while (0)
#define PG8_LDB(dst, b, h) do { _Pragma("unroll") for (int n = 0; n < 2; ++n) _Pragma("unroll") for (int k = 0; k < 2; ++k) dst[n][k] = *(const PG8_LAS bf16x8*)(lds + PG8_SB(b, h) + boff + n * 2048 + k * 1024); } while (0)
#define PG8_MMA(ai, bj, At, Bt) do { __builtin_amdgcn_s_setprio(1); _Pragma("unroll") for (int m = 0; m < 4; ++m) _Pragma("unroll") for (int n = 0; n < 2; ++n) _Pragma("unroll") for (int k = 0; k < 2; ++k) \
        acc[ai][bj][m][n] = __builtin_amdgcn_mfma_f32_16x16x32_bf16(Bt[n][k], At[m][k], acc[ai][bj][m][n], 0, 0, 0); __builtin_amdgcn_s_setprio(0); } while (0)
#define PG8_WAIT_V(n) asm volatile("s_waitcnt vmcnt(" #n ")" ::: "memory")
#define PG8_WAIT_L(n) asm volatile("s_waitcnt lgkmcnt(" #n ")" ::: "memory")
#define PG8_BAR __builtin_amdgcn_s_barrier()
#define PG8_SCHED __builtin_amdgcn_sched_barrier(0)
    Unit cur, nxt; int ui = 0;
    if (!S.next(0, cur)) return;
    f32x4 acc[2][2][4][2];
#pragma unroll
    for (int a = 0; a < 2; ++a)
#pragma unroll
        for (int b = 0; b < 2; ++b)
#pragma unroll
            for (int m = 0; m < 4; ++m)
#pragma unroll
                for (int n = 0; n < 2; ++n) acc[a][b][m][n] = (f32x4){0.f, 0.f, 0.f, 0.f};
    bf16x8 At[4][2], B0[2][2], B1[2][2];
    const char* cA = g.abase(cur); const char* cB = g.bbase(cur);
    S.a_ready(cur);
    if constexpr (SP2) {
        PG8_STAGE(PG8_SB(0, 0), cB, voffB); PG8_STAGE(PG8_SB(0, 1), cB + hstepB, voffB); PG8_STAGE(PG8_SA(0, 0), cA, voffA); PG8_STAGE(PG8_SA(0, 1), cA + hstepA, voffA);
        if (wr == 1) PG8_BAR;
        PG8_WAIT_V(2); PG8_BAR;
        PG8_STAGE(PG8_SB(1, 0), cB + kstep, voffB); PG8_STAGE(PG8_SA(1, 0), cA + kstep, voffA); PG8_STAGE(PG8_SB(1, 1), cB + hstepB + kstep, voffB);
        PG8_WAIT_V(6); PG8_BAR;
    } else {
        PG8_STAGE(PG8_SB(0, 0), cB, voffB); PG8_STAGE(PG8_SA(0, 0), cA, voffA); PG8_STAGE(PG8_SB(0, 1), cB + hstepB, voffB); PG8_STAGE(PG8_SA(0, 1), cA + hstepA, voffA);
        if (wr == 1) PG8_BAR;
        PG8_WAIT_V(4); PG8_BAR;
        PG8_STAGE(PG8_SB(1, 0), cB + kstep, voffB); PG8_STAGE(PG8_SA(1, 0), cA + kstep, voffA); PG8_STAGE(PG8_SB(1, 1), cB + hstepB + kstep, voffB);
        PG8_WAIT_V(6); PG8_BAR;
    }
    for (;;) {
        const bool has_next = S.next(ui + 1, nxt);
        const char* nA = has_next ? g.abase(nxt) : cA; const char* nB = has_next ? g.bbase(nxt) : cB;
        for (int t = 0; t < nt; t += 2) {
            const bool last = (t == nt - 2);
            const char* a1 = cA + (size_t)(t + 1) * kstep - ((t + 1) >= g.kwrap ? wrapb : (size_t)0);
            const char* a2 = last ? nA : cA + (size_t)(t + 2) * kstep - ((t + 2) >= g.kwrap ? wrapb : (size_t)0); const char* b2 = last ? nB : cB + (size_t)(t + 2) * kstep;
            const char* a3 = a2 + kstep; const char* b3 = b2 + kstep;
            if (last && has_next) S.a_ready(nxt);
            if constexpr (SP2) {
            PG8_LDB(B0, 0, 0); PG8_LDB(B1, 0, 1); PG8_SCHED; PG8_LDA(At, 0, 0); PG8_STAGE(PG8_SA(1, 1), a1 + hstepA, voffA);
            PG8_WAIT_V(8); PG8_WAIT_L(0); PG8_BAR; PG8_MMA(0, 0, At, B0); PG8_MMA(0, 1, At, B1); PG8_BAR; PG8_SCHED;
            PG8_LDA(At, 0, 1); PG8_STAGE(PG8_SB(0, 0), b2, voffB); PG8_STAGE(PG8_SB(0, 1), b2 + hstepB, voffB); PG8_STAGE(PG8_SA(0, 0), a2, voffA);
            PG8_WAIT_V(8); PG8_WAIT_L(0); PG8_BAR; PG8_MMA(1, 0, At, B0); PG8_MMA(1, 1, At, B1); PG8_BAR; PG8_SCHED;
            PG8_LDB(B0, 1, 0); PG8_LDB(B1, 1, 1); PG8_SCHED; PG8_LDA(At, 1, 0); PG8_STAGE(PG8_SA(0, 1), a2 + hstepA, voffA);
            PG8_WAIT_V(8); PG8_WAIT_L(0); PG8_BAR; PG8_MMA(0, 0, At, B0); PG8_MMA(0, 1, At, B1); PG8_BAR; PG8_SCHED;
            PG8_LDA(At, 1, 1); PG8_STAGE(PG8_SB(1, 0), b3, voffB); PG8_STAGE(PG8_SB(1, 1), b3 + hstepB, voffB); PG8_STAGE(PG8_SA(1, 0), a3, voffA);
            PG8_WAIT_V(8); PG8_WAIT_L(0); PG8_BAR; PG8_MMA(1, 0, At, B0); PG8_MMA(1, 1, At, B1); PG8_BAR; PG8_SCHED;
            } else {
            PG8_LDB(B0, 0, 0); PG8_SCHED; PG8_LDA(At, 0, 0); PG8_STAGE(PG8_SA(1, 1), a1 + hstepA, voffA);
            PG8_WAIT_L(8); PG8_BAR; PG8_WAIT_L(0); PG8_MMA(0, 0, At, B0); PG8_BAR; PG8_SCHED;
            PG8_LDB(B1, 0, 1); PG8_STAGE(PG8_SB(0, 0), b2, voffB);
            PG8_BAR; PG8_WAIT_L(0); PG8_MMA(0, 1, At, B1); PG8_BAR;
            PG8_LDA(At, 0, 1); PG8_STAGE(PG8_SA(0, 0), a2, voffA);
            PG8_BAR; PG8_WAIT_L(0); PG8_MMA(1, 0, At, B0); PG8_BAR; PG8_SCHED;
            PG8_STAGE(PG8_SB(0, 1), b2 + hstepB, voffB);
            PG8_WAIT_V(6); PG8_BAR; PG8_MMA(1, 1, At, B1); PG8_BAR;
            PG8_LDB(B0, 1, 0); PG8_SCHED; PG8_LDA(At, 1, 0); PG8_STAGE(PG8_SA(0, 1), a2 + hstepA, voffA);
            PG8_WAIT_L(8); PG8_BAR; PG8_WAIT_L(0); PG8_MMA(0, 0, At, B0); PG8_BAR; PG8_SCHED;
            PG8_LDB(B1, 1, 1); PG8_STAGE(PG8_SB(1, 0), b3, voffB);
            PG8_BAR; PG8_WAIT_L(0); PG8_MMA(0, 1, At, B1); PG8_BAR;
            PG8_LDA(At, 1, 1); PG8_STAGE(PG8_SA(1, 0), a3, voffA);
            PG8_BAR; PG8_WAIT_L(0); PG8_MMA(1, 0, At, B0); PG8_BAR; PG8_SCHED;
            PG8_STAGE(PG8_SB(1, 1), b3 + hstepB, voffB);
            PG8_WAIT_V(6); PG8_BAR; PG8_MMA(1, 1, At, B1); PG8_BAR;
            }
        }
        if constexpr (ALIGN_EPI) { if (wr == 0) PG8_BAR; }
        if constexpr (!Epi::AFTER_DRAIN) { E(acc, cur, wr, wc, fr, fq); S.done(cur); }
        if (!has_next) break;
#pragma unroll
        for (int a = 0; a < 2; ++a)
#pragma unroll
            for (int b = 0; b < 2; ++b)
#pragma unroll
                for (int m = 0; m < 4; ++m)
#pragma unroll
                    for (int n = 0; n < 2; ++n) acc[a][b][m][n] = (f32x4){0.f, 0.f, 0.f, 0.f};
        cur = nxt; cA = nA; cB = nB; ++ui;
        if constexpr (ALIGN_EPI) { if (wr == 1) PG8_BAR; }
    }
    PG8_WAIT_V(0);
    if constexpr (!ALIGN_EPI) { if (wr == 0) PG8_BAR; }
    PG8_BAR;
    if constexpr (Epi::AFTER_DRAIN) { E.fused(acc, cur, wr, wc, fr, fq, lds, wid, lane); S.done(cur); }
#undef PG8_SA
#undef PG8_SB
#undef PG8_STAGE
#undef PG8_LDA
#undef PG8_LDB
#undef PG8_MMA
#undef PG8_WAIT_V
#undef PG8_WAIT_L
#undef PG8_BAR
#undef PG8_SCHED
}
}
#include <hip/hip_bf16.h>
#include <cmath>
namespace attn_body {
using bf16=__hip_bfloat16;
using bf16x8=__attribute__((ext_vector_type(8)))short;
using s16x4=__attribute__((ext_vector_type(4)))short;
using f32x16=__attribute__((ext_vector_type(16)))float;
using u32x4=__attribute__((ext_vector_type(4)))unsigned;
constexpr int BATCH=4,NHEAD=16,SEQ=4096,D=64,DMQ=512,DMO=1024;
constexpr int NW=8,QBLK=32,QB=QBLK*NW,KVBLK=64,NQB=SEQ/QB;
constexpr int ATTN_UNIT_ROWS=QB;
__device__ __forceinline__ int crow(int r,int hi){return (r&3)+8*(r>>2)+4*hi;}
#define SBAR() __builtin_amdgcn_sched_barrier(0)
__device__ __forceinline__ void cmask(f32x16&p0,f32x16&p1,int jb,int qrel,int hi){
  const float NEG=-INFINITY; int kb=64*jb+4*hi;
  #pragma unroll
  for(int r=0;r<16;++r){int kv=kb+(r&3)+8*(r>>2); if(kv>qrel)p0[r]=NEG; if(kv+32>qrel)p1[r]=NEG;}
}

constexpr int NSLOT=3, SLOTB=8192;
constexpr int LDS_K=0, LDS_V=NSLOT*SLOTB, LDS_WS=2*NSLOT*SLOTB, LDS_OST=LDS_WS+NW*64*4, LDS_BYTES=LDS_OST+NW*4096;
constexpr float C2=0.125f*1.4426950408889634f;
__device__ __forceinline__ void glds16(const void*gsrc,unsigned lds_dst){unsigned keep;
  asm volatile("s_mov_b32 %0, m0\n\ts_mov_b32 m0, %2\n\ts_nop 0\n\tglobal_load_lds_dwordx4 %1, off\n\ts_mov_b32 m0, %0":"=&s"(keep):"v"(gsrc),"s"(lds_dst):"memory");}
__device__ __forceinline__ float max3f(float a,float b,float c){float r;asm("v_max3_f32 %0, %1, %2, %3":"=v"(r):"v"(a),"v"(b),"v"(c));return r;}
__device__ __forceinline__ float max2f(float a,float b){float r;asm("v_max_f32_e32 %0, %1, %2":"=v"(r):"v"(a),"v"(b));return r;}
__device__ __forceinline__ float fadd_s(float a,float b){float r;asm("v_add_f32_e32 %0, %1, %2":"=v"(r):"v"(a),"v"(b));return r;}
__device__ __forceinline__ float fsub_s(float a,float b){float r;asm("v_sub_f32_e32 %0, %1, %2":"=v"(r):"v"(a),"v"(b));return r;}
typedef float f32x2_t __attribute__((ext_vector_type(2))); typedef __bf16 bf16x2_t __attribute__((ext_vector_type(2)));
__device__ __forceinline__ unsigned cvtpk_s(float lo,float hi){f32x2_t v={lo,hi};bf16x2_t b=__builtin_convertvector(v,bf16x2_t);return __builtin_bit_cast(unsigned,b);}
#define WAIT_BAR(N) asm volatile("s_waitcnt vmcnt(" #N ") lgkmcnt(0)\n\ts_barrier":::"memory")

__device__ __forceinline__ void qkt(f32x16&p0,f32x16&p1,const char*Kslot,const bf16x8*qr,const f32x16&negm,int r32,int hi){
  const char*kb=Kslot+hi*1024+r32*16;
  #pragma unroll
  for(int d0=0;d0<4;++d0){
    const bf16x8 b0=*reinterpret_cast<const bf16x8*>(kb+d0*2048);
    const bf16x8 b1=*reinterpret_cast<const bf16x8*>(kb+d0*2048+512);
    if(d0==0){p0=__builtin_amdgcn_mfma_f32_32x32x16_bf16(b0,qr[0],negm,0,0,0);p1=__builtin_amdgcn_mfma_f32_32x32x16_bf16(b1,qr[0],negm,0,0,0);}
    else{p0=__builtin_amdgcn_mfma_f32_32x32x16_bf16(b0,qr[d0],p0,0,0,0);p1=__builtin_amdgcn_mfma_f32_32x32x16_bf16(b1,qr[d0],p1,0,0,0);}}
}
typedef __attribute__((address_space(3))) const char* lds_cptr;
typedef short v4i16_t __attribute__((ext_vector_type(4)));
__device__ __forceinline__ void kload8(bf16x8*kf,lds_cptr kp){
  kf[0]=*(const __attribute__((address_space(3))) bf16x8*)(kp);      kf[1]=*(const __attribute__((address_space(3))) bf16x8*)(kp+512);
  kf[2]=*(const __attribute__((address_space(3))) bf16x8*)(kp+2048); kf[3]=*(const __attribute__((address_space(3))) bf16x8*)(kp+2560);
  kf[4]=*(const __attribute__((address_space(3))) bf16x8*)(kp+4096); kf[5]=*(const __attribute__((address_space(3))) bf16x8*)(kp+4608);
  kf[6]=*(const __attribute__((address_space(3))) bf16x8*)(kp+6144); kf[7]=*(const __attribute__((address_space(3))) bf16x8*)(kp+6656);
}
__device__ __forceinline__ void kload2(bf16x8*kf,lds_cptr kp,int j){ kf[2*j]=*(const __attribute__((address_space(3))) bf16x8*)(kp+j*2048); kf[2*j+1]=*(const __attribute__((address_space(3))) bf16x8*)(kp+j*2048+512); }
__device__ __forceinline__ s16x4 vtr(lds_cptr p){ return __builtin_bit_cast(s16x4,__builtin_amdgcn_ds_read_tr16_b64_v4i16((__attribute__((address_space(3))) v4i16_t*)p)); }
__device__ __forceinline__ float rowmax(const f32x16&p0,const f32x16&p1){
  float a=max3f(p0[0],p0[1],p1[0]),b=max3f(p0[2],p0[3],p1[1]);a=max3f(a,p1[2],p1[3]);
  #pragma unroll
  for(int r=4;r<16;r+=4){a=max3f(a,p0[r],p0[r+1]);b=max3f(b,p0[r+2],p0[r+3]);a=max3f(a,p1[r],p1[r+1]);b=max3f(b,p1[r+2],p1[r+3]);}
  const float m=max2f(a,b);
  auto rr=__builtin_amdgcn_permlane32_swap(__float_as_uint(m),__float_as_uint(m),false,false);
  return max2f(__uint_as_float(rr[0]),__uint_as_float(rr[1]));
}
__device__ __forceinline__ void pv(f32x16*o,int vb,bf16x8 pa0,bf16x8 pa1,bf16x8 pa2,bf16x8 pa3){
  #pragma unroll
  for(int d0=0;d0<2;++d0){s16x4 lo[4],hi[4];
    #pragma unroll
    for(int ks=0;ks<4;++ks){
      asm volatile("ds_read_b64_tr_b16 %0,%1 offset:%c2":"=&v"(lo[ks]):"v"(vb),"i"(d0*4096+ks*1024):"memory");
      asm volatile("ds_read_b64_tr_b16 %0,%1 offset:%c2":"=&v"(hi[ks]):"v"(vb),"i"(d0*4096+ks*1024+512):"memory");}
    asm volatile("s_waitcnt lgkmcnt(0)":::"memory");SBAR();
    #define PK(k) (bf16x8){lo[k][0],lo[k][1],lo[k][2],lo[k][3],hi[k][0],hi[k][1],hi[k][2],hi[k][3]}
    o[d0]=__builtin_amdgcn_mfma_f32_32x32x16_bf16(pa0,PK(0),o[d0],0,0,0);
    o[d0]=__builtin_amdgcn_mfma_f32_32x32x16_bf16(pa1,PK(1),o[d0],0,0,0);
    o[d0]=__builtin_amdgcn_mfma_f32_32x32x16_bf16(pa2,PK(2),o[d0],0,0,0);
    o[d0]=__builtin_amdgcn_mfma_f32_32x32x16_bf16(pa3,PK(3),o[d0],0,0,0);
    #undef PK
  }
}

#ifndef ATTN_STORE16
#define ATTN_STORE16(p,v) (*(u32x4*)(p)=(v))
#endif
template<int THRL> __device__ __forceinline__ void attn_unit(int b,int cq,int ck,int cv,int co,int qb,const bf16*Q,const bf16*__restrict__ K,const bf16*__restrict__ V,bf16*O,char*shm,int wave_hint){
  int tid_l=wave_hint*64+(int)__builtin_amdgcn_mbcnt_hi(~0u,__builtin_amdgcn_mbcnt_lo(~0u,0u)); asm volatile("":"+v"(tid_l)); const int tid=tid_l,lane=tid&63,r32=lane&31,hi=lane>>5; const int wid=__builtin_amdgcn_readfirstlane(tid>>6);
  const long rowbase=(long)b*SEQ; const int q0=qb*QB;
  const bf16*Qw=Q+(rowbase+q0+wid*QBLK)*DMQ+cq;
  const bf16*Kh=K+rowbase*DMQ+ck,*Vh=V+rowbase*DMQ+cv;
  const unsigned lds0=(unsigned)(uintptr_t)shm;
  float*wsf=(float*)(shm+LDS_WS)+wid*64;
  const bf16*ksrc=Kh+(long)lane*DMQ+wid*8;
  const bf16*vsrc=Vh+(long)(16*(wid&3)+(lane>>2))*DMQ+(wid>>2)*32+(lane&3)*8;
  const unsigned kdst=lds0+LDS_K+wid*1024, vdst=lds0+LDS_V+wid*1024;
  #define DMA_K(t,slot) glds16(ksrc+(long)(t)*KVBLK*DMQ,(unsigned)__builtin_amdgcn_readfirstlane(kdst+(slot)))
  #define DMA_V(t,slot) glds16(vsrc+(long)(t)*KVBLK*DMQ,(unsigned)__builtin_amdgcn_readfirstlane(vdst+(slot)))
  const int vb0=(int)(lds0+LDS_V)+((lane>>4)&1)*32+(lane&3)*8+(4*hi+((lane&15)>>2))*64;
  const char*Kbase=shm+LDS_K; bf16x8 kf[8];
  const lds_cptr shm3=(lds_cptr)shm; const lds_cptr kp0=shm3+LDS_K+hi*1024+r32*16; const lds_cptr vp0=shm3+LDS_V+((lane>>4)&1)*32+(lane&3)*8+(4*hi+((lane&15)>>2))*64;
  const int NT=(q0+QB)/KVBLK;
  DMA_K(0,0);DMA_V(0,0);DMA_K(1,SLOTB);
  bf16x8 qr[4];
  #pragma unroll
  for(int d0=0;d0<4;++d0)qr[d0]=*reinterpret_cast<const bf16x8*>(&Qw[(long)r32*DMQ+d0*16+hi*8]);
  float mhat=0.f,l_reg=0.f;f32x16 o[2];o[0]=f32x16{};o[1]=f32x16{};f32x16 negm=f32x16{};asm volatile("":"+v"(negm));
  const int qrel=wid*QBLK+r32;
  #define CMASK(P0,P1,t) do{int jb_=(t)-(NT-4); if(jb_>=0)cmask(P0,P1,jb_,qrel,hi);}while(0)
  bool resc=false;
  #define START(P0,P1) do{ const float rm=rowmax(P0,P1); resc=false; \
    { const float dl=rm; mhat=fadd_s(mhat,dl); \
      _Pragma("unroll") for(int r=0;r<16;++r){P0[r]=fsub_s(P0[r],dl);P1[r]=fsub_s(P1[r],dl);} \
      _Pragma("unroll") for(int r=0;r<16;++r)negm[r]=-mhat; asm volatile("":"+v"(negm)); } \
    _Pragma("unroll") for(int r=0;r<16;++r)P0[r]=__builtin_amdgcn_exp2f(P0[r]); }while(0)
  #define RESC() do{ if(resc){ asm volatile("s_waitcnt lgkmcnt(0)":::"memory"); \
      _Pragma("unroll") for(int d_=0;d_<2;++d_) _Pragma("unroll") for(int r=0;r<16;++r)o[d_][r]*=wsf[crow(r,hi)]; } }while(0)
  f32x16 pA0,pA1,pB0,pB1;
  int sl_prev=0,sl_cur=0,sl_next=SLOTB;
  #define ROT() do{sl_prev=sl_cur;sl_cur=sl_next;sl_next=(sl_next==(NSLOT-1)*SLOTB)?0:sl_next+SLOTB;}while(0)
  DMA_K(2,2*SLOTB);
  WAIT_BAR(3);
  qkt(pA0,pA1,Kbase,qr,negm,r32,hi);asm volatile("s_nop 15\n\ts_nop 7":"+v"(pA0),"+v"(pA1));CMASK(pA0,pA1,0);
  START(pA0,pA1);
  _Pragma("unroll") for(int r=0;r<16;++r)pA1[r]=__builtin_amdgcn_exp2f(pA1[r]);
  WAIT_BAR(0);
  DMA_K(3,0);DMA_V(1,SLOTB);
  ROT();
  kload8(kf,kp0+sl_cur);
  WAIT_BAR(2);
  s16x4 vlo[8],vhi[8]; u32x4 pw0,pw1,pw2,pw3;
  #define PKW(P,B) cvtpk_s(P[B],P[B+1])
  #define PAF(k) __builtin_bit_cast(bf16x8,pw##k)
  #define VFR(i) (bf16x8){vlo[i][0],vlo[i][1],vlo[i][2],vlo[i][3],vhi[i][0],vhi[i][1],vhi[i][2],vhi[i][3]}
  #define PIN(x) asm volatile("":"+v"(x))
  #define MX3(a,b,c) __builtin_fmaxf(__builtin_fmaxf((a),(b)),(c))
  #define GAPA(MF,A0,A1,A2,A3,W0,W1,PW) do{ MF; sacc+=A0; sacc+=A1; sacc+=A2; sacc+=A3; PIN(sacc); W0; W1; PIN(PW); SBAR(); }while(0)
  #define EX(v) __builtin_amdgcn_exp2f(v)
  #define GAPB(MF,X,B) do{ MF; X[B]=EX(X[B]); X[B+1]=EX(X[B+1]); X[B+2]=EX(X[B+2]); X[B+3]=EX(X[B+3]); PIN(X); SBAR(); }while(0)
  #define VRD(i) do{ vlo[i]=vtr(vp_+(((i)>>2)*4096+((i)&3)*1024)); vhi[i]=vtr(vp_+(((i)>>2)*4096+((i)&3)*1024+512)); }while(0)
  #define KRD(G,j) do{ if(G){ kload2(kf,kp0+sl_next,j); SBAR(); } }while(0)
  #define STEP(C0,C1,P0,P1,t,GK,GV,GL) do{ SBAR(); \
    const lds_cptr vp_=vp0+sl_prev; \
    VRD(0); SBAR(); float sacc=(P0[0]+P0[1]); \
    GAPA(C0=__builtin_amdgcn_mfma_f32_32x32x16_bf16(kf[0],qr[0],negm,0,0,0), P0[2],P0[3],P0[4],P0[5],     pw0[0]=PKW(P0,0), pw0[1]=PKW(P0,2), pw0); \
    VRD(4); SBAR(); GAPA(C1=__builtin_amdgcn_mfma_f32_32x32x16_bf16(kf[1],qr[0],negm,0,0,0), P0[6],P0[7],P0[8],P0[9],     pw0[2]=PKW(P0,4), pw0[3]=PKW(P0,6), pw0); \
    VRD(1); SBAR(); GAPA(C0=__builtin_amdgcn_mfma_f32_32x32x16_bf16(kf[2],qr[1],C0,0,0,0),   P0[10],P0[11],P0[12],P0[13], pw1[0]=PKW(P0,8), pw1[1]=PKW(P0,10), pw1); \
    VRD(5); SBAR(); GAPA(C1=__builtin_amdgcn_mfma_f32_32x32x16_bf16(kf[3],qr[1],C1,0,0,0),   P0[14],P0[15],P1[0],P1[1],   pw1[2]=PKW(P0,12),pw1[3]=PKW(P0,14), pw1); \
    VRD(2); SBAR(); GAPA(C0=__builtin_amdgcn_mfma_f32_32x32x16_bf16(kf[4],qr[2],C0,0,0,0),   P1[2],P1[3],P1[4],P1[5],     pw2[0]=PKW(P1,0), pw2[1]=PKW(P1,2), pw2); \
    VRD(6); SBAR(); GAPA(C1=__builtin_amdgcn_mfma_f32_32x32x16_bf16(kf[5],qr[2],C1,0,0,0),   P1[6],P1[7],P1[8],P1[9],     pw2[2]=PKW(P1,4), pw2[3]=PKW(P1,6), pw2); \
    VRD(3); SBAR(); GAPA(C0=__builtin_amdgcn_mfma_f32_32x32x16_bf16(kf[6],qr[3],C0,0,0,0),   P1[10],P1[11],P1[12],P1[13], pw3[0]=PKW(P1,8), pw3[1]=PKW(P1,10), pw3); \
    VRD(7); SBAR(); GAPA(C1=__builtin_amdgcn_mfma_f32_32x32x16_bf16(kf[7],qr[3],C1,0,0,0),   P1[14],P1[15],0.f,0.f,       pw3[2]=PKW(P1,12),pw3[3]=PKW(P1,14), pw3); \
    l_reg+=sacc; \
    if(GK){DMA_K((t)+3,sl_cur);} if(GV){DMA_V((t)+1,sl_next);} \
    CMASK(C0,C1,t); \
    { float a=MX3(C0[0],C0[1],C1[0]),b=MX3(C0[2],C0[3],C1[1]); a=MX3(a,C1[2],C1[3]); \
      _Pragma("unroll") for(int r=4;r<16;r+=4){a=MX3(a,C0[r],C0[r+1]);b=MX3(b,C0[r+2],C0[r+3]);a=MX3(a,C1[r],C1[r+1]);b=MX3(b,C1[r+2],C1[r+3]);} \
      float rm=__builtin_fmaxf(a,b); { auto rr=__builtin_amdgcn_permlane32_swap(__float_as_uint(rm),__float_as_uint(rm),false,false); rm=__builtin_fmaxf(__uint_as_float(rr[0]),__uint_as_float(rr[1])); } \
      resc=false; \
      if(__builtin_expect(__any(rm>(float)THRL),0)){ const float dl=__builtin_fmaxf(rm,0.f); mhat+=dl; \
        _Pragma("unroll") for(int r=0;r<16;++r){C0[r]-=dl;C1[r]-=dl;} \
        _Pragma("unroll") for(int r=0;r<16;++r)negm[r]=-mhat; asm volatile("":"+v"(negm)); \
        const float f=__builtin_amdgcn_exp2f(-dl); l_reg*=f; if(hi==0)wsf[r32]=f; resc=true; } } \
    SBAR(); \
    GAPB(o[0]=__builtin_amdgcn_mfma_f32_32x32x16_bf16(PAF(0),VFR(0),o[0],0,0,0), C0,0); \
    GAPB(o[1]=__builtin_amdgcn_mfma_f32_32x32x16_bf16(PAF(0),VFR(4),o[1],0,0,0), C0,4); \
    KRD(GL,0); GAPB(o[0]=__builtin_amdgcn_mfma_f32_32x32x16_bf16(PAF(1),VFR(1),o[0],0,0,0), C0,8); \
    KRD(GL,1); GAPB(o[1]=__builtin_amdgcn_mfma_f32_32x32x16_bf16(PAF(1),VFR(5),o[1],0,0,0), C0,12); \
    KRD(GL,2); GAPB(o[0]=__builtin_amdgcn_mfma_f32_32x32x16_bf16(PAF(2),VFR(2),o[0],0,0,0), C1,0); \
    KRD(GL,3); GAPB(o[1]=__builtin_amdgcn_mfma_f32_32x32x16_bf16(PAF(2),VFR(6),o[1],0,0,0), C1,4); \
    GAPB(o[0]=__builtin_amdgcn_mfma_f32_32x32x16_bf16(PAF(3),VFR(3),o[0],0,0,0), C1,8); \
    GAPB(o[1]=__builtin_amdgcn_mfma_f32_32x32x16_bf16(PAF(3),VFR(7),o[1],0,0,0), C1,12); \
    }while(0)
  int t=1;
  #undef CMASK
  #define CMASK(P0,P1,t) do{}while(0)
  for(;t+5<NT;t+=2){
    STEP(pB0,pB1,pA0,pA1,t,true,true,true);     WAIT_BAR(2); RESC(); ROT();
    STEP(pA0,pA1,pB0,pB1,t+1,true,true,true);   WAIT_BAR(2); RESC(); ROT();
  }
  #undef CMASK
  #define CMASK(P0,P1,t) do{int jb_=(t)-(NT-4); if(jb_>=0)cmask(P0,P1,jb_,qrel,hi);}while(0)
  #define ENDW(tt) do{ if((tt)+3<NT){WAIT_BAR(2);} else if((tt)+2<NT){WAIT_BAR(1);} else {WAIT_BAR(0);} }while(0)
  for(;t+1<NT;t+=2){
    STEP(pB0,pB1,pA0,pA1,t,(t+3<NT),(t+1<NT),(t+1<NT));       ENDW(t);   RESC(); ROT();
    STEP(pA0,pA1,pB0,pB1,t+1,(t+4<NT),(t+2<NT),(t+2<NT));     ENDW(t+1); RESC(); ROT();
  }
  STEP(pB0,pB1,pA0,pA1,NT-1,false,false,false); RESC();
  { float sacc=pB0[0]+pB0[1]; _Pragma("unroll") for(int r=2;r<16;++r)sacc+=pB0[r]; _Pragma("unroll") for(int r=0;r<16;++r)sacc+=pB1[r]; l_reg+=sacc;
    pw0=(u32x4){PKW(pB0,0),PKW(pB0,2),PKW(pB0,4),PKW(pB0,6)};pw1=(u32x4){PKW(pB0,8),PKW(pB0,10),PKW(pB0,12),PKW(pB0,14)};pw2=(u32x4){PKW(pB1,0),PKW(pB1,2),PKW(pB1,4),PKW(pB1,6)};pw3=(u32x4){PKW(pB1,8),PKW(pB1,10),PKW(pB1,12),PKW(pB1,14)};
    SBAR(); pv(o,vb0+sl_cur,PAF(0),PAF(1),PAF(2),PAF(3)); }
  #undef PKW
  #undef PAF
  #undef VFR
  #undef PIN
  #undef MX3
  #undef GAPA
  #undef GAPB
  #undef EX
  #undef VRD
  #undef KRD
  #undef STEP
  #undef ENDW
  {auto rr=__builtin_amdgcn_permlane32_swap(__float_as_uint(l_reg),__float_as_uint(l_reg),false,false);l_reg=__uint_as_float(rr[0])+__uint_as_float(rr[1]);}
  if(hi==0)wsf[32+r32]=l_reg;asm volatile("s_waitcnt lgkmcnt(0)":::"memory");
  float rli[16];
  #pragma unroll
  for(int r=0;r<16;++r)rli[r]=__builtin_amdgcn_rcpf(wsf[32+crow(r,hi)]);
  bf16*Ow=O+(rowbase+q0+wid*QBLK)*DMO+co;
  { bf16*stg=(bf16*)(shm+LDS_OST)+wid*2048;
    #pragma unroll
    for(int r=0;r<16;++r){const int orow=crow(r,hi);
      #pragma unroll
      for(int d0=0;d0<2;++d0)stg[orow*64+d0*32+r32]=__float2bfloat16(o[d0][r]*rli[r]);}
    asm volatile("s_waitcnt lgkmcnt(0)":::"memory");
    #pragma unroll
    for(int i=0;i<4;++i){const int row=i*8+(lane>>3),ch=lane&7; const u32x4 v=*(const u32x4*)(stg+row*64+ch*8); ATTN_STORE16(Ow+(long)row*DMO+ch*8,v);} }
  asm volatile("s_waitcnt lgkmcnt(0)\n\ts_barrier":::"memory");
  #undef DMA_K
  #undef DMA_V
  #undef CMASK
  #undef START
  #undef RESC
  #undef ROT
}
constexpr int ATTN_LDS_BYTES=LDS_BYTES;
#undef SBAR
#undef WAIT_BAR
}
namespace cg = cooperative_groups;
#define GAS __attribute__((address_space(1)))
#define LAS __attribute__((address_space(3)))
typedef unsigned short bf16;
typedef unsigned v4u __attribute__((ext_vector_type(4)));
typedef unsigned v2u __attribute__((ext_vector_type(2)));
typedef float f32x4 __attribute__((ext_vector_type(4)));
constexpr int NWAVES = 8, NTHR = 512;
constexpr int M = 16384, DMOD = 1024, SEQ = 4096, NIN = 6816, DFF = 2816, ZP = 1728;
constexpr size_t MiB = 1u << 20;
constexpr size_t WS_CTL = 0;
constexpr size_t WS_WGLU = 1 * MiB, WS_WB = WS_WGLU + MiB / 2, WS_WO = WS_WB + 3 * MiB, WS_WFI = WS_WO + 2 * MiB, WS_WFO = WS_WFI + 11 * MiB;
constexpr size_t WS_WX = 23 * MiB, WS_W1A = WS_WX, WS_W1B = WS_WX + 4 * MiB, WS_E = WS_WX, WS_WG = WS_WX;
constexpr size_t WS_VF = 40 * MiB, WS_US = 56 * MiB, WS_YA = 80 * MiB, WS_Z = 96 * MiB, WS_QB = 150 * MiB, WS_KB = 166 * MiB, WS_VB = 182 * MiB;
constexpr size_t WS_XNP = 198 * MiB, WS_O = 198 * MiB, WS_AB = 231 * MiB, WS_PT = 247 * MiB, WS_MT = 249 * MiB, WS_END = 256 * MiB;
constexpr size_t WS_XN = 150 * MiB, WS_YL = 182 * MiB, WS_P12 = 182 * MiB, WS_G0 = 214 * MiB, WS_H2N = 96 * MiB, WS_HID = 150 * MiB;
static_assert(WS_WFO + (size_t)1024 * 2816 * 2 <= WS_WX && WS_Z + (size_t)M * ZP * 2 <= WS_QB && WS_XNP + (size_t)4 * 4097 * 1024 * 2 <= WS_AB && WS_MT + (size_t)32 * 256 * 384 * 2 <= WS_END && WS_HID + (size_t)M * DFF * 2 <= WS_END, "ws map");
constexpr int LDS_BYTES = 148480; constexpr int LDS_XB = 147456; constexpr int CW_BAR = 4096;
constexpr float C2Q = 0.125f * 1.4426950408889634f;

__device__ __forceinline__ unsigned f2bf(float f) { unsigned u = __builtin_bit_cast(unsigned, f); return (u + 0x7fffu + ((u >> 16) & 1u)) >> 16; }
__device__ __forceinline__ float bf2f(unsigned b) { return __uint_as_float(b << 16); }
__device__ __forceinline__ void unpack8(const v4u w, float* f) {
    f[0] = __uint_as_float(w.x << 16); f[1] = __uint_as_float(w.x & 0xffff0000u); f[2] = __uint_as_float(w.y << 16); f[3] = __uint_as_float(w.y & 0xffff0000u);
    f[4] = __uint_as_float(w.z << 16); f[5] = __uint_as_float(w.z & 0xffff0000u); f[6] = __uint_as_float(w.w << 16); f[7] = __uint_as_float(w.w & 0xffff0000u); }
__device__ __forceinline__ v4u pack8(const float* f) { v4u w; w.x = pg8::cvt_pk_bf16(f[0], f[1]); w.y = pg8::cvt_pk_bf16(f[2], f[3]); w.z = pg8::cvt_pk_bf16(f[4], f[5]); w.w = pg8::cvt_pk_bf16(f[6], f[7]); return w; }
__device__ __forceinline__ float sigm(float x) { return __builtin_amdgcn_rcpf(1.f + __expf(-x)); }
__device__ __forceinline__ float tanh_f(float x) { return 1.f - 2.f * __builtin_amdgcn_rcpf(1.f + __expf(2.f * x)); }
__device__ __forceinline__ float wave_sum(float v) {
#pragma unroll
    for (int o = 1; o < 64; o <<= 1) v += __shfl_xor(v, o);
    return v; }
__device__ __forceinline__ float dppf(float x, const int ctrl) { return x; }
#define DPP_ADD(x, ctrl) ((x) + __builtin_bit_cast(float, __builtin_amdgcn_update_dpp(0, __builtin_bit_cast(int, (x)), (ctrl), 0xf, 0xf, true)))
__device__ __forceinline__ float row16_sum(float x) { x = DPP_ADD(x, 0xB1); x = DPP_ADD(x, 0x4E); x = DPP_ADD(x, 0x141); x = DPP_ADD(x, 0x140); return x; }

template <int MODE> struct Epi8 {
    static constexpr bool PERM = true, AFTER_DRAIN = false;
    bf16* O; int ldc; const bf16* X; const float* P;
    __device__ __forceinline__ void operator()(const pg8::f32x4 (&acc)[2][2][4][2], const pg8::Unit& u, int wr, int wc, int fr, int fq) const {
#pragma unroll
        for (int ai = 0; ai < 2; ++ai)
#pragma unroll
            for (int m = 0; m < 4; ++m) {
                const int row = u.pm * 256 + ai * 128 + wr * 64 + m * 16 + fr;
                if (MODE == 8) {
                    float o[8];
#pragma unroll
                    for (int i = 0; i < 8; ++i) { const float gte = acc[ai][0][m][i >> 2][i & 3], up = acc[ai][1][m][i >> 2][i & 3]; o[i] = gte * sigm(gte) * up; }
                    *(v4u*)(O + (size_t)row * DFF + u.pn * 128 + wc * 32 + 8 * fq) = pack8(o);
                } else {
#pragma unroll
                for (int bj = 0; bj < 2; ++bj) {
                    const int col = u.pn * 256 + bj * 128 + wc * 32 + 8 * fq;
                    float v[8];
#pragma unroll
                    for (int i = 0; i < 8; ++i) v[i] = acc[ai][bj][m][i >> 2][i & 3];
                    if (MODE == 0) { if (col < ldc) *(v4u*)(O + (size_t)row * ldc + col) = pack8(v); }
                    else if (MODE == 1) {
                        if (u.pn < 2) { const int g = col >> 4, cc = col & 15, b = row >> 12, t = row & 4095, ch = t >> 4, s = t & 15;
                            *(v4u*)((bf16*)X + ((size_t)(g * 1024 + b * 256 + ch) * 384 + s * 16 + cc)) = pack8(v); }
                        else { const int tsel = (col >> 9) - 1, cl = col & 511; *(v4u*)(O + (size_t)tsel * (8u * MiB) + (size_t)row * 512 + cl) = pack8(v); }
                    }
                    else if (MODE == 2) { if (bj == 0) *(v4u*)(O + (size_t)row * 384 + 256 + (col & 255)) = pack8(v); }
                    else if (MODE == 3) {
                        const int g = row >> 10, b = (row >> 8) & 3, ch = row & 255, cl = col & 255, t = cl >> 4, cc = cl & 15;
                        float uu[8]; unpack8(*(const v4u*)(X + (size_t)row * 384 + cl), uu);
#pragma unroll
                        for (int i = 0; i < 8; ++i) { const float y = v[i] + P[g * 16 + cc + i] * uu[i]; v[i] = y * sigm(1.5957691216f * (y + 0.044715f * y * y * y)); }
                        *(v4u*)(O + (size_t)(b * 4096 + ch * 16 + t) * 512 + g * 16 + cc) = pack8(v);
                    }
                    else if (MODE == 4) { float y[8]; unpack8(*(const v4u*)(X + (size_t)row * 512 + col), y);
#pragma unroll
                        for (int i = 0; i < 8; ++i) v[i] = y[i] * sigm(v[i]);
                        *(v4u*)(O + (size_t)row * 512 + col) = pack8(v); }
                    else if (MODE == 5) {
#pragma unroll
                        for (int i = 0; i < 8; ++i) v[i] = sigm(v[i]);
                        *(v4u*)(O + (size_t)row * 1024 + col) = pack8(v); }
                    else if (MODE == 10) {
#pragma unroll
                        for (int i = 0; i < 8; ++i) v[i] = sigm(v[i]);
                        *(v4u*)(O + (size_t)(col >> 10) * ((size_t)M * 1024) + (size_t)row * 1024 + (col & 1023)) = pack8(v); }
                    else if (MODE == 11) {
                        const int np = col >> 10, d = col & 1023; float gt[8], pp[8];
                        unpack8(*(const v4u*)(O + (size_t)np * ((size_t)M * 1024) + (size_t)row * 1024 + d), gt);
                        if (np) unpack8(*(const v4u*)(O + (size_t)row * 1024 + d), pp);
#pragma unroll
                        for (int i = 0; i < 8; ++i) v[i] = (np ? pp[i] : 0.f) + gt[i] * v[i];
                        *(v4u*)(O + (size_t)row * 1024 + d) = pack8(v); }
                    else if (MODE == 6 || MODE == 7) { float gt[8]; unpack8(*(const v4u*)(X + (size_t)row * 1024 + col), gt);
                        float pm_[8];
                        if (MODE == 7) unpack8(*(const v4u*)(O + (size_t)row * 1024 + col), pm_);
#pragma unroll
                        for (int i = 0; i < 8; ++i) v[i] = (MODE == 7 ? pm_[i] : 0.f) + gt[i] * v[i];
                        *(v4u*)(O + (size_t)row * 1024 + col) = pack8(v); }
                }
                }
            }
    }
};
struct EpiRes {
    static constexpr bool PERM = false, AFTER_DRAIN = false;
    const float* xin; float* xout;
    __device__ __forceinline__ void operator()(const pg8::f32x4 (&acc)[2][2][4][2], const pg8::Unit& u, int wr, int wc, int fr, int fq) const {
#pragma unroll
        for (int ai = 0; ai < 2; ++ai)
#pragma unroll
            for (int m = 0; m < 4; ++m) { const size_t off = (size_t)(u.pm * 256 + ai * 128 + wr * 64 + m * 16 + fr) * 1024 + u.pn * 256 + wc * 32 + 4 * fq;
#pragma unroll
                for (int bj = 0; bj < 2; ++bj)
#pragma unroll
                    for (int n = 0; n < 2; ++n) { const f32x4 b = *(const f32x4*)(xin + off + bj * 128 + n * 16); f32x4 o; o.x = b.x + acc[ai][bj][m][n][0]; o.y = b.y + acc[ai][bj][m][n][1]; o.z = b.z + acc[ai][bj][m][n][2]; o.w = b.w + acc[ai][bj][m][n][3];
                        *(f32x4*)(xout + off + bj * 128 + n * 16) = o; } }
    }
};
__device__ __forceinline__ pg8::Gemm mkgemm(const bf16* A, const bf16* Bt, int Mr, int N, int K, int lda, int ldb) {
    pg8::Gemm g; g.A = A; g.Bt = Bt; g.M = Mr; g.N = N; g.K = K; g.lda = lda; g.ldb = ldb; g.a_skip_shift = 30; g.a_skip_bytes = 0; g.kwrap = 1 << 20; g.wrap_bytes = 0; g.b_shift = 30; g.b_stride_bytes = 0; g.a_pn_shift = 30; g.a_pn_bytes = 0; return g; }
template <class Epi> __device__ __forceinline__ void run_gemm_w(int wave_hint, LAS unsigned char* lds, const pg8::Gemm& g, const Epi& E, int G, int c) {
    asm volatile("" : "+s"(G), "+s"(c));
    pg8::StaticOrder S; S.init(g.M, g.N, G, c);
    pg8::gemm_phase<Epi, pg8::StaticOrder, true, true>(lds, g, S, E, wave_hint);
}

struct PairOrder { pg8::StaticOrder S0;
    __device__ void init(int Mr, int G, int c) { S0.init(Mr, 1024, G, c); }
    __device__ bool next(int i, pg8::Unit& u) const { if (!S0.next(i >> 1, u)) return false; u.pn += 4 * (i & 1); return true; }
    __device__ __forceinline__ void a_ready(const pg8::Unit&) const {}
    __device__ __forceinline__ void done(const pg8::Unit&) const {} };
template <class Epi> __device__ __forceinline__ void run_gemm_pair_w(int wave_hint, LAS unsigned char* lds, const pg8::Gemm& g, const Epi& E, int G, int c) {
    asm volatile("" : "+s"(G), "+s"(c));
    PairOrder S; S.init(g.M, G, c);
    pg8::gemm_phase<Epi, PairOrder, true, true>(lds, g, S, E, wave_hint);
}

#define run_gemm(...) run_gemm_w(wave, __VA_ARGS__)
#define run_gemm_pair(...) run_gemm_pair_w(wave, __VA_ARGS__)
__device__ __forceinline__ void tr_item(const float* W, int ldw, int k0, int c0, bf16* WT, int ldt, int drow, int koff, const float* mu, int smode, LAS float* scr, int lane) {
    { const int kr = lane >> 3, nq = (lane & 7) * 4; f32x4 t[8];
#pragma unroll
      for (int i = 0; i < 8; ++i) t[i] = *(const f32x4*)(W + (size_t)(k0 + i * 8 + kr) * ldw + c0 + nq);
#pragma unroll
      for (int i = 0; i < 8; ++i) { LAS float* d = scr + (i * 8 + kr) * 33 + nq; d[0] = t[i].x; d[1] = t[i].y; d[2] = t[i].z; d[3] = t[i].w; } }
    asm volatile("s_waitcnt lgkmcnt(0)" ::: "memory");
    const int c = lane & 7;
#pragma unroll
    for (int j = 0; j < 4; ++j) { const int n = (lane >> 3) + 8 * j; const LAS float* s = scr + (8 * c) * 33 + n;
        float sc = 1.f; if (smode) { const float m_ = mu[n]; sc = (smode == 1) ? 1.f - m_ : m_; }
        v4u o; o.x = pg8::cvt_pk_bf16(s[0 * 33] * sc, s[1 * 33] * sc); o.y = pg8::cvt_pk_bf16(s[2 * 33] * sc, s[3 * 33] * sc); o.z = pg8::cvt_pk_bf16(s[4 * 33] * sc, s[5 * 33] * sc); o.w = pg8::cvt_pk_bf16(s[6 * 33] * sc, s[7 * 33] * sc);
        *(v4u*)(WT + (size_t)(drow + n) * ldt + koff + k0 + 8 * c) = o; }
    asm volatile("s_waitcnt lgkmcnt(0)" ::: "memory");
}
__device__ __forceinline__ void rms_row(const float* xrow, const float* gain, bf16* orow, int lane) {
    const f32x4* xr = (const f32x4*)xrow + lane; const f32x4* gr = (const f32x4*)gain + lane;
    f32x4 v[4]; float s = 0.f;
#pragma unroll
    for (int j = 0; j < 4; ++j) { v[j] = xr[64 * j]; s += (v[j].x * v[j].x + v[j].y * v[j].y) + (v[j].z * v[j].z + v[j].w * v[j].w); }
    const float rstd = 1.f / sqrtf(wave_sum(s) * (1.f / 1024.f) + 1e-6f);
    v2u* o8 = (v2u*)orow + lane;
#pragma unroll
    for (int j = 0; j < 4; ++j) { const f32x4 g = gr[64 * j]; v2u w; w.x = pg8::cvt_pk_bf16(v[j].x * rstd * g.x, v[j].y * rstd * g.y); w.y = pg8::cvt_pk_bf16(v[j].z * rstd * g.z, v[j].w * rstd * g.w); o8[64 * j] = w; }
}
struct Ptrs { const float* in[35]; float* out; unsigned char* ws; };

__device__ __forceinline__ void weight_items(const Ptrs& P, int L, int gw, int NGW, LAS float* scr, int lane, int it_lo, int it_hi) {
    unsigned char* ws = P.ws;
    const float* w_in = P.in[2] + (size_t)L * 1024 * NIN; const float* mu = P.in[16] + (size_t)L * 1696;
    constexpr int I1A = 16 * 64, I1B = 16 * 53, IGLU = 8 * 16, IWB = 8 * 32, IWO = 16 * 32, IFI = 16 * 176, IFO = 44 * 32;
    constexpr int NIT = I1A + 2 * I1B + IGLU + 3 * IWB + IWO + IFI + IFO;
    for (int it = it_lo + gw; it < it_hi; it += NGW) {
        int r = it;
        if (r < I1A) { const int kb = r / 64, nb = r % 64; tr_item(w_in, NIN, kb * 64, nb * 32, (bf16*)(ws + WS_W1A), 1024, nb * 32, 0, nullptr, 0, scr, lane); continue; } r -= I1A;
        if (r < I1B) { const int kb = r / 53, nb = r % 53; tr_item(w_in, NIN, kb * 64, 2048 + nb * 32, (bf16*)(ws + WS_W1B), 2048, nb * 32, 0, mu + nb * 32, 1, scr, lane); continue; } r -= I1B;
        if (r < I1B) { const int kb = r / 53, nb = r % 53; tr_item(w_in, NIN, kb * 64, 2048 + nb * 32, (bf16*)(ws + WS_W1B), 2048, nb * 32, 1024, mu + nb * 32, 2, scr, lane); continue; } r -= I1B;
        if (r < IGLU) { const int kb = r / 16, nb = r % 16; tr_item(P.in[11] + (size_t)L * 512 * 512, 512, kb * 64, nb * 32, (bf16*)(ws + WS_WGLU), 512, nb * 32, 0, nullptr, 0, scr, lane); continue; } r -= IGLU;
        if (r < 3 * IWB) { const int n = r / IWB, q = r % IWB, kb = q / 32, nb = q % 32; tr_item(P.in[30] + ((size_t)L * 3 + n) * 512 * 1024, 1024, kb * 64, nb * 32, (bf16*)(ws + WS_WB) + (size_t)n * 1024 * 512, 512, nb * 32, 0, nullptr, 0, scr, lane); continue; } r -= 3 * IWB;
        if (r < IWO) { const int kb = r / 32, nb = r % 32; tr_item(P.in[31] + (size_t)L * 1024 * 1024, 1024, kb * 64, nb * 32, (bf16*)(ws + WS_WO), 1024, nb * 32, 0, nullptr, 0, scr, lane); continue; } r -= IWO;
        if (r < IFI) { const int kb = r / 176, nb = r % 176; const int n0 = nb * 32; const int drow = (n0 < DFF) ? (n0 / 128) * 256 + (n0 % 128) : ((n0 - DFF) / 128) * 256 + 128 + ((n0 - DFF) % 128);
            tr_item(P.in[33] + (size_t)L * 1024 * 2 * DFF, 2 * DFF, kb * 64, n0, (bf16*)(ws + WS_WFI), 1024, drow, 0, nullptr, 0, scr, lane); continue; } r -= IFI;
        { const int kb = r / 32, nb = r % 32; tr_item(P.in[34] + (size_t)L * DFF * 1024, 1024, kb * 64, nb * 32, (bf16*)(ws + WS_WFO), DFF, nb * 32, 0, nullptr, 0, scr, lane); }
    }
}
__device__ __forceinline__ void s5_tables(const Ptrs& P, int L, int g, int part, LAS float* sm, int tid) {
    LAS float* apr = sm; LAS float* api = sm + 17 * 64; LAS float* bbr = sm + 2 * 17 * 64; LAS float* bbi = bbr + 1024; LAS float* Ks = bbi + 1024;
    const float* lre = P.in[3] + (size_t)L * 2048; const float* lim = P.in[4] + (size_t)L * 2048; const float* ldt = P.in[5] + L * 32;
    const float* bre = P.in[6] + (size_t)L * 32768; const float* bim = P.in[7] + (size_t)L * 32768; const float* cre = P.in[8] + (size_t)L * 32768; const float* cim = P.in[9] + (size_t)L * 32768;
    if (tid < 64) { const int p = tid; const float dt = __expf(ldt[g]); const float lr = lre[g * 64 + p], li = lim[g * 64 + p];
        for (int j = 0; j <= 16; ++j) { const double ang = (double)j * (double)li * (double)dt * 0.15915494309189535; const float rev = (float)(ang - __builtin_floor(ang));
            const float mg = __expf((float)j * lr * dt); apr[j * 64 + p] = mg * __builtin_amdgcn_cosf(rev); api[j * 64 + p] = mg * __builtin_amdgcn_sinf(rev); }
        const float ar = apr[64 + p], ai = api[64 + p], den = lr * lr + li * li, nr = ar - 1.f, kr = (nr * lr + ai * li) / den, ki = (ai * lr - nr * li) / den;
        for (int c = 0; c < 16; ++c) { const float br = bre[(g * 64 + p) * 16 + c], bi = bim[(g * 64 + p) * 16 + c]; bbr[p * 16 + c] = kr * br - ki * bi; bbi[p * 16 + c] = kr * bi + ki * br; } }
    __syncthreads();
    { const int j = tid >> 5, cl = tid & 31, cp = 2 * part + (cl >> 4), c = cl & 15; float s = 0.f;
        for (int p = 0; p < 64; ++p) { const float tr = apr[j * 64 + p] * bbr[p * 16 + c] - api[j * 64 + p] * bbi[p * 16 + c], ti = apr[j * 64 + p] * bbi[p * 16 + c] + api[j * 64 + p] * bbr[p * 16 + c];
            s += cre[(g * 16 + cp) * 64 + p] * tr - cim[(g * 16 + cp) * 64 + p] * ti; }
        Ks[j * 32 + cl] = s; }
    __syncthreads();
    bf16* Mt = (bf16*)(P.ws + WS_MT) + (size_t)g * 256 * 384; bf16* Pt = (bf16*)(P.ws + WS_PT) + (size_t)g * 128 * 256;
    for (int idx = tid; idx < 32 * 48; idx += NTHR) { const int rl = idx / 48, kg = idx % 48, t = rl >> 1, cpl = rl & 1, cp = 2 * part + cpl, n = t * 16 + cp; float v[8];
        if (kg < 32) { const int s = kg >> 1, c0 = (kg & 1) * 8;
#pragma unroll
            for (int i = 0; i < 8; ++i) v[i] = (s <= t) ? Ks[(t - s) * 32 + cpl * 16 + c0 + i] : 0.f; }
        else {
#pragma unroll
            for (int i = 0; i < 8; ++i) { const int jj = (kg - 32) * 8 + i, p = jj & 63; const float cr = cre[(g * 16 + cp) * 64 + p], ci = cim[(g * 16 + cp) * 64 + p], ar = apr[(t + 1) * 64 + p], ai = api[(t + 1) * 64 + p];
                v[i] = (jj < 64) ? (cr * ar - ci * ai) : -(cr * ai + ci * ar); } }
        *(v4u*)(Mt + (size_t)n * 384 + kg * 8) = pack8(v); }
    { const int jj = part * 16 + (tid >> 5), kg = tid & 31, p = jj & 63, s = kg >> 1, c0 = (kg & 1) * 8; float v[8];
        const float ar = apr[(15 - s) * 64 + p], ai = api[(15 - s) * 64 + p];
#pragma unroll
        for (int i = 0; i < 8; ++i) { const float br = bbr[p * 16 + c0 + i], bi = bbi[p * 16 + c0 + i]; v[i] = (jj < 64) ? (ar * br - ai * bi) : (ar * bi + ai * br); }
        *(v4u*)(Pt + (size_t)jj * 256 + kg * 8) = pack8(v); }
    __syncthreads();
}
__device__ __forceinline__ void s5_chunk_scan(const Ptrs& P, int L, int gidx) {
    const int p = gidx & 63, g = (gidx >> 6) & 31, b = gidx >> 11;
    const float dt = __expf(P.in[5][L * 32 + g]); const float lr = P.in[3][(size_t)L * 2048 + g * 64 + p], li = P.in[4][(size_t)L * 2048 + g * 64 + p];
    const double ang = 16.0 * (double)li * (double)dt * 0.15915494309189535; const float rev = (float)(ang - __builtin_floor(ang)); const float mg = __expf(16.f * lr * dt);
    const float ar = mg * __builtin_amdgcn_cosf(rev), ai = mg * __builtin_amdgcn_sinf(rev);
    bf16* base = (bf16*)(P.ws + WS_US) + (size_t)(g * 1024 + b * 256) * 384 + 256 + p;
    float xr = 0.f, xi = 0.f;
#pragma unroll 32
    for (int c = 0; c < 256; ++c) { bf16* q = base + (size_t)c * 384; const float sr = bf2f(q[0]), si = bf2f(q[64]); q[0] = (bf16)f2bf(xr); q[64] = (bf16)f2bf(xi);
        const float nr = ar * xr - ai * xi + sr, ni = ar * xi + ai * xr + si; xr = nr; xi = ni; }
}

typedef float f2p __attribute__((ext_vector_type(2)));
#define RDL(x, l) __builtin_bit_cast(float, __builtin_amdgcn_readlane(__builtin_bit_cast(int, (x)), (l)))
#define LORA2(acc, tA, tB, off, wptr) do { _Pragma("unroll") for (int j_ = 0; j_ < 32; ++j_) { const f2p s_ = {RDL(tA, j_ + (off)), RDL(tB, j_ + (off))}; \
        float w8_[8]; unpack8(*(const LAS v4u*)((wptr) + j_ * 512 + c0), w8_); \
        _Pragma("unroll") for (int i_ = 0; i_ < 8; ++i_) acc[i_] = __builtin_elementwise_fma((f2p){w8_[i_], w8_[i_]}, s_, acc[i_]); \
 } } while (0)
#define LORA2F(acc, tA, tB, off, wptr) do { _Pragma("unroll") for (int j_ = 0; j_ < 32; ++j_) { const f2p s_ = {RDL(tA, j_ + (off)), RDL(tB, j_ + (off))}; \
        float w8_[8]; unpack8(*(const LAS v4u*)((wptr) + j_ * 512 + c0), w8_); \
        _Pragma("unroll") for (int i_ = 0; i_ < 8; ++i_) acc[i_] = __builtin_elementwise_fma((f2p){w8_[i_], w8_[i_]}, s_, acc[i_]); \
        if ((j_ & 3) == 3) asm volatile("" ::: "memory"); } } while (0)
__device__ __forceinline__ void prep_phase(const Ptrs& P, int L, LAS unsigned char* lds, int gw, int NGW, int tid, int wave, int lane) {
    asm volatile("" : "+v"(tid), "+v"(lane)); asm volatile("" : "+s"(wave));
    unsigned char* ws = P.ws;
    LAS bf16* w2s = (LAS bf16*)lds; LAS bf16* a2s = w2s + 32 * 512; LAS bf16* v2s = a2s + 32 * 512; LAS unsigned* v1s = (LAS unsigned*)(v2s + 32 * 512);
    LAS unsigned* vrow = (LAS unsigned*)(lds + 131072) + wave * 512;
    const float* w2 = P.in[18] + (size_t)L * 32 * 512; const float* a2 = P.in[20] + (size_t)L * 32 * 512;
    for (int i = tid; i < 32 * 512; i += NTHR) { w2s[i] = (bf16)f2bf(w2[i]); a2s[i] = (bf16)f2bf(a2[i]); }
    if (L == 1) { const float* v2 = P.in[29]; const float* v1 = P.in[28];
        for (int i = tid; i < 32 * 512; i += NTHR) v2s[i] = (bf16)f2bf(v2[i]);
        for (int i = tid; i < 256 * 32; i += NTHR) { const int c2 = i >> 5, j = i & 31; v1s[i] = f2bf(v1[(2 * c2) * 32 + j]) | (f2bf(v1[(2 * c2 + 1) * 32 + j]) << 16); } }
    __syncthreads();
    const int c0 = lane * 8;
    float qg[8], kg[8], w0r[8], a0r[8], v0r[8];
#pragma unroll
    for (int i = 0; i < 8; ++i) { qg[i] = P.in[12][L * 128 + ((c0 + i) & 127)] * C2Q; kg[i] = P.in[13][L * 128 + ((c0 + i) & 127)]; w0r[i] = P.in[17][L * 512 + c0 + i]; a0r[i] = P.in[19][L * 512 + c0 + i]; v0r[i] = (L == 1) ? P.in[27][c0 + i] : 0.f; }
    for (int pr = gw; pr < M / 2; pr += NGW) {
        const size_t m0 = (size_t)pr * 2;
        float tz[2];
#pragma unroll
        for (int t = 0; t < 2; ++t) {
            const size_t m = m0 + t;
            bf16* qp = (bf16*)(ws + WS_QB) + m * 512 + c0; bf16* kp = (bf16*)(ws + WS_KB) + m * 512 + c0;
            float q[8], k[8]; unpack8(*(const v4u*)qp, q); unpack8(*(const v4u*)kp, k);
            float sq = 0.f, sk = 0.f;
#pragma unroll
            for (int i = 0; i < 8; ++i) { sq += q[i] * q[i]; sk += k[i] * k[i]; }
            sq += __shfl_xor(sq, 1); sq += __shfl_xor(sq, 2); sq += __shfl_xor(sq, 4); sk += __shfl_xor(sk, 1); sk += __shfl_xor(sk, 2); sk += __shfl_xor(sk, 4);
            const float rq = 1.f / sqrtf(sq * (1.f / 64.f) + 1e-6f), rk = 1.f / sqrtf(sk * (1.f / 64.f) + 1e-6f);
#pragma unroll
            for (int i = 0; i < 8; ++i) { q[i] *= rq * qg[i]; k[i] *= rk * kg[i]; }
            *(v4u*)qp = pack8(q); *(v4u*)kp = pack8(k);
            const float zz = bf2f(((const bf16*)(ws + WS_Z))[m * ZP + 1536 + lane]);
            tz[t] = (lane < 32) ? tanh_f(zz) : zz;
        }
        f2p aw[8], aa[8];
#pragma unroll
        for (int i = 0; i < 8; ++i) { aw[i] = (f2p){w0r[i], w0r[i]}; aa[i] = (f2p){a0r[i], a0r[i]}; }
        LORA2(aw, tz[0], tz[1], 0, w2s);
        LORA2(aa, tz[0], tz[1], 32, a2s);
#pragma unroll
        for (int t = 0; t < 2; ++t) { float e8[8], a8[8];
#pragma unroll
            for (int i = 0; i < 8; ++i) { e8[i] = 0.6065306597f * sigm(t ? aw[i].y : aw[i].x); a8[i] = sigm(t ? aa[i].y : aa[i].x); }
            *(v4u*)((bf16*)(ws + WS_E) + (m0 + t) * 512 + c0) = pack8(e8); *(v4u*)((bf16*)(ws + WS_AB) + (m0 + t) * 512 + c0) = pack8(a8); }
        bf16* zr0 = (bf16*)(ws + WS_Z) + m0 * ZP; bf16* zr1 = zr0 + ZP;
        const v4u vA = *(const v4u*)(zr0 + 1024 + c0), vB = *(const v4u*)(zr1 + 1024 + c0);
        if (L == 0) { *(v4u*)((bf16*)(ws + WS_VF) + m0 * 512 + c0) = vA; *(v4u*)((bf16*)(ws + WS_VF) + (m0 + 1) * 512 + c0) = vB; }
        else {
            *(LAS v4u*)(vrow + c0) = (v4u){(vA.x & 0xffffu) | (vB.x << 16), (vA.x >> 16) | (vB.x & 0xffff0000u), (vA.y & 0xffffu) | (vB.y << 16), (vA.y >> 16) | (vB.y & 0xffff0000u)};
            *(LAS v4u*)(vrow + c0 + 4) = (v4u){(vA.z & 0xffffu) | (vB.z << 16), (vA.z >> 16) | (vB.z & 0xffff0000u), (vA.w & 0xffffu) | (vB.w << 16), (vA.w >> 16) | (vB.w & 0xffff0000u)};
            asm volatile("s_waitcnt lgkmcnt(0)" ::: "memory");
            const int j = lane & 31, hf = lane >> 5; f2p s = {0.f, 0.f};
#pragma unroll 8
            for (int c2 = 0; c2 < 128; ++c2) { const unsigned pk = v1s[(hf * 128 + c2) * 32 + j]; const v2u d = *(const LAS v2u*)(vrow + hf * 256 + 2 * c2);
                const float wl = __uint_as_float(pk << 16), wh = __uint_as_float(pk & 0xffff0000u);
                s = __builtin_elementwise_fma((f2p){__uint_as_float(d.x << 16), __uint_as_float(d.x & 0xffff0000u)}, (f2p){wl, wl}, s);
                s = __builtin_elementwise_fma((f2p){__uint_as_float(d.y << 16), __uint_as_float(d.y & 0xffff0000u)}, (f2p){wh, wh}, s); }
            float sx = s.x + __shfl_xor(s.x, 32), sy = s.y + __shfl_xor(s.y, 32);
            f2p am[8];
#pragma unroll
            for (int i = 0; i < 8; ++i) am[i] = (f2p){v0r[i], v0r[i]};
            LORA2(am, sx, sy, 0, v2s);
            float va[8], vb[8], fa[8], fb[8]; unpack8(vA, va); unpack8(vB, vb);
            unpack8(*(const v4u*)((const bf16*)(ws + WS_VF) + m0 * 512 + c0), fa); unpack8(*(const v4u*)((const bf16*)(ws + WS_VF) + (m0 + 1) * 512 + c0), fb);
#pragma unroll
            for (int i = 0; i < 8; ++i) { va[i] = va[i] + (fa[i] - va[i]) * sigm(am[i].x); vb[i] = vb[i] + (fb[i] - vb[i]) * sigm(am[i].y); }
            *(v4u*)(zr0 + 1024 + c0) = pack8(va); *(v4u*)(zr1 + 1024 + c0) = pack8(vb);
            asm volatile("s_waitcnt lgkmcnt(0)" ::: "memory"); }
    }
    __syncthreads();
}

__device__ __forceinline__ void rwkv_unit(const Ptrs& P, int L, LAS unsigned char* lds, int b, int h, int qr, int tid, int wave, int lane) {
    constexpr int T = 32, TOKF = 336;
    asm volatile("" : "+v"(tid), "+v"(lane)); asm volatile("" : "+s"(wave));
    unsigned char* ws = P.ws;
    const bf16* Z = (const bf16*)(ws + WS_Z); const bf16* AB = (const bf16*)(ws + WS_AB); const bf16* EB = (const bf16*)(ws + WS_E); bf16* YC = (bf16*)(ws + WS_YA);
    LAS float* buf0 = (LAS float*)lds; LAS float* buf1 = buf0 + T * TOKF;
    const bool producer = wave >= 4;
    const int pt = tid - 256, tok = pt >> 3, ks = (pt & 7) * 8;
    float kkk[8], kka[8];
    if (producer) {
#pragma unroll
        for (int i = 0; i < 8; ++i) { kkk[i] = P.in[22][L * 512 + h * 64 + ks + i]; kka[i] = P.in[23][L * 512 + h * 64 + ks + i]; } }
    const int row = wave * 4 + (lane >> 4), kq = lane & 15;
    typedef float f2s __attribute__((ext_vector_type(2)));
    f2s Slo = {0.f, 0.f}, Shi = {0.f, 0.f};
    const size_t m00 = (size_t)b * SEQ;
#define RW_PRODUCE(c, buf) do { const size_t m_ = m00 + (size_t)(c) * T + tok; const bf16* zr_ = Z + m_ * ZP; \
        float r_[8], k_[8], a_[8], e_[8]; unpack8(*(const v4u*)(zr_ + h * 64 + ks), r_); unpack8(*(const v4u*)(zr_ + 512 + h * 64 + ks), k_); \
        unpack8(*(const v4u*)(AB + m_ * 512 + h * 64 + ks), a_); unpack8(*(const v4u*)(EB + m_ * 512 + h * 64 + ks), e_); \
        float kk_[8], ss_ = 0.f; _Pragma("unroll") for (int i = 0; i < 8; ++i) { kk_[i] = k_[i] * kkk[i]; ss_ += kk_[i] * kk_[i]; } \
        ss_ += __shfl_xor(ss_, 1); ss_ += __shfl_xor(ss_, 2); ss_ += __shfl_xor(ss_, 4); const float inv_ = 1.f / fmaxf(sqrtf(ss_), 1e-12f); \
        LAS float* d_ = (buf) + tok * TOKF + ks; f32x4 o0, o1; \
        o0 = (f32x4){-kk_[0] * inv_, -kk_[1] * inv_, -kk_[2] * inv_, -kk_[3] * inv_}; o1 = (f32x4){-kk_[4] * inv_, -kk_[5] * inv_, -kk_[6] * inv_, -kk_[7] * inv_}; *(LAS f32x4*)(d_) = o0; *(LAS f32x4*)(d_ + 4) = o1; \
        o0 = (f32x4){kk_[0] * inv_ * a_[0], kk_[1] * inv_ * a_[1], kk_[2] * inv_ * a_[2], kk_[3] * inv_ * a_[3]}; o1 = (f32x4){kk_[4] * inv_ * a_[4], kk_[5] * inv_ * a_[5], kk_[6] * inv_ * a_[6], kk_[7] * inv_ * a_[7]}; *(LAS f32x4*)(d_ + 64) = o0; *(LAS f32x4*)(d_ + 68) = o1; \
        o0 = (f32x4){__expf(-e_[0]), __expf(-e_[1]), __expf(-e_[2]), __expf(-e_[3])}; o1 = (f32x4){__expf(-e_[4]), __expf(-e_[5]), __expf(-e_[6]), __expf(-e_[7])}; *(LAS f32x4*)(d_ + 128) = o0; *(LAS f32x4*)(d_ + 132) = o1; \
        o0 = (f32x4){k_[0] * (1.f + (a_[0] - 1.f) * kka[0]), k_[1] * (1.f + (a_[1] - 1.f) * kka[1]), k_[2] * (1.f + (a_[2] - 1.f) * kka[2]), k_[3] * (1.f + (a_[3] - 1.f) * kka[3])}; \
        o1 = (f32x4){k_[4] * (1.f + (a_[4] - 1.f) * kka[4]), k_[5] * (1.f + (a_[5] - 1.f) * kka[5]), k_[6] * (1.f + (a_[6] - 1.f) * kka[6]), k_[7] * (1.f + (a_[7] - 1.f) * kka[7])}; *(LAS f32x4*)(d_ + 192) = o0; *(LAS f32x4*)(d_ + 196) = o1; \
        o0 = (f32x4){r_[0], r_[1], r_[2], r_[3]}; o1 = (f32x4){r_[4], r_[5], r_[6], r_[7]}; *(LAS f32x4*)(d_ + 256) = o0; *(LAS f32x4*)(d_ + 260) = o1; \
        if ((pt & 7) < 2) { float v_[8]; unpack8(*(const v4u*)(zr_ + 1024 + h * 64 + qr * 16 + ks), v_); LAS float* dv_ = (buf) + tok * TOKF + 320 + ks; \
            *(LAS f32x4*)(dv_) = (f32x4){v_[0], v_[1], v_[2], v_[3]}; *(LAS f32x4*)(dv_ + 4) = (f32x4){v_[4], v_[5], v_[6], v_[7]}; } } while (0)
    if (producer) RW_PRODUCE(0, buf0);
    __syncthreads();
    if (!producer) __builtin_amdgcn_s_setprio(3);
    for (int c = 0; c < SEQ / T; ++c) {
        LAS float* cur = (c & 1) ? buf1 : buf0; LAS float* nxt = (c & 1) ? buf0 : buf1;
        if (producer) { if (c + 1 < SEQ / T) RW_PRODUCE(c + 1, nxt); }
        else {
            typedef float f2 __attribute__((ext_vector_type(2)));
            bf16* yo = YC + (m00 + (size_t)c * T) * 512 + h * 64 + qr * 16 + row;
            const LAS float* bs = cur + kq * 4; const LAS float* vs = cur + 320 + row;
            f32x4 a4 = *(const LAS f32x4*)(bs), b4 = *(const LAS f32x4*)(bs + 64), w4 = *(const LAS f32x4*)(bs + 128), k4 = *(const LAS f32x4*)(bs + 192), r4 = *(const LAS f32x4*)(bs + 256);
            float vv = vs[0]; float yp = 0.f, ykeep = 0.f;
#pragma unroll
            for (int t = 0; t < T; ++t) {
                const LAS float* nb = bs + (t + 1) * TOKF;
                const f32x4 na4 = *(const LAS f32x4*)(nb), nb4 = *(const LAS f32x4*)(nb + 64), nw4 = *(const LAS f32x4*)(nb + 128), nk4 = *(const LAS f32x4*)(nb + 192), nr4 = *(const LAS f32x4*)(nb + 256);
                const float nvv = vs[(t + 1) * TOKF];
                f2 p = Slo * (f2){a4.x, a4.y}; p = __builtin_elementwise_fma(Shi, (f2){a4.z, a4.w}, p);
                float sa = p.x + p.y;
                sa = DPP_ADD(sa, 0xB1); yp = DPP_ADD(yp, 0xB1); sa = DPP_ADD(sa, 0x4E); yp = DPP_ADD(yp, 0x4E); sa = DPP_ADD(sa, 0x141); yp = DPP_ADD(yp, 0x141); sa = DPP_ADD(sa, 0x140); yp = DPP_ADD(yp, 0x140);
                if (t > 0) ykeep = __builtin_bit_cast(float, __builtin_amdgcn_update_dpp(__builtin_bit_cast(int, yp), __builtin_bit_cast(int, ykeep), 0x111, 0xf, 0xf, false));
                if (t == 16) yo[(size_t)(15 - kq) * 512] = (bf16)f2bf(ykeep);
                const f2 sa2 = {sa, sa}, vv2 = {vv, vv};
                f2 tl = (f2){k4.x, k4.y} * vv2, th = (f2){k4.z, k4.w} * vv2;
                tl = __builtin_elementwise_fma((f2){b4.x, b4.y}, sa2, tl); th = __builtin_elementwise_fma((f2){b4.z, b4.w}, sa2, th);
                Slo = __builtin_elementwise_fma(Slo, (f2){w4.x, w4.y}, tl); Shi = __builtin_elementwise_fma(Shi, (f2){w4.z, w4.w}, th);
                f2 q = Slo * (f2){r4.x, r4.y}; q = __builtin_elementwise_fma(Shi, (f2){r4.z, r4.w}, q);
                yp = q.x + q.y;
                a4 = na4; b4 = nb4; w4 = nw4; k4 = nk4; r4 = nr4; vv = nvv; }
            yp = row16_sum(yp);
            ykeep = __builtin_bit_cast(float, __builtin_amdgcn_update_dpp(__builtin_bit_cast(int, yp), __builtin_bit_cast(int, ykeep), 0x111, 0xf, 0xf, false));
            yo[(size_t)(31 - kq) * 512] = (bf16)f2bf(ykeep);
        }
        __syncthreads();
    }
    __builtin_amdgcn_s_setprio(0);
#undef RW_PRODUCE
}

__device__ __forceinline__ void post_phase(const Ptrs& P, int L, LAS unsigned char* lds, int gw, int NGW, int tid, int wave, int lane) {
    asm volatile("" : "+v"(tid), "+v"(lane)); asm volatile("" : "+s"(wave));
    unsigned char* ws = P.ws;
    LAS bf16* g2s = (LAS bf16*)lds;
    const float* g2 = P.in[21] + (size_t)L * 96 * 512;
    for (int i = tid; i < 96 * 512; i += NTHR) g2s[i] = (bf16)f2bf(g2[i]);
    __syncthreads();
    const float lam_init = (L == 0) ? 0.2f : 0.35550906f;
    const float* lv = P.in[14] + L * 256;
    const float lam = __expf(wave_sum(lv[lane] * lv[64 + lane])) - __expf(wave_sum(lv[128 + lane] * lv[192 + lane])) + lam_init;
    const int c0 = lane * 8;
    float sg[8], lng[8], lnb[8], rk[8], ka[8];
#pragma unroll
    for (int i = 0; i < 8; ++i) { sg[i] = P.in[15][L * 128 + ((c0 + i) & 127)] * (1.f - lam_init); lng[i] = P.in[25][L * 512 + c0 + i]; lnb[i] = P.in[26][L * 512 + c0 + i]; rk[i] = P.in[24][L * 512 + c0 + i]; ka[i] = P.in[23][L * 512 + c0 + i]; }
    const float* xsrc = (L == 0) ? P.in[0] : P.out;
    for (int pr = gw; pr < M / 2; pr += NGW) {
        const size_t m0 = (size_t)pr * 2;
        float z0[2], z1[2], z2[2];
#pragma unroll
        for (int t = 0; t < 2; ++t) { const bf16* zr = (const bf16*)(ws + WS_Z) + (m0 + t) * ZP;
            z0[t] = sigm(bf2f(zr[1600 + (lane & 31)])); z1[t] = sigm(bf2f(zr[1632 + (lane & 31)])); z2[t] = sigm(bf2f(zr[1664 + (lane & 31)])); }
        f2p gacc[8];
#pragma unroll
        for (int i = 0; i < 8; ++i) gacc[i] = (f2p){0.f, 0.f};
        LORA2F(gacc, z0[0], z0[1], 0, g2s);
        LORA2F(gacc, z1[0], z1[1], 0, g2s + 32 * 512);
        LORA2F(gacc, z2[0], z2[1], 0, g2s + 64 * 512);
#pragma unroll
        for (int t = 0; t < 2; ++t) {
        const size_t m = m0 + t;
        bf16* zr = (bf16*)(ws + WS_Z) + m * ZP;
        float r[8], k[8], v[8], a[8], yr[8];
        unpack8(*(const v4u*)(zr + c0), r); unpack8(*(const v4u*)(zr + 512 + c0), k); unpack8(*(const v4u*)(zr + 1024 + c0), v);
        unpack8(*(const v4u*)((const bf16*)(ws + WS_AB) + m * 512 + c0), a); unpack8(*(const v4u*)((const bf16*)(ws + WS_YA) + m * 512 + c0), yr);
        float s1 = 0.f;
#pragma unroll
        for (int i = 0; i < 8; ++i) s1 += yr[i];
        s1 += __shfl_xor(s1, 1); s1 += __shfl_xor(s1, 2); s1 += __shfl_xor(s1, 4); const float mean = s1 * (1.f / 64.f);
        float s2 = 0.f, bd = 0.f;
#pragma unroll
        for (int i = 0; i < 8; ++i) { const float d = yr[i] - mean; s2 += d * d; bd += r[i] * (k[i] * (1.f + (a[i] - 1.f) * ka[i])) * rk[i]; }
        s2 += __shfl_xor(s2, 1); s2 += __shfl_xor(s2, 2); s2 += __shfl_xor(s2, 4); bd += __shfl_xor(bd, 1); bd += __shfl_xor(bd, 2); bd += __shfl_xor(bd, 4);
        const float rstd = 1.f / sqrtf(s2 * (1.f / 64.f) + 64e-5f);
        float yc[8];
#pragma unroll
        for (int i = 0; i < 8; ++i) yc[i] = ((yr[i] - mean) * rstd * lng[i] + lnb[i] + bd * v[i]) * (t ? gacc[i].y : gacc[i].x);
        const int hd = lane >> 4, j0 = (lane & 15) * 8; const bf16* orow = (const bf16*)(ws + WS_O) + m * 1024 + hd * 256 + j0;
        float o0[8], o1[8]; unpack8(*(const v4u*)orow, o0); unpack8(*(const v4u*)(orow + 128), o1);
        float so = 0.f;
#pragma unroll
        for (int i = 0; i < 8; ++i) { o0[i] = o0[i] - lam * o1[i]; so += o0[i] * o0[i]; }
        so += __shfl_xor(so, 1); so += __shfl_xor(so, 2); so += __shfl_xor(so, 4); so += __shfl_xor(so, 8);
        const float ro = 1.f / sqrtf(so * (1.f / 128.f) + 1e-5f);
#pragma unroll
        for (int i = 0; i < 8; ++i) o0[i] *= ro * sg[i];
        *(v4u*)(zr + c0) = pack8(yc); *(v4u*)(zr + 512 + c0) = pack8(o0);
        }
    }
    __syncthreads();
}


__device__ __forceinline__ void dump_stage(const Ptrs& P, int k, int blk, int G, int tid) {
    unsigned char* ws = P.ws; float* out = P.out;
    for (size_t i = (size_t)blk * NTHR + tid; i < (size_t)M * 1024; i += (size_t)G * NTHR) {
        const size_t m = i >> 10; const int c = (int)(i & 1023); float v = 0.f;
        const bf16* Z = (const bf16*)(ws + WS_Z); const bf16* US = (const bf16*)(ws + WS_US);
        if (k == 1) v = bf2f(Z[m * ZP + c]) + bf2f(Z[m * ZP + 704 + c]) + bf2f(((const bf16*)(ws + WS_QB))[m * 512 + (c & 511)]) + bf2f(((const bf16*)(ws + WS_KB))[m * 512 + (c & 511)]) + bf2f(((const bf16*)(ws + WS_VB))[m * 512 + (c & 511)]) + bf2f(US[m * 768 + (c % 768)]);
        else if (k == 2) {
#if !defined(DSEL) || DSEL==1
            v += bf2f(US[m * 768 + (c % 768)]);
#endif
#if !defined(DSEL) || DSEL==2
            v += bf2f(((const bf16*)(ws + WS_E))[m * 512 + (c & 511)]) + bf2f(((const bf16*)(ws + WS_AB))[m * 512 + (c & 511)]);
#endif
#if !defined(DSEL) || DSEL==3
            v += bf2f(((const bf16*)(ws + WS_QB))[m * 512 + (c & 511)]) + bf2f(((const bf16*)(ws + WS_KB))[m * 512 + (c & 511)]);
#endif
#if !defined(DSEL) || DSEL==4
            v += bf2f(Z[m * ZP + 1024 + (c & 511)]) + bf2f(((const bf16*)(ws + WS_VF))[m * 512 + (c & 511)]);
#endif
        }
        else if (k == 3) v = bf2f(((const bf16*)(ws + WS_O))[m * 1024 + c]) + bf2f(((const bf16*)(ws + WS_YA))[m * 512 + (c & 511)]) + bf2f(US[m * 768 + (c % 768)]);
        else if (k == 4) v = bf2f(Z[m * ZP + c]) + bf2f(((const bf16*)(ws + WS_XN))[m * 1024 + c]) + bf2f(((const bf16*)(ws + WS_YL))[m * 512 + (c & 511)]);
        else if (k == 5) v = bf2f(((const bf16*)(ws + WS_YA))[m * 512 + (c & 511)]);
        else if (k == 6) v = bf2f(((const bf16*)(ws + WS_P12))[m * 1024 + c]);
        else if (k == 9) v = bf2f(((const bf16*)(ws + WS_HID))[m * DFF + c]) + bf2f(((const bf16*)(ws + WS_HID))[m * DFF + 1024 + c]) + bf2f(((const bf16*)(ws + WS_H2N))[m * 1024 + c]);
        out[i] = v;
    }
}
#define XB_TMO      128
#define XB_XCNT(j)  (256  + 64 * (j))
#define XB_XSUB(j)  (1280 + 64 * (j))
#define XB_XGEN(j)  (2304 + 64 * (j))
#define XB_TOP      3328
#define XB_TOPGEN   3392
#define XCD_BAR_WORDS 3456
#define XB_SPIN_CAP (1u << 18)

__device__ __forceinline__ unsigned xb_ld(unsigned* p)              { return __hip_atomic_load(p, __ATOMIC_RELAXED, __HIP_MEMORY_SCOPE_AGENT); }
__device__ __forceinline__ unsigned xb_add(unsigned* p, unsigned v) { return __hip_atomic_fetch_add(p, v, __ATOMIC_RELAXED, __HIP_MEMORY_SCOPE_AGENT); }
__device__ __forceinline__ unsigned xb_xcc_id() { return (unsigned)__builtin_amdgcn_s_getreg((3 << 11) | 20) & 0xFu; }
#define XB_SPIN(cond, bar) do { unsigned _sp = 0; while (cond) { __builtin_amdgcn_s_sleep(1); \
    if ((++_sp & 255u) == 0u) { if (xb_ld(&(bar)[XB_TMO])) break; if (_sp > XB_SPIN_CAP) { atomicAdd(&(bar)[XB_TMO], 1u); break; } } } } while (0)

struct XcdBarrier {
    unsigned* bar; unsigned x;
    volatile LAS unsigned* st;
};

__device__ __forceinline__ XcdBarrier xcd_barrier_post(unsigned* bar, volatile LAS unsigned* st) {
    XcdBarrier b; b.bar = bar; b.x = xb_xcc_id(); b.st = st;
    if (threadIdx.x == 0) (void)xb_add(&bar[XB_XCNT(b.x)], 1u);
    return b;
}
__device__ __forceinline__ void xcd_barrier_complete(unsigned* bar, unsigned x, unsigned& nloc, unsigned& nx) {
    const unsigned G = gridDim.x * gridDim.y * gridDim.z;
    unsigned sum, cnt, mine, sp = 0u;
    for (;;) {
        sum = 0u; cnt = 0u; mine = 0u;
#pragma unroll
        for (unsigned j = 0; j < 16; ++j) { const unsigned c = xb_ld(&bar[XB_XCNT(j)]); sum += c; cnt += (c > 0u) ? 1u : 0u; mine = (j == x) ? c : mine; }
        if (sum == G) break;
        __builtin_amdgcn_s_sleep(1);
        if ((++sp & 255u) == 0u) { if (xb_ld(&bar[XB_TMO])) break; if (sp > XB_SPIN_CAP) { atomicAdd(&bar[XB_TMO], 1u); break; } }
    }
    nloc = mine > 0u ? mine : 1u; nx = cnt > 0u ? cnt : 1u;
}

__device__ __forceinline__ void xcd_barrier(const XcdBarrier& b, const int tid_hint) {
    asm volatile("s_waitcnt vmcnt(0)" ::: "memory");
    __syncthreads();
    if (tid_hint == 0) {
        unsigned* bar = b.bar;
        __builtin_amdgcn_s_waitcnt(0);
        unsigned nloc = b.st[0], nx = b.st[1];
        if (nloc == 0u) { xcd_barrier_complete(bar, b.x, nloc, nx); b.st[0] = nloc; b.st[1] = nx; }
        const unsigned old = xb_add(&bar[XB_XSUB(b.x)], 1u);
        const unsigned gen = old / nloc;
        if (old + 1u == (gen + 1u) * nloc) {
            __builtin_amdgcn_fence(__ATOMIC_RELEASE, "agent");
            asm volatile("s_waitcnt vmcnt(0)" ::: "memory");
            const unsigned og = xb_add(&bar[XB_TOP], 1u);
            const unsigned tg = og / nx;
            if (og + 1u == (tg + 1u) * nx) xb_add(&bar[XB_TOPGEN], 1u);
            else XB_SPIN(xb_ld(&bar[XB_TOPGEN]) == tg, bar);
            __builtin_amdgcn_fence(__ATOMIC_ACQUIRE, "agent");
            xb_add(&bar[XB_XGEN(b.x)], 1u);
            asm volatile("s_waitcnt vmcnt(0)" ::: "memory");
        } else {
            XB_SPIN(xb_ld(&bar[XB_XGEN(b.x)]) == gen, bar);
            __builtin_amdgcn_fence(__ATOMIC_ACQUIRE, "agent");
            asm volatile("s_waitcnt vmcnt(0)" ::: "memory");
        }
    }
    __syncthreads();
}


#define GSYNC() do { xcd_barrier(xbar, tid); } while (0)
#if defined(PROBE_A)
#define STAMP(k) do { if (blk0 == 0 && tid0 == 0) ((LAS unsigned long long*)(lds + LDS_XB + 256))[(k)] = __builtin_amdgcn_s_memrealtime(); } while (0)
#else
#define STAMP(k) do { } while (0)
#endif
struct Args { Ptrs p; int pad0, pad1; };
__global__ void __launch_bounds__(NTHR, 2) mega_fwd(Args args) {
    extern __shared__ __attribute__((aligned(16))) unsigned char lds_raw[];
    LAS unsigned char* lds = (LAS unsigned char*)lds_raw;
    cg::grid_group grid = cg::this_grid();
    const Ptrs& P = args.p;
    unsigned char* ws = P.ws;
    const int tid0 = threadIdx.x, wave0 = __builtin_amdgcn_readfirstlane(tid0 >> 6);
    const int wave = wave0;
    const int G0 = gridDim.x, blk0 = blockIdx.x;
    const int gw0 = blk0 * NWAVES + wave, NGW0 = G0 * NWAVES;
    unsigned* ctl = (unsigned*)(ws + WS_CTL);
    if (tid0 < 64) ((LAS unsigned*)(lds + LDS_XB))[tid0] = 0u;
    __syncthreads();
    XcdBarrier xbar = xcd_barrier_post(ctl + CW_BAR, (volatile LAS unsigned*)(lds + LDS_XB));
    grid.sync();
    for (int L = 0; L < 2; ++L) {
        int gw = gw0, NGW = NGW0, blk = blk0, G = G0; asm volatile("" : "+s"(gw), "+s"(NGW), "+s"(blk), "+s"(G));
        int tid = wave * 64 + (int)__builtin_amdgcn_mbcnt_hi(~0u, __builtin_amdgcn_mbcnt_lo(~0u, 0u)); asm volatile("" : "+v"(tid)); int lane = tid & 63;
#define RELAUNDER() do { tid = wave * 64 + (int)__builtin_amdgcn_mbcnt_hi(~0u, __builtin_amdgcn_mbcnt_lo(~0u, 0u)); asm volatile("" : "+v"(tid)); lane = tid & 63; asm volatile("" : "+s"(gw), "+s"(NGW), "+s"(blk), "+s"(G)); } while (0)
        STAMP(13 * L);
        const float* xsrc = (L == 0) ? P.in[0] : P.out;
#if !defined(ONLY) || ONLY==0
#if defined(DUP_PH0)
        for (int rep = 0; rep < 2; ++rep)
#endif
        {
        s5_tables(P, L, blk >> 3, blk & 7, (LAS float*)lds, tid);
        if (L == 0) weight_items(P, L, gw, NGW, (LAS float*)(lds + wave * 16384), lane, 0, 4128);
        weight_items(P, L, gw, NGW, (LAS float*)(lds + wave * 16384), lane, 6944, 8352);
        for (int i = blk * NTHR + tid; i < 96 * 2048 / 8; i += G * NTHR) ((v4u*)((bf16*)(ws + WS_W1B) + (size_t)1696 * 2048))[i] = (v4u){0u, 0u, 0u, 0u};
        if (blk < 4) { for (int i = tid; i < 128; i += NTHR) ((v4u*)((bf16*)(ws + WS_XNP) + (size_t)blk * 4097 * 1024))[i] = (v4u){0u, 0u, 0u, 0u}; }
        for (int m = gw; m < M; m += NGW) rms_row(xsrc + (size_t)m * 1024, P.in[1] + L * 1024, (bf16*)(ws + WS_XNP) + ((size_t)(m >> 12) * 4097 + 1 + (m & 4095)) * 1024, lane);
        }
        GSYNC(); RELAUNDER(); STAMP(1 + 13 * L);
#endif
#if !defined(ONLY) || ONLY==1
#if defined(DUP_PH1)
        for (int rep = 0; rep < 2; ++rep)
#endif
        {
        { pg8::Gemm g = mkgemm((const bf16*)(ws + WS_XNP) + 1024, (const bf16*)(ws + WS_W1A), M, 2048, 1024, 1024, 1024); g.a_skip_shift = 4; g.a_skip_bytes = 2048;
          Epi8<1> E{(bf16*)(ws + WS_QB), 512, (const bf16*)(ws + WS_US), nullptr};
#if !defined(SUB) || SUB==0
          run_gemm(lds, g, E, G, blk);
#endif
          }
        { pg8::Gemm g = mkgemm((const bf16*)(ws + WS_XNP) + 1024, (const bf16*)(ws + WS_W1B), M, 1792, 2048, 1024, 2048); g.a_skip_shift = 4; g.a_skip_bytes = 2048; g.kwrap = 16; g.wrap_bytes = 4096;
          Epi8<0> E{(bf16*)(ws + WS_Z), ZP, nullptr, nullptr};
#if !defined(SUB) || SUB==1
          run_gemm(lds, g, E, G, blk);
#endif
          }
        if (blk >= 192) { __syncthreads(); weight_items(P, L, (blk - 192) * NWAVES + wave, 64 * NWAVES, (LAS float*)(lds + wave * 16384), lane, 4128, 6944); }
        }
        GSYNC(); RELAUNDER(); STAMP(2 + 13 * L);
#if defined(STOP_AFTER) && STOP_AFTER==1
        dump_stage(P, 1, blk, G, tid); return;
#endif
#endif
#if !defined(ONLY) || ONLY==2
        { pg8::Gemm g = mkgemm((const bf16*)(ws + WS_US), (const bf16*)(ws + WS_PT), 32768, 256, 256, 384, 256); g.b_shift = 2; g.b_stride_bytes = 128 * 256 * 2;
          Epi8<2> E{(bf16*)(ws + WS_US), 384, nullptr, nullptr}; run_gemm(lds, g, E, G, blk);
#if defined(DUP_S5G)
          run_gemm(lds, g, E, G, blk);
#endif
          }
        __syncthreads();
        prep_phase(P, L, lds, gw, NGW, tid, wave, lane);
        GSYNC(); RELAUNDER(); STAMP(3 + 13 * L);
#if defined(STOP_AFTER) && STOP_AFTER==2
        dump_stage(P, 2, blk, G, tid); return;
#endif
#endif
#if !defined(ONLY) || ONLY==3
        if (blk < 128) rwkv_unit(P, L, lds, blk >> 5, (blk >> 2) & 7, blk & 3, tid, wave, lane);
#if defined(DUP_RWKV)
        if (blk < 128) rwkv_unit(P, L, lds, blk >> 5, (blk >> 2) & 7, blk & 3, tid, wave, lane);
#endif
        else if (blk >= G - 16) s5_chunk_scan(P, L, (blk - (G - 16)) * NTHR + tid);
        __syncthreads();
        {
            volatile LAS unsigned* qslot = (volatile LAS unsigned*)(lds + 140000);
            for (;;) {
                if (tid == 0) qslot[0] = atomicAdd(ctl + 64 * L, 1u);
                __syncthreads();
                const unsigned uidx = qslot[0];
                __syncthreads();
                if (uidx >= 1024u) break;
                const int qb = 15 - (int)(uidx >> 6), bhv = uidx & 63, b = bhv >> 4, hv = bhv & 15, hh = hv >> 2, cc = (hv >> 1) & 1, half = hv & 1;
                attn_body::attn_unit<8>(b, (2 * hh + cc) * 64, (2 * hh + cc) * 64, (2 * hh + half) * 64, hv * 64, qb,
                    (const attn_body::bf16*)(ws + WS_QB), (const attn_body::bf16*)(ws + WS_KB), (const attn_body::bf16*)(ws + WS_VB), (attn_body::bf16*)(ws + WS_O), (char*)lds_raw, wave);
#if defined(DUP_ATT)
                attn_body::attn_unit<8>(b, (2 * hh + cc) * 64, (2 * hh + cc) * 64, (2 * hh + half) * 64, hv * 64, qb,
                    (const attn_body::bf16*)(ws + WS_QB), (const attn_body::bf16*)(ws + WS_KB), (const attn_body::bf16*)(ws + WS_VB), (attn_body::bf16*)(ws + WS_O), (char*)lds_raw, wave);
#endif
            }
        }
        GSYNC(); RELAUNDER(); STAMP(4 + 13 * L);
#if defined(STOP_AFTER) && STOP_AFTER==3
        dump_stage(P, 3, blk, G, tid); return;
#endif
#endif
#if !defined(ONLY) || ONLY==4
        { pg8::Gemm g = mkgemm((const bf16*)(ws + WS_US), (const bf16*)(ws + WS_MT), 32768, 256, 384, 384, 384); g.b_shift = 2; g.b_stride_bytes = 256 * 384 * 2;
          Epi8<3> E{(bf16*)(ws + WS_YL), 512, (const bf16*)(ws + WS_US), P.in[10] + L * 512}; run_gemm(lds, g, E, G, blk);
#if defined(DUP_S5G)
          run_gemm(lds, g, E, G, blk);
#endif
          }
        __syncthreads();
        post_phase(P, L, lds, gw, NGW, tid, wave, lane);
        GSYNC(); RELAUNDER(); STAMP(5 + 13 * L);
#if defined(STOP_AFTER) && STOP_AFTER==4
        dump_stage(P, 4, blk, G, tid); return;
#endif
#endif
#if !defined(ONLY) || ONLY==5
        { pg8::Gemm g = mkgemm((const bf16*)(ws + WS_YL), (const bf16*)(ws + WS_WGLU), M, 512, 512, 512, 512);
          Epi8<4> E{(bf16*)(ws + WS_YA), 512, (const bf16*)(ws + WS_YL), nullptr}; run_gemm(lds, g, E, G, blk);
#if defined(DUP_S5G)
          run_gemm(lds, g, E, G, blk);
#endif
          }
        __syncthreads();
        { const float* w_in = P.in[2] + (size_t)L * 1024 * NIN; LAS float* scr = (LAS float*)(lds + wave * 16384);
          for (int it = gw; it < 16 * 96; it += NGW) { const int kb = it / 96, nb = it % 96; tr_item(w_in, NIN, kb * 64, 3744 + nb * 32, (bf16*)(ws + WS_WG), 1024, nb * 32, 0, nullptr, 0, scr, lane); } }
        { const int nsh = (blk < 128) ? 1 : 2; const int vw0 = (blk < 128) ? blk * NWAVES + wave : 1024 + ((blk - 128) * NWAVES + wave) * 2;
          for (int s = 0; s < nsh; ++s) for (int m = vw0 + s; m < M; m += 3072) rms_row(xsrc + (size_t)m * 1024, P.in[1] + L * 1024, (bf16*)(ws + WS_XN) + (size_t)m * 1024, lane); }
        GSYNC(); RELAUNDER(); STAMP(6 + 13 * L);
#if defined(STOP_AFTER) && STOP_AFTER==5
        dump_stage(P, 5, blk, G, tid); return;
#endif
        { pg8::Gemm g = mkgemm((const bf16*)(ws + WS_XN), (const bf16*)(ws + WS_WG) + (size_t)1024 * 1024, M, 2048, 1024, 1024, 1024);
          Epi8<10> E{(bf16*)(ws + WS_P12), 1024, nullptr, nullptr}; run_gemm_pair(lds, g, E, G, blk); }
        { pg8::Gemm g = mkgemm((const bf16*)(ws + WS_Z) + 512, (const bf16*)(ws + WS_WB) + (size_t)1024 * 512, M, 2048, 512, ZP, 512); g.a_pn_shift = 2; g.a_pn_bytes = -1024;
          Epi8<11> E{(bf16*)(ws + WS_P12), 1024, nullptr, nullptr}; run_gemm_pair(lds, g, E, G, blk); }
        RELAUNDER(); STAMP(7 + 13 * L);
#endif
#if !defined(ONLY) || ONLY==6
        { pg8::Gemm g = mkgemm((const bf16*)(ws + WS_XN), (const bf16*)(ws + WS_WG), M, 1024, 1024, 1024, 1024);
          Epi8<5> E{(bf16*)(ws + WS_G0), 1024, nullptr, nullptr}; run_gemm(lds, g, E, G, blk); }
        { pg8::Gemm g = mkgemm((const bf16*)(ws + WS_YA), (const bf16*)(ws + WS_WB), M, 1024, 512, 512, 512);
          Epi8<7> E{(bf16*)(ws + WS_P12), 1024, (const bf16*)(ws + WS_G0), nullptr}; run_gemm(lds, g, E, G, blk); }
        GSYNC(); RELAUNDER(); STAMP(8 + 13 * L);
#if defined(STOP_AFTER) && STOP_AFTER==6
        dump_stage(P, 6, blk, G, tid); return;
#endif
#endif
#if !defined(ONLY) || ONLY==7
        { pg8::Gemm g = mkgemm((const bf16*)(ws + WS_P12), (const bf16*)(ws + WS_WO), M, 1024, 1024, 1024, 1024);
          EpiRes E{xsrc, P.out}; run_gemm(lds, g, E, G, blk); }
        GSYNC(); RELAUNDER(); STAMP(9 + 13 * L);
#endif
#if !defined(ONLY) || ONLY==8
#if defined(DUP_SYNC)
        for (int rep = 0; rep < 10; ++rep) { GSYNC(); }
#endif
        for (int m = gw; m < M; m += NGW) rms_row(P.out + (size_t)m * 1024, P.in[32] + L * 1024, (bf16*)(ws + WS_H2N) + (size_t)m * 1024, lane);
#if defined(DUP_PH8)
        for (int m = gw; m < M; m += NGW) rms_row(P.out + (size_t)m * 1024, P.in[32] + L * 1024, (bf16*)(ws + WS_H2N) + (size_t)m * 1024, lane);
#endif
        GSYNC(); RELAUNDER(); STAMP(10 + 13 * L);
#endif
#if !defined(ONLY) || ONLY==9
        { pg8::Gemm g = mkgemm((const bf16*)(ws + WS_H2N), (const bf16*)(ws + WS_WFI), M, 2 * DFF, 1024, 1024, 1024);
          Epi8<8> E{(bf16*)(ws + WS_HID), DFF, nullptr, nullptr}; run_gemm(lds, g, E, G, blk);
#if defined(DUP_FFN1)
          run_gemm(lds, g, E, G, blk);
#endif
          }
        if (L == 0 && blk >= 128) { __syncthreads(); weight_items(P, 1, (blk - 128) * NWAVES + wave, 128 * NWAVES, (LAS float*)(lds + wave * 16384), lane, 0, 4128); }
        GSYNC(); RELAUNDER(); STAMP(11 + 13 * L);
#if defined(STOP_AFTER) && STOP_AFTER==9
        dump_stage(P, 9, blk, G, tid); return;
#endif
#endif
#if !defined(ONLY) || ONLY==10
        { pg8::Gemm g = mkgemm((const bf16*)(ws + WS_HID), (const bf16*)(ws + WS_WFO), M, 1024, DFF, DFF, DFF);
          EpiRes E{P.out, P.out}; run_gemm(lds, g, E, G, blk); }
#endif
        if (L == 0) { GSYNC(); STAMP(12); }
    }
#if defined(PROBE_A)
    GSYNC();
    if (blk0 == 0) { STAMP(25); __syncthreads(); LAS unsigned long long* st = (LAS unsigned long long*)(lds + LDS_XB + 256);
        float dA = 0.f, dB = 0.f;
        for (int L = 0; L < 2; ++L) { for (int k = 0; k < 12; ++k) { const int k1 = (L == 1 && k == 11) ? 25 : 13 * L + k + 1; const float d = (float)(long long)(st[k1] - st[13 * L + k]); if ((PROBE_A >> k) & 1) dA += d; if ((PROBE_B >> k) & 1) dB += d; } }
#if defined(PROBE_CAL)
        dB = 50000.f;
#endif
        const float qa = __expf(0.04f * rintf(__logf(fmaxf(dA, 1.f)) * 25.f)), qb = __expf(0.04f * rintf(__logf(fmaxf(dB, 1.f)) * 25.f));
        if (tid0 == 0) { P.out[3] += qa * 0.01f; } }
#endif
}

extern "C" void kernel_launch(void* const* d_in, const int* in_sizes, int n_in, void* d_out, int out_size, void* d_ws, size_t ws_size, hipStream_t stream) {
    static int grid = 0;
    if (grid == 0) {
        if (n_in != 35 || out_size != M * DMOD || ws_size < WS_END) { fprintf(stderr, "kernel_launch: unexpected shapes (n_in %d out %d ws %zu)\n", n_in, out_size, ws_size); grid = -1; return; }
        int dev = 0, cus = 0, per_cu = 0;
        hipGetDevice(&dev); hipDeviceGetAttribute(&cus, hipDeviceAttributeMultiprocessorCount, dev);
        hipFuncSetAttribute((const void*)mega_fwd, hipFuncAttributeMaxDynamicSharedMemorySize, LDS_BYTES);
        hipOccupancyMaxActiveBlocksPerMultiprocessor(&per_cu, (const void*)mega_fwd, NTHR, LDS_BYTES);
        if (per_cu < 1) { fprintf(stderr, "kernel_launch: occupancy query says %d\n", per_cu); grid = -1; return; }
        grid = cus;
        if (grid != 256) { fprintf(stderr, "kernel_launch: built for a 256-CU device (one workgroup per CU); got %d\n", grid); grid = -1; return; }
    }
    if (grid < 0) return;
    hipMemsetAsync((char*)d_ws + WS_CTL, 0, 65536, stream);
    Args a{};
    for (int i = 0; i < 35; ++i) a.p.in[i] = (const float*)d_in[i];
    a.p.out = (float*)d_out; a.p.ws = (unsigned char*)d_ws;
    void* kargs[] = {&a};
    hipError_t e = hipLaunchCooperativeKernel((const void*)mega_fwd, dim3(grid), dim3(NTHR), kargs, LDS_BYTES, stream);
    if (e != hipSuccess) fprintf(stderr, "cooperative launch failed: %s (grid %d)\n", hipGetErrorString(e), grid);
}
```

```cpp
#include <hip/hip_runtime.h>
#include <hip/hip_cooperative_groups.h>
#include <cstdio>
#include <cstdint>

namespace pg8 {
#define PG8_LAS __attribute__((address_space(3)))
typedef unsigned short bf16_t;
typedef short bf16x8 __attribute__((ext_vector_type(8)));
typedef float f32x4 __attribute__((ext_vector_type(4)));
typedef unsigned u32x4 __attribute__((ext_vector_type(4)));
constexpr int BM = 256, BK = 64, HALF = 128, HTB = HALF * BK * 2  , STAGE_BYTES = 8 * HTB, NXCD = 8, WGM = 8;

__host__ __device__ __forceinline__ int lds_byte(int r, int c) { const int st = (r >> 4) * 2 + (c >> 5), rr = r & 15, cc = c & 31, ob = rr * 64 + cc * 2; return st * 1024 + (ob ^ (((ob >> 9) & 1) << 5)); }
__host__ __device__ __forceinline__ void stage_rc(int b, int& R, int& C) { const int st = b / 1024, sb = b % 1024, swz = sb ^ (((sb >> 9) & 1) << 5); R = (st >> 1) * 16 + swz / 64; C = (st & 1) * 32 + (swz % 64) / 2; }
__host__ __device__ __forceinline__ int perm32(int rho) { const int n = rho >> 4, i = rho & 15; return 8 * (i >> 2) + 4 * n + (i & 3); }

struct Unit { int pm, pn; };
struct Gemm { const bf16_t* A; const bf16_t* Bt; int M, N, K; int lda, ldb; int a_skip_shift; int a_skip_bytes; int kwrap; int wrap_bytes; int b_shift; int b_stride_bytes; int a_pn_shift; int a_pn_bytes;
  __device__ __forceinline__ const char* abase(const Unit& u) const { return (const char*)A + (size_t)u.pm * (size_t)(256 * 2) * lda + (size_t)(u.pm >> a_skip_shift) * a_skip_bytes + (long)(u.pn >> a_pn_shift) * (long)a_pn_bytes; }
  __device__ __forceinline__ const char* bbase(const Unit& u) const { return (const char*)Bt + (size_t)u.pn * (size_t)(256 * 2) * ldb + (size_t)(u.pm >> b_shift) * b_stride_bytes; } };

struct StaticOrder {
    int nM, nN, nwg, G, c;
    __host__ __device__ void init(int M, int N, int G_, int c_) { nM = M / BM; nN = N / BM; nwg = nM * nN; G = G_; c = c_; }
    __host__ __device__ bool next(int i, Unit& u) const {
        const long L = (long)i * G + c; if (L >= nwg) return false;
        int wgid = (int)L; { const int q = nwg / NXCD, r = nwg % NXCD, xcd = wgid % NXCD, off = wgid / NXCD; wgid = (xcd < r ? xcd * (q + 1) : r * (q + 1) + (xcd - r) * q) + off; }
        const int nig = WGM * nN, gid = wgid / nig, fm = gid * WGM, gsz = (nM - fm) < WGM ? (nM - fm) : WGM;
        u.pm = fm + ((wgid % nig) % gsz); u.pn = (wgid % nig) / gsz; return true;
    }
    __device__ __forceinline__ void a_ready(const Unit&) const {}
    __device__ __forceinline__ void done(const Unit&) const {}
};

typedef float cvt_f32x2_t __attribute__((ext_vector_type(2))); typedef __bf16 cvt_bf16x2_t __attribute__((ext_vector_type(2)));
__device__ __forceinline__ unsigned cvt_pk_bf16(float lo, float hi) { cvt_f32x2_t v = {lo, hi}; cvt_bf16x2_t b = __builtin_convertvector(v, cvt_bf16x2_t); return __builtin_bit_cast(unsigned, b); }
typedef float f32x2 __attribute__((ext_vector_type(2)));
__device__ __forceinline__ f32x2 gelu_pk(f32x2 v) {
    const f32x2 av = __builtin_elementwise_abs(v), d = av * 0.2316418882f + 1.0f;
    f32x2 t; t.x = __builtin_amdgcn_rcpf(d.x); t.y = __builtin_amdgcn_rcpf(d.y);
    f32x2 q = t * 0.5307027145f + (-0.7265760135f); q = q * t + 0.7107068705f; q = q * t + (-0.142248368f); q = q * t + 0.127414796f; q = q * t;
    const f32x2 s = (v * v) * (-0.72134752044f);
    f32x2 e; e.x = __builtin_amdgcn_exp2f(s.x); e.y = __builtin_amdgcn_exp2f(s.y);
    const f32x2 m = v * (q * e), r = v - m;
    f32x2 o; o.x = v.x < 0.f ? m.x : r.x; o.y = v.y < 0.f ? m.y : r.y; return o;
}

template <int ACT  > struct EpiBf16 {
    static constexpr bool PERM = true, AFTER_DRAIN = false; static_assert(ACT == 0 || ACT == 1, "EpiBf16: ACT is 0 (none) or 1 (gelu_pk)");
    bf16_t* O; int ldc; const float* bias; int split_cols; size_t split_stride; float scale0;
    __device__ __forceinline__ void operator()(const f32x4 (&acc)[2][2][4][2], const Unit& u, int wr, int wc, int fr, int fq) const {
        const int row0 = u.pm * BM + wr * 64 + fr; int colt = u.pn * BM; bf16_t* base = O;
        float sc = 1.f; if (split_cols) { const int t = colt / split_cols; base += (size_t)t * split_stride; colt -= t * split_cols; if (t == 0) sc = scale0; }
        const int col0 = colt + wc * 32 + 8 * fq, bcol0 = u.pn * BM + wc * 32 + 8 * fq;
        f32x4 bv[2][2];
#pragma unroll
        for (int bj = 0; bj < 2; ++bj)
#pragma unroll
            for (int n = 0; n < 2; ++n) bv[bj][n] = bias ? *(const f32x4*)(bias + bcol0 + bj * HALF + 4 * n) : (f32x4){0.f, 0.f, 0.f, 0.f};
#pragma unroll
        for (int ai = 0; ai < 2; ++ai)
#pragma unroll
            for (int m = 0; m < 4; ++m) { bf16_t* rowp = base + (size_t)(row0 + ai * HALF + m * 16) * ldc + col0;
#pragma unroll
                for (int bj = 0; bj < 2; ++bj) { f32x4 v0 = acc[ai][bj][m][0] + bv[bj][0], v1 = acc[ai][bj][m][1] + bv[bj][1];
                    if (ACT == 1) { f32x2 a = gelu_pk((f32x2){v0[0], v0[1]}), b = gelu_pk((f32x2){v0[2], v0[3]}), c = gelu_pk((f32x2){v1[0], v1[1]}), d = gelu_pk((f32x2){v1[2], v1[3]});
                        v0 = (f32x4){a.x, a.y, b.x, b.y}; v1 = (f32x4){c.x, c.y, d.x, d.y}; }
                    v0 = v0 * sc; v1 = v1 * sc; u32x4 w; w.x = cvt_pk_bf16(v0[0], v0[1]); w.y = cvt_pk_bf16(v0[2], v0[3]); w.z = cvt_pk_bf16(v1[0], v1[1]); w.w = cvt_pk_bf16(v1[2], v1[3]);
                    *(u32x4*)(rowp + bj * HALF) = w; } }
    }
};
template <class Epi, class Sched, bool ALIGN_EPI = false, bool SP2 = false>
__device__ __forceinline__ void gemm_phase(PG8_LAS unsigned char* lds, const Gemm g, const Sched& S, const Epi& E, int wave_hint) {
    int tid_l = wave_hint * 64 + (int)__builtin_amdgcn_mbcnt_hi(~0u, __builtin_amdgcn_mbcnt_lo(~0u, 0u)); asm volatile("" : "+v"(tid_l)); const int tid = tid_l, wid = __builtin_amdgcn_readfirstlane(tid >> 6), lane = tid & 63, wr = wid >> 2, wc = wid & 3, fr = lane & 15, fq = lane >> 4;
    const int K = g.K, nt = K / BK;
    unsigned voffA[2], voffB[2];
#pragma unroll
    for (int i = 0; i < 2; ++i) { int R, C; stage_rc(tid * 16 + i * 8192, R, C); const int Rb = Epi::PERM ? ((R & ~31) + perm32(R & 31)) : R;
        voffA[i] = (unsigned)(R * g.lda + C) * 2u; voffB[i] = (unsigned)(Rb * g.ldb + C) * 2u; }
    const size_t kstep = (size_t)(BK * 2);
    const size_t hstepA = (size_t)HALF * g.lda * 2, hstepB = (size_t)HALF * g.ldb * 2; const size_t wrapb = (size_t)g.wrap_bytes;
    const unsigned ldsw = (unsigned)wid * 1024u;
    const int aoff = lds_byte(wr * 64 + fr, fq * 8), boff = lds_byte(wc * 32 + fr, fq * 8);
#define PG8_SA(b, h) (((b) * 2 + (h)) * HTB)
#define PG8_SB(b, h) ((4 + (b) * 2 + (h)) * HTB)
#define PG8_STAGE(bufoff, gbase, voff) do { _Pragma("unroll") for (int _i = 0; _i < 2; ++_i) \
        __builtin_amdgcn_global_load_lds((const unsigned*)((const char*)(gbase) + (voff)[_i]), (PG8_LAS unsigned*)(lds + (bufoff) + ldsw + _i * 8192), 16, 0, 0); } while (0)
#define PG8_LDA(dst, b, h) do { _Pragma("unroll") for (int m = 0; m < 4; ++m) _Pragma("unroll") for (int k = 0; k < 2; ++k) dst[m][k] = *(const PG8_LAS bf16x8*)(lds + PG8_SA(b, h) + aoff + m * 2048 + k * 1024); } while (0)
#define PG8_LDB(dst, b, h) do { _Pragma("unroll") for (int n = 0; n < 2; ++n) _Pragma("unroll") for (int k = 0; k < 2; ++k) dst[n][k] = *(const PG8_LAS bf16x8*)(lds + PG8_SB(b, h) + boff + n * 2048 + k * 1024); } while (0)
#define PG8_MMA(ai, bj, At, Bt) do { __builtin_amdgcn_s_setprio(1); _Pragma("unroll") for (int m = 0; m < 4; ++m) _Pragma("unroll") for (int n = 0; n < 2; ++n) _Pragma("unroll") for (int k = 0; k < 2; ++k) \
        acc[ai][bj][m][n] = __builtin_amdgcn_mfma_f32_16x16x32_bf16(Bt[n][k], At[m][k], acc[ai][bj][m][n], 0, 0, 0); __builtin_amdgcn_s_setprio(0); } while (0)
#define PG8_WAIT_V(n) asm volatile("s_waitcnt vmcnt(" #n ")" ::: "memory")
#define PG8_WAIT_L(n) asm volatile("s_waitcnt lgkmcnt(" #n ")" ::: "memory")
#define PG8_BAR __builtin_amdgcn_s_barrier()
#define PG8_SCHED __builtin_amdgcn_sched_barrier(0)
    Unit cur, nxt; int ui = 0;
    if (!S.next(0, cur)) return;
    f32x4 acc[2][2][4][2];
#pragma unroll
    for (int a = 0; a < 2; ++a)
#pragma unroll
        for (int b = 0; b < 2; ++b)
#pragma unroll
            for (int m = 0; m < 4; ++m)
#pragma unroll
                for (int n = 0; n < 2; ++n) acc[a][b][m][n] = (f32x4){0.f, 0.f, 0.f, 0.f};
    bf16x8 At[4][2], B0[2][2], B1[2][2];
    const char* cA = g.abase(cur); const char* cB = g.bbase(cur);
    S.a_ready(cur);
    if constexpr (SP2) {
        PG8_STAGE(PG8_SB(0, 0), cB, voffB); PG8_STAGE(PG8_SB(0, 1), cB + hstepB, voffB); PG8_STAGE(PG8_SA(0, 0), cA, voffA); PG8_STAGE(PG8_SA(0, 1), cA + hstepA, voffA);
        if (wr == 1) PG8_BAR;
        PG8_WAIT_V(2); PG8_BAR;
        PG8_STAGE(PG8_SB(1, 0), cB + kstep, voffB); PG8_STAGE(PG8_SA(1, 0), cA + kstep, voffA); PG8_STAGE(PG8_SB(1, 1), cB + hstepB + kstep, voffB);
        PG8_WAIT_V(6); PG8_BAR;
    } else {
        PG8_STAGE(PG8_SB(0, 0), cB, voffB); PG8_STAGE(PG8_SA(0, 0), cA, voffA); PG8_STAGE(PG8_SB(0, 1), cB + hstepB, voffB); PG8_STAGE(PG8_SA(0, 1), cA + hstepA, voffA);
        if (wr == 1) PG8_BAR;
        PG8_WAIT_V(4); PG8_BAR;
        PG8_STAGE(PG8_SB(1, 0), cB + kstep, voffB); PG8_STAGE(PG8_SA(1, 0), cA + kstep, voffA); PG8_STAGE(PG8_SB(1, 1), cB + hstepB + kstep, voffB);
        PG8_WAIT_V(6); PG8_BAR;
    }
    for (;;) {
        const bool has_next = S.next(ui + 1, nxt);
        const char* nA = has_next ? g.abase(nxt) : cA; const char* nB = has_next ? g.bbase(nxt) : cB;
        for (int t = 0; t < nt; t += 2) {
            const bool last = (t == nt - 2);
            const char* a1 = cA + (size_t)(t + 1) * kstep - ((t + 1) >= g.kwrap ? wrapb : (size_t)0);
            const char* a2 = last ? nA : cA + (size_t)(t + 2) * kstep - ((t + 2) >= g.kwrap ? wrapb : (size_t)0); const char* b2 = last ? nB : cB + (size_t)(t + 2) * kstep;
            const char* a3 = a2 + kstep; const char* b3 = b2 + kstep;
            if (last && has_next) S.a_ready(nxt);
            if constexpr (SP2) {
            PG8_LDB(B0, 0, 0); PG8_LDB(B1, 0, 1); PG8_SCHED; PG8_LDA(At, 0, 0); PG8_STAGE(PG8_SA(1, 1), a1 + hstepA, voffA);
            PG8_WAIT_V(8); PG8_WAIT_L(0); PG8_BAR; PG8_MMA(0, 0, At, B0); PG8_MMA(0, 1, At, B1); PG8_BAR; PG8_SCHED;
            PG8_LDA(At, 0, 1); PG8_STAGE(PG8_SB(0, 0), b2, voffB); PG8_STAGE(PG8_SB(0, 1), b2 + hstepB, voffB); PG8_STAGE(PG8_SA(0, 0), a2, voffA);
            PG8_WAIT_V(8); PG8_WAIT_L(0); PG8_BAR; PG8_MMA(1, 0, At, B0); PG8_MMA(1, 1, At, B1); PG8_BAR; PG8_SCHED;
            PG8_LDB(B0, 1, 0); PG8_LDB(B1, 1, 1); PG8_SCHED; PG8_LDA(At, 1, 0); PG8_STAGE(PG8_SA(0, 1), a2 + hstepA, voffA);
            PG8_WAIT_V(8); PG8_WAIT_L(0); PG8_BAR; PG8_MMA(0, 0, At, B0); PG8_MMA(0, 1, At, B1); PG8_BAR; PG8_SCHED;
            PG8_LDA(At, 1, 1); PG8_STAGE(PG8_SB(1, 0), b3, voffB); PG8_STAGE(PG8_SB(1, 1), b3 + hstepB, voffB); PG8_STAGE(PG8_SA(1, 0), a3, voffA);
            PG8_WAIT_V(8); PG8_WAIT_L(0); PG8_BAR; PG8_MMA(1, 0, At, B0); PG8_MMA(1, 1, At, B1); PG8_BAR; PG8_SCHED;
            } else {
            PG8_LDB(B0, 0, 0); PG8_SCHED; PG8_LDA(At, 0, 0); PG8_STAGE(PG8_SA(1, 1), a1 + hstepA, voffA);
            PG8_WAIT_L(8); PG8_BAR; PG8_WAIT_L(0); PG8_MMA(0, 0, At, B0); PG8_BAR; PG8_SCHED;
            PG8_LDB(B1, 0, 1); PG8_STAGE(PG8_SB(0, 0), b2, voffB);
            PG8_BAR; PG8_WAIT_L(0); PG8_MMA(0, 1, At, B1); PG8_BAR;
            PG8_LDA(At, 0, 1); PG8_STAGE(PG8_SA(0, 0), a2, voffA);
            PG8_BAR; PG8_WAIT_L(0); PG8_MMA(1, 0, At, B0); PG8_BAR; PG8_SCHED;
            PG8_STAGE(PG8_SB(0, 1), b2 + hstepB, voffB);
            PG8_WAIT_V(6); PG8_BAR; PG8_MMA(1, 1, At, B1); PG8_BAR;
            PG8_LDB(B0, 1, 0); PG8_SCHED; PG8_LDA(At, 1, 0); PG8_STAGE(PG8_SA(0, 1), a2 + hstepA, voffA);
            PG8_WAIT_L(8); PG8_BAR; PG8_WAIT_L(0); PG8_MMA(0, 0, At, B0); PG8_BAR; PG8_SCHED;
            PG8_LDB(B1, 1, 1); PG8_STAGE(PG8_SB(1, 0), b3, voffB);
            PG8_BAR; PG8_WAIT_L(0); PG8_MMA(0, 1, At, B1); PG8_BAR;
            PG8_LDA(At, 1, 1); PG8_STAGE(PG8_SA(1, 0), a3, voffA);
            PG8_BAR; PG8_WAIT_L(0); PG8_MMA(1, 0, At, B0); PG8_BAR; PG8_SCHED;
            PG8_STAGE(PG8_SB(1, 1), b3 + hstepB, voffB);
            PG8_WAIT_V(6); PG8_BAR; PG8_MMA(1, 1, At, B1); PG8_BAR;
            }
        }
        if constexpr (ALIGN_EPI) { if (wr == 0) PG8_BAR; }
        if constexpr (!Epi::AFTER_DRAIN) { E(acc, cur, wr, wc, fr, fq); S.done(cur); }
        if (!has_next) break;
#pragma unroll
        for (int a = 0; a < 2; ++a)
#pragma unroll
            for (int b = 0; b < 2; ++b)
#pragma unroll
                for (int m = 0; m < 4; ++m)
#pragma unroll
                    for (int n = 0; n < 2; ++n) acc[a][b][m][n] = (f32x4){0.f, 0.f, 0.f, 0.f};
        cur = nxt; cA = nA; cB = nB; ++ui;
        if constexpr (ALIGN_EPI) { if (wr == 1) PG8_BAR; }
    }
    PG8_WAIT_V(0);
    if constexpr (!ALIGN_EPI) { if (wr == 0) PG8_BAR; }
    PG8_BAR;
    if constexpr (Epi::AFTER_DRAIN) { E.fused(acc, cur, wr, wc, fr, fq, lds, wid, lane); S.done(cur); }
#undef PG8_SA
#undef PG8_SB
#undef PG8_STAGE
#undef PG8_LDA
#undef PG8_LDB
#undef PG8_MMA
#undef PG8_WAIT_V
#undef PG8_WAIT_L
#undef PG8_BAR
#undef PG8_SCHED
}
}
#include <hip/hip_bf16.h>
#include <cmath>
namespace attn_body {
using bf16=__hip_bfloat16;
using bf16x8=__attribute__((ext_vector_type(8)))short;
using s16x4=__attribute__((ext_vector_type(4)))short;
using f32x16=__attribute__((ext_vector_type(16)))float;
using u32x4=__attribute__((ext_vector_type(4)))unsigned;
constexpr int BATCH=4,NHEAD=16,SEQ=4096,D=64,DMQ=512,DMO=1024;
constexpr int NW=8,QBLK=32,QB=QBLK*NW,KVBLK=64,NQB=SEQ/QB;
constexpr int ATTN_UNIT_ROWS=QB;
__device__ __forceinline__ int crow(int r,int hi){return (r&3)+8*(r>>2)+4*hi;}
#define SBAR() __builtin_amdgcn_sched_barrier(0)
__device__ __forceinline__ void cmask(f32x16&p0,f32x16&p1,int jb,int qrel,int hi){
  const float NEG=-INFINITY; int kb=64*jb+4*hi;
  #pragma unroll
  for(int r=0;r<16;++r){int kv=kb+(r&3)+8*(r>>2); if(kv>qrel)p0[r]=NEG; if(kv+32>qrel)p1[r]=NEG;}
}

constexpr int NSLOT=3, SLOTB=8192;
constexpr int LDS_K=0, LDS_V=NSLOT*SLOTB, LDS_WS=2*NSLOT*SLOTB, LDS_OST=LDS_WS+NW*64*4, LDS_BYTES=LDS_OST+NW*4096;
constexpr float C2=0.125f*1.4426950408889634f;
__device__ __forceinline__ void glds16(const void*gsrc,unsigned lds_dst){unsigned keep;
  asm volatile("s_mov_b32 %0, m0\n\ts_mov_b32 m0, %2\n\ts_nop 0\n\tglobal_load_lds_dwordx4 %1, off\n\ts_mov_b32 m0, %0":"=&s"(keep):"v"(gsrc),"s"(lds_dst):"memory");}
__device__ __forceinline__ float max3f(float a,float b,float c){float r;asm("v_max3_f32 %0, %1, %2, %3":"=v"(r):"v"(a),"v"(b),"v"(c));return r;}
__device__ __forceinline__ float max2f(float a,float b){float r;asm("v_max_f32_e32 %0, %1, %2":"=v"(r):"v"(a),"v"(b));return r;}
__device__ __forceinline__ float fadd_s(float a,float b){float r;asm("v_add_f32_e32 %0, %1, %2":"=v"(r):"v"(a),"v"(b));return r;}
__device__ __forceinline__ float fsub_s(float a,float b){float r;asm("v_sub_f32_e32 %0, %1, %2":"=v"(r):"v"(a),"v"(b));return r;}
typedef float f32x2_t __attribute__((ext_vector_type(2))); typedef __bf16 bf16x2_t __attribute__((ext_vector_type(2)));
__device__ __forceinline__ unsigned cvtpk_s(float lo,float hi){f32x2_t v={lo,hi};bf16x2_t b=__builtin_convertvector(v,bf16x2_t);return __builtin_bit_cast(unsigned,b);}
#define WAIT_BAR(N) asm volatile("s_waitcnt vmcnt(" #N ") lgkmcnt(0)\n\ts_barrier":::"memory")

__device__ __forceinline__ void qkt(f32x16&p0,f32x16&p1,const char*Kslot,const bf16x8*qr,const f32x16&negm,int r32,int hi){
  const char*kb=Kslot+hi*1024+r32*16;
  #pragma unroll
  for(int d0=0;d0<4;++d0){
    const bf16x8 b0=*reinterpret_cast<const bf16x8*>(kb+d0*2048);
    const bf16x8 b1=*reinterpret_cast<const bf16x8*>(kb+d0*2048+512);
    if(d0==0){p0=__builtin_amdgcn_mfma_f32_32x32x16_bf16(b0,qr[0],negm,0,0,0);p1=__builtin_amdgcn_mfma_f32_32x32x16_bf16(b1,qr[0],negm,0,0,0);}
    else{p0=__builtin_amdgcn_mfma_f32_32x32x16_bf16(b0,qr[d0],p0,0,0,0);p1=__builtin_amdgcn_mfma_f32_32x32x16_bf16(b1,qr[d0],p1,0,0,0);}}
}
typedef __attribute__((address_space(3))) const char* lds_cptr;
typedef short v4i16_t __attribute__((ext_vector_type(4)));
__device__ __forceinline__ void kload8(bf16x8*kf,lds_cptr kp){
  kf[0]=*(const __attribute__((address_space(3))) bf16x8*)(kp);      kf[1]=*(const __attribute__((address_space(3))) bf16x8*)(kp+512);
  kf[2]=*(const __attribute__((address_space(3))) bf16x8*)(kp+2048); kf[3]=*(const __attribute__((address_space(3))) bf16x8*)(kp+2560);
  kf[4]=*(const __attribute__((address_space(3))) bf16x8*)(kp+4096); kf[5]=*(const __attribute__((address_space(3))) bf16x8*)(kp+4608);
  kf[6]=*(const __attribute__((address_space(3))) bf16x8*)(kp+6144); kf[7]=*(const __attribute__((address_space(3))) bf16x8*)(kp+6656);
}
__device__ __forceinline__ void kload2(bf16x8*kf,lds_cptr kp,int j){ kf[2*j]=*(const __attribute__((address_space(3))) bf16x8*)(kp+j*2048); kf[2*j+1]=*(const __attribute__((address_space(3))) bf16x8*)(kp+j*2048+512); }
__device__ __forceinline__ s16x4 vtr(lds_cptr p){ return __builtin_bit_cast(s16x4,__builtin_amdgcn_ds_read_tr16_b64_v4i16((__attribute__((address_space(3))) v4i16_t*)p)); }
__device__ __forceinline__ float rowmax(const f32x16&p0,const f32x16&p1){
  float a=max3f(p0[0],p0[1],p1[0]),b=max3f(p0[2],p0[3],p1[1]);a=max3f(a,p1[2],p1[3]);
  #pragma unroll
  for(int r=4;r<16;r+=4){a=max3f(a,p0[r],p0[r+1]);b=max3f(b,p0[r+2],p0[r+3]);a=max3f(a,p1[r],p1[r+1]);b=max3f(b,p1[r+2],p1[r+3]);}
  const float m=max2f(a,b);
  auto rr=__builtin_amdgcn_permlane32_swap(__float_as_uint(m),__float_as_uint(m),false,false);
  return max2f(__uint_as_float(rr[0]),__uint_as_float(rr[1]));
}
__device__ __forceinline__ void pv(f32x16*o,int vb,bf16x8 pa0,bf16x8 pa1,bf16x8 pa2,bf16x8 pa3){
  #pragma unroll
  for(int d0=0;d0<2;++d0){s16x4 lo[4],hi[4];
    #pragma unroll
    for(int ks=0;ks<4;++ks){
      asm volatile("ds_read_b64_tr_b16 %0,%1 offset:%c2":"=&v"(lo[ks]):"v"(vb),"i"(d0*4096+ks*1024):"memory");
      asm volatile("ds_read_b64_tr_b16 %0,%1 offset:%c2":"=&v"(hi[ks]):"v"(vb),"i"(d0*4096+ks*1024+512):"memory");}
    asm volatile("s_waitcnt lgkmcnt(0)":::"memory");SBAR();
    #define PK(k) (bf16x8){lo[k][0],lo[k][1],lo[k][2],lo[k][3],hi[k][0],hi[k][1],hi[k][2],hi[k][3]}
    o[d0]=__builtin_amdgcn_mfma_f32_32x32x16_bf16(pa0,PK(0),o[d0],0,0,0);
    o[d0]=__builtin_amdgcn_mfma_f32_32x32x16_bf16(pa1,PK(1),o[d0],0,0,0);
    o[d0]=__builtin_amdgcn_mfma_f32_32x32x16_bf16(pa2,PK(2),o[d0],0,0,0);
    o[d0]=__builtin_amdgcn_mfma_f32_32x32x16_bf16(pa3,PK(3),o[d0],0,0,0);
    #undef PK
  }
}

#ifndef ATTN_STORE16
#define ATTN_STORE16(p,v) (*(u32x4*)(p)=(v))
#endif
template<int THRL> __device__ __forceinline__ void attn_unit(int b,int cq,int ck,int cv,int co,int qb,const bf16*Q,const bf16*__restrict__ K,const bf16*__restrict__ V,bf16*O,char*shm,int wave_hint){
  int tid_l=wave_hint*64+(int)__builtin_amdgcn_mbcnt_hi(~0u,__builtin_amdgcn_mbcnt_lo(~0u,0u)); asm volatile("":"+v"(tid_l)); const int tid=tid_l,lane=tid&63,r32=lane&31,hi=lane>>5; const int wid=__builtin_amdgcn_readfirstlane(tid>>6);
  const long rowbase=(long)b*SEQ; const int q0=qb*QB;
  const bf16*Qw=Q+(rowbase+q0+wid*QBLK)*DMQ+cq;
  const bf16*Kh=K+rowbase*DMQ+ck,*Vh=V+rowbase*DMQ+cv;
  const unsigned lds0=(unsigned)(uintptr_t)shm;
  float*wsf=(float*)(shm+LDS_WS)+wid*64;
  const bf16*ksrc=Kh+(long)lane*DMQ+wid*8;
  const bf16*vsrc=Vh+(long)(16*(wid&3)+(lane>>2))*DMQ+(wid>>2)*32+(lane&3)*8;
  const unsigned kdst=lds0+LDS_K+wid*1024, vdst=lds0+LDS_V+wid*1024;
  #define DMA_K(t,slot) glds16(ksrc+(long)(t)*KVBLK*DMQ,(unsigned)__builtin_amdgcn_readfirstlane(kdst+(slot)))
  #define DMA_V(t,slot) glds16(vsrc+(long)(t)*KVBLK*DMQ,(unsigned)__builtin_amdgcn_readfirstlane(vdst+(slot)))
  const int vb0=(int)(lds0+LDS_V)+((lane>>4)&1)*32+(lane&3)*8+(4*hi+((lane&15)>>2))*64;
  const char*Kbase=shm+LDS_K; bf16x8 kf[8];
  const lds_cptr shm3=(lds_cptr)shm; const lds_cptr kp0=shm3+LDS_K+hi*1024+r32*16; const lds_cptr vp0=shm3+LDS_V+((lane>>4)&1)*32+(lane&3)*8+(4*hi+((lane&15)>>2))*64;
  const int NT=(q0+QB)/KVBLK;
  DMA_K(0,0);DMA_V(0,0);DMA_K(1,SLOTB);
  bf16x8 qr[4];
  #pragma unroll
  for(int d0=0;d0<4;++d0)qr[d0]=*reinterpret_cast<const bf16x8*>(&Qw[(long)r32*DMQ+d0*16+hi*8]);
  float mhat=0.f,l_reg=0.f;f32x16 o[2];o[0]=f32x16{};o[1]=f32x16{};f32x16 negm=f32x16{};asm volatile("":"+v"(negm));
  const int qrel=wid*QBLK+r32;
  #define CMASK(P0,P1,t) do{int jb_=(t)-(NT-4); if(jb_>=0)cmask(P0,P1,jb_,qrel,hi);}while(0)
  bool resc=false;
  #define START(P0,P1) do{ const float rm=rowmax(P0,P1); resc=false; \
    { const float dl=rm; mhat=fadd_s(mhat,dl); \
      _Pragma("unroll") for(int r=0;r<16;++r){P0[r]=fsub_s(P0[r],dl);P1[r]=fsub_s(P1[r],dl);} \
      _Pragma("unroll") for(int r=0;r<16;++r)negm[r]=-mhat; asm volatile("":"+v"(negm)); } \
    _Pragma("unroll") for(int r=0;r<16;++r)P0[r]=__builtin_amdgcn_exp2f(P0[r]); }while(0)
  #define RESC() do{ if(resc){ asm volatile("s_waitcnt lgkmcnt(0)":::"memory"); \
      _Pragma("unroll") for(int d_=0;d_<2;++d_) _Pragma("unroll") for(int r=0;r<16;++r)o[d_][r]*=wsf[crow(r,hi)]; } }while(0)
  f32x16 pA0,pA1,pB0,pB1;
  int sl_prev=0,sl_cur=0,sl_next=SLOTB;
  #define ROT() do{sl_prev=sl_cur;sl_cur=sl_next;sl_next=(sl_next==(NSLOT-1)*SLOTB)?0:sl_next+SLOTB;}while(0)
  DMA_K(2,2*SLOTB);
  WAIT_BAR(3);
  qkt(pA0,pA1,Kbase,qr,negm,r32,hi);asm volatile("s_nop 15\n\ts_nop 7":"+v"(pA0),"+v"(pA1));CMASK(pA0,pA1,0);
  START(pA0,pA1);
  _Pragma("unroll") for(int r=0;r<16;++r)pA1[r]=__builtin_amdgcn_exp2f(pA1[r]);
  WAIT_BAR(0);
  DMA_K(3,0);DMA_V(1,SLOTB);
  ROT();
  kload8(kf,kp0+sl_cur);
  WAIT_BAR(2);
  s16x4 vlo[8],vhi[8]; u32x4 pw0,pw1,pw2,pw3;
  #define PKW(P,B) cvtpk_s(P[B],P[B+1])
  #define PAF(k) __builtin_bit_cast(bf16x8,pw##k)
  #define VFR(i) (bf16x8){vlo[i][0],vlo[i][1],vlo[i][2],vlo[i][3],vhi[i][0],vhi[i][1],vhi[i][2],vhi[i][3]}
  #define PIN(x) asm volatile("":"+v"(x))
  #define MX3(a,b,c) __builtin_fmaxf(__builtin_fmaxf((a),(b)),(c))
  #define GAPA(MF,A0,A1,A2,A3,W0,W1,PW) do{ MF; sacc+=A0; sacc+=A1; sacc+=A2; sacc+=A3; PIN(sacc); W0; W1; PIN(PW); SBAR(); }while(0)
  #define EX(v) __builtin_amdgcn_exp2f(v)
  #define GAPB(MF,X,B) do{ MF; X[B]=EX(X[B]); X[B+1]=EX(X[B+1]); X[B+2]=EX(X[B+2]); X[B+3]=EX(X[B+3]); PIN(X); SBAR(); }while(0)
  #define VRD(i) do{ vlo[i]=vtr(vp_+(((i)>>2)*4096+((i)&3)*1024)); vhi[i]=vtr(vp_+(((i)>>2)*4096+((i)&3)*1024+512)); }while(0)
  #define KRD(G,j) do{ if(G){ kload2(kf,kp0+sl_next,j); SBAR(); } }while(0)
  #define STEP(C0,C1,P0,P1,t,GK,GV,GL) do{ SBAR(); \
    const lds_cptr vp_=vp0+sl_prev; \
    VRD(0); SBAR(); float sacc=(P0[0]+P0[1]); \
    GAPA(C0=__builtin_amdgcn_mfma_f32_32x32x16_bf16(kf[0],qr[0],negm,0,0,0), P0[2],P0[3],P0[4],P0[5],     pw0[0]=PKW(P0,0), pw0[1]=PKW(P0,2), pw0); \
    VRD(4); SBAR(); GAPA(C1=__builtin_amdgcn_mfma_f32_32x32x16_bf16(kf[1],qr[0],negm,0,0,0), P0[6],P0[7],P0[8],P0[9],     pw0[2]=PKW(P0,4), pw0[3]=PKW(P0,6), pw0); \
    VRD(1); SBAR(); GAPA(C0=__builtin_amdgcn_mfma_f32_32x32x16_bf16(kf[2],qr[1],C0,0,0,0),   P0[10],P0[11],P0[12],P0[13], pw1[0]=PKW(P0,8), pw1[1]=PKW(P0,10), pw1); \
    VRD(5); SBAR(); GAPA(C1=__builtin_amdgcn_mfma_f32_32x32x16_bf16(kf[3],qr[1],C1,0,0,0),   P0[14],P0[15],P1[0],P1[1],   pw1[2]=PKW(P0,12),pw1[3]=PKW(P0,14), pw1); \
    VRD(2); SBAR(); GAPA(C0=__builtin_amdgcn_mfma_f32_32x32x16_bf16(kf[4],qr[2],C0,0,0,0),   P1[2],P1[3],P1[4],P1[5],     pw2[0]=PKW(P1,0), pw2[1]=PKW(P1,2), pw2); \
    VRD(6); SBAR(); GAPA(C1=__builtin_amdgcn_mfma_f32_32x32x16_bf16(kf[5],qr[2],C1,0,0,0),   P1[6],P1[7],P1[8],P1[9],     pw2[2]=PKW(P1,4), pw2[3]=PKW(P1,6), pw2); \
    VRD(3); SBAR(); GAPA(C0=__builtin_amdgcn_mfma_f32_32x32x16_bf16(kf[6],qr[3],C0,0,0,0),   P1[10],P1[11],P1[12],P1[13], pw3[0]=PKW(P1,8), pw3[1]=PKW(P1,10), pw3); \
    VRD(7); SBAR(); GAPA(C1=__builtin_amdgcn_mfma_f32_32x32x16_bf16(kf[7],qr[3],C1,0,0,0),   P1[14],P1[15],0.f,0.f,       pw3[2]=PKW(P1,12),pw3[3]=PKW(P1,14), pw3); \
    l_reg+=sacc; \
    if(GK){DMA_K((t)+3,sl_cur);} if(GV){DMA_V((t)+1,sl_next);} \
    CMASK(C0,C1,t); \
    { float a=MX3(C0[0],C0[1],C1[0]),b=MX3(C0[2],C0[3],C1[1]); a=MX3(a,C1[2],C1[3]); \
      _Pragma("unroll") for(int r=4;r<16;r+=4){a=MX3(a,C0[r],C0[r+1]);b=MX3(b,C0[r+2],C0[r+3]);a=MX3(a,C1[r],C1[r+1]);b=MX3(b,C1[r+2],C1[r+3]);} \
      float rm=__builtin_fmaxf(a,b); { auto rr=__builtin_amdgcn_permlane32_swap(__float_as_uint(rm),__float_as_uint(rm),false,false); rm=__builtin_fmaxf(__uint_as_float(rr[0]),__uint_as_float(rr[1])); } \
      resc=false; \
      if(__builtin_expect(__any(rm>(float)THRL),0)){ const float dl=__builtin_fmaxf(rm,0.f); mhat+=dl; \
        _Pragma("unroll") for(int r=0;r<16;++r){C0[r]-=dl;C1[r]-=dl;} \
        _Pragma("unroll") for(int r=0;r<16;++r)negm[r]=-mhat; asm volatile("":"+v"(negm)); \
        const float f=__builtin_amdgcn_exp2f(-dl); l_reg*=f; if(hi==0)wsf[r32]=f; resc=true; } } \
    SBAR(); \
    GAPB(o[0]=__builtin_amdgcn_mfma_f32_32x32x16_bf16(PAF(0),VFR(0),o[0],0,0,0), C0,0); \
    GAPB(o[1]=__builtin_amdgcn_mfma_f32_32x32x16_bf16(PAF(0),VFR(4),o[1],0,0,0), C0,4); \
    KRD(GL,0); GAPB(o[0]=__builtin_amdgcn_mfma_f32_32x32x16_bf16(PAF(1),VFR(1),o[0],0,0,0), C0,8); \
    KRD(GL,1); GAPB(o[1]=__builtin_amdgcn_mfma_f32_32x32x16_bf16(PAF(1),VFR(5),o[1],0,0,0), C0,12); \
    KRD(GL,2); GAPB(o[0]=__builtin_amdgcn_mfma_f32_32x32x16_bf16(PAF(2),VFR(2),o[0],0,0,0), C1,0); \
    KRD(GL,3); GAPB(o[1]=__builtin_amdgcn_mfma_f32_32x32x16_bf16(PAF(2),VFR(6),o[1],0,0,0), C1,4); \
    GAPB(o[0]=__builtin_amdgcn_mfma_f32_32x32x16_bf16(PAF(3),VFR(3),o[0],0,0,0), C1,8); \
    GAPB(o[1]=__builtin_amdgcn_mfma_f32_32x32x16_bf16(PAF(3),VFR(7),o[1],0,0,0), C1,12); \
    }while(0)
  int t=1;
  #undef CMASK
  #define CMASK(P0,P1,t) do{}while(0)
  for(;t+5<NT;t+=2){
    STEP(pB0,pB1,pA0,pA1,t,true,true,true);     WAIT_BAR(2); RESC(); ROT();
    STEP(pA0,pA1,pB0,pB1,t+1,true,true,true);   WAIT_BAR(2); RESC(); ROT();
  }
  #undef CMASK
  #define CMASK(P0,P1,t) do{int jb_=(t)-(NT-4); if(jb_>=0)cmask(P0,P1,jb_,qrel,hi);}while(0)
  #define ENDW(tt) do{ if((tt)+3<NT){WAIT_BAR(2);} else if((tt)+2<NT){WAIT_BAR(1);} else {WAIT_BAR(0);} }while(0)
  for(;t+1<NT;t+=2){
    STEP(pB0,pB1,pA0,pA1,t,(t+3<NT),(t+1<NT),(t+1<NT));       ENDW(t);   RESC(); ROT();
    STEP(pA0,pA1,pB0,pB1,t+1,(t+4<NT),(t+2<NT),(t+2<NT));     ENDW(t+1); RESC(); ROT();
  }
  STEP(pB0,pB1,pA0,pA1,NT-1,false,false,false); RESC();
  { float sacc=pB0[0]+pB0[1]; _Pragma("unroll") for(int r=2;r<16;++r)sacc+=pB0[r]; _Pragma("unroll") for(int r=0;r<16;++r)sacc+=pB1[r]; l_reg+=sacc;
    pw0=(u32x4){PKW(pB0,0),PKW(pB0,2),PKW(pB0,4),PKW(pB0,6)};pw1=(u32x4){PKW(pB0,8),PKW(pB0,10),PKW(pB0,12),PKW(pB0,14)};pw2=(u32x4){PKW(pB1,0),PKW(pB1,2),PKW(pB1,4),PKW(pB1,6)};pw3=(u32x4){PKW(pB1,8),PKW(pB1,10),PKW(pB1,12),PKW(pB1,14)};
    SBAR(); pv(o,vb0+sl_cur,PAF(0),PAF(1),PAF(2),PAF(3)); }
  #undef PKW
  #undef PAF
  #undef VFR
  #undef PIN
  #undef MX3
  #undef GAPA
  #undef GAPB
  #undef EX
  #undef VRD
  #undef KRD
  #undef STEP
  #undef ENDW
  {auto rr=__builtin_amdgcn_permlane32_swap(__float_as_uint(l_reg),__float_as_uint(l_reg),false,false);l_reg=__uint_as_float(rr[0])+__uint_as_float(rr[1]);}
  if(hi==0)wsf[32+r32]=l_reg;asm volatile("s_waitcnt lgkmcnt(0)":::"memory");
  float rli[16];
  #pragma unroll
  for(int r=0;r<16;++r)rli[r]=__builtin_amdgcn_rcpf(wsf[32+crow(r,hi)]);
  bf16*Ow=O+(rowbase+q0+wid*QBLK)*DMO+co;
  { bf16*stg=(bf16*)(shm+LDS_OST)+wid*2048;
    #pragma unroll
    for(int r=0;r<16;++r){const int orow=crow(r,hi);
      #pragma unroll
      for(int d0=0;d0<2;++d0)stg[orow*64+d0*32+r32]=__float2bfloat16(o[d0][r]*rli[r]);}
    asm volatile("s_waitcnt lgkmcnt(0)":::"memory");
    #pragma unroll
    for(int i=0;i<4;++i){const int row=i*8+(lane>>3),ch=lane&7; const u32x4 v=*(const u32x4*)(stg+row*64+ch*8); ATTN_STORE16(Ow+(long)row*DMO+ch*8,v);} }
  asm volatile("s_waitcnt lgkmcnt(0)\n\ts_barrier":::"memory");
  #undef DMA_K
  #undef DMA_V
  #undef CMASK
  #undef START
  #undef RESC
  #undef ROT
}
constexpr int ATTN_LDS_BYTES=LDS_BYTES;
#undef SBAR
#undef WAIT_BAR
}
namespace cg = cooperative_groups;
#define GAS __attribute__((address_space(1)))
#define LAS __attribute__((address_space(3)))
typedef unsigned short bf16;
typedef unsigned v4u __attribute__((ext_vector_type(4)));
typedef unsigned v2u __attribute__((ext_vector_type(2)));
typedef float f32x4 __attribute__((ext_vector_type(4)));
constexpr int NWAVES = 8, NTHR = 512;
constexpr int M = 16384, DMOD = 1024, SEQ = 4096, NIN = 6816, DFF = 2816, ZP = 1728;
constexpr size_t MiB = 1u << 20;
constexpr size_t WS_CTL = 0;
constexpr size_t WS_WGLU = 1 * MiB, WS_WB = WS_WGLU + MiB / 2, WS_WO = WS_WB + 3 * MiB, WS_WFI = WS_WO + 2 * MiB, WS_WFO = WS_WFI + 11 * MiB;
constexpr size_t WS_WX = 23 * MiB, WS_W1A = WS_WX, WS_W1B = WS_WX + 4 * MiB, WS_E = WS_WX, WS_WG = WS_WX;
constexpr size_t WS_VF = 40 * MiB, WS_US = 56 * MiB, WS_YA = 80 * MiB, WS_Z = 96 * MiB, WS_QB = 150 * MiB, WS_KB = 166 * MiB, WS_VB = 182 * MiB;
constexpr size_t WS_XNP = 198 * MiB, WS_O = 198 * MiB, WS_AB = 231 * MiB, WS_PT = 247 * MiB, WS_MT = 249 * MiB, WS_END = 256 * MiB;
constexpr size_t WS_XN = 150 * MiB, WS_YL = 182 * MiB, WS_P12 = 182 * MiB, WS_G0 = 214 * MiB, WS_H2N = 96 * MiB, WS_HID = 150 * MiB;
static_assert(WS_WFO + (size_t)1024 * 2816 * 2 <= WS_WX && WS_Z + (size_t)M * ZP * 2 <= WS_QB && WS_XNP + (size_t)4 * 4097 * 1024 * 2 <= WS_AB && WS_MT + (size_t)32 * 256 * 384 * 2 <= WS_END && WS_HID + (size_t)M * DFF * 2 <= WS_END, "ws map");
constexpr int LDS_BYTES = 148480; constexpr int LDS_XB = 147456; constexpr int CW_BAR = 4096;
constexpr float C2Q = 0.125f * 1.4426950408889634f;

__device__ __forceinline__ unsigned f2bf(float f) { unsigned u = __builtin_bit_cast(unsigned, f); return (u + 0x7fffu + ((u >> 16) & 1u)) >> 16; }
__device__ __forceinline__ float bf2f(unsigned b) { return __uint_as_float(b << 16); }
__device__ __forceinline__ void unpack8(const v4u w, float* f) {
    f[0] = __uint_as_float(w.x << 16); f[1] = __uint_as_float(w.x & 0xffff0000u); f[2] = __uint_as_float(w.y << 16); f[3] = __uint_as_float(w.y & 0xffff0000u);
    f[4] = __uint_as_float(w.z << 16); f[5] = __uint_as_float(w.z & 0xffff0000u); f[6] = __uint_as_float(w.w << 16); f[7] = __uint_as_float(w.w & 0xffff0000u); }
__device__ __forceinline__ v4u pack8(const float* f) { v4u w; w.x = pg8::cvt_pk_bf16(f[0], f[1]); w.y = pg8::cvt_pk_bf16(f[2], f[3]); w.z = pg8::cvt_pk_bf16(f[4], f[5]); w.w = pg8::cvt_pk_bf16(f[6], f[7]); return w; }
__device__ __forceinline__ float sigm(float x) { return __builtin_amdgcn_rcpf(1.f + __expf(-x)); }
__device__ __forceinline__ float tanh_f(float x) { return 1.f - 2.f * __builtin_amdgcn_rcpf(1.f + __expf(2.f * x)); }
__device__ __forceinline__ float wave_sum(float v) {
#pragma unroll
    for (int o = 1; o < 64; o <<= 1) v += __shfl_xor(v, o);
    return v; }
__device__ __forceinline__ float dppf(float x, const int ctrl) { return x; }
#define DPP_ADD(x, ctrl) ((x) + __builtin_bit_cast(float, __builtin_amdgcn_update_dpp(0, __builtin_bit_cast(int, (x)), (ctrl), 0xf, 0xf, true)))
__device__ __forceinline__ float row16_sum(float x) { x = DPP_ADD(x, 0xB1); x = DPP_ADD(x, 0x4E); x = DPP_ADD(x, 0x141); x = DPP_ADD(x, 0x140); return x; }

template <int MODE> struct Epi8 {
    static constexpr bool PERM = true, AFTER_DRAIN = false;
    bf16* O; int ldc; const bf16* X; const float* P;
    __device__ __forceinline__ void operator()(const pg8::f32x4 (&acc)[2][2][4][2], const pg8::Unit& u, int wr, int wc, int fr, int fq) const {
#pragma unroll
        for (int ai = 0; ai < 2; ++ai)
#pragma unroll
            for (int m = 0; m < 4; ++m) {
                const int row = u.pm * 256 + ai * 128 + wr * 64 + m * 16 + fr;
                if (MODE == 8) {
                    float o[8];
#pragma unroll
                    for (int i = 0; i < 8; ++i) { const float gte = acc[ai][0][m][i >> 2][i & 3], up = acc[ai][1][m][i >> 2][i & 3]; o[i] = gte * sigm(gte) * up; }
                    *(v4u*)(O + (size_t)row * DFF + u.pn * 128 + wc * 32 + 8 * fq) = pack8(o);
                } else {
#pragma unroll
                for (int bj = 0; bj < 2; ++bj) {
                    const int col = u.pn * 256 + bj * 128 + wc * 32 + 8 * fq;
                    float v[8];
#pragma unroll
                    for (int i = 0; i < 8; ++i) v[i] = acc[ai][bj][m][i >> 2][i & 3];
                    if (MODE == 0) { if (col < ldc) *(v4u*)(O + (size_t)row * ldc + col) = pack8(v); }
                    else if (MODE == 1) {
                        if (u.pn < 2) { const int g = col >> 4, cc = col & 15, b = row >> 12, t = row & 4095, ch = t >> 4, s = t & 15;
                            *(v4u*)((bf16*)X + ((size_t)(g * 1024 + b * 256 + ch) * 384 + s * 16 + cc)) = pack8(v); }
                        else { const int tsel = (col >> 9) - 1, cl = col & 511; *(v4u*)(O + (size_t)tsel * (8u * MiB) + (size_t)row * 512 + cl) = pack8(v); }
                    }
                    else if (MODE == 2) { if (bj == 0) *(v4u*)(O + (size_t)row * 384 + 256 + (col & 255)) = pack8(v); }
                    else if (MODE == 3) {
                        const int g = row >> 10, b = (row >> 8) & 3, ch = row & 255, cl = col & 255, t = cl >> 4, cc = cl & 15;
                        float uu[8]; unpack8(*(const v4u*)(X + (size_t)row * 384 + cl), uu);
#pragma unroll
                        for (int i = 0; i < 8; ++i) { const float y = v[i] + P[g * 16 + cc + i] * uu[i]; v[i] = y * sigm(1.5957691216f * (y + 0.044715f * y * y * y)); }
                        *(v4u*)(O + (size_t)(b * 4096 + ch * 16 + t) * 512 + g * 16 + cc) = pack8(v);
                    }
                    else if (MODE == 4) { float y[8]; unpack8(*(const v4u*)(X + (size_t)row * 512 + col), y);
#pragma unroll
                        for (int i = 0; i < 8; ++i) v[i] = y[i] * sigm(v[i]);
                        *(v4u*)(O + (size_t)row * 512 + col) = pack8(v); }
                    else if (MODE == 5) {
#pragma unroll
                        for (int i = 0; i < 8; ++i) v[i] = sigm(v[i]);
                        *(v4u*)(O + (size_t)row * 1024 + col) = pack8(v); }
                    else if (MODE == 10) {
#pragma unroll
                        for (int i = 0; i < 8; ++i) v[i] = sigm(v[i]);
                        *(v4u*)(O + (size_t)(col >> 10) * ((size_t)M * 1024) + (size_t)row * 1024 + (col & 1023)) = pack8(v); }
                    else if (MODE == 11) {
                        const int np = col >> 10, d = col & 1023; float gt[8], pp[8];
                        unpack8(*(const v4u*)(O + (size_t)np * ((size_t)M * 1024) + (size_t)row * 1024 + d), gt);
                        if (np) unpack8(*(const v4u*)(O + (size_t)row * 1024 + d), pp);
#pragma unroll
                        for (int i = 0; i < 8; ++i) v[i] = (np ? pp[i] : 0.f) + gt[i] * v[i];
                        *(v4u*)(O + (size_t)row * 1024 + d) = pack8(v); }
                    else if (MODE == 6 || MODE == 7) { float gt[8]; unpack8(*(const v4u*)(X + (size_t)row * 1024 + col), gt);
                        float pm_[8];
                        if (MODE == 7) unpack8(*(const v4u*)(O + (size_t)row * 1024 + col), pm_);
#pragma unroll
                        for (int i = 0; i < 8; ++i) v[i] = (MODE == 7 ? pm_[i] : 0.f) + gt[i] * v[i];
                        *(v4u*)(O + (size_t)row * 1024 + col) = pack8(v); }
                }
                }
            }
    }
};
struct EpiRes {
    static constexpr bool PERM = false, AFTER_DRAIN = false;
    const float* xin; float* xout;
    __device__ __forceinline__ void operator()(const pg8::f32x4 (&acc)[2][2][4][2], const pg8::Unit& u, int wr, int wc, int fr, int fq) const {
#pragma unroll
        for (int ai = 0; ai < 2; ++ai)
#pragma unroll
            for (int m = 0; m < 4; ++m) { const size_t off = (size_t)(u.pm * 256 + ai * 128 + wr * 64 + m * 16 + fr) * 1024 + u.pn * 256 + wc * 32 + 4 * fq;
#pragma unroll
                for (int bj = 0; bj < 2; ++bj)
#pragma unroll
                    for (int n = 0; n < 2; ++n) { const f32x4 b = *(const f32x4*)(xin + off + bj * 128 + n * 16); f32x4 o; o.x = b.x + acc[ai][bj][m][n][0]; o.y = b.y + acc[ai][bj][m][n][1]; o.z = b.z + acc[ai][bj][m][n][2]; o.w = b.w + acc[ai][bj][m][n][3];
                        *(f32x4*)(xout + off + bj * 128 + n * 16) = o; } }
    }
};
__device__ __forceinline__ pg8::Gemm mkgemm(const bf16* A, const bf16* Bt, int Mr, int N, int K, int lda, int ldb) {
    pg8::Gemm g; g.A = A; g.Bt = Bt; g.M = Mr; g.N = N; g.K = K; g.lda = lda; g.ldb = ldb; g.a_skip_shift = 30; g.a_skip_bytes = 0; g.kwrap = 1 << 20; g.wrap_bytes = 0; g.b_shift = 30; g.b_stride_bytes = 0; g.a_pn_shift = 30; g.a_pn_bytes = 0; return g; }
template <class Epi> __device__ __forceinline__ void run_gemm_w(int wave_hint, LAS unsigned char* lds, const pg8::Gemm& g, const Epi& E, int G, int c) {
    asm volatile("" : "+s"(G), "+s"(c));
    pg8::StaticOrder S; S.init(g.M, g.N, G, c);
    pg8::gemm_phase<Epi, pg8::StaticOrder, true, true>(lds, g, S, E, wave_hint);
}

struct PairOrder { pg8::StaticOrder S0;
    __device__ void init(int Mr, int G, int c) { S0.init(Mr, 1024, G, c); }
    __device__ bool next(int i, pg8::Unit& u) const { if (!S0.next(i >> 1, u)) return false; u.pn += 4 * (i & 1); return true; }
    __device__ __forceinline__ void a_ready(const pg8::Unit&) const {}
    __device__ __forceinline__ void done(const pg8::Unit&) const {} };
template <class Epi> __device__ __forceinline__ void run_gemm_pair_w(int wave_hint, LAS unsigned char* lds, const pg8::Gemm& g, const Epi& E, int G, int c) {
    asm volatile("" : "+s"(G), "+s"(c));
    PairOrder S; S.init(g.M, G, c);
    pg8::gemm_phase<Epi, PairOrder, true, true>(lds, g, S, E, wave_hint);
}

#define run_gemm(...) run_gemm_w(wave, __VA_ARGS__)
#define run_gemm_pair(...) run_gemm_pair_w(wave, __VA_ARGS__)
__device__ __forceinline__ void tr_item(const float* W, int ldw, int k0, int c0, bf16* WT, int ldt, int drow, int koff, const float* mu, int smode, LAS float* scr, int lane) {
    { const int kr = lane >> 3, nq = (lane & 7) * 4; f32x4 t[8];
#pragma unroll
      for (int i = 0; i < 8; ++i) t[i] = *(const f32x4*)(W + (size_t)(k0 + i * 8 + kr) * ldw + c0 + nq);
#pragma unroll
      for (int i = 0; i < 8; ++i) { LAS float* d = scr + (i * 8 + kr) * 33 + nq; d[0] = t[i].x; d[1] = t[i].y; d[2] = t[i].z; d[3] = t[i].w; } }
    asm volatile("s_waitcnt lgkmcnt(0)" ::: "memory");
    const int c = lane & 7;
#pragma unroll
    for (int j = 0; j < 4; ++j) { const int n = (lane >> 3) + 8 * j; const LAS float* s = scr + (8 * c) * 33 + n;
        float sc = 1.f; if (smode) { const float m_ = mu[n]; sc = (smode == 1) ? 1.f - m_ : m_; }
        v4u o; o.x = pg8::cvt_pk_bf16(s[0 * 33] * sc, s[1 * 33] * sc); o.y = pg8::cvt_pk_bf16(s[2 * 33] * sc, s[3 * 33] * sc); o.z = pg8::cvt_pk_bf16(s[4 * 33] * sc, s[5 * 33] * sc); o.w = pg8::cvt_pk_bf16(s[6 * 33] * sc, s[7 * 33] * sc);
        *(v4u*)(WT + (size_t)(drow + n) * ldt + koff + k0 + 8 * c) = o; }
    asm volatile("s_waitcnt lgkmcnt(0)" ::: "memory");
}
__device__ __forceinline__ void rms_row(const float* xrow, const float* gain, bf16* orow, int lane) {
    const f32x4* xr = (const f32x4*)xrow + lane; const f32x4* gr = (const f32x4*)gain + lane;
    f32x4 v[4]; float s = 0.f;
#pragma unroll
    for (int j = 0; j < 4; ++j) { v[j] = xr[64 * j]; s += (v[j].x * v[j].x + v[j].y * v[j].y) + (v[j].z * v[j].z + v[j].w * v[j].w); }
    const float rstd = 1.f / sqrtf(wave_sum(s) * (1.f / 1024.f) + 1e-6f);
    v2u* o8 = (v2u*)orow + lane;
#pragma unroll
    for (int j = 0; j < 4; ++j) { const f32x4 g = gr[64 * j]; v2u w; w.x = pg8::cvt_pk_bf16(v[j].x * rstd * g.x, v[j].y * rstd * g.y); w.y = pg8::cvt_pk_bf16(v[j].z * rstd * g.z, v[j].w * rstd * g.w); o8[64 * j] = w; }
}
__device__ __forceinline__ void rms_row2(const float* xa, const float* xb_, const float* gain, bf16* oa, bf16* ob, int lane) {
    const f32x4* ra = (const f32x4*)xa + lane; const f32x4* rb = (const f32x4*)xb_ + lane; const f32x4* gr = (const f32x4*)gain + lane;
    f32x4 va[4], vb[4]; float sa = 0.f, sb = 0.f;
#pragma unroll
    for (int j = 0; j < 4; ++j) { va[j] = ra[64 * j]; vb[j] = rb[64 * j]; }
#pragma unroll
    for (int j = 0; j < 4; ++j) { sa += (va[j].x * va[j].x + va[j].y * va[j].y) + (va[j].z * va[j].z + va[j].w * va[j].w); sb += (vb[j].x * vb[j].x + vb[j].y * vb[j].y) + (vb[j].z * vb[j].z + vb[j].w * vb[j].w); }
#pragma unroll
    for (int o = 1; o < 64; o <<= 1) { sa += __shfl_xor(sa, o); sb += __shfl_xor(sb, o); }
    const float rsa = 1.f / sqrtf(sa * (1.f / 1024.f) + 1e-6f), rsb = 1.f / sqrtf(sb * (1.f / 1024.f) + 1e-6f);
    v2u* pa = (v2u*)oa + lane; v2u* pb = (v2u*)ob + lane;
#pragma unroll
    for (int j = 0; j < 4; ++j) { const f32x4 g = gr[64 * j]; v2u w;
        w.x = pg8::cvt_pk_bf16(va[j].x * rsa * g.x, va[j].y * rsa * g.y); w.y = pg8::cvt_pk_bf16(va[j].z * rsa * g.z, va[j].w * rsa * g.w); pa[64 * j] = w;
        w.x = pg8::cvt_pk_bf16(vb[j].x * rsb * g.x, vb[j].y * rsb * g.y); w.y = pg8::cvt_pk_bf16(vb[j].z * rsb * g.z, vb[j].w * rsb * g.w); pb[64 * j] = w; }
}
struct Ptrs { const float* in[35]; float* out; unsigned char* ws; };

__device__ __forceinline__ void weight_items(const Ptrs& P, int L, int gw, int NGW, LAS float* scr, int lane, int it_lo, int it_hi) {
    unsigned char* ws = P.ws;
    const float* w_in = P.in[2] + (size_t)L * 1024 * NIN; const float* mu = P.in[16] + (size_t)L * 1696;
    constexpr int I1A = 16 * 64, I1B = 16 * 53, IGLU = 8 * 16, IWB = 8 * 32, IWO = 16 * 32, IFI = 16 * 176, IFO = 44 * 32;
    constexpr int NIT = I1A + 2 * I1B + IGLU + 3 * IWB + IWO + IFI + IFO;
    for (int it = it_lo + gw; it < it_hi; it += NGW) {
        int r = it;
        if (r < I1A) { const int kb = r / 64, nb = r % 64; tr_item(w_in, NIN, kb * 64, nb * 32, (bf16*)(ws + WS_W1A), 1024, nb * 32, 0, nullptr, 0, scr, lane); continue; } r -= I1A;
        if (r < I1B) { const int kb = r / 53, nb = r % 53; tr_item(w_in, NIN, kb * 64, 2048 + nb * 32, (bf16*)(ws + WS_W1B), 2048, nb * 32, 0, mu + nb * 32, 1, scr, lane); continue; } r -= I1B;
        if (r < I1B) { const int kb = r / 53, nb = r % 53; tr_item(w_in, NIN, kb * 64, 2048 + nb * 32, (bf16*)(ws + WS_W1B), 2048, nb * 32, 1024, mu + nb * 32, 2, scr, lane); continue; } r -= I1B;
        if (r < IGLU) { const int kb = r / 16, nb = r % 16; tr_item(P.in[11] + (size_t)L * 512 * 512, 512, kb * 64, nb * 32, (bf16*)(ws + WS_WGLU), 512, nb * 32, 0, nullptr, 0, scr, lane); continue; } r -= IGLU;
        if (r < 3 * IWB) { const int n = r / IWB, q = r % IWB, kb = q / 32, nb = q % 32; tr_item(P.in[30] + ((size_t)L * 3 + n) * 512 * 1024, 1024, kb * 64, nb * 32, (bf16*)(ws + WS_WB) + (size_t)n * 1024 * 512, 512, nb * 32, 0, nullptr, 0, scr, lane); continue; } r -= 3 * IWB;
        if (r < IWO) { const int kb = r / 32, nb = r % 32; tr_item(P.in[31] + (size_t)L * 1024 * 1024, 1024, kb * 64, nb * 32, (bf16*)(ws + WS_WO), 1024, nb * 32, 0, nullptr, 0, scr, lane); continue; } r -= IWO;
        if (r < IFI) { const int kb = r / 176, nb = r % 176; const int n0 = nb * 32; const int drow = (n0 < DFF) ? (n0 / 128) * 256 + (n0 % 128) : ((n0 - DFF) / 128) * 256 + 128 + ((n0 - DFF) % 128);
            tr_item(P.in[33] + (size_t)L * 1024 * 2 * DFF, 2 * DFF, kb * 64, n0, (bf16*)(ws + WS_WFI), 1024, drow, 0, nullptr, 0, scr, lane); continue; } r -= IFI;
        { const int kb = r / 32, nb = r % 32; tr_item(P.in[34] + (size_t)L * DFF * 1024, 1024, kb * 64, nb * 32, (bf16*)(ws + WS_WFO), DFF, nb * 32, 0, nullptr, 0, scr, lane); }
    }
}
__device__ __forceinline__ void s5_tables(const Ptrs& P, int L, int g, int part, LAS float* sm, int tid) {
    LAS float* apr = sm; LAS float* api = sm + 17 * 64; LAS float* bbr = sm + 2 * 17 * 64; LAS float* bbi = bbr + 1024; LAS float* Ks = bbi + 1024;
    const float* lre = P.in[3] + (size_t)L * 2048; const float* lim = P.in[4] + (size_t)L * 2048; const float* ldt = P.in[5] + L * 32;
    const float* bre = P.in[6] + (size_t)L * 32768; const float* bim = P.in[7] + (size_t)L * 32768; const float* cre = P.in[8] + (size_t)L * 32768; const float* cim = P.in[9] + (size_t)L * 32768;
    if (tid < 64) { const int p = tid; const float dt = __expf(ldt[g]); const float lr = lre[g * 64 + p], li = lim[g * 64 + p];
        for (int j = 0; j <= 16; ++j) { const double ang = (double)j * (double)li * (double)dt * 0.15915494309189535; const float rev = (float)(ang - __builtin_floor(ang));
            const float mg = __expf((float)j * lr * dt); apr[j * 64 + p] = mg * __builtin_amdgcn_cosf(rev); api[j * 64 + p] = mg * __builtin_amdgcn_sinf(rev); }
        const float ar = apr[64 + p], ai = api[64 + p], den = lr * lr + li * li, nr = ar - 1.f, kr = (nr * lr + ai * li) / den, ki = (ai * lr - nr * li) / den;
        for (int c = 0; c < 16; ++c) { const float br = bre[(g * 64 + p) * 16 + c], bi = bim[(g * 64 + p) * 16 + c]; bbr[p * 16 + c] = kr * br - ki * bi; bbi[p * 16 + c] = kr * bi + ki * br; } }
    __syncthreads();
    { const int j = tid >> 5, cl = tid & 31, cp = 2 * part + (cl >> 4), c = cl & 15; float s = 0.f;
        for (int p = 0; p < 64; ++p) { const float tr = apr[j * 64 + p] * bbr[p * 16 + c] - api[j * 64 + p] * bbi[p * 16 + c], ti = apr[j * 64 + p] * bbi[p * 16 + c] + api[j * 64 + p] * bbr[p * 16 + c];
            s += cre[(g * 16 + cp) * 64 + p] * tr - cim[(g * 16 + cp) * 64 + p] * ti; }
        Ks[j * 32 + cl] = s; }
    __syncthreads();
    bf16* Mt = (bf16*)(P.ws + WS_MT) + (size_t)g * 256 * 384; bf16* Pt = (bf16*)(P.ws + WS_PT) + (size_t)g * 128 * 256;
    for (int idx = tid; idx < 32 * 48; idx += NTHR) { const int rl = idx / 48, kg = idx % 48, t = rl >> 1, cpl = rl & 1, cp = 2 * part + cpl, n = t * 16 + cp; float v[8];
        if (kg < 32) { const int s = kg >> 1, c0 = (kg & 1) * 8;
#pragma unroll
            for (int i = 0; i < 8; ++i) v[i] = (s <= t) ? Ks[(t - s) * 32 + cpl * 16 + c0 + i] : 0.f; }
        else {
#pragma unroll
            for (int i = 0; i < 8; ++i) { const int jj = (kg - 32) * 8 + i, p = jj & 63; const float cr = cre[(g * 16 + cp) * 64 + p], ci = cim[(g * 16 + cp) * 64 + p], ar = apr[(t + 1) * 64 + p], ai = api[(t + 1) * 64 + p];
                v[i] = (jj < 64) ? (cr * ar - ci * ai) : -(cr * ai + ci * ar); } }
        *(v4u*)(Mt + (size_t)n * 384 + kg * 8) = pack8(v); }
    { const int jj = part * 16 + (tid >> 5), kg = tid & 31, p = jj & 63, s = kg >> 1, c0 = (kg & 1) * 8; float v[8];
        const float ar = apr[(15 - s) * 64 + p], ai = api[(15 - s) * 64 + p];
#pragma unroll
        for (int i = 0; i < 8; ++i) { const float br = bbr[p * 16 + c0 + i], bi = bbi[p * 16 + c0 + i]; v[i] = (jj < 64) ? (ar * br - ai * bi) : (ar * bi + ai * br); }
        *(v4u*)(Pt + (size_t)jj * 256 + kg * 8) = pack8(v); }
    __syncthreads();
}
__device__ __forceinline__ void s5_chunk_scan(const Ptrs& P, int L, int gidx) {
    const int p = gidx & 63, g = (gidx >> 6) & 31, b = gidx >> 11;
    const float dt = __expf(P.in[5][L * 32 + g]); const float lr = P.in[3][(size_t)L * 2048 + g * 64 + p], li = P.in[4][(size_t)L * 2048 + g * 64 + p];
    const double ang = 16.0 * (double)li * (double)dt * 0.15915494309189535; const float rev = (float)(ang - __builtin_floor(ang)); const float mg = __expf(16.f * lr * dt);
    const float ar = mg * __builtin_amdgcn_cosf(rev), ai = mg * __builtin_amdgcn_sinf(rev);
    bf16* base = (bf16*)(P.ws + WS_US) + (size_t)(g * 1024 + b * 256) * 384 + 256 + p;
    float xr = 0.f, xi = 0.f;
#pragma unroll 32
    for (int c = 0; c < 256; ++c) { bf16* q = base + (size_t)c * 384; const float sr = bf2f(q[0]), si = bf2f(q[64]); q[0] = (bf16)f2bf(xr); q[64] = (bf16)f2bf(xi);
        const float nr = ar * xr - ai * xi + sr, ni = ar * xi + ai * xr + si; xr = nr; xi = ni; }
}

typedef float f2p __attribute__((ext_vector_type(2)));
#define RDL(x, l) __builtin_bit_cast(float, __builtin_amdgcn_readlane(__builtin_bit_cast(int, (x)), (l)))
#define LORA2(acc, tA, tB, off, wptr) do { _Pragma("unroll") for (int j_ = 0; j_ < 32; ++j_) { const f2p s_ = {RDL(tA, j_ + (off)), RDL(tB, j_ + (off))}; \
        float w8_[8]; unpack8(*(const LAS v4u*)((wptr) + j_ * 512 + c0), w8_); \
        _Pragma("unroll") for (int i_ = 0; i_ < 8; ++i_) acc[i_] = __builtin_elementwise_fma((f2p){w8_[i_], w8_[i_]}, s_, acc[i_]); \
 } } while (0)
#define LORA2F(acc, tA, tB, off, wptr) do { _Pragma("unroll") for (int j_ = 0; j_ < 32; ++j_) { const f2p s_ = {RDL(tA, j_ + (off)), RDL(tB, j_ + (off))}; \
        float w8_[8]; unpack8(*(const LAS v4u*)((wptr) + j_ * 512 + c0), w8_); \
        _Pragma("unroll") for (int i_ = 0; i_ < 8; ++i_) acc[i_] = __builtin_elementwise_fma((f2p){w8_[i_], w8_[i_]}, s_, acc[i_]); \
        if ((j_ & 3) == 3) asm volatile("" ::: "memory"); } } while (0)
__device__ __forceinline__ void prep_phase(const Ptrs& P, int L, LAS unsigned char* lds, int gw, int NGW, int tid, int wave, int lane) {
    asm volatile("" : "+v"(tid), "+v"(lane)); asm volatile("" : "+s"(wave));
    unsigned char* ws = P.ws;
    LAS bf16* w2s = (LAS bf16*)lds; LAS bf16* a2s = w2s + 32 * 512; LAS bf16* v2s = a2s + 32 * 512; LAS unsigned* v1s = (LAS unsigned*)(v2s + 32 * 512);
    LAS unsigned* vrow = (LAS unsigned*)(lds + 131072) + wave * 512;
    const float* w2 = P.in[18] + (size_t)L * 32 * 512; const float* a2 = P.in[20] + (size_t)L * 32 * 512;
    for (int i = tid; i < 32 * 512; i += NTHR) { w2s[i] = (bf16)f2bf(w2[i]); a2s[i] = (bf16)f2bf(a2[i]); }
    if (L == 1) { const float* v2 = P.in[29]; const float* v1 = P.in[28];
        for (int i = tid; i < 32 * 512; i += NTHR) v2s[i] = (bf16)f2bf(v2[i]);
        for (int i = tid; i < 256 * 32; i += NTHR) { const int c2 = i >> 5, j = i & 31; v1s[i] = f2bf(v1[(2 * c2) * 32 + j]) | (f2bf(v1[(2 * c2 + 1) * 32 + j]) << 16); } }
    __syncthreads();
    const int c0 = lane * 8;
    float qg[8], kg[8], w0r[8], a0r[8], v0r[8];
#pragma unroll
    for (int i = 0; i < 8; ++i) { qg[i] = P.in[12][L * 128 + ((c0 + i) & 127)] * C2Q; kg[i] = P.in[13][L * 128 + ((c0 + i) & 127)]; w0r[i] = P.in[17][L * 512 + c0 + i]; a0r[i] = P.in[19][L * 512 + c0 + i]; v0r[i] = (L == 1) ? P.in[27][c0 + i] : 0.f; }
    for (int pr = gw; pr < M / 2; pr += NGW) {
        const size_t m0 = (size_t)pr * 2;
        float tz[2];
#pragma unroll
        for (int t = 0; t < 2; ++t) {
            const size_t m = m0 + t;
            bf16* qp = (bf16*)(ws + WS_QB) + m * 512 + c0; bf16* kp = (bf16*)(ws + WS_KB) + m * 512 + c0;
            float q[8], k[8]; unpack8(*(const v4u*)qp, q); unpack8(*(const v4u*)kp, k);
            float sq = 0.f, sk = 0.f;
#pragma unroll
            for (int i = 0; i < 8; ++i) { sq += q[i] * q[i]; sk += k[i] * k[i]; }
            sq += __shfl_xor(sq, 1); sq += __shfl_xor(sq, 2); sq += __shfl_xor(sq, 4); sk += __shfl_xor(sk, 1); sk += __shfl_xor(sk, 2); sk += __shfl_xor(sk, 4);
            const float rq = 1.f / sqrtf(sq * (1.f / 64.f) + 1e-6f), rk = 1.f / sqrtf(sk * (1.f / 64.f) + 1e-6f);
#pragma unroll
            for (int i = 0; i < 8; ++i) { q[i] *= rq * qg[i]; k[i] *= rk * kg[i]; }
            *(v4u*)qp = pack8(q); *(v4u*)kp = pack8(k);
            const float zz = bf2f(((const bf16*)(ws + WS_Z))[m * ZP + 1536 + lane]);
            tz[t] = (lane < 32) ? tanh_f(zz) : zz;
        }
        f2p aw[8], aa[8];
#pragma unroll
        for (int i = 0; i < 8; ++i) { aw[i] = (f2p){w0r[i], w0r[i]}; aa[i] = (f2p){a0r[i], a0r[i]}; }
        LORA2(aw, tz[0], tz[1], 0, w2s);
        LORA2(aa, tz[0], tz[1], 32, a2s);
#pragma unroll
        for (int t = 0; t < 2; ++t) { float e8[8], a8[8];
#pragma unroll
            for (int i = 0; i < 8; ++i) { e8[i] = 0.6065306597f * sigm(t ? aw[i].y : aw[i].x); a8[i] = sigm(t ? aa[i].y : aa[i].x); }
            *(v4u*)((bf16*)(ws + WS_E) + (m0 + t) * 512 + c0) = pack8(e8); *(v4u*)((bf16*)(ws + WS_AB) + (m0 + t) * 512 + c0) = pack8(a8); }
        bf16* zr0 = (bf16*)(ws + WS_Z) + m0 * ZP; bf16* zr1 = zr0 + ZP;
        const v4u vA = *(const v4u*)(zr0 + 1024 + c0), vB = *(const v4u*)(zr1 + 1024 + c0);
        if (L == 0) { *(v4u*)((bf16*)(ws + WS_VF) + m0 * 512 + c0) = vA; *(v4u*)((bf16*)(ws + WS_VF) + (m0 + 1) * 512 + c0) = vB; }
        else {
            *(LAS v4u*)(vrow + c0) = (v4u){(vA.x & 0xffffu) | (vB.x << 16), (vA.x >> 16) | (vB.x & 0xffff0000u), (vA.y & 0xffffu) | (vB.y << 16), (vA.y >> 16) | (vB.y & 0xffff0000u)};
            *(LAS v4u*)(vrow + c0 + 4) = (v4u){(vA.z & 0xffffu) | (vB.z << 16), (vA.z >> 16) | (vB.z & 0xffff0000u), (vA.w & 0xffffu) | (vB.w << 16), (vA.w >> 16) | (vB.w & 0xffff0000u)};
            asm volatile("s_waitcnt lgkmcnt(0)" ::: "memory");
            const int j = lane & 31, hf = lane >> 5; f2p s = {0.f, 0.f};
#pragma unroll 8
            for (int c2 = 0; c2 < 128; ++c2) { const unsigned pk = v1s[(hf * 128 + c2) * 32 + j]; const v2u d = *(const LAS v2u*)(vrow + hf * 256 + 2 * c2);
                const float wl = __uint_as_float(pk << 16), wh = __uint_as_float(pk & 0xffff0000u);
                s = __builtin_elementwise_fma((f2p){__uint_as_float(d.x << 16), __uint_as_float(d.x & 0xffff0000u)}, (f2p){wl, wl}, s);
                s = __builtin_elementwise_fma((f2p){__uint_as_float(d.y << 16), __uint_as_float(d.y & 0xffff0000u)}, (f2p){wh, wh}, s); }
            float sx = s.x + __shfl_xor(s.x, 32), sy = s.y + __shfl_xor(s.y, 32);
            f2p am[8];
#pragma unroll
            for (int i = 0; i < 8; ++i) am[i] = (f2p){v0r[i], v0r[i]};
            LORA2(am, sx, sy, 0, v2s);
            float va[8], vb[8], fa[8], fb[8]; unpack8(vA, va); unpack8(vB, vb);
            unpack8(*(const v4u*)((const bf16*)(ws + WS_VF) + m0 * 512 + c0), fa); unpack8(*(const v4u*)((const bf16*)(ws + WS_VF) + (m0 + 1) * 512 + c0), fb);
#pragma unroll
            for (int i = 0; i < 8; ++i) { va[i] = va[i] + (fa[i] - va[i]) * sigm(am[i].x); vb[i] = vb[i] + (fb[i] - vb[i]) * sigm(am[i].y); }
            *(v4u*)(zr0 + 1024 + c0) = pack8(va); *(v4u*)(zr1 + 1024 + c0) = pack8(vb);
            asm volatile("s_waitcnt lgkmcnt(0)" ::: "memory"); }
    }
    __syncthreads();
}

__device__ __forceinline__ void rwkv_unit(const Ptrs& P, int L, LAS unsigned char* lds, int b, int h, int qr, int tid, int wave, int lane) {
    constexpr int T = 32, TOKF = 336;
    asm volatile("" : "+v"(tid), "+v"(lane)); asm volatile("" : "+s"(wave));
    unsigned char* ws = P.ws;
    const bf16* Z = (const bf16*)(ws + WS_Z); const bf16* AB = (const bf16*)(ws + WS_AB); const bf16* EB = (const bf16*)(ws + WS_E); bf16* YC = (bf16*)(ws + WS_YA);
    LAS float* buf0 = (LAS float*)lds; LAS float* buf1 = buf0 + T * TOKF;
    const bool producer = wave >= 4;
    const int pt = tid - 256, tok = pt >> 3, ks = (pt & 7) * 8;
    float kkk[8], kka[8];
    if (producer) {
#pragma unroll
        for (int i = 0; i < 8; ++i) { kkk[i] = P.in[22][L * 512 + h * 64 + ks + i]; kka[i] = P.in[23][L * 512 + h * 64 + ks + i]; } }
    const int row = wave * 4 + (lane >> 4), kq = lane & 15;
    typedef float f2s __attribute__((ext_vector_type(2)));
    f2s Slo = {0.f, 0.f}, Shi = {0.f, 0.f};
    const size_t m00 = (size_t)b * SEQ;
#define RW_PRODUCE(c, buf) do { const size_t m_ = m00 + (size_t)(c) * T + tok; const bf16* zr_ = Z + m_ * ZP; \
        float r_[8], k_[8], a_[8], e_[8]; unpack8(*(const v4u*)(zr_ + h * 64 + ks), r_); unpack8(*(const v4u*)(zr_ + 512 + h * 64 + ks), k_); \
        unpack8(*(const v4u*)(AB + m_ * 512 + h * 64 + ks), a_); unpack8(*(const v4u*)(EB + m_ * 512 + h * 64 + ks), e_); \
        float kk_[8], ss_ = 0.f; _Pragma("unroll") for (int i = 0; i < 8; ++i) { kk_[i] = k_[i] * kkk[i]; ss_ += kk_[i] * kk_[i]; } \
        ss_ += __shfl_xor(ss_, 1); ss_ += __shfl_xor(ss_, 2); ss_ += __shfl_xor(ss_, 4); const float inv_ = 1.f / fmaxf(sqrtf(ss_), 1e-12f); \
        LAS float* d_ = (buf) + tok * TOKF + ks; f32x4 o0, o1; \
        o0 = (f32x4){-kk_[0] * inv_, -kk_[1] * inv_, -kk_[2] * inv_, -kk_[3] * inv_}; o1 = (f32x4){-kk_[4] * inv_, -kk_[5] * inv_, -kk_[6] * inv_, -kk_[7] * inv_}; *(LAS f32x4*)(d_) = o0; *(LAS f32x4*)(d_ + 4) = o1; \
        o0 = (f32x4){kk_[0] * inv_ * a_[0], kk_[1] * inv_ * a_[1], kk_[2] * inv_ * a_[2], kk_[3] * inv_ * a_[3]}; o1 = (f32x4){kk_[4] * inv_ * a_[4], kk_[5] * inv_ * a_[5], kk_[6] * inv_ * a_[6], kk_[7] * inv_ * a_[7]}; *(LAS f32x4*)(d_ + 64) = o0; *(LAS f32x4*)(d_ + 68) = o1; \
        o0 = (f32x4){__expf(-e_[0]), __expf(-e_[1]), __expf(-e_[2]), __expf(-e_[3])}; o1 = (f32x4){__expf(-e_[4]), __expf(-e_[5]), __expf(-e_[6]), __expf(-e_[7])}; *(LAS f32x4*)(d_ + 128) = o0; *(LAS f32x4*)(d_ + 132) = o1; \
        o0 = (f32x4){k_[0] * (1.f + (a_[0] - 1.f) * kka[0]), k_[1] * (1.f + (a_[1] - 1.f) * kka[1]), k_[2] * (1.f + (a_[2] - 1.f) * kka[2]), k_[3] * (1.f + (a_[3] - 1.f) * kka[3])}; \
        o1 = (f32x4){k_[4] * (1.f + (a_[4] - 1.f) * kka[4]), k_[5] * (1.f + (a_[5] - 1.f) * kka[5]), k_[6] * (1.f + (a_[6] - 1.f) * kka[6]), k_[7] * (1.f + (a_[7] - 1.f) * kka[7])}; *(LAS f32x4*)(d_ + 192) = o0; *(LAS f32x4*)(d_ + 196) = o1; \
        o0 = (f32x4){r_[0], r_[1], r_[2], r_[3]}; o1 = (f32x4){r_[4], r_[5], r_[6], r_[7]}; *(LAS f32x4*)(d_ + 256) = o0; *(LAS f32x4*)(d_ + 260) = o1; \
        if ((pt & 7) < 2) { float v_[8]; unpack8(*(const v4u*)(zr_ + 1024 + h * 64 + qr * 16 + ks), v_); LAS float* dv_ = (buf) + tok * TOKF + 320 + ks; \
            *(LAS f32x4*)(dv_) = (f32x4){v_[0], v_[1], v_[2], v_[3]}; *(LAS f32x4*)(dv_ + 4) = (f32x4){v_[4], v_[5], v_[6], v_[7]}; } } while (0)
    if (producer) RW_PRODUCE(0, buf0);
    __syncthreads();
    if (!producer) __builtin_amdgcn_s_setprio(3);
    for (int c = 0; c < SEQ / T; ++c) {
        LAS float* cur = (c & 1) ? buf1 : buf0; LAS float* nxt = (c & 1) ? buf0 : buf1;
        if (producer) { if (c + 1 < SEQ / T) RW_PRODUCE(c + 1, nxt); }
        else {
            typedef float f2 __attribute__((ext_vector_type(2)));
            bf16* yo = YC + (m00 + (size_t)c * T) * 512 + h * 64 + qr * 16 + row;
            const LAS float* bs = cur + kq * 4; const LAS float* vs = cur + 320 + row;
            f32x4 a4 = *(const LAS f32x4*)(bs), b4 = *(const LAS f32x4*)(bs + 64), w4 = *(const LAS f32x4*)(bs + 128), k4 = *(const LAS f32x4*)(bs + 192), r4 = *(const LAS f32x4*)(bs + 256);
            float vv = vs[0]; float yp = 0.f, ykeep = 0.f;
#pragma unroll
            for (int t = 0; t < T; ++t) {
                const LAS float* nb = bs + (t + 1) * TOKF;
                const f32x4 na4 = *(const LAS f32x4*)(nb), nb4 = *(const LAS f32x4*)(nb + 64), nw4 = *(const LAS f32x4*)(nb + 128), nk4 = *(const LAS f32x4*)(nb + 192), nr4 = *(const LAS f32x4*)(nb + 256);
                const float nvv = vs[(t + 1) * TOKF];
                f2 p = Slo * (f2){a4.x, a4.y}; p = __builtin_elementwise_fma(Shi, (f2){a4.z, a4.w}, p);
                float sa = p.x + p.y;
                sa = DPP_ADD(sa, 0xB1); yp = DPP_ADD(yp, 0xB1); sa = DPP_ADD(sa, 0x4E); yp = DPP_ADD(yp, 0x4E); sa = DPP_ADD(sa, 0x141); yp = DPP_ADD(yp, 0x141); sa = DPP_ADD(sa, 0x140); yp = DPP_ADD(yp, 0x140);
                if (t > 0) ykeep = __builtin_bit_cast(float, __builtin_amdgcn_update_dpp(__builtin_bit_cast(int, yp), __builtin_bit_cast(int, ykeep), 0x111, 0xf, 0xf, false));
                if (t == 16) yo[(size_t)(15 - kq) * 512] = (bf16)f2bf(ykeep);
                const f2 sa2 = {sa, sa}, vv2 = {vv, vv};
                f2 tl = (f2){k4.x, k4.y} * vv2, th = (f2){k4.z, k4.w} * vv2;
                tl = __builtin_elementwise_fma((f2){b4.x, b4.y}, sa2, tl); th = __builtin_elementwise_fma((f2){b4.z, b4.w}, sa2, th);
                Slo = __builtin_elementwise_fma(Slo, (f2){w4.x, w4.y}, tl); Shi = __builtin_elementwise_fma(Shi, (f2){w4.z, w4.w}, th);
                f2 q = Slo * (f2){r4.x, r4.y}; q = __builtin_elementwise_fma(Shi, (f2){r4.z, r4.w}, q);
                yp = q.x + q.y;
                a4 = na4; b4 = nb4; w4 = nw4; k4 = nk4; r4 = nr4; vv = nvv; }
            yp = row16_sum(yp);
            ykeep = __builtin_bit_cast(float, __builtin_amdgcn_update_dpp(__builtin_bit_cast(int, yp), __builtin_bit_cast(int, ykeep), 0x111, 0xf, 0xf, false));
            yo[(size_t)(31 - kq) * 512] = (bf16)f2bf(ykeep);
        }
        __syncthreads();
    }
    __builtin_amdgcn_s_setprio(0);
#undef RW_PRODUCE
}

__device__ __forceinline__ void post_phase(const Ptrs& P, int L, LAS unsigned char* lds, int gw, int NGW, int tid, int wave, int lane) {
    asm volatile("" : "+v"(tid), "+v"(lane)); asm volatile("" : "+s"(wave));
    unsigned char* ws = P.ws;
    LAS bf16* g2s = (LAS bf16*)lds;
    const float* g2 = P.in[21] + (size_t)L * 96 * 512;
    for (int i = tid; i < 96 * 512; i += NTHR) g2s[i] = (bf16)f2bf(g2[i]);
    __syncthreads();
    const float lam_init = (L == 0) ? 0.2f : 0.35550906f;
    const float* lv = P.in[14] + L * 256;
    const float lam = __expf(wave_sum(lv[lane] * lv[64 + lane])) - __expf(wave_sum(lv[128 + lane] * lv[192 + lane])) + lam_init;
    const int c0 = lane * 8;
    float sg[8], lng[8], lnb[8], rk[8], ka[8];
#pragma unroll
    for (int i = 0; i < 8; ++i) { sg[i] = P.in[15][L * 128 + ((c0 + i) & 127)] * (1.f - lam_init); lng[i] = P.in[25][L * 512 + c0 + i]; lnb[i] = P.in[26][L * 512 + c0 + i]; rk[i] = P.in[24][L * 512 + c0 + i]; ka[i] = P.in[23][L * 512 + c0 + i]; }
    const float* xsrc = (L == 0) ? P.in[0] : P.out;
    for (int pr = gw; pr < M / 2; pr += NGW) {
        const size_t m0 = (size_t)pr * 2;
        float z0[2], z1[2], z2[2];
#pragma unroll
        for (int t = 0; t < 2; ++t) { const bf16* zr = (const bf16*)(ws + WS_Z) + (m0 + t) * ZP;
            z0[t] = sigm(bf2f(zr[1600 + (lane & 31)])); z1[t] = sigm(bf2f(zr[1632 + (lane & 31)])); z2[t] = sigm(bf2f(zr[1664 + (lane & 31)])); }
        f2p gacc[8];
#pragma unroll
        for (int i = 0; i < 8; ++i) gacc[i] = (f2p){0.f, 0.f};
        LORA2F(gacc, z0[0], z0[1], 0, g2s);
        LORA2F(gacc, z1[0], z1[1], 0, g2s + 32 * 512);
        LORA2F(gacc, z2[0], z2[1], 0, g2s + 64 * 512);
#pragma unroll
        for (int t = 0; t < 2; ++t) {
        const size_t m = m0 + t;
        bf16* zr = (bf16*)(ws + WS_Z) + m * ZP;
        float r[8], k[8], v[8], a[8], yr[8];
        unpack8(*(const v4u*)(zr + c0), r); unpack8(*(const v4u*)(zr + 512 + c0), k); unpack8(*(const v4u*)(zr + 1024 + c0), v);
        unpack8(*(const v4u*)((const bf16*)(ws + WS_AB) + m * 512 + c0), a); unpack8(*(const v4u*)((const bf16*)(ws + WS_YA) + m * 512 + c0), yr);
        float s1 = 0.f;
#pragma unroll
        for (int i = 0; i < 8; ++i) s1 += yr[i];
        s1 += __shfl_xor(s1, 1); s1 += __shfl_xor(s1, 2); s1 += __shfl_xor(s1, 4); const float mean = s1 * (1.f / 64.f);
        float s2 = 0.f, bd = 0.f;
#pragma unroll
        for (int i = 0; i < 8; ++i) { const float d = yr[i] - mean; s2 += d * d; bd += r[i] * (k[i] * (1.f + (a[i] - 1.f) * ka[i])) * rk[i]; }
        s2 += __shfl_xor(s2, 1); s2 += __shfl_xor(s2, 2); s2 += __shfl_xor(s2, 4); bd += __shfl_xor(bd, 1); bd += __shfl_xor(bd, 2); bd += __shfl_xor(bd, 4);
        const float rstd = 1.f / sqrtf(s2 * (1.f / 64.f) + 64e-5f);
        float yc[8];
#pragma unroll
        for (int i = 0; i < 8; ++i) yc[i] = ((yr[i] - mean) * rstd * lng[i] + lnb[i] + bd * v[i]) * (t ? gacc[i].y : gacc[i].x);
        const int hd = lane >> 4, j0 = (lane & 15) * 8; const bf16* orow = (const bf16*)(ws + WS_O) + m * 1024 + hd * 256 + j0;
        float o0[8], o1[8]; unpack8(*(const v4u*)orow, o0); unpack8(*(const v4u*)(orow + 128), o1);
        float so = 0.f;
#pragma unroll
        for (int i = 0; i < 8; ++i) { o0[i] = o0[i] - lam * o1[i]; so += o0[i] * o0[i]; }
        so += __shfl_xor(so, 1); so += __shfl_xor(so, 2); so += __shfl_xor(so, 4); so += __shfl_xor(so, 8);
        const float ro = 1.f / sqrtf(so * (1.f / 128.f) + 1e-5f);
#pragma unroll
        for (int i = 0; i < 8; ++i) o0[i] *= ro * sg[i];
        *(v4u*)(zr + c0) = pack8(yc); *(v4u*)(zr + 512 + c0) = pack8(o0);
        }
    }
    __syncthreads();
}


__device__ __forceinline__ void dump_stage(const Ptrs& P, int k, int blk, int G, int tid) {
    unsigned char* ws = P.ws; float* out = P.out;
    for (size_t i = (size_t)blk * NTHR + tid; i < (size_t)M * 1024; i += (size_t)G * NTHR) {
        const size_t m = i >> 10; const int c = (int)(i & 1023); float v = 0.f;
        const bf16* Z = (const bf16*)(ws + WS_Z); const bf16* US = (const bf16*)(ws + WS_US);
        if (k == 1) v = bf2f(Z[m * ZP + c]) + bf2f(Z[m * ZP + 704 + c]) + bf2f(((const bf16*)(ws + WS_QB))[m * 512 + (c & 511)]) + bf2f(((const bf16*)(ws + WS_KB))[m * 512 + (c & 511)]) + bf2f(((const bf16*)(ws + WS_VB))[m * 512 + (c & 511)]) + bf2f(US[m * 768 + (c % 768)]);
        else if (k == 2) {
#if !defined(DSEL) || DSEL==1
            v += bf2f(US[m * 768 + (c % 768)]);
#endif
#if !defined(DSEL) || DSEL==2
            v += bf2f(((const bf16*)(ws + WS_E))[m * 512 + (c & 511)]) + bf2f(((const bf16*)(ws + WS_AB))[m * 512 + (c & 511)]);
#endif
#if !defined(DSEL) || DSEL==3
            v += bf2f(((const bf16*)(ws + WS_QB))[m * 512 + (c & 511)]) + bf2f(((const bf16*)(ws + WS_KB))[m * 512 + (c & 511)]);
#endif
#if !defined(DSEL) || DSEL==4
            v += bf2f(Z[m * ZP + 1024 + (c & 511)]) + bf2f(((const bf16*)(ws + WS_VF))[m * 512 + (c & 511)]);
#endif
        }
        else if (k == 3) v = bf2f(((const bf16*)(ws + WS_O))[m * 1024 + c]) + bf2f(((const bf16*)(ws + WS_YA))[m * 512 + (c & 511)]) + bf2f(US[m * 768 + (c % 768)]);
        else if (k == 4) v = bf2f(Z[m * ZP + c]) + bf2f(((const bf16*)(ws + WS_XN))[m * 1024 + c]) + bf2f(((const bf16*)(ws + WS_YL))[m * 512 + (c & 511)]);
        else if (k == 5) v = bf2f(((const bf16*)(ws + WS_YA))[m * 512 + (c & 511)]);
        else if (k == 6) v = bf2f(((const bf16*)(ws + WS_P12))[m * 1024 + c]);
        else if (k == 9) v = bf2f(((const bf16*)(ws + WS_HID))[m * DFF + c]) + bf2f(((const bf16*)(ws + WS_HID))[m * DFF + 1024 + c]) + bf2f(((const bf16*)(ws + WS_H2N))[m * 1024 + c]);
        out[i] = v;
    }
}
#define XB_TMO      128
#define XB_XCNT(j)  (256  + 64 * (j))
#define XB_XSUB(j)  (1280 + 64 * (j))
#define XB_XGEN(j)  (2304 + 64 * (j))
#define XB_TOP      3328
#define XB_TOPGEN   3392
#define XCD_BAR_WORDS 3456
#define XB_SPIN_CAP (1u << 18)

__device__ __forceinline__ unsigned xb_ld(unsigned* p)              { return __hip_atomic_load(p, __ATOMIC_RELAXED, __HIP_MEMORY_SCOPE_AGENT); }
__device__ __forceinline__ unsigned xb_add(unsigned* p, unsigned v) { return __hip_atomic_fetch_add(p, v, __ATOMIC_RELAXED, __HIP_MEMORY_SCOPE_AGENT); }
__device__ __forceinline__ unsigned xb_xcc_id() { return (unsigned)__builtin_amdgcn_s_getreg((3 << 11) | 20) & 0xFu; }
#define XB_SPIN(cond, bar) do { unsigned _sp = 0; while (cond) { __builtin_amdgcn_s_sleep(1); \
    if ((++_sp & 255u) == 0u) { if (xb_ld(&(bar)[XB_TMO])) break; if (_sp > XB_SPIN_CAP) { atomicAdd(&(bar)[XB_TMO], 1u); break; } } } } while (0)

struct XcdBarrier {
    unsigned* bar; unsigned x;
    volatile LAS unsigned* st;
};

__device__ __forceinline__ XcdBarrier xcd_barrier_post(unsigned* bar, volatile LAS unsigned* st) {
    XcdBarrier b; b.bar = bar; b.x = xb_xcc_id(); b.st = st;
    if (threadIdx.x == 0) (void)xb_add(&bar[XB_XCNT(b.x)], 1u);
    return b;
}
__device__ __forceinline__ void xcd_barrier_complete(unsigned* bar, unsigned x, unsigned& nloc, unsigned& nx) {
    const unsigned G = gridDim.x * gridDim.y * gridDim.z;
    unsigned sum, cnt, mine, sp = 0u;
    for (;;) {
        sum = 0u; cnt = 0u; mine = 0u;
#pragma unroll
        for (unsigned j = 0; j < 16; ++j) { const unsigned c = xb_ld(&bar[XB_XCNT(j)]); sum += c; cnt += (c > 0u) ? 1u : 0u; mine = (j == x) ? c : mine; }
        if (sum == G) break;
        __builtin_amdgcn_s_sleep(1);
        if ((++sp & 255u) == 0u) { if (xb_ld(&bar[XB_TMO])) break; if (sp > XB_SPIN_CAP) { atomicAdd(&bar[XB_TMO], 1u); break; } }
    }
    nloc = mine > 0u ? mine : 1u; nx = cnt > 0u ? cnt : 1u;
}

__device__ __forceinline__ void xcd_barrier(const XcdBarrier& b, const int tid_hint) {
    asm volatile("s_waitcnt vmcnt(0)" ::: "memory");
    __syncthreads();
    if (tid_hint == 0) {
        unsigned* bar = b.bar;
        __builtin_amdgcn_s_waitcnt(0);
        unsigned nloc = b.st[0], nx = b.st[1];
        if (nloc == 0u) { xcd_barrier_complete(bar, b.x, nloc, nx); b.st[0] = nloc; b.st[1] = nx; }
        const unsigned old = xb_add(&bar[XB_XSUB(b.x)], 1u);
        const unsigned gen = old / nloc;
        if (old + 1u == (gen + 1u) * nloc) {
            __builtin_amdgcn_fence(__ATOMIC_RELEASE, "agent");
            asm volatile("s_waitcnt vmcnt(0)" ::: "memory");
            const unsigned og = xb_add(&bar[XB_TOP], 1u);
            const unsigned tg = og / nx;
            if (og + 1u == (tg + 1u) * nx) xb_add(&bar[XB_TOPGEN], 1u);
            else XB_SPIN(xb_ld(&bar[XB_TOPGEN]) == tg, bar);
            __builtin_amdgcn_fence(__ATOMIC_ACQUIRE, "agent");
            xb_add(&bar[XB_XGEN(b.x)], 1u);
            asm volatile("s_waitcnt vmcnt(0)" ::: "memory");
        } else {
            XB_SPIN(xb_ld(&bar[XB_XGEN(b.x)]) == gen, bar);
            __builtin_amdgcn_fence(__ATOMIC_ACQUIRE, "agent");
            asm volatile("s_waitcnt vmcnt(0)" ::: "memory");
        }
    }
    __syncthreads();
}


#define GSYNC() do { xcd_barrier(xbar, tid); } while (0)
#if defined(PROBE_A)
#define STAMP(k) do { if (blk0 == 0 && tid0 == 0) ((LAS unsigned long long*)(lds + LDS_XB + 256))[(k)] = __builtin_amdgcn_s_memrealtime(); } while (0)
#else
#define STAMP(k) do { } while (0)
#endif
struct Args { Ptrs p; int pad0, pad1; };
__global__ void __launch_bounds__(NTHR, 2) mega_fwd(Args args) {
    extern __shared__ __attribute__((aligned(16))) unsigned char lds_raw[];
    LAS unsigned char* lds = (LAS unsigned char*)lds_raw;
    cg::grid_group grid = cg::this_grid();
    const Ptrs& P = args.p;
    unsigned char* ws = P.ws;
    const int tid0 = threadIdx.x, wave0 = __builtin_amdgcn_readfirstlane(tid0 >> 6);
    const int wave = wave0;
    const int G0 = gridDim.x, blk0 = blockIdx.x;
    const int gw0 = blk0 * NWAVES + wave, NGW0 = G0 * NWAVES;
    unsigned* ctl = (unsigned*)(ws + WS_CTL);
    if (tid0 < 64) ((LAS unsigned*)(lds + LDS_XB))[tid0] = 0u;
    __syncthreads();
    XcdBarrier xbar = xcd_barrier_post(ctl + CW_BAR, (volatile LAS unsigned*)(lds + LDS_XB));
    grid.sync();
    for (int L = 0; L < 2; ++L) {
        int gw = gw0, NGW = NGW0, blk = blk0, G = G0; asm volatile("" : "+s"(gw), "+s"(NGW), "+s"(blk), "+s"(G));
        int tid = wave * 64 + (int)__builtin_amdgcn_mbcnt_hi(~0u, __builtin_amdgcn_mbcnt_lo(~0u, 0u)); asm volatile("" : "+v"(tid)); int lane = tid & 63;
#define RELAUNDER() do { tid = wave * 64 + (int)__builtin_amdgcn_mbcnt_hi(~0u, __builtin_amdgcn_mbcnt_lo(~0u, 0u)); asm volatile("" : "+v"(tid)); lane = tid & 63; asm volatile("" : "+s"(gw), "+s"(NGW), "+s"(blk), "+s"(G)); } while (0)
        STAMP(13 * L);
        const float* xsrc = (L == 0) ? P.in[0] : P.out;
#if !defined(ONLY) || ONLY==0
#if defined(DUP_PH0)
        for (int rep = 0; rep < 2; ++rep)
#endif
        {
        s5_tables(P, L, blk >> 3, blk & 7, (LAS float*)lds, tid);
        if (L == 0) weight_items(P, L, gw, NGW, (LAS float*)(lds + wave * 16384), lane, 0, 4128);
        weight_items(P, L, gw, NGW, (LAS float*)(lds + wave * 16384), lane, 6944, 8352);
        for (int i = blk * NTHR + tid; i < 96 * 2048 / 8; i += G * NTHR) ((v4u*)((bf16*)(ws + WS_W1B) + (size_t)1696 * 2048))[i] = (v4u){0u, 0u, 0u, 0u};
        if (blk < 4) { for (int i = tid; i < 128; i += NTHR) ((v4u*)((bf16*)(ws + WS_XNP) + (size_t)blk * 4097 * 1024))[i] = (v4u){0u, 0u, 0u, 0u}; }
        for (int m = gw; m < M; m += 2 * NGW) { const int m2 = m + NGW;
            rms_row2(xsrc + (size_t)m * 1024, xsrc + (size_t)m2 * 1024, P.in[1] + L * 1024, (bf16*)(ws + WS_XNP) + ((size_t)(m >> 12) * 4097 + 1 + (m & 4095)) * 1024, (bf16*)(ws + WS_XNP) + ((size_t)(m2 >> 12) * 4097 + 1 + (m2 & 4095)) * 1024, lane); }
        }
        GSYNC(); RELAUNDER(); STAMP(1 + 13 * L);
#endif
#if !defined(ONLY) || ONLY==1
#if defined(DUP_PH1)
        for (int rep = 0; rep < 2; ++rep)
#endif
        {
        { pg8::Gemm g = mkgemm((const bf16*)(ws + WS_XNP) + 1024, (const bf16*)(ws + WS_W1A), M, 2048, 1024, 1024, 1024); g.a_skip_shift = 4; g.a_skip_bytes = 2048;
          Epi8<1> E{(bf16*)(ws + WS_QB), 512, (const bf16*)(ws + WS_US), nullptr};
#if !defined(SUB) || SUB==0
          run_gemm(lds, g, E, G, blk);
#endif
          }
        { pg8::Gemm g = mkgemm((const bf16*)(ws + WS_XNP) + 1024, (const bf16*)(ws + WS_W1B), M, 1792, 2048, 1024, 2048); g.a_skip_shift = 4; g.a_skip_bytes = 2048; g.kwrap = 16; g.wrap_bytes = 4096;
          Epi8<0> E{(bf16*)(ws + WS_Z), ZP, nullptr, nullptr};
#if !defined(SUB) || SUB==1
          run_gemm(lds, g, E, G, blk);
#endif
          }
        if (blk >= 192) { __syncthreads(); weight_items(P, L, (blk - 192) * NWAVES + wave, 64 * NWAVES, (LAS float*)(lds + wave * 16384), lane, 4128, 6944); }
        }
        GSYNC(); RELAUNDER(); STAMP(2 + 13 * L);
#if defined(STOP_AFTER) && STOP_AFTER==1
        dump_stage(P, 1, blk, G, tid); return;
#endif
#endif
#if !defined(ONLY) || ONLY==2
        { pg8::Gemm g = mkgemm((const bf16*)(ws + WS_US), (const bf16*)(ws + WS_PT), 32768, 256, 256, 384, 256); g.b_shift = 2; g.b_stride_bytes = 128 * 256 * 2;
          Epi8<2> E{(bf16*)(ws + WS_US), 384, nullptr, nullptr}; run_gemm(lds, g, E, G, blk);
#if defined(DUP_S5G)
          run_gemm(lds, g, E, G, blk);
#endif
          }
        __syncthreads();
        prep_phase(P, L, lds, gw, NGW, tid, wave, lane);
        GSYNC(); RELAUNDER(); STAMP(3 + 13 * L);
#if defined(STOP_AFTER) && STOP_AFTER==2
        dump_stage(P, 2, blk, G, tid); return;
#endif
#endif
#if !defined(ONLY) || ONLY==3
        if (blk < 128) rwkv_unit(P, L, lds, blk >> 5, (blk >> 2) & 7, blk & 3, tid, wave, lane);
#if defined(DUP_RWKV)
        if (blk < 128) rwkv_unit(P, L, lds, blk >> 5, (blk >> 2) & 7, blk & 3, tid, wave, lane);
#endif
        else if (blk >= G - 16) s5_chunk_scan(P, L, (blk - (G - 16)) * NTHR + tid);
        __syncthreads();
        {
            volatile LAS unsigned* qslot = (volatile LAS unsigned*)(lds + 140000);
            for (;;) {
                if (tid == 0) qslot[0] = atomicAdd(ctl + 64 * L, 1u);
                __syncthreads();
                const unsigned uidx = qslot[0];
                __syncthreads();
                if (uidx >= 1024u) break;
                const int qb = 15 - (int)(uidx >> 6), bhv = uidx & 63, b = bhv >> 4, hv = bhv & 15, hh = hv >> 2, cc = (hv >> 1) & 1, half = hv & 1;
                attn_body::attn_unit<8>(b, (2 * hh + cc) * 64, (2 * hh + cc) * 64, (2 * hh + half) * 64, hv * 64, qb,
                    (const attn_body::bf16*)(ws + WS_QB), (const attn_body::bf16*)(ws + WS_KB), (const attn_body::bf16*)(ws + WS_VB), (attn_body::bf16*)(ws + WS_O), (char*)lds_raw, wave);
#if defined(DUP_ATT)
                attn_body::attn_unit<8>(b, (2 * hh + cc) * 64, (2 * hh + cc) * 64, (2 * hh + half) * 64, hv * 64, qb,
                    (const attn_body::bf16*)(ws + WS_QB), (const attn_body::bf16*)(ws + WS_KB), (const attn_body::bf16*)(ws + WS_VB), (attn_body::bf16*)(ws + WS_O), (char*)lds_raw, wave);
#endif
            }
        }
        GSYNC(); RELAUNDER(); STAMP(4 + 13 * L);
#if defined(STOP_AFTER) && STOP_AFTER==3
        dump_stage(P, 3, blk, G, tid); return;
#endif
#endif
#if !defined(ONLY) || ONLY==4
        { pg8::Gemm g = mkgemm((const bf16*)(ws + WS_US), (const bf16*)(ws + WS_MT), 32768, 256, 384, 384, 384); g.b_shift = 2; g.b_stride_bytes = 256 * 384 * 2;
          Epi8<3> E{(bf16*)(ws + WS_YL), 512, (const bf16*)(ws + WS_US), P.in[10] + L * 512}; run_gemm(lds, g, E, G, blk);
#if defined(DUP_S5G)
          run_gemm(lds, g, E, G, blk);
#endif
          }
        __syncthreads();
        post_phase(P, L, lds, gw, NGW, tid, wave, lane);
        GSYNC(); RELAUNDER(); STAMP(5 + 13 * L);
#if defined(STOP_AFTER) && STOP_AFTER==4
        dump_stage(P, 4, blk, G, tid); return;
#endif
#endif
#if !defined(ONLY) || ONLY==5
        { pg8::Gemm g = mkgemm((const bf16*)(ws + WS_YL), (const bf16*)(ws + WS_WGLU), M, 512, 512, 512, 512);
          Epi8<4> E{(bf16*)(ws + WS_YA), 512, (const bf16*)(ws + WS_YL), nullptr}; run_gemm(lds, g, E, G, blk);
#if defined(DUP_S5G)
          run_gemm(lds, g, E, G, blk);
#endif
          }
        __syncthreads();
        { const float* w_in = P.in[2] + (size_t)L * 1024 * NIN; LAS float* scr = (LAS float*)(lds + wave * 16384);
          for (int it = gw; it < 16 * 96; it += NGW) { const int kb = it / 96, nb = it % 96; tr_item(w_in, NIN, kb * 64, 3744 + nb * 32, (bf16*)(ws + WS_WG), 1024, nb * 32, 0, nullptr, 0, scr, lane); } }
        { const int nsh = (blk < 128) ? 1 : 2; const int vw0 = (blk < 128) ? blk * NWAVES + wave : 1024 + ((blk - 128) * NWAVES + wave) * 2;
          for (int s = 0; s < nsh; ++s) for (int m = vw0 + s; m < M; m += 3072) rms_row(xsrc + (size_t)m * 1024, P.in[1] + L * 1024, (bf16*)(ws + WS_XN) + (size_t)m * 1024, lane); }
        GSYNC(); RELAUNDER(); STAMP(6 + 13 * L);
#if defined(STOP_AFTER) && STOP_AFTER==5
        dump_stage(P, 5, blk, G, tid); return;
#endif
        { pg8::Gemm g = mkgemm((const bf16*)(ws + WS_XN), (const bf16*)(ws + WS_WG) + (size_t)1024 * 1024, M, 2048, 1024, 1024, 1024);
          Epi8<10> E{(bf16*)(ws + WS_P12), 1024, nullptr, nullptr}; run_gemm_pair(lds, g, E, G, blk); }
        { pg8::Gemm g = mkgemm((const bf16*)(ws + WS_Z) + 512, (const bf16*)(ws + WS_WB) + (size_t)1024 * 512, M, 2048, 512, ZP, 512); g.a_pn_shift = 2; g.a_pn_bytes = -1024;
          Epi8<11> E{(bf16*)(ws + WS_P12), 1024, nullptr, nullptr}; run_gemm_pair(lds, g, E, G, blk); }
        RELAUNDER(); STAMP(7 + 13 * L);
#endif
#if !defined(ONLY) || ONLY==6
        { pg8::Gemm g = mkgemm((const bf16*)(ws + WS_XN), (const bf16*)(ws + WS_WG), M, 1024, 1024, 1024, 1024);
          Epi8<5> E{(bf16*)(ws + WS_G0), 1024, nullptr, nullptr}; run_gemm(lds, g, E, G, blk); }
        { pg8::Gemm g = mkgemm((const bf16*)(ws + WS_YA), (const bf16*)(ws + WS_WB), M, 1024, 512, 512, 512);
          Epi8<7> E{(bf16*)(ws + WS_P12), 1024, (const bf16*)(ws + WS_G0), nullptr}; run_gemm(lds, g, E, G, blk); }
        GSYNC(); RELAUNDER(); STAMP(8 + 13 * L);
#if defined(STOP_AFTER) && STOP_AFTER==6
        dump_stage(P, 6, blk, G, tid); return;
#endif
#endif
#if !defined(ONLY) || ONLY==7
        { pg8::Gemm g = mkgemm((const bf16*)(ws + WS_P12), (const bf16*)(ws + WS_WO), M, 1024, 1024, 1024, 1024);
          EpiRes E{xsrc, P.out}; run_gemm(lds, g, E, G, blk); }
        GSYNC(); RELAUNDER(); STAMP(9 + 13 * L);
#endif
#if !defined(ONLY) || ONLY==8
#if defined(DUP_SYNC)
        for (int rep = 0; rep < 10; ++rep) { GSYNC(); }
#endif
        for (int m = gw; m < M; m += 2 * NGW) rms_row2(P.out + (size_t)m * 1024, P.out + (size_t)(m + NGW) * 1024, P.in[32] + L * 1024, (bf16*)(ws + WS_H2N) + (size_t)m * 1024, (bf16*)(ws + WS_H2N) + (size_t)(m + NGW) * 1024, lane);
#if defined(DUP_PH8)
        for (int m = gw; m < M; m += NGW) rms_row(P.out + (size_t)m * 1024, P.in[32] + L * 1024, (bf16*)(ws + WS_H2N) + (size_t)m * 1024, lane);
#endif
        GSYNC(); RELAUNDER(); STAMP(10 + 13 * L);
#endif
#if !defined(ONLY) || ONLY==9
        { pg8::Gemm g = mkgemm((const bf16*)(ws + WS_H2N), (const bf16*)(ws + WS_WFI), M, 2 * DFF, 1024, 1024, 1024);
          Epi8<8> E{(bf16*)(ws + WS_HID), DFF, nullptr, nullptr}; run_gemm(lds, g, E, G, blk);
#if defined(DUP_FFN1)
          run_gemm(lds, g, E, G, blk);
#endif
          }
        if (L == 0 && blk >= 128) { __syncthreads(); weight_items(P, 1, (blk - 128) * NWAVES + wave, 128 * NWAVES, (LAS float*)(lds + wave * 16384), lane, 0, 4128); }
        GSYNC(); RELAUNDER(); STAMP(11 + 13 * L);
#if defined(STOP_AFTER) && STOP_AFTER==9
        dump_stage(P, 9, blk, G, tid); return;
#endif
#endif
#if !defined(ONLY) || ONLY==10
        { pg8::Gemm g = mkgemm((const bf16*)(ws + WS_HID), (const bf16*)(ws + WS_WFO), M, 1024, DFF, DFF, DFF);
          EpiRes E{P.out, P.out}; run_gemm(lds, g, E, G, blk); }
#endif
        if (L == 0) { GSYNC(); STAMP(12); }
    }
#if defined(PROBE_A)
    GSYNC();
    if (blk0 == 0) { STAMP(25); __syncthreads(); LAS unsigned long long* st = (LAS unsigned long long*)(lds + LDS_XB + 256);
        float dA = 0.f, dB = 0.f;
        for (int L = 0; L < 2; ++L) { for (int k = 0; k < 12; ++k) { const int k1 = (L == 1 && k == 11) ? 25 : 13 * L + k + 1; const float d = (float)(long long)(st[k1] - st[13 * L + k]); if ((PROBE_A >> k) & 1) dA += d; if ((PROBE_B >> k) & 1) dB += d; } }
#if defined(PROBE_CAL)
        dB = 50000.f;
#endif
        const float qa = __expf(0.04f * rintf(__logf(fmaxf(dA, 1.f)) * 25.f)), qb = __expf(0.04f * rintf(__logf(fmaxf(dB, 1.f)) * 25.f));
        if (tid0 == 0) { P.out[3] += qa * 0.01f; } }
#endif
}

extern "C" void kernel_launch(void* const* d_in, const int* in_sizes, int n_in, void* d_out, int out_size, void* d_ws, size_t ws_size, hipStream_t stream) {
    static int grid = 0;
    if (grid == 0) {
        if (n_in != 35 || out_size != M * DMOD || ws_size < WS_END) { fprintf(stderr, "kernel_launch: unexpected shapes (n_in %d out %d ws %zu)\n", n_in, out_size, ws_size); grid = -1; return; }
        int dev = 0, cus = 0, per_cu = 0;
        hipGetDevice(&dev); hipDeviceGetAttribute(&cus, hipDeviceAttributeMultiprocessorCount, dev);
        hipFuncSetAttribute((const void*)mega_fwd, hipFuncAttributeMaxDynamicSharedMemorySize, LDS_BYTES);
        hipOccupancyMaxActiveBlocksPerMultiprocessor(&per_cu, (const void*)mega_fwd, NTHR, LDS_BYTES);
        if (per_cu < 1) { fprintf(stderr, "kernel_launch: occupancy query says %d\n", per_cu); grid = -1; return; }
        grid = cus;
        if (grid != 256) { fprintf(stderr, "kernel_launch: built for a 256-CU device (one workgroup per CU); got %d\n", grid); grid = -1; return; }
    }
    if (grid < 0) return;
    hipMemsetAsync((char*)d_ws + WS_CTL, 0, 65536, stream);
    Args a{};
    for (int i = 0; i < 35; ++i) a.p.in[i] = (const float*)d_in[i];
    a.p.out = (float*)d_out; a.p.ws = (unsigned char*)d_ws;
    void* kargs[] = {&a};
    hipError_t e = hipLaunchCooperativeKernel((const void*)mega_fwd, dim3(grid), dim3(NTHR), kargs, LDS_BYTES, stream);
    if (e != hipSuccess) fprintf(stderr, "cooperative launch failed: %s (grid %d)\n", hipGetErrorString(e), grid);
}
```

```cpp
#include <hip/hip_runtime.h>
#include <hip/hip_cooperative_groups.h>
#include <cstdio>
#include <cstdint>

namespace pg8 {
#define PG8_LAS __attribute__((address_space(3)))
typedef unsigned short bf16_t;
typedef short bf16x8 __attribute__((ext_vector_type(8)));
typedef float f32x4 __attribute__((ext_vector_type(4)));
typedef unsigned u32x4 __attribute__((ext_vector_type(4)));
constexpr int BM = 256, BK = 64, HALF = 128, HTB = HALF * BK * 2  , STAGE_BYTES = 8 * HTB, NXCD = 8, WGM = 8;

__host__ __device__ __forceinline__ int lds_byte(int r, int c) { const int st = (r >> 4) * 2 + (c >> 5), rr = r & 15, cc = c & 31, ob = rr * 64 + cc * 2; return st * 1024 + (ob ^ (((ob >> 9) & 1) << 5)); }
__host__ __device__ __forceinline__ void stage_rc(int b, int& R, int& C) { const int st = b / 1024, sb = b % 1024, swz = sb ^ (((sb >> 9) & 1) << 5); R = (st >> 1) * 16 + swz / 64; C = (st & 1) * 32 + (swz % 64) / 2; }
__host__ __device__ __forceinline__ int perm32(int rho) { const int n = rho >> 4, i = rho & 15; return 8 * (i >> 2) + 4 * n + (i & 3); }

struct Unit { int pm, pn; };
struct Gemm { const bf16_t* A; const bf16_t* Bt; int M, N, K; int lda, ldb; int a_skip_shift; int a_skip_bytes; int kwrap; int wrap_bytes; int b_shift; int b_stride_bytes; int a_pn_shift; int a_pn_bytes;
  __device__ __forceinline__ const char* abase(const Unit& u) const { return (const char*)A + (size_t)u.pm * (size_t)(256 * 2) * lda + (size_t)(u.pm >> a_skip_shift) * a_skip_bytes + (long)(u.pn >> a_pn_shift) * (long)a_pn_bytes; }
  __device__ __forceinline__ const char* bbase(const Unit& u) const { return (const char*)Bt + (size_t)u.pn * (size_t)(256 * 2) * ldb + (size_t)(u.pm >> b_shift) * b_stride_bytes; } };

struct StaticOrder {
    int nM, nN, nwg, G, c;
    __host__ __device__ void init(int M, int N, int G_, int c_) { nM = M / BM; nN = N / BM; nwg = nM * nN; G = G_; c = c_; }
    __host__ __device__ bool next(int i, Unit& u) const {
        const long L = (long)i * G + c; if (L >= nwg) return false;
        int wgid = (int)L; { const int q = nwg / NXCD, r = nwg % NXCD, xcd = wgid % NXCD, off = wgid / NXCD; wgid = (xcd < r ? xcd * (q + 1) : r * (q + 1) + (xcd - r) * q) + off; }
        const int nig = WGM * nN, gid = wgid / nig, fm = gid * WGM, gsz = (nM - fm) < WGM ? (nM - fm) : WGM;
        u.pm = fm + ((wgid % nig) % gsz); u.pn = (wgid % nig) / gsz; return true;
    }
    __device__ __forceinline__ void a_ready(const Unit&) const {}
    __device__ __forceinline__ void done(const Unit&) const {}
};

typedef float cvt_f32x2_t __attribute__((ext_vector_type(2))); typedef __bf16 cvt_bf16x2_t __attribute__((ext_vector_type(2)));
__device__ __forceinline__ unsigned cvt_pk_bf16(float lo, float hi) { cvt_f32x2_t v = {lo, hi}; cvt_bf16x2_t b = __builtin_convertvector(v, cvt_bf16x2_t); return __builtin_bit_cast(unsigned, b); }
typedef float f32x2 __attribute__((ext_vector_type(2)));
__device__ __forceinline__ f32x2 gelu_pk(f32x2 v) {
    const f32x2 av = __builtin_elementwise_abs(v), d = av * 0.2316418882f + 1.0f;
    f32x2 t; t.x = __builtin_amdgcn_rcpf(d.x); t.y = __builtin_amdgcn_rcpf(d.y);
    f32x2 q = t * 0.5307027145f + (-0.7265760135f); q = q * t + 0.7107068705f; q = q * t + (-0.142248368f); q = q * t + 0.127414796f; q = q * t;
    const f32x2 s = (v * v) * (-0.72134752044f);
    f32x2 e; e.x = __builtin_amdgcn_exp2f(s.x); e.y = __builtin_amdgcn_exp2f(s.y);
    const f32x2 m = v * (q * e), r = v - m;
    f32x2 o; o.x = v.x < 0.f ? m.x : r.x; o.y = v.y < 0.f ? m.y : r.y; return o;
}

template <int ACT  > struct EpiBf16 {
    static constexpr bool PERM = true, AFTER_DRAIN = false; static_assert(ACT == 0 || ACT == 1, "EpiBf16: ACT is 0 (none) or 1 (gelu_pk)");
    bf16_t* O; int ldc; const float* bias; int split_cols; size_t split_stride; float scale0;
    __device__ __forceinline__ void operator()(const f32x4 (&acc)[2][2][4][2], const Unit& u, int wr, int wc, int fr, int fq) const {
        const int row0 = u.pm * BM + wr * 64 + fr; int colt = u.pn * BM; bf16_t* base = O;
        float sc = 1.f; if (split_cols) { const int t = colt / split_cols; base += (size_t)t * split_stride; colt -= t * split_cols; if (t == 0) sc = scale0; }
        const int col0 = colt + wc * 32 + 8 * fq, bcol0 = u.pn * BM + wc * 32 + 8 * fq;
        f32x4 bv[2][2];
#pragma unroll
        for (int bj = 0; bj < 2; ++bj)
#pragma unroll
            for (int n = 0; n < 2; ++n) bv[bj][n] = bias ? *(const f32x4*)(bias + bcol0 + bj * HALF + 4 * n) : (f32x4){0.f, 0.f, 0.f, 0.f};
#pragma unroll
        for (int ai = 0; ai < 2; ++ai)
#pragma unroll
            for (int m = 0; m < 4; ++m) { bf16_t* rowp = base + (size_t)(row0 + ai * HALF + m * 16) * ldc + col0;
#pragma unroll
                for (int bj = 0; bj < 2; ++bj) { f32x4 v0 = acc[ai][bj][m][0] + bv[bj][0], v1 = acc[ai][bj][m][1] + bv[bj][1];
                    if (ACT == 1) { f32x2 a = gelu_pk((f32x2){v0[0], v0[1]}), b = gelu_pk((f32x2){v0[2], v0[3]}), c = gelu_pk((f32x2){v1[0], v1[1]}), d = gelu_pk((f32x2){v1[2], v1[3]});
                        v0 = (f32x4){a.x, a.y, b.x, b.y}; v1 = (f32x4){c.x, c.y, d.x, d.y}; }
                    v0 = v0 * sc; v1 = v1 * sc; u32x4 w; w.x = cvt_pk_bf16(v0[0], v0[1]); w.y = cvt_pk_bf16(v0[2], v0[3]); w.z = cvt_pk_bf16(v1[0], v1[1]); w.w = cvt_pk_bf16(v1[2], v1[3]);
                    *(u32x4*)(rowp + bj * HALF) = w; } }
    }
};
template <class Epi, class Sched, bool ALIGN_EPI = false, bool SP2 = false>
__device__ __forceinline__ void gemm_phase(PG8_LAS unsigned char* lds, const Gemm g, const Sched& S, const Epi& E, int wave_hint) {
    int tid_l = wave_hint * 64 + (int)__builtin_amdgcn_mbcnt_hi(~0u, __builtin_amdgcn_mbcnt_lo(~0u, 0u)); asm volatile("" : "+v"(tid_l)); const int tid = tid_l, wid = __builtin_amdgcn_readfirstlane(tid >> 6), lane = tid & 63, wr = wid >> 2, wc = wid & 3, fr = lane & 15, fq = lane >> 4;
    const int K = g.K, nt = K / BK;
    unsigned voffA[2], voffB[2];
#pragma unroll
    for (int i = 0; i < 2; ++i) { int R, C; stage_rc(tid * 16 + i * 8192, R, C); const int Rb = Epi::PERM ? ((R & ~31) + perm32(R & 31)) : R;
        voffA[i] = (unsigned)(R * g.lda + C) * 2u; voffB[i] = (unsigned)(Rb * g.ldb + C) * 2u; }
    const size_t kstep = (size_t)(BK * 2);
    const size_t hstepA = (size_t)HALF * g.lda * 2, hstepB = (size_t)HALF * g.ldb * 2; const size_t wrapb = (size_t)g.wrap_bytes;
    const unsigned ldsw = (unsigned)wid * 1024u;
    const int aoff = lds_byte(wr * 64 + fr, fq * 8), boff = lds_byte(wc * 32 + fr, fq * 8);
#define PG8_SA(b, h) (((b) * 2 + (h)) * HTB)
#define PG8_SB(b, h) ((4 + (b) * 2 + (h)) * HTB)
#define PG8_STAGE(bufoff, gbase, voff) do { _Pragma("unroll") for (int _i = 0; _i < 2; ++_i) \
        __builtin_amdgcn_global_load_lds((const unsigned*)((const char*)(gbase) + (voff)[_i]), (PG8_LAS unsigned*)(lds + (bufoff) + ldsw + _i * 8192), 16, 0, 0); } while (0)
#define PG8_LDA(dst, b, h) do { _Pragma("unroll") for (int m = 0; m < 4; ++m) _Pragma("unroll") for (int k = 0; k < 2; ++k) dst[m][k] = *(const PG8_LAS bf16x8*)(lds + PG8_SA(b, h) + aoff + m * 2048 + k * 1024); } while (0)
#define PG8_LDB(dst, b, h) do { _Pragma("unroll") for (int n = 0; n < 2; ++n) _Pragma("unroll") for (int k = 0; k < 2; ++k) dst[n][k] = *(const PG8_LAS bf16x8*)(lds + PG8_SB(b, h) + boff + n * 2048 + k * 1024); } while (0)
#define PG8_MMA(ai, bj, At, Bt) do { __builtin_amdgcn_s_setprio(1); _Pragma("unroll") for (int m = 0; m < 4; ++m) _Pragma("unroll") for (int n = 0; n < 2; ++n) _Pragma("unroll") for (int k = 0; k < 2; ++k) \
        acc[ai][bj][m][n] = __builtin_amdgcn_mfma_f32_16x16x32_bf16(Bt[n][k], At[m][k], acc[ai][bj][m][n], 0, 0, 0); __builtin_amdgcn_s_setprio(0); } while (0)
#define PG8_WAIT_V(n) asm volatile("s_waitcnt vmcnt(" #n ")" ::: "memory")
#define PG8_WAIT_L(n) asm volatile("s_waitcnt lgkmcnt(" #n ")" ::: "memory")
#define PG8_BAR __builtin_amdgcn_s_barrier()
#define PG8_SCHED __builtin_amdgcn_sched_barrier(0)
    Unit cur, nxt; int ui = 0;
    if (!S.next(0, cur)) return;
    f32x4 acc[2][2][4][2];
#pragma unroll
    for (int a = 0; a < 2; ++a)
#pragma unroll
        for (int b = 0; b < 2; ++b)
#pragma unroll
            for (int m = 0; m < 4; ++m)
#pragma unroll
                for (int n = 0; n < 2; ++n) acc[a][b][m][n] = (f32x4){0.f, 0.f, 0.f, 0.f};
    bf16x8 At[4][2], B0[2][2], B1[2][2];
    const char* cA = g.abase(cur); const char* cB = g.bbase(cur);
    S.a_ready(cur);
    if constexpr (SP2) {
        PG8_STAGE(PG8_SB(0, 0), cB, voffB); PG8_STAGE(PG8_SB(0, 1), cB + hstepB, voffB); PG8_STAGE(PG8_SA(0, 0), cA, voffA); PG8_STAGE(PG8_SA(0, 1), cA + hstepA, voffA);
        if (wr == 1) PG8_BAR;
        PG8_WAIT_V(2); PG8_BAR;
        PG8_STAGE(PG8_SB(1, 0), cB + kstep, voffB); PG8_STAGE(PG8_SA(1, 0), cA + kstep, voffA); PG8_STAGE(PG8_SB(1, 1), cB + hstepB + kstep, voffB);
        PG8_WAIT_V(6); PG8_BAR;
    } else {
        PG8_STAGE(PG8_SB(0, 0), cB, voffB); PG8_STAGE(PG8_SA(0, 0), cA, voffA); PG8_STAGE(PG8_SB(0, 1), cB + hstepB, voffB); PG8_STAGE(PG8_SA(0, 1), cA + hstepA, voffA);
        if (wr == 1) PG8_BAR;
        PG8_WAIT_V(4); PG8_BAR;
        PG8_STAGE(PG8_SB(1, 0), cB + kstep, voffB); PG8_STAGE(PG8_SA(1, 0), cA + kstep, voffA); PG8_STAGE(PG8_SB(1, 1), cB + hstepB + kstep, voffB);
        PG8_WAIT_V(6); PG8_BAR;
    }
    for (;;) {
        const bool has_next = S.next(ui + 1, nxt);
        const char* nA = has_next ? g.abase(nxt) : cA; const char* nB = has_next ? g.bbase(nxt) : cB;
        for (int t = 0; t < nt; t += 2) {
            const bool last = (t == nt - 2);
            const char* a1 = cA + (size_t)(t + 1) * kstep - ((t + 1) >= g.kwrap ? wrapb : (size_t)0);
            const char* a2 = last ? nA : cA + (size_t)(t + 2) * kstep - ((t + 2) >= g.kwrap ? wrapb : (size_t)0); const char* b2 = last ? nB : cB + (size_t)(t + 2) * kstep;
            const char* a3 = a2 + kstep; const char* b3 = b2 + kstep;
            if (last && has_next) S.a_ready(nxt);
            if constexpr (SP2) {
            PG8_LDB(B0, 0, 0); PG8_LDB(B1, 0, 1); PG8_SCHED; PG8_LDA(At, 0, 0); PG8_STAGE(PG8_SA(1, 1), a1 + hstepA, voffA);
            PG8_WAIT_V(8); PG8_WAIT_L(0); PG8_BAR; PG8_MMA(0, 0, At, B0); PG8_MMA(0, 1, At, B1); PG8_BAR; PG8_SCHED;
            PG8_LDA(At, 0, 1); PG8_STAGE(PG8_SB(0, 0), b2, voffB); PG8_STAGE(PG8_SB(0, 1), b2 + hstepB, voffB); PG8_STAGE(PG8_SA(0, 0), a2, voffA);
            PG8_WAIT_V(8); PG8_WAIT_L(0); PG8_BAR; PG8_MMA(1, 0, At, B0); PG8_MMA(1, 1, At, B1); PG8_BAR; PG8_SCHED;
            PG8_LDB(B0, 1, 0); PG8_LDB(B1, 1, 1); PG8_SCHED; PG8_LDA(At, 1, 0); PG8_STAGE(PG8_SA(0, 1), a2 + hstepA, voffA);
            PG8_WAIT_V(8); PG8_WAIT_L(0); PG8_BAR; PG8_MMA(0, 0, At, B0); PG8_MMA(0, 1, At, B1); PG8_BAR; PG8_SCHED;
            PG8_LDA(At, 1, 1); PG8_STAGE(PG8_SB(1, 0), b3, voffB); PG8_STAGE(PG8_SB(1, 1), b3 + hstepB, voffB); PG8_STAGE(PG8_SA(1, 0), a3, voffA);
            PG8_WAIT_V(8); PG8_WAIT_L(0); PG8_BAR; PG8_MMA(1, 0, At, B0); PG8_MMA(1, 1, At, B1); PG8_BAR; PG8_SCHED;
            } else {
            PG8_LDB(B0, 0, 0); PG8_SCHED; PG8_LDA(At, 0, 0); PG8_STAGE(PG8_SA(1, 1), a1 + hstepA, voffA);
            PG8_WAIT_L(8); PG8_BAR; PG8_WAIT_L(0); PG8_MMA(0, 0, At, B0); PG8_BAR; PG8_SCHED;
            PG8_LDB(B1, 0, 1); PG8_STAGE(PG8_SB(0, 0), b2, voffB);
            PG8_BAR; PG8_WAIT_L(0); PG8_MMA(0, 1, At, B1); PG8_BAR;
            PG8_LDA(At, 0, 1); PG8_STAGE(PG8_SA(0, 0), a2, voffA);
            PG8_BAR; PG8_WAIT_L(0); PG8_MMA(1, 0, At, B0); PG8_BAR; PG8_SCHED;
            PG8_STAGE(PG8_SB(0, 1), b2 + hstepB, voffB);
            PG8_WAIT_V(6); PG8_BAR; PG8_MMA(1, 1, At, B1); PG8_BAR;
            PG8_LDB(B0, 1, 0); PG8_SCHED; PG8_LDA(At, 1, 0); PG8_STAGE(PG8_SA(0, 1), a2 + hstepA, voffA);
            PG8_WAIT_L(8); PG8_BAR; PG8_WAIT_L(0); PG8_MMA(0, 0, At, B0); PG8_BAR; PG8_SCHED;
            PG8_LDB(B1, 1, 1); PG8_STAGE(PG8_SB(1, 0), b3, voffB);
            PG8_BAR; PG8_WAIT_L(0); PG8_MMA(0, 1, At, B1); PG8_BAR;
            PG8_LDA(At, 1, 1); PG8_STAGE(PG8_SA(1, 0), a3, voffA);
            PG8_BAR; PG8_WAIT_L(0); PG8_MMA(1, 0, At, B0); PG8_BAR; PG8_SCHED;
            PG8_STAGE(PG8_SB(1, 1), b3 + hstepB, voffB);
            PG8_WAIT_V(6); PG8_BAR; PG8_MMA(1, 1, At, B1); PG8_BAR;
            }
        }
        if constexpr (ALIGN_EPI) { if (wr == 0) PG8_BAR; }
        if constexpr (!Epi::AFTER_DRAIN) { E(acc, cur, wr, wc, fr, fq); S.done(cur); }
        if (!has_next) break;
#pragma unroll
        for (int a = 0; a < 2; ++a)
#pragma unroll
            for (int b = 0; b < 2; ++b)
#pragma unroll
                for (int m = 0; m < 4; ++m)
#pragma unroll
                    for (int n = 0; n < 2; ++n) acc[a][b][m][n] = (f32x4){0.f, 0.f, 0.f, 0.f};
        cur = nxt; cA = nA; cB = nB; ++ui;
        if constexpr (ALIGN_EPI) { if (wr == 1) PG8_BAR; }
    }
    PG8_WAIT_V(0);
    if constexpr (!ALIGN_EPI) { if (wr == 0) PG8_BAR; }
    PG8_BAR;
    if constexpr (Epi::AFTER_DRAIN) { E.fused(acc, cur, wr, wc, fr, fq, lds, wid, lane); S.done(cur); }
#undef PG8_SA
#undef PG8_SB
#undef PG8_STAGE
#undef PG8_LDA
#undef PG8_LDB
#undef PG8_MMA
#undef PG8_WAIT_V
#undef PG8_WAIT_L
#undef PG8_BAR
#undef PG8_SCHED
}
}
#include <hip/hip_bf16.h>
#include <cmath>
namespace attn_body {
using bf16=__hip_bfloat16;
using bf16x8=__attribute__((ext_vector_type(8)))short;
using s16x4=__attribute__((ext_vector_type(4)))short;
using f32x16=__attribute__((ext_vector_type(16)))float;
using u32x4=__attribute__((ext_vector_type(4)))unsigned;
constexpr int BATCH=4,NHEAD=16,SEQ=4096,D=64,DMQ=512,DMO=1024;
constexpr int NW=8,QBLK=32,QB=QBLK*NW,KVBLK=64,NQB=SEQ/QB;
constexpr int ATTN_UNIT_ROWS=QB;
__device__ __forceinline__ int crow(int r,int hi){return (r&3)+8*(r>>2)+4*hi;}
#define SBAR() __builtin_amdgcn_sched_barrier(0)
__device__ __forceinline__ void cmask(f32x16&p0,f32x16&p1,int jb,int qrel,int hi){
  const float NEG=-INFINITY; int kb=64*jb+4*hi;
  #pragma unroll
  for(int r=0;r<16;++r){int kv=kb+(r&3)+8*(r>>2); if(kv>qrel)p0[r]=NEG; if(kv+32>qrel)p1[r]=NEG;}
}

constexpr int NSLOT=3, SLOTB=8192;
constexpr int LDS_K=0, LDS_V=NSLOT*SLOTB, LDS_WS=2*NSLOT*SLOTB, LDS_OST=LDS_WS+NW*64*4, LDS_BYTES=LDS_OST+NW*4096;
constexpr float C2=0.125f*1.4426950408889634f;
__device__ __forceinline__ void glds16(const void*gsrc,unsigned lds_dst){unsigned keep;
  asm volatile("s_mov_b32 %0, m0\n\ts_mov_b32 m0, %2\n\ts_nop 0\n\tglobal_load_lds_dwordx4 %1, off\n\ts_mov_b32 m0, %0":"=&s"(keep):"v"(gsrc),"s"(lds_dst):"memory");}
__device__ __forceinline__ float max3f(float a,float b,float c){float r;asm("v_max3_f32 %0, %1, %2, %3":"=v"(r):"v"(a),"v"(b),"v"(c));return r;}
__device__ __forceinline__ float max2f(float a,float b){float r;asm("v_max_f32_e32 %0, %1, %2":"=v"(r):"v"(a),"v"(b));return r;}
__device__ __forceinline__ float fadd_s(float a,float b){float r;asm("v_add_f32_e32 %0, %1, %2":"=v"(r):"v"(a),"v"(b));return r;}
__device__ __forceinline__ float fsub_s(float a,float b){float r;asm("v_sub_f32_e32 %0, %1, %2":"=v"(r):"v"(a),"v"(b));return r;}
typedef float f32x2_t __attribute__((ext_vector_type(2))); typedef __bf16 bf16x2_t __attribute__((ext_vector_type(2)));
__device__ __forceinline__ unsigned cvtpk_s(float lo,float hi){f32x2_t v={lo,hi};bf16x2_t b=__builtin_convertvector(v,bf16x2_t);return __builtin_bit_cast(unsigned,b);}
#define WAIT_BAR(N) asm volatile("s_waitcnt vmcnt(" #N ") lgkmcnt(0)\n\ts_barrier":::"memory")

__device__ __forceinline__ void qkt(f32x16&p0,f32x16&p1,const char*Kslot,const bf16x8*qr,const f32x16&negm,int r32,int hi){
  const char*kb=Kslot+hi*1024+r32*16;
  #pragma unroll
  for(int d0=0;d0<4;++d0){
    const bf16x8 b0=*reinterpret_cast<const bf16x8*>(kb+d0*2048);
    const bf16x8 b1=*reinterpret_cast<const bf16x8*>(kb+d0*2048+512);
    if(d0==0){p0=__builtin_amdgcn_mfma_f32_32x32x16_bf16(b0,qr[0],negm,0,0,0);p1=__builtin_amdgcn_mfma_f32_32x32x16_bf16(b1,qr[0],negm,0,0,0);}
    else{p0=__builtin_amdgcn_mfma_f32_32x32x16_bf16(b0,qr[d0],p0,0,0,0);p1=__builtin_amdgcn_mfma_f32_32x32x16_bf16(b1,qr[d0],p1,0,0,0);}}
}
typedef __attribute__((address_space(3))) const char* lds_cptr;
typedef short v4i16_t __attribute__((ext_vector_type(4)));
__device__ __forceinline__ void kload8(bf16x8*kf,lds_cptr kp){
  kf[0]=*(const __attribute__((address_space(3))) bf16x8*)(kp);      kf[1]=*(const __attribute__((address_space(3))) bf16x8*)(kp+512);
  kf[2]=*(const __attribute__((address_space(3))) bf16x8*)(kp+2048); kf[3]=*(const __attribute__((address_space(3))) bf16x8*)(kp+2560);
  kf[4]=*(const __attribute__((address_space(3))) bf16x8*)(kp+4096); kf[5]=*(const __attribute__((address_space(3))) bf16x8*)(kp+4608);
  kf[6]=*(const __attribute__((address_space(3))) bf16x8*)(kp+6144); kf[7]=*(const __attribute__((address_space(3))) bf16x8*)(kp+6656);
}
__device__ __forceinline__ void kload2(bf16x8*kf,lds_cptr kp,int j){ kf[2*j]=*(const __attribute__((address_space(3))) bf16x8*)(kp+j*2048); kf[2*j+1]=*(const __attribute__((address_space(3))) bf16x8*)(kp+j*2048+512); }
__device__ __forceinline__ s16x4 vtr(lds_cptr p){ return __builtin_bit_cast(s16x4,__builtin_amdgcn_ds_read_tr16_b64_v4i16((__attribute__((address_space(3))) v4i16_t*)p)); }
__device__ __forceinline__ float rowmax(const f32x16&p0,const f32x16&p1){
  float a=max3f(p0[0],p0[1],p1[0]),b=max3f(p0[2],p0[3],p1[1]);a=max3f(a,p1[2],p1[3]);
  #pragma unroll
  for(int r=4;r<16;r+=4){a=max3f(a,p0[r],p0[r+1]);b=max3f(b,p0[r+2],p0[r+3]);a=max3f(a,p1[r],p1[r+1]);b=max3f(b,p1[r+2],p1[r+3]);}
  const float m=max2f(a,b);
  auto rr=__builtin_amdgcn_permlane32_swap(__float_as_uint(m),__float_as_uint(m),false,false);
  return max2f(__uint_as_float(rr[0]),__uint_as_float(rr[1]));
}
__device__ __forceinline__ void pv(f32x16*o,int vb,bf16x8 pa0,bf16x8 pa1,bf16x8 pa2,bf16x8 pa3){
  #pragma unroll
  for(int d0=0;d0<2;++d0){s16x4 lo[4],hi[4];
    #pragma unroll
    for(int ks=0;ks<4;++ks){
      asm volatile("ds_read_b64_tr_b16 %0,%1 offset:%c2":"=&v"(lo[ks]):"v"(vb),"i"(d0*4096+ks*1024):"memory");
      asm volatile("ds_read_b64_tr_b16 %0,%1 offset:%c2":"=&v"(hi[ks]):"v"(vb),"i"(d0*4096+ks*1024+512):"memory");}
    asm volatile("s_waitcnt lgkmcnt(0)":::"memory");SBAR();
    #define PK(k) (bf16x8){lo[k][0],lo[k][1],lo[k][2],lo[k][3],hi[k][0],hi[k][1],hi[k][2],hi[k][3]}
    o[d0]=__builtin_amdgcn_mfma_f32_32x32x16_bf16(pa0,PK(0),o[d0],0,0,0);
    o[d0]=__builtin_amdgcn_mfma_f32_32x32x16_bf16(pa1,PK(1),o[d0],0,0,0);
    o[d0]=__builtin_amdgcn_mfma_f32_32x32x16_bf16(pa2,PK(2),o[d0],0,0,0);
    o[d0]=__builtin_amdgcn_mfma_f32_32x32x16_bf16(pa3,PK(3),o[d0],0,0,0);
    #undef PK
  }
}

#ifndef ATTN_STORE16
#define ATTN_STORE16(p,v) (*(u32x4*)(p)=(v))
#endif
template<int THRL> __device__ __forceinline__ void attn_unit(int b,int cq,int ck,int cv,int co,int qb,const bf16*Q,const bf16*__restrict__ K,const bf16*__restrict__ V,bf16*O,char*shm,int wave_hint){
  int tid_l=wave_hint*64+(int)__builtin_amdgcn_mbcnt_hi(~0u,__builtin_amdgcn_mbcnt_lo(~0u,0u)); asm volatile("":"+v"(tid_l)); const int tid=tid_l,lane=tid&63,r32=lane&31,hi=lane>>5; const int wid=__builtin_amdgcn_readfirstlane(tid>>6);
  const long rowbase=(long)b*SEQ; const int q0=qb*QB;
  const bf16*Qw=Q+(rowbase+q0+wid*QBLK)*DMQ+cq;
  const bf16*Kh=K+rowbase*DMQ+ck,*Vh=V+rowbase*DMQ+cv;
  const unsigned lds0=(unsigned)(uintptr_t)shm;
  float*wsf=(float*)(shm+LDS_WS)+wid*64;
  const bf16*ksrc=Kh+(long)lane*DMQ+wid*8;
  const bf16*vsrc=Vh+(long)(16*(wid&3)+(lane>>2))*DMQ+(wid>>2)*32+(lane&3)*8;
  const unsigned kdst=lds0+LDS_K+wid*1024, vdst=lds0+LDS_V+wid*1024;
  #define DMA_K(t,slot) glds16(ksrc+(long)(t)*KVBLK*DMQ,(unsigned)__builtin_amdgcn_readfirstlane(kdst+(slot)))
  #define DMA_V(t,slot) glds16(vsrc+(long)(t)*KVBLK*DMQ,(unsigned)__builtin_amdgcn_readfirstlane(vdst+(slot)))
  const int vb0=(int)(lds0+LDS_V)+((lane>>4)&1)*32+(lane&3)*8+(4*hi+((lane&15)>>2))*64;
  const char*Kbase=shm+LDS_K; bf16x8 kf[8];
  const lds_cptr shm3=(lds_cptr)shm; const lds_cptr kp0=shm3+LDS_K+hi*1024+r32*16; const lds_cptr vp0=shm3+LDS_V+((lane>>4)&1)*32+(lane&3)*8+(4*hi+((lane&15)>>2))*64;
  const int NT=(q0+QB)/KVBLK;
  DMA_K(0,0);DMA_V(0,0);DMA_K(1,SLOTB);
  bf16x8 qr[4];
  #pragma unroll
  for(int d0=0;d0<4;++d0)qr[d0]=*reinterpret_cast<const bf16x8*>(&Qw[(long)r32*DMQ+d0*16+hi*8]);
  float mhat=0.f,l_reg=0.f;f32x16 o[2];o[0]=f32x16{};o[1]=f32x16{};f32x16 negm=f32x16{};asm volatile("":"+v"(negm));
  const int qrel=wid*QBLK+r32;
  #define CMASK(P0,P1,t) do{int jb_=(t)-(NT-4); if(jb_>=0)cmask(P0,P1,jb_,qrel,hi);}while(0)
  bool resc=false;
  #define START(P0,P1) do{ const float rm=rowmax(P0,P1); resc=false; \
    { const float dl=rm; mhat=fadd_s(mhat,dl); \
      _Pragma("unroll") for(int r=0;r<16;++r){P0[r]=fsub_s(P0[r],dl);P1[r]=fsub_s(P1[r],dl);} \
      _Pragma("unroll") for(int r=0;r<16;++r)negm[r]=-mhat; asm volatile("":"+v"(negm)); } \
    _Pragma("unroll") for(int r=0;r<16;++r)P0[r]=__builtin_amdgcn_exp2f(P0[r]); }while(0)
  #define RESC() do{ if(resc){ asm volatile("s_waitcnt lgkmcnt(0)":::"memory"); \
      _Pragma("unroll") for(int d_=0;d_<2;++d_) _Pragma("unroll") for(int r=0;r<16;++r)o[d_][r]*=wsf[crow(r,hi)]; } }while(0)
  f32x16 pA0,pA1,pB0,pB1;
  int sl_prev=0,sl_cur=0,sl_next=SLOTB;
  #define ROT() do{sl_prev=sl_cur;sl_cur=sl_next;sl_next=(sl_next==(NSLOT-1)*SLOTB)?0:sl_next+SLOTB;}while(0)
  DMA_K(2,2*SLOTB);
  WAIT_BAR(3);
  qkt(pA0,pA1,Kbase,qr,negm,r32,hi);asm volatile("s_nop 15\n\ts_nop 7":"+v"(pA0),"+v"(pA1));CMASK(pA0,pA1,0);
  START(pA0,pA1);
  _Pragma("unroll") for(int r=0;r<16;++r)pA1[r]=__builtin_amdgcn_exp2f(pA1[r]);
  WAIT_BAR(0);
  DMA_K(3,0);DMA_V(1,SLOTB);
  ROT();
  kload8(kf,kp0+sl_cur);
  WAIT_BAR(2);
  s16x4 vlo[8],vhi[8]; u32x4 pw0,pw1,pw2,pw3;
  #define PKW(P,B) cvtpk_s(P[B],P[B+1])
  #define PAF(k) __builtin_bit_cast(bf16x8,pw##k)
  #define VFR(i) (bf16x8){vlo[i][0],vlo[i][1],vlo[i][2],vlo[i][3],vhi[i][0],vhi[i][1],vhi[i][2],vhi[i][3]}
  #define PIN(x) asm volatile("":"+v"(x))
  #define MX3(a,b,c) __builtin_fmaxf(__builtin_fmaxf((a),(b)),(c))
  #define GAPA(MF,A0,A1,A2,A3,W0,W1,PW) do{ MF; sacc+=A0; sacc+=A1; sacc+=A2; sacc+=A3; PIN(sacc); W0; W1; PIN(PW); SBAR(); }while(0)
  #define EX(v) __builtin_amdgcn_exp2f(v)
  #define GAPB(MF,X,B) do{ MF; X[B]=EX(X[B]); X[B+1]=EX(X[B+1]); X[B+2]=EX(X[B+2]); X[B+3]=EX(X[B+3]); PIN(X); SBAR(); }while(0)
  #define VRD(i) do{ vlo[i]=vtr(vp_+(((i)>>2)*4096+((i)&3)*1024)); vhi[i]=vtr(vp_+(((i)>>2)*4096+((i)&3)*1024+512)); }while(0)
  #define KRD(G,j) do{ if(G){ kload2(kf,kp0+sl_next,j); SBAR(); } }while(0)
  #define STEP(C0,C1,P0,P1,t,GK,GV,GL) do{ SBAR(); \
    const lds_cptr vp_=vp0+sl_prev; \
    VRD(0); SBAR(); float sacc=(P0[0]+P0[1]); \
    GAPA(C0=__builtin_amdgcn_mfma_f32_32x32x16_bf16(kf[0],qr[0],negm,0,0,0), P0[2],P0[3],P0[4],P0[5],     pw0[0]=PKW(P0,0), pw0[1]=PKW(P0,2), pw0); \
    VRD(4); SBAR(); GAPA(C1=__builtin_amdgcn_mfma_f32_32x32x16_bf16(kf[1],qr[0],negm,0,0,0), P0[6],P0[7],P0[8],P0[9],     pw0[2]=PKW(P0,4), pw0[3]=PKW(P0,6), pw0); \
    VRD(1); SBAR(); GAPA(C0=__builtin_amdgcn_mfma_f32_32x32x16_bf16(kf[2],qr[1],C0,0,0,0),   P0[10],P0[11],P0[12],P0[13], pw1[0]=PKW(P0,8), pw1[1]=PKW(P0,10), pw1); \
    VRD(5); SBAR(); GAPA(C1=__builtin_amdgcn_mfma_f32_32x32x16_bf16(kf[3],qr[1],C1,0,0,0),   P0[14],P0[15],P1[0],P1[1],   pw1[2]=PKW(P0,12),pw1[3]=PKW(P0,14), pw1); \
    VRD(2); SBAR(); GAPA(C0=__builtin_amdgcn_mfma_f32_32x32x16_bf16(kf[4],qr[2],C0,0,0,0),   P1[2],P1[3],P1[4],P1[5],     pw2[0]=PKW(P1,0), pw2[1]=PKW(P1,2), pw2); \
    VRD(6); SBAR(); GAPA(C1=__builtin_amdgcn_mfma_f32_32x32x16_bf16(kf[5],qr[2],C1,0,0,0),   P1[6],P1[7],P1[8],P1[9],     pw2[2]=PKW(P1,4), pw2[3]=PKW(P1,6), pw2); \
    VRD(3); SBAR(); GAPA(C0=__builtin_amdgcn_mfma_f32_32x32x16_bf16(kf[6],qr[3],C0,0,0,0),   P1[10],P1[11],P1[12],P1[13], pw3[0]=PKW(P1,8), pw3[1]=PKW(P1,10), pw3); \
    VRD(7); SBAR(); GAPA(C1=__builtin_amdgcn_mfma_f32_32x32x16_bf16(kf[7],qr[3],C1,0,0,0),   P1[14],P1[15],0.f,0.f,       pw3[2]=PKW(P1,12),pw3[3]=PKW(P1,14), pw3); \
    l_reg+=sacc; \
    if(GK){DMA_K((t)+3,sl_cur);} if(GV){DMA_V((t)+1,sl_next);} \
    CMASK(C0,C1,t); \
    { float a=MX3(C0[0],C0[1],C1[0]),b=MX3(C0[2],C0[3],C1[1]); a=MX3(a,C1[2],C1[3]); \
      _Pragma("unroll") for(int r=4;r<16;r+=4){a=MX3(a,C0[r],C0[r+1]);b=MX3(b,C0[r+2],C0[r+3]);a=MX3(a,C1[r],C1[r+1]);b=MX3(b,C1[r+2],C1[r+3]);} \
      float rm=__builtin_fmaxf(a,b); { auto rr=__builtin_amdgcn_permlane32_swap(__float_as_uint(rm),__float_as_uint(rm),false,false); rm=__builtin_fmaxf(__uint_as_float(rr[0]),__uint_as_float(rr[1])); } \
      resc=false; \
      if(__builtin_expect(__any(rm>(float)THRL),0)){ const float dl=__builtin_fmaxf(rm,0.f); mhat+=dl; \
        _Pragma("unroll") for(int r=0;r<16;++r){C0[r]-=dl;C1[r]-=dl;} \
        _Pragma("unroll") for(int r=0;r<16;++r)negm[r]=-mhat; asm volatile("":"+v"(negm)); \
        const float f=__builtin_amdgcn_exp2f(-dl); l_reg*=f; if(hi==0)wsf[r32]=f; resc=true; } } \
    SBAR(); \
    GAPB(o[0]=__builtin_amdgcn_mfma_f32_32x32x16_bf16(PAF(0),VFR(0),o[0],0,0,0), C0,0); \
    GAPB(o[1]=__builtin_amdgcn_mfma_f32_32x32x16_bf16(PAF(0),VFR(4),o[1],0,0,0), C0,4); \
    KRD(GL,0); GAPB(o[0]=__builtin_amdgcn_mfma_f32_32x32x16_bf16(PAF(1),VFR(1),o[0],0,0,0), C0,8); \
    KRD(GL,1); GAPB(o[1]=__builtin_amdgcn_mfma_f32_32x32x16_bf16(PAF(1),VFR(5),o[1],0,0,0), C0,12); \
    KRD(GL,2); GAPB(o[0]=__builtin_amdgcn_mfma_f32_32x32x16_bf16(PAF(2),VFR(2),o[0],0,0,0), C1,0); \
    KRD(GL,3); GAPB(o[1]=__builtin_amdgcn_mfma_f32_32x32x16_bf16(PAF(2),VFR(6),o[1],0,0,0), C1,4); \
    GAPB(o[0]=__builtin_amdgcn_mfma_f32_32x32x16_bf16(PAF(3),VFR(3),o[0],0,0,0), C1,8); \
    GAPB(o[1]=__builtin_amdgcn_mfma_f32_32x32x16_bf16(PAF(3),VFR(7),o[1],0,0,0), C1,12); \
    }while(0)
  int t=1;
  #undef CMASK
  #define CMASK(P0,P1,t) do{}while(0)
  for(;t+5<NT;t+=2){
    STEP(pB0,pB1,pA0,pA1,t,true,true,true);     WAIT_BAR(2); RESC(); ROT();
    STEP(pA0,pA1,pB0,pB1,t+1,true,true,true);   WAIT_BAR(2); RESC(); ROT();
  }
  #undef CMASK
  #define CMASK(P0,P1,t) do{int jb_=(t)-(NT-4); if(jb_>=0)cmask(P0,P1,jb_,qrel,hi);}while(0)
  #define ENDW(tt) do{ if((tt)+3<NT){WAIT_BAR(2);} else if((tt)+2<NT){WAIT_BAR(1);} else {WAIT_BAR(0);} }while(0)
  for(;t+1<NT;t+=2){
    STEP(pB0,pB1,pA0,pA1,t,(t+3<NT),(t+1<NT),(t+1<NT));       ENDW(t);   RESC(); ROT();
    STEP(pA0,pA1,pB0,pB1,t+1,(t+4<NT),(t+2<NT),(t+2<NT));     ENDW(t+1); RESC(); ROT();
  }
  STEP(pB0,pB1,pA0,pA1,NT-1,false,false,false); RESC();
  { float sacc=pB0[0]+pB0[1]; _Pragma("unroll") for(int r=2;r<16;++r)sacc+=pB0[r]; _Pragma("unroll") for(int r=0;r<16;++r)sacc+=pB1[r]; l_reg+=sacc;
    pw0=(u32x4){PKW(pB0,0),PKW(pB0,2),PKW(pB0,4),PKW(pB0,6)};pw1=(u32x4){PKW(pB0,8),PKW(pB0,10),PKW(pB0,12),PKW(pB0,14)};pw2=(u32x4){PKW(pB1,0),PKW(pB1,2),PKW(pB1,4),PKW(pB1,6)};pw3=(u32x4){PKW(pB1,8),PKW(pB1,10),PKW(pB1,12),PKW(pB1,14)};
    SBAR(); pv(o,vb0+sl_cur,PAF(0),PAF(1),PAF(2),PAF(3)); }
  #undef PKW
  #undef PAF
  #undef VFR
  #undef PIN
  #undef MX3
  #undef GAPA
  #undef GAPB
  #undef EX
  #undef VRD
  #undef KRD
  #undef STEP
  #undef ENDW
  {auto rr=__builtin_amdgcn_permlane32_swap(__float_as_uint(l_reg),__float_as_uint(l_reg),false,false);l_reg=__uint_as_float(rr[0])+__uint_as_float(rr[1]);}
  if(hi==0)wsf[32+r32]=l_reg;asm volatile("s_waitcnt lgkmcnt(0)":::"memory");
  float rli[16];
  #pragma unroll
  for(int r=0;r<16;++r)rli[r]=__builtin_amdgcn_rcpf(wsf[32+crow(r,hi)]);
  bf16*Ow=O+(rowbase+q0+wid*QBLK)*DMO+co;
  { bf16*stg=(bf16*)(shm+LDS_OST)+wid*2048;
    #pragma unroll
    for(int r=0;r<16;++r){const int orow=crow(r,hi);
      #pragma unroll
      for(int d0=0;d0<2;++d0)stg[orow*64+d0*32+r32]=__float2bfloat16(o[d0][r]*rli[r]);}
    asm volatile("s_waitcnt lgkmcnt(0)":::"memory");
    #pragma unroll
    for(int i=0;i<4;++i){const int row=i*8+(lane>>3),ch=lane&7; const u32x4 v=*(const u32x4*)(stg+row*64+ch*8); ATTN_STORE16(Ow+(long)row*DMO+ch*8,v);} }
  asm volatile("s_waitcnt lgkmcnt(0)\n\ts_barrier":::"memory");
  #undef DMA_K
  #undef DMA_V
  #undef CMASK
  #undef START
  #undef RESC
  #undef ROT
}
constexpr int ATTN_LDS_BYTES=LDS_BYTES;
#undef SBAR
#undef WAIT_BAR
}
namespace cg = cooperative_groups;
#define GAS __attribute__((address_space(1)))
#define LAS __attribute__((address_space(3)))
typedef unsigned short bf16;
typedef unsigned v4u __attribute__((ext_vector_type(4)));
typedef unsigned v2u __attribute__((ext_vector_type(2)));
typedef float f32x4 __attribute__((ext_vector_type(4)));
constexpr int NWAVES = 8, NTHR = 512;
constexpr int M = 16384, DMOD = 1024, SEQ = 4096, NIN = 6816, DFF = 2816, ZP = 1728;
constexpr size_t MiB = 1u << 20;
constexpr size_t WS_CTL = 0;
constexpr size_t WS_WGLU = 1 * MiB, WS_WB = WS_WGLU + MiB / 2, WS_WO = WS_WB + 3 * MiB, WS_WFI = WS_WO + 2 * MiB, WS_WFO = WS_WFI + 11 * MiB;
constexpr size_t WS_WX = 23 * MiB, WS_W1A = WS_WX, WS_W1B = WS_WX + 4 * MiB, WS_E = WS_WX, WS_WG = WS_WX;
constexpr size_t WS_VF = 40 * MiB, WS_US = 56 * MiB, WS_YA = 80 * MiB, WS_Z = 96 * MiB, WS_QB = 150 * MiB, WS_KB = 166 * MiB, WS_VB = 182 * MiB;
constexpr size_t WS_XNP = 198 * MiB, WS_O = 198 * MiB, WS_AB = 231 * MiB, WS_PT = 247 * MiB, WS_MT = 249 * MiB, WS_END = 256 * MiB;
constexpr size_t WS_XN = 150 * MiB, WS_YL = 182 * MiB, WS_P12 = 182 * MiB, WS_G0 = 214 * MiB, WS_H2N = 96 * MiB, WS_HID = 150 * MiB;
static_assert(WS_WFO + (size_t)1024 * 2816 * 2 <= WS_WX && WS_Z + (size_t)M * ZP * 2 <= WS_QB && WS_XNP + (size_t)4 * 4097 * 1024 * 2 <= WS_AB && WS_MT + (size_t)32 * 256 * 384 * 2 <= WS_END && WS_HID + (size_t)M * DFF * 2 <= WS_END, "ws map");
constexpr int LDS_BYTES = 148480; constexpr int LDS_XB = 147456; constexpr int CW_BAR = 4096;
constexpr float C2Q = 0.125f * 1.4426950408889634f;

__device__ __forceinline__ unsigned f2bf(float f) { unsigned u = __builtin_bit_cast(unsigned, f); return (u + 0x7fffu + ((u >> 16) & 1u)) >> 16; }
__device__ __forceinline__ float bf2f(unsigned b) { return __uint_as_float(b << 16); }
__device__ __forceinline__ void unpack8(const v4u w, float* f) {
    f[0] = __uint_as_float(w.x << 16); f[1] = __uint_as_float(w.x & 0xffff0000u); f[2] = __uint_as_float(w.y << 16); f[3] = __uint_as_float(w.y & 0xffff0000u);
    f[4] = __uint_as_float(w.z << 16); f[5] = __uint_as_float(w.z & 0xffff0000u); f[6] = __uint_as_float(w.w << 16); f[7] = __uint_as_float(w.w & 0xffff0000u); }
__device__ __forceinline__ v4u pack8(const float* f) { v4u w; w.x = pg8::cvt_pk_bf16(f[0], f[1]); w.y = pg8::cvt_pk_bf16(f[2], f[3]); w.z = pg8::cvt_pk_bf16(f[4], f[5]); w.w = pg8::cvt_pk_bf16(f[6], f[7]); return w; }
__device__ __forceinline__ float sigm(float x) { return __builtin_amdgcn_rcpf(1.f + __expf(-x)); }
__device__ __forceinline__ float tanh_f(float x) { return 1.f - 2.f * __builtin_amdgcn_rcpf(1.f + __expf(2.f * x)); }
__device__ __forceinline__ float wave_sum(float v) {
#pragma unroll
    for (int o = 1; o < 64; o <<= 1) v += __shfl_xor(v, o);
    return v; }
__device__ __forceinline__ float dppf(float x, const int ctrl) { return x; }
#define DPP_ADD(x, ctrl) ((x) + __builtin_bit_cast(float, __builtin_amdgcn_update_dpp(0, __builtin_bit_cast(int, (x)), (ctrl), 0xf, 0xf, true)))
__device__ __forceinline__ float row16_sum(float x) { x = DPP_ADD(x, 0xB1); x = DPP_ADD(x, 0x4E); x = DPP_ADD(x, 0x141); x = DPP_ADD(x, 0x140); return x; }

template <int MODE> struct Epi8 {
    static constexpr bool PERM = true, AFTER_DRAIN = false;
    bf16* O; int ldc; const bf16* X; const float* P;
    __device__ __forceinline__ void operator()(const pg8::f32x4 (&acc)[2][2][4][2], const pg8::Unit& u, int wr, int wc, int fr, int fq) const {
#pragma unroll
        for (int ai = 0; ai < 2; ++ai)
#pragma unroll
            for (int m = 0; m < 4; ++m) {
                const int row = u.pm * 256 + ai * 128 + wr * 64 + m * 16 + fr;
                if (MODE == 8) {
                    float o[8];
#pragma unroll
                    for (int i = 0; i < 8; ++i) { const float gte = acc[ai][0][m][i >> 2][i & 3], up = acc[ai][1][m][i >> 2][i & 3]; o[i] = gte * sigm(gte) * up; }
                    *(v4u*)(O + (size_t)row * DFF + u.pn * 128 + wc * 32 + 8 * fq) = pack8(o);
                } else {
#pragma unroll
                for (int bj = 0; bj < 2; ++bj) {
                    const int col = u.pn * 256 + bj * 128 + wc * 32 + 8 * fq;
                    float v[8];
#pragma unroll
                    for (int i = 0; i < 8; ++i) v[i] = acc[ai][bj][m][i >> 2][i & 3];
                    if (MODE == 0) { if (col < ldc) *(v4u*)(O + (size_t)row * ldc + col) = pack8(v); }
                    else if (MODE == 1) {
                        if (u.pn < 2) { const int g = col >> 4, cc = col & 15, b = row >> 12, t = row & 4095, ch = t >> 4, s = t & 15;
                            *(v4u*)((bf16*)X + ((size_t)(g * 1024 + b * 256 + ch) * 384 + s * 16 + cc)) = pack8(v); }
                        else { const int tsel = (col >> 9) - 1, cl = col & 511; *(v4u*)(O + (size_t)tsel * (8u * MiB) + (size_t)row * 512 + cl) = pack8(v); }
                    }
                    else if (MODE == 2) { if (bj == 0) *(v4u*)(O + (size_t)row * 384 + 256 + (col & 255)) = pack8(v); }
                    else if (MODE == 3) {
                        const int g = row >> 10, b = (row >> 8) & 3, ch = row & 255, cl = col & 255, t = cl >> 4, cc = cl & 15;
                        float uu[8]; unpack8(*(const v4u*)(X + (size_t)row * 384 + cl), uu);
#pragma unroll
                        for (int i = 0; i < 8; ++i) { const float y = v[i] + P[g * 16 + cc + i] * uu[i]; v[i] = y * sigm(1.5957691216f * (y + 0.044715f * y * y * y)); }
                        *(v4u*)(O + (size_t)(b * 4096 + ch * 16 + t) * 512 + g * 16 + cc) = pack8(v);
                    }
                    else if (MODE == 4) { float y[8]; unpack8(*(const v4u*)(X + (size_t)row * 512 + col), y);
#pragma unroll
                        for (int i = 0; i < 8; ++i) v[i] = y[i] * sigm(v[i]);
                        *(v4u*)(O + (size_t)row * 512 + col) = pack8(v); }
                    else if (MODE == 5) {
#pragma unroll
                        for (int i = 0; i < 8; ++i) v[i] = sigm(v[i]);
                        *(v4u*)(O + (size_t)row * 1024 + col) = pack8(v); }
                    else if (MODE == 10) {
#pragma unroll
                        for (int i = 0; i < 8; ++i) v[i] = sigm(v[i]);
                        *(v4u*)(O + (size_t)(col >> 10) * ((size_t)M * 1024) + (size_t)row * 1024 + (col & 1023)) = pack8(v); }
                    else if (MODE == 11) {
                        const int np = col >> 10, d = col & 1023; float gt[8], pp[8];
                        unpack8(*(const v4u*)(O + (size_t)np * ((size_t)M * 1024) + (size_t)row * 1024 + d), gt);
                        if (np) unpack8(*(const v4u*)(O + (size_t)row * 1024 + d), pp);
#pragma unroll
                        for (int i = 0; i < 8; ++i) v[i] = (np ? pp[i] : 0.f) + gt[i] * v[i];
                        *(v4u*)(O + (size_t)row * 1024 + d) = pack8(v); }
                    else if (MODE == 6 || MODE == 7) { float gt[8]; unpack8(*(const v4u*)(X + (size_t)row * 1024 + col), gt);
                        float pm_[8];
                        if (MODE == 7) unpack8(*(const v4u*)(O + (size_t)row * 1024 + col), pm_);
#pragma unroll
                        for (int i = 0; i < 8; ++i) v[i] = (MODE == 7 ? pm_[i] : 0.f) + gt[i] * v[i];
                        *(v4u*)(O + (size_t)row * 1024 + col) = pack8(v); }
                }
                }
            }
    }
};
struct EpiRes {
    static constexpr bool PERM = false, AFTER_DRAIN = false;
    const float* xin; float* xout;
    __device__ __forceinline__ void operator()(const pg8::f32x4 (&acc)[2][2][4][2], const pg8::Unit& u, int wr, int wc, int fr, int fq) const {
#pragma unroll
        for (int ai = 0; ai < 2; ++ai)
#pragma unroll
            for (int m = 0; m < 4; ++m) { const size_t off = (size_t)(u.pm * 256 + ai * 128 + wr * 64 + m * 16 + fr) * 1024 + u.pn * 256 + wc * 32 + 4 * fq;
#pragma unroll
                for (int bj = 0; bj < 2; ++bj)
#pragma unroll
                    for (int n = 0; n < 2; ++n) { const f32x4 b = *(const f32x4*)(xin + off + bj * 128 + n * 16); f32x4 o; o.x = b.x + acc[ai][bj][m][n][0]; o.y = b.y + acc[ai][bj][m][n][1]; o.z = b.z + acc[ai][bj][m][n][2]; o.w = b.w + acc[ai][bj][m][n][3];
                        *(f32x4*)(xout + off + bj * 128 + n * 16) = o; } }
    }
};
__device__ __forceinline__ pg8::Gemm mkgemm(const bf16* A, const bf16* Bt, int Mr, int N, int K, int lda, int ldb) {
    pg8::Gemm g; g.A = A; g.Bt = Bt; g.M = Mr; g.N = N; g.K = K; g.lda = lda; g.ldb = ldb; g.a_skip_shift = 30; g.a_skip_bytes = 0; g.kwrap = 1 << 20; g.wrap_bytes = 0; g.b_shift = 30; g.b_stride_bytes = 0; g.a_pn_shift = 30; g.a_pn_bytes = 0; return g; }
template <class Epi> __device__ __forceinline__ void run_gemm_w(int wave_hint, LAS unsigned char* lds, const pg8::Gemm& g, const Epi& E, int G, int c) {
    asm volatile("" : "+s"(G), "+s"(c));
    pg8::StaticOrder S; S.init(g.M, g.N, G, c);
    pg8::gemm_phase<Epi, pg8::StaticOrder, true, true>(lds, g, S, E, wave_hint);
}

struct PairOrder { pg8::StaticOrder S0;
    __device__ void init(int Mr, int G, int c) { S0.init(Mr, 1024, G, c); }
    __device__ bool next(int i, pg8::Unit& u) const { if (!S0.next(i >> 1, u)) return false; u.pn += 4 * (i & 1); return true; }
    __device__ __forceinline__ void a_ready(const pg8::Unit&) const {}
    __device__ __forceinline__ void done(const pg8::Unit&) const {} };
template <class Epi> __device__ __forceinline__ void run_gemm_pair_w(int wave_hint, LAS unsigned char* lds, const pg8::Gemm& g, const Epi& E, int G, int c) {
    asm volatile("" : "+s"(G), "+s"(c));
    PairOrder S; S.init(g.M, G, c);
    pg8::gemm_phase<Epi, PairOrder, true, true>(lds, g, S, E, wave_hint);
}

#define run_gemm(...) run_gemm_w(wave, __VA_ARGS__)
#define run_gemm_pair(...) run_gemm_pair_w(wave, __VA_ARGS__)
__device__ __forceinline__ void tr_item(const float* W, int ldw, int k0, int c0, bf16* WT, int ldt, int drow, int koff, const float* mu, int smode, LAS float* scr, int lane) {
    { const int kr = lane >> 3, nq = (lane & 7) * 4; f32x4 t[8];
#pragma unroll
      for (int i = 0; i < 8; ++i) t[i] = *(const f32x4*)(W + (size_t)(k0 + i * 8 + kr) * ldw + c0 + nq);
#pragma unroll
      for (int i = 0; i < 8; ++i) { LAS float* d = scr + (i * 8 + kr) * 33 + nq; d[0] = t[i].x; d[1] = t[i].y; d[2] = t[i].z; d[3] = t[i].w; } }
    asm volatile("s_waitcnt lgkmcnt(0)" ::: "memory");
    const int c = lane & 7;
#pragma unroll
    for (int j = 0; j < 4; ++j) { const int n = (lane >> 3) + 8 * j; const LAS float* s = scr + (8 * c) * 33 + n;
        float sc = 1.f; if (smode) { const float m_ = mu[n]; sc = (smode == 1) ? 1.f - m_ : m_; }
        v4u o; o.x = pg8::cvt_pk_bf16(s[0 * 33] * sc, s[1 * 33] * sc); o.y = pg8::cvt_pk_bf16(s[2 * 33] * sc, s[3 * 33] * sc); o.z = pg8::cvt_pk_bf16(s[4 * 33] * sc, s[5 * 33] * sc); o.w = pg8::cvt_pk_bf16(s[6 * 33] * sc, s[7 * 33] * sc);
        *(v4u*)(WT + (size_t)(drow + n) * ldt + koff + k0 + 8 * c) = o; }
    asm volatile("s_waitcnt lgkmcnt(0)" ::: "memory");
}
__device__ __forceinline__ void rms_row(const float* xrow, const float* gain, bf16* orow, int lane) {
    const f32x4* xr = (const f32x4*)xrow + lane; const f32x4* gr = (const f32x4*)gain + lane;
    f32x4 v[4]; float s = 0.f;
#pragma unroll
    for (int j = 0; j < 4; ++j) { v[j] = xr[64 * j]; s += (v[j].x * v[j].x + v[j].y * v[j].y) + (v[j].z * v[j].z + v[j].w * v[j].w); }
    const float rstd = 1.f / sqrtf(wave_sum(s) * (1.f / 1024.f) + 1e-6f);
    v2u* o8 = (v2u*)orow + lane;
#pragma unroll
    for (int j = 0; j < 4; ++j) { const f32x4 g = gr[64 * j]; v2u w; w.x = pg8::cvt_pk_bf16(v[j].x * rstd * g.x, v[j].y * rstd * g.y); w.y = pg8::cvt_pk_bf16(v[j].z * rstd * g.z, v[j].w * rstd * g.w); o8[64 * j] = w; }
}
__device__ __forceinline__ void rms_row2(const float* xa, const float* xb_, const float* gain, bf16* oa, bf16* ob, int lane) {
    const f32x4* ra = (const f32x4*)xa + lane; const f32x4* rb = (const f32x4*)xb_ + lane; const f32x4* gr = (const f32x4*)gain + lane;
    f32x4 va[4], vb[4]; float sa = 0.f, sb = 0.f;
#pragma unroll
    for (int j = 0; j < 4; ++j) { va[j] = ra[64 * j]; vb[j] = rb[64 * j]; }
#pragma unroll
    for (int j = 0; j < 4; ++j) { sa += (va[j].x * va[j].x + va[j].y * va[j].y) + (va[j].z * va[j].z + va[j].w * va[j].w); sb += (vb[j].x * vb[j].x + vb[j].y * vb[j].y) + (vb[j].z * vb[j].z + vb[j].w * vb[j].w); }
#pragma unroll
    for (int o = 1; o < 64; o <<= 1) { sa += __shfl_xor(sa, o); sb += __shfl_xor(sb, o); }
    const float rsa = 1.f / sqrtf(sa * (1.f / 1024.f) + 1e-6f), rsb = 1.f / sqrtf(sb * (1.f / 1024.f) + 1e-6f);
    v2u* pa = (v2u*)oa + lane; v2u* pb = (v2u*)ob + lane;
#pragma unroll
    for (int j = 0; j < 4; ++j) { const f32x4 g = gr[64 * j]; v2u w;
        w.x = pg8::cvt_pk_bf16(va[j].x * rsa * g.x, va[j].y * rsa * g.y); w.y = pg8::cvt_pk_bf16(va[j].z * rsa * g.z, va[j].w * rsa * g.w); pa[64 * j] = w;
        w.x = pg8::cvt_pk_bf16(vb[j].x * rsb * g.x, vb[j].y * rsb * g.y); w.y = pg8::cvt_pk_bf16(vb[j].z * rsb * g.z, vb[j].w * rsb * g.w); pb[64 * j] = w; }
}
struct Ptrs { const float* in[35]; float* out; unsigned char* ws; };

__device__ __forceinline__ void weight_items(const Ptrs& P, int L, int gw, int NGW, LAS float* scr, int lane, int it_lo, int it_hi) {
    unsigned char* ws = P.ws;
    const float* w_in = P.in[2] + (size_t)L * 1024 * NIN; const float* mu = P.in[16] + (size_t)L * 1696;
    constexpr int I1A = 16 * 64, I1B = 16 * 53, IGLU = 8 * 16, IWB = 8 * 32, IWO = 16 * 32, IFI = 16 * 176, IFO = 44 * 32;
    constexpr int NIT = I1A + 2 * I1B + IGLU + 3 * IWB + IWO + IFI + IFO;
    for (int it = it_lo + gw; it < it_hi; it += NGW) {
        int r = it;
        if (r < I1A) { const int kb = r / 64, nb = r % 64; tr_item(w_in, NIN, kb * 64, nb * 32, (bf16*)(ws + WS_W1A), 1024, nb * 32, 0, nullptr, 0, scr, lane); continue; } r -= I1A;
        if (r < I1B) { const int kb = r / 53, nb = r % 53; tr_item(w_in, NIN, kb * 64, 2048 + nb * 32, (bf16*)(ws + WS_W1B), 2048, nb * 32, 0, mu + nb * 32, 1, scr, lane); continue; } r -= I1B;
        if (r < I1B) { const int kb = r / 53, nb = r % 53; tr_item(w_in, NIN, kb * 64, 2048 + nb * 32, (bf16*)(ws + WS_W1B), 2048, nb * 32, 1024, mu + nb * 32, 2, scr, lane); continue; } r -= I1B;
        if (r < IGLU) { const int kb = r / 16, nb = r % 16; tr_item(P.in[11] + (size_t)L * 512 * 512, 512, kb * 64, nb * 32, (bf16*)(ws + WS_WGLU), 512, nb * 32, 0, nullptr, 0, scr, lane); continue; } r -= IGLU;
        if (r < 3 * IWB) { const int n = r / IWB, q = r % IWB, kb = q / 32, nb = q % 32; tr_item(P.in[30] + ((size_t)L * 3 + n) * 512 * 1024, 1024, kb * 64, nb * 32, (bf16*)(ws + WS_WB) + (size_t)n * 1024 * 512, 512, nb * 32, 0, nullptr, 0, scr, lane); continue; } r -= 3 * IWB;
        if (r < IWO) { const int kb = r / 32, nb = r % 32; tr_item(P.in[31] + (size_t)L * 1024 * 1024, 1024, kb * 64, nb * 32, (bf16*)(ws + WS_WO), 1024, nb * 32, 0, nullptr, 0, scr, lane); continue; } r -= IWO;
        if (r < IFI) { const int kb = r / 176, nb = r % 176; const int n0 = nb * 32; const int drow = (n0 < DFF) ? (n0 / 128) * 256 + (n0 % 128) : ((n0 - DFF) / 128) * 256 + 128 + ((n0 - DFF) % 128);
            tr_item(P.in[33] + (size_t)L * 1024 * 2 * DFF, 2 * DFF, kb * 64, n0, (bf16*)(ws + WS_WFI), 1024, drow, 0, nullptr, 0, scr, lane); continue; } r -= IFI;
        { const int kb = r / 32, nb = r % 32; tr_item(P.in[34] + (size_t)L * DFF * 1024, 1024, kb * 64, nb * 32, (bf16*)(ws + WS_WFO), DFF, nb * 32, 0, nullptr, 0, scr, lane); }
    }
}
__device__ __forceinline__ void s5_tables(const Ptrs& P, int L, int g, int part, LAS float* sm, int tid) {
    LAS float* apr = sm; LAS float* api = sm + 17 * 64; LAS float* bbr = sm + 2 * 17 * 64; LAS float* bbi = bbr + 1024; LAS float* Ks = bbi + 1024;
    const float* lre = P.in[3] + (size_t)L * 2048; const float* lim = P.in[4] + (size_t)L * 2048; const float* ldt = P.in[5] + L * 32;
    const float* bre = P.in[6] + (size_t)L * 32768; const float* bim = P.in[7] + (size_t)L * 32768; const float* cre = P.in[8] + (size_t)L * 32768; const float* cim = P.in[9] + (size_t)L * 32768;
    if (tid < 64) { const int p = tid; const float dt = __expf(ldt[g]); const float lr = lre[g * 64 + p], li = lim[g * 64 + p];
        for (int j = 0; j <= 16; ++j) { const double ang = (double)j * (double)li * (double)dt * 0.15915494309189535; const float rev = (float)(ang - __builtin_floor(ang));
            const float mg = __expf((float)j * lr * dt); apr[j * 64 + p] = mg * __builtin_amdgcn_cosf(rev); api[j * 64 + p] = mg * __builtin_amdgcn_sinf(rev); }
        const float ar = apr[64 + p], ai = api[64 + p], den = lr * lr + li * li, nr = ar - 1.f, kr = (nr * lr + ai * li) / den, ki = (ai * lr - nr * li) / den;
        for (int c = 0; c < 16; ++c) { const float br = bre[(g * 64 + p) * 16 + c], bi = bim[(g * 64 + p) * 16 + c]; bbr[p * 16 + c] = kr * br - ki * bi; bbi[p * 16 + c] = kr * bi + ki * br; } }
    __syncthreads();
    { const int j = tid >> 5, cl = tid & 31, cp = 2 * part + (cl >> 4), c = cl & 15; float s = 0.f;
        for (int p = 0; p < 64; ++p) { const float tr = apr[j * 64 + p] * bbr[p * 16 + c] - api[j * 64 + p] * bbi[p * 16 + c], ti = apr[j * 64 + p] * bbi[p * 16 + c] + api[j * 64 + p] * bbr[p * 16 + c];
            s += cre[(g * 16 + cp) * 64 + p] * tr - cim[(g * 16 + cp) * 64 + p] * ti; }
        Ks[j * 32 + cl] = s; }
    __syncthreads();
    bf16* Mt = (bf16*)(P.ws + WS_MT) + (size_t)g * 256 * 384; bf16* Pt = (bf16*)(P.ws + WS_PT) + (size_t)g * 128 * 256;
    for (int idx = tid; idx < 32 * 48; idx += NTHR) { const int rl = idx / 48, kg = idx % 48, t = rl >> 1, cpl = rl & 1, cp = 2 * part + cpl, n = t * 16 + cp; float v[8];
        if (kg < 32) { const int s = kg >> 1, c0 = (kg & 1) * 8;
#pragma unroll
            for (int i = 0; i < 8; ++i) v[i] = (s <= t) ? Ks[(t - s) * 32 + cpl * 16 + c0 + i] : 0.f; }
        else {
#pragma unroll
            for (int i = 0; i < 8; ++i) { const int jj = (kg - 32) * 8 + i, p = jj & 63; const float cr = cre[(g * 16 + cp) * 64 + p], ci = cim[(g * 16 + cp) * 64 + p], ar = apr[(t + 1) * 64 + p], ai = api[(t + 1) * 64 + p];
                v[i] = (jj < 64) ? (cr * ar - ci * ai) : -(cr * ai + ci * ar); } }
        *(v4u*)(Mt + (size_t)n * 384 + kg * 8) = pack8(v); }
    { const int jj = part * 16 + (tid >> 5), kg = tid & 31, p = jj & 63, s = kg >> 1, c0 = (kg & 1) * 8; float v[8];
        const float ar = apr[(15 - s) * 64 + p], ai = api[(15 - s) * 64 + p];
#pragma unroll
        for (int i = 0; i < 8; ++i) { const float br = bbr[p * 16 + c0 + i], bi = bbi[p * 16 + c0 + i]; v[i] = (jj < 64) ? (ar * br - ai * bi) : (ar * bi + ai * br); }
        *(v4u*)(Pt + (size_t)jj * 256 + kg * 8) = pack8(v); }
    __syncthreads();
}
__device__ __forceinline__ void s5_chunk_scan(const Ptrs& P, int L, int gidx) {
    const int p = gidx & 63, g = (gidx >> 6) & 31, b = gidx >> 11;
    const float dt = __expf(P.in[5][L * 32 + g]); const float lr = P.in[3][(size_t)L * 2048 + g * 64 + p], li = P.in[4][(size_t)L * 2048 + g * 64 + p];
    const double ang = 16.0 * (double)li * (double)dt * 0.15915494309189535; const float rev = (float)(ang - __builtin_floor(ang)); const float mg = __expf(16.f * lr * dt);
    const float ar = mg * __builtin_amdgcn_cosf(rev), ai = mg * __builtin_amdgcn_sinf(rev);
    bf16* base = (bf16*)(P.ws + WS_US) + (size_t)(g * 1024 + b * 256) * 384 + 256 + p;
    float xr = 0.f, xi = 0.f;
#pragma unroll 32
    for (int c = 0; c < 256; ++c) { bf16* q = base + (size_t)c * 384; const float sr = bf2f(q[0]), si = bf2f(q[64]); q[0] = (bf16)f2bf(xr); q[64] = (bf16)f2bf(xi);
        const float nr = ar * xr - ai * xi + sr, ni = ar * xi + ai * xr + si; xr = nr; xi = ni; }
}

typedef float f2p __attribute__((ext_vector_type(2)));
#define RDL(x, l) __builtin_bit_cast(float, __builtin_amdgcn_readlane(__builtin_bit_cast(int, (x)), (l)))
#define LORA2(acc, tA, tB, off, wptr) do { _Pragma("unroll") for (int j_ = 0; j_ < 32; ++j_) { const f2p s_ = {RDL(tA, j_ + (off)), RDL(tB, j_ + (off))}; \
        float w8_[8]; unpack8(*(const LAS v4u*)((wptr) + j_ * 512 + c0), w8_); \
        _Pragma("unroll") for (int i_ = 0; i_ < 8; ++i_) acc[i_] = __builtin_elementwise_fma((f2p){w8_[i_], w8_[i_]}, s_, acc[i_]); \
 } } while (0)
#define LORA2F(acc, tA, tB, off, wptr) do { _Pragma("unroll") for (int j_ = 0; j_ < 32; ++j_) { const f2p s_ = {RDL(tA, j_ + (off)), RDL(tB, j_ + (off))}; \
        float w8_[8]; unpack8(*(const LAS v4u*)((wptr) + j_ * 512 + c0), w8_); \
        _Pragma("unroll") for (int i_ = 0; i_ < 8; ++i_) acc[i_] = __builtin_elementwise_fma((f2p){w8_[i_], w8_[i_]}, s_, acc[i_]); \
        if ((j_ & 3) == 3) asm volatile("" ::: "memory"); } } while (0)
__device__ __forceinline__ void prep_phase(const Ptrs& P, int L, LAS unsigned char* lds, int gw, int NGW, int tid, int wave, int lane) {
    asm volatile("" : "+v"(tid), "+v"(lane)); asm volatile("" : "+s"(wave));
    unsigned char* ws = P.ws;
    LAS bf16* w2s = (LAS bf16*)lds; LAS bf16* a2s = w2s + 32 * 512; LAS bf16* v2s = a2s + 32 * 512; LAS unsigned* v1s = (LAS unsigned*)(v2s + 32 * 512);
    LAS unsigned* vrow = (LAS unsigned*)(lds + 131072) + wave * 512;
    const float* w2 = P.in[18] + (size_t)L * 32 * 512; const float* a2 = P.in[20] + (size_t)L * 32 * 512;
    for (int i = tid; i < 32 * 512; i += NTHR) { w2s[i] = (bf16)f2bf(w2[i]); a2s[i] = (bf16)f2bf(a2[i]); }
    if (L == 1) { const float* v2 = P.in[29]; const float* v1 = P.in[28];
        for (int i = tid; i < 32 * 512; i += NTHR) v2s[i] = (bf16)f2bf(v2[i]);
        for (int i = tid; i < 256 * 32; i += NTHR) { const int c2 = i >> 5, j = i & 31; v1s[i] = f2bf(v1[(2 * c2) * 32 + j]) | (f2bf(v1[(2 * c2 + 1) * 32 + j]) << 16); } }
    __syncthreads();
    const int c0 = lane * 8;
    float qg[8], kg[8], w0r[8], a0r[8], v0r[8];
#pragma unroll
    for (int i = 0; i < 8; ++i) { qg[i] = P.in[12][L * 128 + ((c0 + i) & 127)] * C2Q; kg[i] = P.in[13][L * 128 + ((c0 + i) & 127)]; w0r[i] = P.in[17][L * 512 + c0 + i]; a0r[i] = P.in[19][L * 512 + c0 + i]; v0r[i] = (L == 1) ? P.in[27][c0 + i] : 0.f; }
    for (int pr = gw; pr < M / 2; pr += NGW) {
        const size_t m0 = (size_t)pr * 2;
        float tz[2];
#pragma unroll
        for (int t = 0; t < 2; ++t) {
            const size_t m = m0 + t;
            bf16* qp = (bf16*)(ws + WS_QB) + m * 512 + c0; bf16* kp = (bf16*)(ws + WS_KB) + m * 512 + c0;
            float q[8], k[8]; unpack8(*(const v4u*)qp, q); unpack8(*(const v4u*)kp, k);
            float sq = 0.f, sk = 0.f;
#pragma unroll
            for (int i = 0; i < 8; ++i) { sq += q[i] * q[i]; sk += k[i] * k[i]; }
            sq += __shfl_xor(sq, 1); sq += __shfl_xor(sq, 2); sq += __shfl_xor(sq, 4); sk += __shfl_xor(sk, 1); sk += __shfl_xor(sk, 2); sk += __shfl_xor(sk, 4);
            const float rq = 1.f / sqrtf(sq * (1.f / 64.f) + 1e-6f), rk = 1.f / sqrtf(sk * (1.f / 64.f) + 1e-6f);
#pragma unroll
            for (int i = 0; i < 8; ++i) { q[i] *= rq * qg[i]; k[i] *= rk * kg[i]; }
            *(v4u*)qp = pack8(q); *(v4u*)kp = pack8(k);
            const float zz = bf2f(((const bf16*)(ws + WS_Z))[m * ZP + 1536 + lane]);
            tz[t] = (lane < 32) ? tanh_f(zz) : zz;
        }
        f2p aw[8], aa[8];
#pragma unroll
        for (int i = 0; i < 8; ++i) { aw[i] = (f2p){w0r[i], w0r[i]}; aa[i] = (f2p){a0r[i], a0r[i]}; }
        LORA2(aw, tz[0], tz[1], 0, w2s);
        LORA2(aa, tz[0], tz[1], 32, a2s);
#pragma unroll
        for (int t = 0; t < 2; ++t) { float e8[8], a8[8];
#pragma unroll
            for (int i = 0; i < 8; ++i) { e8[i] = 0.6065306597f * sigm(t ? aw[i].y : aw[i].x); a8[i] = sigm(t ? aa[i].y : aa[i].x); }
            *(v4u*)((bf16*)(ws + WS_E) + (m0 + t) * 512 + c0) = pack8(e8); *(v4u*)((bf16*)(ws + WS_AB) + (m0 + t) * 512 + c0) = pack8(a8); }
        bf16* zr0 = (bf16*)(ws + WS_Z) + m0 * ZP; bf16* zr1 = zr0 + ZP;
        const v4u vA = *(const v4u*)(zr0 + 1024 + c0), vB = *(const v4u*)(zr1 + 1024 + c0);
        if (L == 0) { *(v4u*)((bf16*)(ws + WS_VF) + m0 * 512 + c0) = vA; *(v4u*)((bf16*)(ws + WS_VF) + (m0 + 1) * 512 + c0) = vB; }
        else {
            *(LAS v4u*)(vrow + c0) = (v4u){(vA.x & 0xffffu) | (vB.x << 16), (vA.x >> 16) | (vB.x & 0xffff0000u), (vA.y & 0xffffu) | (vB.y << 16), (vA.y >> 16) | (vB.y & 0xffff0000u)};
            *(LAS v4u*)(vrow + c0 + 4) = (v4u){(vA.z & 0xffffu) | (vB.z << 16), (vA.z >> 16) | (vB.z & 0xffff0000u), (vA.w & 0xffffu) | (vB.w << 16), (vA.w >> 16) | (vB.w & 0xffff0000u)};
            asm volatile("s_waitcnt lgkmcnt(0)" ::: "memory");
            const int j = lane & 31, hf = lane >> 5; f2p s = {0.f, 0.f};
#pragma unroll 8
            for (int c2 = 0; c2 < 128; ++c2) { const unsigned pk = v1s[(hf * 128 + c2) * 32 + j]; const v2u d = *(const LAS v2u*)(vrow + hf * 256 + 2 * c2);
                const float wl = __uint_as_float(pk << 16), wh = __uint_as_float(pk & 0xffff0000u);
                s = __builtin_elementwise_fma((f2p){__uint_as_float(d.x << 16), __uint_as_float(d.x & 0xffff0000u)}, (f2p){wl, wl}, s);
                s = __builtin_elementwise_fma((f2p){__uint_as_float(d.y << 16), __uint_as_float(d.y & 0xffff0000u)}, (f2p){wh, wh}, s); }
            float sx = s.x + __shfl_xor(s.x, 32), sy = s.y + __shfl_xor(s.y, 32);
            f2p am[8];
#pragma unroll
            for (int i = 0; i < 8; ++i) am[i] = (f2p){v0r[i], v0r[i]};
            LORA2(am, sx, sy, 0, v2s);
            float va[8], vb[8], fa[8], fb[8]; unpack8(vA, va); unpack8(vB, vb);
            unpack8(*(const v4u*)((const bf16*)(ws + WS_VF) + m0 * 512 + c0), fa); unpack8(*(const v4u*)((const bf16*)(ws + WS_VF) + (m0 + 1) * 512 + c0), fb);
#pragma unroll
            for (int i = 0; i < 8; ++i) { va[i] = va[i] + (fa[i] - va[i]) * sigm(am[i].x); vb[i] = vb[i] + (fb[i] - vb[i]) * sigm(am[i].y); }
            *(v4u*)(zr0 + 1024 + c0) = pack8(va); *(v4u*)(zr1 + 1024 + c0) = pack8(vb);
            asm volatile("s_waitcnt lgkmcnt(0)" ::: "memory"); }
    }
    __syncthreads();
}

__device__ __forceinline__ void rwkv_unit(const Ptrs& P, int L, LAS unsigned char* lds, int b, int h, int qr, int tid, int wave, int lane) {
    constexpr int T = 32, TOKF = 336;
    asm volatile("" : "+v"(tid), "+v"(lane)); asm volatile("" : "+s"(wave));
    unsigned char* ws = P.ws;
    const bf16* Z = (const bf16*)(ws + WS_Z); const bf16* AB = (const bf16*)(ws + WS_AB); const bf16* EB = (const bf16*)(ws + WS_E); bf16* YC = (bf16*)(ws + WS_YA);
    LAS float* buf0 = (LAS float*)lds; LAS float* buf1 = buf0 + T * TOKF;
    const bool producer = wave >= 4;
    const int pt = tid - 256, tok = pt >> 3, ks = (pt & 7) * 8;
    float kkk[8], kka[8];
    if (producer) {
#pragma unroll
        for (int i = 0; i < 8; ++i) { kkk[i] = P.in[22][L * 512 + h * 64 + ks + i]; kka[i] = P.in[23][L * 512 + h * 64 + ks + i]; } }
    const int row = wave * 4 + (lane >> 4), kq = lane & 15;
    typedef float f2s __attribute__((ext_vector_type(2)));
    f2s Slo = {0.f, 0.f}, Shi = {0.f, 0.f};
    const size_t m00 = (size_t)b * SEQ;
#define RW_PRODUCE(c, buf) do { const size_t m_ = m00 + (size_t)(c) * T + tok; const bf16* zr_ = Z + m_ * ZP; \
        float r_[8], k_[8], a_[8], e_[8]; unpack8(*(const v4u*)(zr_ + h * 64 + ks), r_); unpack8(*(const v4u*)(zr_ + 512 + h * 64 + ks), k_); \
        unpack8(*(const v4u*)(AB + m_ * 512 + h * 64 + ks), a_); unpack8(*(const v4u*)(EB + m_ * 512 + h * 64 + ks), e_); \
        float kk_[8], ss_ = 0.f; _Pragma("unroll") for (int i = 0; i < 8; ++i) { kk_[i] = k_[i] * kkk[i]; ss_ += kk_[i] * kk_[i]; } \
        ss_ += __shfl_xor(ss_, 1); ss_ += __shfl_xor(ss_, 2); ss_ += __shfl_xor(ss_, 4); const float inv_ = 1.f / fmaxf(sqrtf(ss_), 1e-12f); \
        LAS float* d_ = (buf) + tok * TOKF + ks; f32x4 o0, o1; \
        o0 = (f32x4){-kk_[0] * inv_, -kk_[1] * inv_, -kk_[2] * inv_, -kk_[3] * inv_}; o1 = (f32x4){-kk_[4] * inv_, -kk_[5] * inv_, -kk_[6] * inv_, -kk_[7] * inv_}; *(LAS f32x4*)(d_) = o0; *(LAS f32x4*)(d_ + 4) = o1; \
        o0 = (f32x4){kk_[0] * inv_ * a_[0], kk_[1] * inv_ * a_[1], kk_[2] * inv_ * a_[2], kk_[3] * inv_ * a_[3]}; o1 = (f32x4){kk_[4] * inv_ * a_[4], kk_[5] * inv_ * a_[5], kk_[6] * inv_ * a_[6], kk_[7] * inv_ * a_[7]}; *(LAS f32x4*)(d_ + 64) = o0; *(LAS f32x4*)(d_ + 68) = o1; \
        o0 = (f32x4){__expf(-e_[0]), __expf(-e_[1]), __expf(-e_[2]), __expf(-e_[3])}; o1 = (f32x4){__expf(-e_[4]), __expf(-e_[5]), __expf(-e_[6]), __expf(-e_[7])}; *(LAS f32x4*)(d_ + 128) = o0; *(LAS f32x4*)(d_ + 132) = o1; \
        o0 = (f32x4){k_[0] * (1.f + (a_[0] - 1.f) * kka[0]), k_[1] * (1.f + (a_[1] - 1.f) * kka[1]), k_[2] * (1.f + (a_[2] - 1.f) * kka[2]), k_[3] * (1.f + (a_[3] - 1.f) * kka[3])}; \
        o1 = (f32x4){k_[4] * (1.f + (a_[4] - 1.f) * kka[4]), k_[5] * (1.f + (a_[5] - 1.f) * kka[5]), k_[6] * (1.f + (a_[6] - 1.f) * kka[6]), k_[7] * (1.f + (a_[7] - 1.f) * kka[7])}; *(LAS f32x4*)(d_ + 192) = o0; *(LAS f32x4*)(d_ + 196) = o1; \
        o0 = (f32x4){r_[0], r_[1], r_[2], r_[3]}; o1 = (f32x4){r_[4], r_[5], r_[6], r_[7]}; *(LAS f32x4*)(d_ + 256) = o0; *(LAS f32x4*)(d_ + 260) = o1; \
        if ((pt & 7) < 2) { float v_[8]; unpack8(*(const v4u*)(zr_ + 1024 + h * 64 + qr * 16 + ks), v_); LAS float* dv_ = (buf) + tok * TOKF + 320 + ks; \
            *(LAS f32x4*)(dv_) = (f32x4){v_[0], v_[1], v_[2], v_[3]}; *(LAS f32x4*)(dv_ + 4) = (f32x4){v_[4], v_[5], v_[6], v_[7]}; } } while (0)
    if (producer) RW_PRODUCE(0, buf0);
    __syncthreads();
    if (!producer) __builtin_amdgcn_s_setprio(3);
    for (int c = 0; c < SEQ / T; ++c) {
        LAS float* cur = (c & 1) ? buf1 : buf0; LAS float* nxt = (c & 1) ? buf0 : buf1;
        if (producer) { if (c + 1 < SEQ / T) RW_PRODUCE(c + 1, nxt); }
        else {
            typedef float f2 __attribute__((ext_vector_type(2)));
            bf16* yo = YC + (m00 + (size_t)c * T) * 512 + h * 64 + qr * 16 + row;
            const LAS float* bs = cur + kq * 4; const LAS float* vs = cur + 320 + row;
            f32x4 a4 = *(const LAS f32x4*)(bs), b4 = *(const LAS f32x4*)(bs + 64), w4 = *(const LAS f32x4*)(bs + 128), k4 = *(const LAS f32x4*)(bs + 192), r4 = *(const LAS f32x4*)(bs + 256);
            float vv = vs[0]; float yp = 0.f, ykeep = 0.f;
#pragma unroll
            for (int t = 0; t < T; ++t) {
                const LAS float* nb = bs + (t + 1) * TOKF;
                const f32x4 na4 = *(const LAS f32x4*)(nb), nb4 = *(const LAS f32x4*)(nb + 64), nw4 = *(const LAS f32x4*)(nb + 128), nk4 = *(const LAS f32x4*)(nb + 192), nr4 = *(const LAS f32x4*)(nb + 256);
                const float nvv = vs[(t + 1) * TOKF];
                f2 p = Slo * (f2){a4.x, a4.y}; p = __builtin_elementwise_fma(Shi, (f2){a4.z, a4.w}, p);
                float sa = p.x + p.y;
                sa = DPP_ADD(sa, 0xB1); yp = DPP_ADD(yp, 0xB1); sa = DPP_ADD(sa, 0x4E); yp = DPP_ADD(yp, 0x4E); sa = DPP_ADD(sa, 0x141); yp = DPP_ADD(yp, 0x141); sa = DPP_ADD(sa, 0x140); yp = DPP_ADD(yp, 0x140);
                if (t > 0) ykeep = __builtin_bit_cast(float, __builtin_amdgcn_update_dpp(__builtin_bit_cast(int, yp), __builtin_bit_cast(int, ykeep), 0x111, 0xf, 0xf, false));
                if (t == 16) yo[(size_t)(15 - kq) * 512] = (bf16)f2bf(ykeep);
                const f2 sa2 = {sa, sa}, vv2 = {vv, vv};
                f2 tl = (f2){k4.x, k4.y} * vv2, th = (f2){k4.z, k4.w} * vv2;
                tl = __builtin_elementwise_fma((f2){b4.x, b4.y}, sa2, tl); th = __builtin_elementwise_fma((f2){b4.z, b4.w}, sa2, th);
                Slo = __builtin_elementwise_fma(Slo, (f2){w4.x, w4.y}, tl); Shi = __builtin_elementwise_fma(Shi, (f2){w4.z, w4.w}, th);
                f2 q = Slo * (f2){r4.x, r4.y}; q = __builtin_elementwise_fma(Shi, (f2){r4.z, r4.w}, q);
                yp = q.x + q.y;
                a4 = na4; b4 = nb4; w4 = nw4; k4 = nk4; r4 = nr4; vv = nvv; }
            yp = row16_sum(yp);
            ykeep = __builtin_bit_cast(float, __builtin_amdgcn_update_dpp(__builtin_bit_cast(int, yp), __builtin_bit_cast(int, ykeep), 0x111, 0xf, 0xf, false));
            yo[(size_t)(31 - kq) * 512] = (bf16)f2bf(ykeep);
        }
        __syncthreads();
    }
    __builtin_amdgcn_s_setprio(0);
#undef RW_PRODUCE
}

__device__ __forceinline__ void post_phase(const Ptrs& P, int L, LAS unsigned char* lds, int gw, int NGW, int tid, int wave, int lane) {
    asm volatile("" : "+v"(tid), "+v"(lane)); asm volatile("" : "+s"(wave));
    unsigned char* ws = P.ws;
    LAS bf16* g2s = (LAS bf16*)lds;
    const float* g2 = P.in[21] + (size_t)L * 96 * 512;
    for (int i = tid; i < 96 * 512; i += NTHR) g2s[i] = (bf16)f2bf(g2[i]);
    __syncthreads();
    const float lam_init = (L == 0) ? 0.2f : 0.35550906f;
    const float* lv = P.in[14] + L * 256;
    const float lam = __expf(wave_sum(lv[lane] * lv[64 + lane])) - __expf(wave_sum(lv[128 + lane] * lv[192 + lane])) + lam_init;
    const int c0 = lane * 8;
    float sg[8], lng[8], lnb[8], rk[8], ka[8];
#pragma unroll
    for (int i = 0; i < 8; ++i) { sg[i] = P.in[15][L * 128 + ((c0 + i) & 127)] * (1.f - lam_init); lng[i] = P.in[25][L * 512 + c0 + i]; lnb[i] = P.in[26][L * 512 + c0 + i]; rk[i] = P.in[24][L * 512 + c0 + i]; ka[i] = P.in[23][L * 512 + c0 + i]; }
    const float* xsrc = (L == 0) ? P.in[0] : P.out;
    for (int pr = gw; pr < M / 2; pr += NGW) {
        const size_t m0 = (size_t)pr * 2;
        float z0[2], z1[2], z2[2];
#pragma unroll
        for (int t = 0; t < 2; ++t) { const bf16* zr = (const bf16*)(ws + WS_Z) + (m0 + t) * ZP;
            z0[t] = sigm(bf2f(zr[1600 + (lane & 31)])); z1[t] = sigm(bf2f(zr[1632 + (lane & 31)])); z2[t] = sigm(bf2f(zr[1664 + (lane & 31)])); }
        f2p gacc[8];
#pragma unroll
        for (int i = 0; i < 8; ++i) gacc[i] = (f2p){0.f, 0.f};
        LORA2F(gacc, z0[0], z0[1], 0, g2s);
        LORA2F(gacc, z1[0], z1[1], 0, g2s + 32 * 512);
        LORA2F(gacc, z2[0], z2[1], 0, g2s + 64 * 512);
#pragma unroll
        for (int t = 0; t < 2; ++t) {
        const size_t m = m0 + t;
        bf16* zr = (bf16*)(ws + WS_Z) + m * ZP;
        float r[8], k[8], v[8], a[8], yr[8];
        unpack8(*(const v4u*)(zr + c0), r); unpack8(*(const v4u*)(zr + 512 + c0), k); unpack8(*(const v4u*)(zr + 1024 + c0), v);
        unpack8(*(const v4u*)((const bf16*)(ws + WS_AB) + m * 512 + c0), a); unpack8(*(const v4u*)((const bf16*)(ws + WS_YA) + m * 512 + c0), yr);
        float s1 = 0.f;
#pragma unroll
        for (int i = 0; i < 8; ++i) s1 += yr[i];
        s1 += __shfl_xor(s1, 1); s1 += __shfl_xor(s1, 2); s1 += __shfl_xor(s1, 4); const float mean = s1 * (1.f / 64.f);
        float s2 = 0.f, bd = 0.f;
#pragma unroll
        for (int i = 0; i < 8; ++i) { const float d = yr[i] - mean; s2 += d * d; bd += r[i] * (k[i] * (1.f + (a[i] - 1.f) * ka[i])) * rk[i]; }
        s2 += __shfl_xor(s2, 1); s2 += __shfl_xor(s2, 2); s2 += __shfl_xor(s2, 4); bd += __shfl_xor(bd, 1); bd += __shfl_xor(bd, 2); bd += __shfl_xor(bd, 4);
        const float rstd = 1.f / sqrtf(s2 * (1.f / 64.f) + 64e-5f);
        float yc[8];
#pragma unroll
        for (int i = 0; i < 8; ++i) yc[i] = ((yr[i] - mean) * rstd * lng[i] + lnb[i] + bd * v[i]) * (t ? gacc[i].y : gacc[i].x);
        const int hd = lane >> 4, j0 = (lane & 15) * 8; const bf16* orow = (const bf16*)(ws + WS_O) + m * 1024 + hd * 256 + j0;
        float o0[8], o1[8]; unpack8(*(const v4u*)orow, o0); unpack8(*(const v4u*)(orow + 128), o1);
        float so = 0.f;
#pragma unroll
        for (int i = 0; i < 8; ++i) { o0[i] = o0[i] - lam * o1[i]; so += o0[i] * o0[i]; }
        so += __shfl_xor(so, 1); so += __shfl_xor(so, 2); so += __shfl_xor(so, 4); so += __shfl_xor(so, 8);
        const float ro = 1.f / sqrtf(so * (1.f / 128.f) + 1e-5f);
#pragma unroll
        for (int i = 0; i < 8; ++i) o0[i] *= ro * sg[i];
        *(v4u*)(zr + c0) = pack8(yc); *(v4u*)(zr + 512 + c0) = pack8(o0);
        }
    }
    __syncthreads();
}


__device__ __forceinline__ void dump_stage(const Ptrs& P, int k, int blk, int G, int tid) {
    unsigned char* ws = P.ws; float* out = P.out;
    for (size_t i = (size_t)blk * NTHR + tid; i < (size_t)M * 1024; i += (size_t)G * NTHR) {
        const size_t m = i >> 10; const int c = (int)(i & 1023); float v = 0.f;
        const bf16* Z = (const bf16*)(ws + WS_Z); const bf16* US = (const bf16*)(ws + WS_US);
        if (k == 1) v = bf2f(Z[m * ZP + c]) + bf2f(Z[m * ZP + 704 + c]) + bf2f(((const bf16*)(ws + WS_QB))[m * 512 + (c & 511)]) + bf2f(((const bf16*)(ws + WS_KB))[m * 512 + (c & 511)]) + bf2f(((const bf16*)(ws + WS_VB))[m * 512 + (c & 511)]) + bf2f(US[m * 768 + (c % 768)]);
        else if (k == 2) {
#if !defined(DSEL) || DSEL==1
            v += bf2f(US[m * 768 + (c % 768)]);
#endif
#if !defined(DSEL) || DSEL==2
            v += bf2f(((const bf16*)(ws + WS_E))[m * 512 + (c & 511)]) + bf2f(((const bf16*)(ws + WS_AB))[m * 512 + (c & 511)]);
#endif
#if !defined(DSEL) || DSEL==3
            v += bf2f(((const bf16*)(ws + WS_QB))[m * 512 + (c & 511)]) + bf2f(((const bf16*)(ws + WS_KB))[m * 512 + (c & 511)]);
#endif
#if !defined(DSEL) || DSEL==4
            v += bf2f(Z[m * ZP + 1024 + (c & 511)]) + bf2f(((const bf16*)(ws + WS_VF))[m * 512 + (c & 511)]);
#endif
        }
        else if (k == 3) v = bf2f(((const bf16*)(ws + WS_O))[m * 1024 + c]) + bf2f(((const bf16*)(ws + WS_YA))[m * 512 + (c & 511)]) + bf2f(US[m * 768 + (c % 768)]);
        else if (k == 4) v = bf2f(Z[m * ZP + c]) + bf2f(((const bf16*)(ws + WS_XN))[m * 1024 + c]) + bf2f(((const bf16*)(ws + WS_YL))[m * 512 + (c & 511)]);
        else if (k == 5) v = bf2f(((const bf16*)(ws + WS_YA))[m * 512 + (c & 511)]);
        else if (k == 6) v = bf2f(((const bf16*)(ws + WS_P12))[m * 1024 + c]);
        else if (k == 9) v = bf2f(((const bf16*)(ws + WS_HID))[m * DFF + c]) + bf2f(((const bf16*)(ws + WS_HID))[m * DFF + 1024 + c]) + bf2f(((const bf16*)(ws + WS_H2N))[m * 1024 + c]);
        out[i] = v;
    }
}
#define XB_TMO      128
#define XB_XCNT(j)  (256  + 64 * (j))
#define XB_XSUB(j)  (1280 + 64 * (j))
#define XB_XGEN(j)  (2304 + 64 * (j))
#define XB_TOP      3328
#define XB_TOPGEN   3392
#define XCD_BAR_WORDS 3456
#define XB_SPIN_CAP (1u << 18)

__device__ __forceinline__ unsigned xb_ld(unsigned* p)              { return __hip_atomic_load(p, __ATOMIC_RELAXED, __HIP_MEMORY_SCOPE_AGENT); }
__device__ __forceinline__ unsigned xb_add(unsigned* p, unsigned v) { return __hip_atomic_fetch_add(p, v, __ATOMIC_RELAXED, __HIP_MEMORY_SCOPE_AGENT); }
__device__ __forceinline__ unsigned xb_xcc_id() { return (unsigned)__builtin_amdgcn_s_getreg((3 << 11) | 20) & 0xFu; }
#define XB_SPIN(cond, bar) do { unsigned _sp = 0; while (cond) { __builtin_amdgcn_s_sleep(1); \
    if ((++_sp & 255u) == 0u) { if (xb_ld(&(bar)[XB_TMO])) break; if (_sp > XB_SPIN_CAP) { atomicAdd(&(bar)[XB_TMO], 1u); break; } } } } while (0)

struct XcdBarrier {
    unsigned* bar; unsigned x;
    volatile LAS unsigned* st;
};

__device__ __forceinline__ XcdBarrier xcd_barrier_post(unsigned* bar, volatile LAS unsigned* st) {
    XcdBarrier b; b.bar = bar; b.x = xb_xcc_id(); b.st = st;
    if (threadIdx.x == 0) (void)xb_add(&bar[XB_XCNT(b.x)], 1u);
    return b;
}
__device__ __forceinline__ void xcd_barrier_complete(unsigned* bar, unsigned x, unsigned& nloc, unsigned& nx) {
    const unsigned G = gridDim.x * gridDim.y * gridDim.z;
    unsigned sum, cnt, mine, sp = 0u;
    for (;;) {
        sum = 0u; cnt = 0u; mine = 0u;
#pragma unroll
        for (unsigned j = 0; j < 16; ++j) { const unsigned c = xb_ld(&bar[XB_XCNT(j)]); sum += c; cnt += (c > 0u) ? 1u : 0u; mine = (j == x) ? c : mine; }
        if (sum == G) break;
        __builtin_amdgcn_s_sleep(1);
        if ((++sp & 255u) == 0u) { if (xb_ld(&bar[XB_TMO])) break; if (sp > XB_SPIN_CAP) { atomicAdd(&bar[XB_TMO], 1u); break; } }
    }
    nloc = mine > 0u ? mine : 1u; nx = cnt > 0u ? cnt : 1u;
}

__device__ __forceinline__ void xcd_barrier(const XcdBarrier& b, const int tid_hint) {
    asm volatile("s_waitcnt vmcnt(0)" ::: "memory");
    __syncthreads();
    if (tid_hint == 0) {
        unsigned* bar = b.bar;
        __builtin_amdgcn_s_waitcnt(0);
        unsigned nloc = b.st[0], nx = b.st[1];
        if (nloc == 0u) { xcd_barrier_complete(bar, b.x, nloc, nx); b.st[0] = nloc; b.st[1] = nx; }
        const unsigned old = xb_add(&bar[XB_XSUB(b.x)], 1u);
        const unsigned gen = old / nloc;
        if (old + 1u == (gen + 1u) * nloc) {
            __builtin_amdgcn_fence(__ATOMIC_RELEASE, "agent");
            asm volatile("s_waitcnt vmcnt(0)" ::: "memory");
            const unsigned og = xb_add(&bar[XB_TOP], 1u);
            const unsigned tg = og / nx;
            if (og + 1u == (tg + 1u) * nx) xb_add(&bar[XB_TOPGEN], 1u);
            else XB_SPIN(xb_ld(&bar[XB_TOPGEN]) == tg, bar);
            __builtin_amdgcn_fence(__ATOMIC_ACQUIRE, "agent");
            xb_add(&bar[XB_XGEN(b.x)], 1u);
            asm volatile("s_waitcnt vmcnt(0)" ::: "memory");
        } else {
            XB_SPIN(xb_ld(&bar[XB_XGEN(b.x)]) == gen, bar);
            __builtin_amdgcn_fence(__ATOMIC_ACQUIRE, "agent");
            asm volatile("s_waitcnt vmcnt(0)" ::: "memory");
        }
    }
    __syncthreads();
}


#define GSYNC() do { xcd_barrier(xbar, tid); } while (0)
#if defined(PROBE_A)
#define STAMP(k) do { if (blk0 == 0 && tid0 == 0) ((LAS unsigned long long*)(lds + LDS_XB + 256))[(k)] = __builtin_amdgcn_s_memrealtime(); } while (0)
#else
#define STAMP(k) do { } while (0)
#endif
struct Args { Ptrs p; int pad0, pad1; };
__global__ void __launch_bounds__(NTHR, 2) mega_fwd(Args args) {
    extern __shared__ __attribute__((aligned(16))) unsigned char lds_raw[];
    LAS unsigned char* lds = (LAS unsigned char*)lds_raw;
    cg::grid_group grid = cg::this_grid();
    const Ptrs& P = args.p;
    unsigned char* ws = P.ws;
    const int tid0 = threadIdx.x, wave0 = __builtin_amdgcn_readfirstlane(tid0 >> 6);
    const int wave = wave0;
    const int G0 = gridDim.x, blk0 = blockIdx.x;
    const int gw0 = blk0 * NWAVES + wave, NGW0 = G0 * NWAVES;
    unsigned* ctl = (unsigned*)(ws + WS_CTL);
    if (tid0 < 64) ((LAS unsigned*)(lds + LDS_XB))[tid0] = 0u;
    __syncthreads();
    XcdBarrier xbar = xcd_barrier_post(ctl + CW_BAR, (volatile LAS unsigned*)(lds + LDS_XB));
    grid.sync();
    for (int L = 0; L < 2; ++L) {
        int gw = gw0, NGW = NGW0, blk = blk0, G = G0; asm volatile("" : "+s"(gw), "+s"(NGW), "+s"(blk), "+s"(G));
        int tid = wave * 64 + (int)__builtin_amdgcn_mbcnt_hi(~0u, __builtin_amdgcn_mbcnt_lo(~0u, 0u)); asm volatile("" : "+v"(tid)); int lane = tid & 63;
#define RELAUNDER() do { tid = wave * 64 + (int)__builtin_amdgcn_mbcnt_hi(~0u, __builtin_amdgcn_mbcnt_lo(~0u, 0u)); asm volatile("" : "+v"(tid)); lane = tid & 63; asm volatile("" : "+s"(gw), "+s"(NGW), "+s"(blk), "+s"(G)); } while (0)
        STAMP(13 * L);
        const float* xsrc = (L == 0) ? P.in[0] : P.out;
#if !defined(ONLY) || ONLY==0
#if defined(DUP_PH0)
        for (int rep = 0; rep < 2; ++rep)
#endif
        {
        s5_tables(P, L, blk >> 3, blk & 7, (LAS float*)lds, tid);
        if (L == 0) weight_items(P, L, gw, NGW, (LAS float*)(lds + wave * 16384), lane, 0, 4128);
        weight_items(P, L, gw, NGW, (LAS float*)(lds + wave * 16384), lane, 6944, 8352);
        for (int i = blk * NTHR + tid; i < 96 * 2048 / 8; i += G * NTHR) ((v4u*)((bf16*)(ws + WS_W1B) + (size_t)1696 * 2048))[i] = (v4u){0u, 0u, 0u, 0u};
        if (blk < 4) { for (int i = tid; i < 128; i += NTHR) ((v4u*)((bf16*)(ws + WS_XNP) + (size_t)blk * 4097 * 1024))[i] = (v4u){0u, 0u, 0u, 0u}; }
        for (int m = gw; m < M; m += 2 * NGW) { const int m2 = m + NGW;
            rms_row2(xsrc + (size_t)m * 1024, xsrc + (size_t)m2 * 1024, P.in[1] + L * 1024, (bf16*)(ws + WS_XNP) + ((size_t)(m >> 12) * 4097 + 1 + (m & 4095)) * 1024, (bf16*)(ws + WS_XNP) + ((size_t)(m2 >> 12) * 4097 + 1 + (m2 & 4095)) * 1024, lane); }
        }
        GSYNC(); RELAUNDER(); STAMP(1 + 13 * L);
#endif
#if !defined(ONLY) || ONLY==1
#if defined(DUP_PH1)
        for (int rep = 0; rep < 2; ++rep)
#endif
        {
        { pg8::Gemm g = mkgemm((const bf16*)(ws + WS_XNP) + 1024, (const bf16*)(ws + WS_W1A), M, 2048, 1024, 1024, 1024); g.a_skip_shift = 4; g.a_skip_bytes = 2048;
          Epi8<1> E{(bf16*)(ws + WS_QB), 512, (const bf16*)(ws + WS_US), nullptr};
#if !defined(SUB) || SUB==0
          run_gemm(lds, g, E, G, blk);
#endif
          }
        { pg8::Gemm g = mkgemm((const bf16*)(ws + WS_XNP) + 1024, (const bf16*)(ws + WS_W1B), M, 1792, 2048, 1024, 2048); g.a_skip_shift = 4; g.a_skip_bytes = 2048; g.kwrap = 16; g.wrap_bytes = 4096;
          Epi8<0> E{(bf16*)(ws + WS_Z), ZP, nullptr, nullptr};
#if !defined(SUB) || SUB==1
          run_gemm(lds, g, E, G, blk);
#endif
          }
        if (blk >= 192) { __syncthreads(); weight_items(P, L, (blk - 192) * NWAVES + wave, 64 * NWAVES, (LAS float*)(lds + wave * 16384), lane, 4128, 6944); }
        }
        GSYNC(); RELAUNDER(); STAMP(2 + 13 * L);
#if defined(STOP_AFTER) && STOP_AFTER==1
        dump_stage(P, 1, blk, G, tid); return;
#endif
#endif
#if !defined(ONLY) || ONLY==2
        { pg8::Gemm g = mkgemm((const bf16*)(ws + WS_US), (const bf16*)(ws + WS_PT), 32768, 256, 256, 384, 256); g.b_shift = 2; g.b_stride_bytes = 128 * 256 * 2;
          Epi8<2> E{(bf16*)(ws + WS_US), 384, nullptr, nullptr}; run_gemm(lds, g, E, G, blk);
#if defined(DUP_S5G)
          run_gemm(lds, g, E, G, blk);
#endif
          }
        __syncthreads();
        prep_phase(P, L, lds, gw, NGW, tid, wave, lane);
        GSYNC(); RELAUNDER(); STAMP(3 + 13 * L);
#if defined(STOP_AFTER) && STOP_AFTER==2
        dump_stage(P, 2, blk, G, tid); return;
#endif
#endif
#if !defined(ONLY) || ONLY==3
        if (blk < 128) rwkv_unit(P, L, lds, blk >> 5, (blk >> 2) & 7, blk & 3, tid, wave, lane);
#if defined(DUP_RWKV)
        if (blk < 128) rwkv_unit(P, L, lds, blk >> 5, (blk >> 2) & 7, blk & 3, tid, wave, lane);
#endif
        else if (blk >= G - 16) s5_chunk_scan(P, L, (blk - (G - 16)) * NTHR + tid);
        __syncthreads();
        {
            volatile LAS unsigned* qslot = (volatile LAS unsigned*)(lds + 140000);
            for (;;) {
                if (tid == 0) qslot[0] = atomicAdd(ctl + 64 * L, 1u);
                __syncthreads();
                const unsigned uidx = qslot[0];
                __syncthreads();
                if (uidx >= 1024u) break;
                const int qb = 15 - (int)(uidx >> 6), bhv = uidx & 63, b = bhv >> 4, hv = bhv & 15, hh = hv >> 2, cc = (hv >> 1) & 1, half = hv & 1;
                attn_body::attn_unit<8>(b, (2 * hh + cc) * 64, (2 * hh + cc) * 64, (2 * hh + half) * 64, hv * 64, qb,
                    (const attn_body::bf16*)(ws + WS_QB), (const attn_body::bf16*)(ws + WS_KB), (const attn_body::bf16*)(ws + WS_VB), (attn_body::bf16*)(ws + WS_O), (char*)lds_raw, wave);
#if defined(DUP_ATT)
                attn_body::attn_unit<8>(b, (2 * hh + cc) * 64, (2 * hh + cc) * 64, (2 * hh + half) * 64, hv * 64, qb,
                    (const attn_body::bf16*)(ws + WS_QB), (const attn_body::bf16*)(ws + WS_KB), (const attn_body::bf16*)(ws + WS_VB), (attn_body::bf16*)(ws + WS_O), (char*)lds_raw, wave);
#endif
            }
        }
        GSYNC(); RELAUNDER(); STAMP(4 + 13 * L);
#if defined(STOP_AFTER) && STOP_AFTER==3
        dump_stage(P, 3, blk, G, tid); return;
#endif
#endif
#if !defined(ONLY) || ONLY==4
        { pg8::Gemm g = mkgemm((const bf16*)(ws + WS_US), (const bf16*)(ws + WS_MT), 32768, 256, 384, 384, 384); g.b_shift = 2; g.b_stride_bytes = 256 * 384 * 2;
          Epi8<3> E{(bf16*)(ws + WS_YL), 512, (const bf16*)(ws + WS_US), P.in[10] + L * 512}; run_gemm(lds, g, E, G, blk);
#if defined(DUP_S5G)
          run_gemm(lds, g, E, G, blk);
#endif
          }
        __syncthreads();
        post_phase(P, L, lds, gw, NGW, tid, wave, lane);
        GSYNC(); RELAUNDER(); STAMP(5 + 13 * L);
#if defined(STOP_AFTER) && STOP_AFTER==4
        dump_stage(P, 4, blk, G, tid); return;
#endif
#endif
#if !defined(ONLY) || ONLY==5
        { pg8::Gemm g = mkgemm((const bf16*)(ws + WS_YL), (const bf16*)(ws + WS_WGLU), M, 512, 512, 512, 512);
          Epi8<4> E{(bf16*)(ws + WS_YA), 512, (const bf16*)(ws + WS_YL), nullptr}; run_gemm(lds, g, E, G, blk);
#if defined(DUP_S5G)
          run_gemm(lds, g, E, G, blk);
#endif
          }
        __syncthreads();
        { const float* w_in = P.in[2] + (size_t)L * 1024 * NIN; LAS float* scr = (LAS float*)(lds + wave * 16384);
          for (int it = gw; it < 16 * 96; it += NGW) { const int kb = it / 96, nb = it % 96; tr_item(w_in, NIN, kb * 64, 3744 + nb * 32, (bf16*)(ws + WS_WG), 1024, nb * 32, 0, nullptr, 0, scr, lane); } }
        { const int nsh = (blk < 128) ? 1 : 2; const int vw0 = (blk < 128) ? blk * NWAVES + wave : 1024 + ((blk - 128) * NWAVES + wave) * 2;
          if (nsh == 2) { for (int m = vw0; m < M; m += 3072) rms_row2(xsrc + (size_t)m * 1024, xsrc + (size_t)(m + 1) * 1024, P.in[1] + L * 1024, (bf16*)(ws + WS_XN) + (size_t)m * 1024, (bf16*)(ws + WS_XN) + (size_t)(m + 1) * 1024, lane); }
          else { for (int m = vw0; m < M; m += 2 * 3072) rms_row2(xsrc + (size_t)m * 1024, xsrc + (size_t)(m + 3072) * 1024, P.in[1] + L * 1024, (bf16*)(ws + WS_XN) + (size_t)m * 1024, (bf16*)(ws + WS_XN) + (size_t)(m + 3072) * 1024, lane); } }
        GSYNC(); RELAUNDER(); STAMP(6 + 13 * L);
#if defined(STOP_AFTER) && STOP_AFTER==5
        dump_stage(P, 5, blk, G, tid); return;
#endif
        { pg8::Gemm g = mkgemm((const bf16*)(ws + WS_XN), (const bf16*)(ws + WS_WG) + (size_t)1024 * 1024, M, 2048, 1024, 1024, 1024);
          Epi8<10> E{(bf16*)(ws + WS_P12), 1024, nullptr, nullptr}; run_gemm_pair(lds, g, E, G, blk); }
        { pg8::Gemm g = mkgemm((const bf16*)(ws + WS_Z) + 512, (const bf16*)(ws + WS_WB) + (size_t)1024 * 512, M, 2048, 512, ZP, 512); g.a_pn_shift = 2; g.a_pn_bytes = -1024;
          Epi8<11> E{(bf16*)(ws + WS_P12), 1024, nullptr, nullptr}; run_gemm_pair(lds, g, E, G, blk); }
        RELAUNDER(); STAMP(7 + 13 * L);
#endif
#if !defined(ONLY) || ONLY==6
        { pg8::Gemm g = mkgemm((const bf16*)(ws + WS_XN), (const bf16*)(ws + WS_WG), M, 1024, 1024, 1024, 1024);
          Epi8<5> E{(bf16*)(ws + WS_G0), 1024, nullptr, nullptr}; run_gemm(lds, g, E, G, blk); }
        { pg8::Gemm g = mkgemm((const bf16*)(ws + WS_YA), (const bf16*)(ws + WS_WB), M, 1024, 512, 512, 512);
          Epi8<7> E{(bf16*)(ws + WS_P12), 1024, (const bf16*)(ws + WS_G0), nullptr}; run_gemm(lds, g, E, G, blk); }
        GSYNC(); RELAUNDER(); STAMP(8 + 13 * L);
#if defined(STOP_AFTER) && STOP_AFTER==6
        dump_stage(P, 6, blk, G, tid); return;
#endif
#endif
#if !defined(ONLY) || ONLY==7
        { pg8::Gemm g = mkgemm((const bf16*)(ws + WS_P12), (const bf16*)(ws + WS_WO), M, 1024, 1024, 1024, 1024);
          EpiRes E{xsrc, P.out}; run_gemm(lds, g, E, G, blk); }
        GSYNC(); RELAUNDER(); STAMP(9 + 13 * L);
#endif
#if !defined(ONLY) || ONLY==8
#if defined(DUP_SYNC)
        for (int rep = 0; rep < 10; ++rep) { GSYNC(); }
#endif
        for (int m = gw; m < M; m += 2 * NGW) rms_row2(P.out + (size_t)m * 1024, P.out + (size_t)(m + NGW) * 1024, P.in[32] + L * 1024, (bf16*)(ws + WS_H2N) + (size_t)m * 1024, (bf16*)(ws + WS_H2N) + (size_t)(m + NGW) * 1024, lane);
#if defined(DUP_PH8)
        for (int m = gw; m < M; m += NGW) rms_row(P.out + (size_t)m * 1024, P.in[32] + L * 1024, (bf16*)(ws + WS_H2N) + (size_t)m * 1024, lane);
#endif
        GSYNC(); RELAUNDER(); STAMP(10 + 13 * L);
#endif
#if !defined(ONLY) || ONLY==9
        { pg8::Gemm g = mkgemm((const bf16*)(ws + WS_H2N), (const bf16*)(ws + WS_WFI), M, 2 * DFF, 1024, 1024, 1024);
          Epi8<8> E{(bf16*)(ws + WS_HID), DFF, nullptr, nullptr}; run_gemm(lds, g, E, G, blk);
#if defined(DUP_FFN1)
          run_gemm(lds, g, E, G, blk);
#endif
          }
        if (L == 0 && blk >= 128) { __syncthreads(); weight_items(P, 1, (blk - 128) * NWAVES + wave, 128 * NWAVES, (LAS float*)(lds + wave * 16384), lane, 0, 4128); }
        GSYNC(); RELAUNDER(); STAMP(11 + 13 * L);
#if defined(STOP_AFTER) && STOP_AFTER==9
        dump_stage(P, 9, blk, G, tid); return;
#endif
#endif
#if !defined(ONLY) || ONLY==10
        { pg8::Gemm g = mkgemm((const bf16*)(ws + WS_HID), (const bf16*)(ws + WS_WFO), M, 1024, DFF, DFF, DFF);
          EpiRes E{P.out, P.out}; run_gemm(lds, g, E, G, blk); }
#endif
        if (L == 0) { GSYNC(); STAMP(12); }
    }
#if defined(PROBE_A)
    GSYNC();
    if (blk0 == 0) { STAMP(25); __syncthreads(); LAS unsigned long long* st = (LAS unsigned long long*)(lds + LDS_XB + 256);
        float dA = 0.f, dB = 0.f;
        for (int L = 0; L < 2; ++L) { for (int k = 0; k < 12; ++k) { const int k1 = (L == 1 && k == 11) ? 25 : 13 * L + k + 1; const float d = (float)(long long)(st[k1] - st[13 * L + k]); if ((PROBE_A >> k) & 1) dA += d; if ((PROBE_B >> k) & 1) dB += d; } }
#if defined(PROBE_CAL)
        dB = 50000.f;
#endif
        const float qa = __expf(0.04f * rintf(__logf(fmaxf(dA, 1.f)) * 25.f)), qb = __expf(0.04f * rintf(__logf(fmaxf(dB, 1.f)) * 25.f));
        if (tid0 == 0) { P.out[3] += qa * 0.01f; } }
#endif
}

extern "C" void kernel_launch(void* const* d_in, const int* in_sizes, int n_in, void* d_out, int out_size, void* d_ws, size_t ws_size, hipStream_t stream) {
    static int grid = 0;
    if (grid == 0) {
        if (n_in != 35 || out_size != M * DMOD || ws_size < WS_END) { fprintf(stderr, "kernel_launch: unexpected shapes (n_in %d out %d ws %zu)\n", n_in, out_size, ws_size); grid = -1; return; }
        int dev = 0, cus = 0, per_cu = 0;
        hipGetDevice(&dev); hipDeviceGetAttribute(&cus, hipDeviceAttributeMultiprocessorCount, dev);
        hipFuncSetAttribute((const void*)mega_fwd, hipFuncAttributeMaxDynamicSharedMemorySize, LDS_BYTES);
        hipOccupancyMaxActiveBlocksPerMultiprocessor(&per_cu, (const void*)mega_fwd, NTHR, LDS_BYTES);
        if (per_cu < 1) { fprintf(stderr, "kernel_launch: occupancy query says %d\n", per_cu); grid = -1; return; }
        grid = cus;
        if (grid != 256) { fprintf(stderr, "kernel_launch: built for a 256-CU device (one workgroup per CU); got %d\n", grid); grid = -1; return; }
    }
    if (grid < 0) return;
    hipMemsetAsync((char*)d_ws + WS_CTL, 0, 65536, stream);
    Args a{};
    for (int i = 0; i < 35; ++i) a.p.in[i] = (const float*)d_in[i];
    a.p.out = (float*)d_out; a.p.ws = (unsigned char*)d_ws;
    void* kargs[] = {&a};
    hipError_t e = hipLaunchCooperativeKernel((const void*)mega_fwd, dim3(grid), dim3(NTHR), kargs, LDS_BYTES, stream);
    if (e != hipSuccess) fprintf(stderr, "cooperative launch failed: %s (grid %d)\n", hipGetErrorString(e), grid);
}
```
